# Optimizing an MI355X kernel written in HIP

```python
import jax, jax.numpy as jnp
from jax import lax
import numpy as np

D_MODEL = 1024
BATCH = 8
SEQ = 4096
DEPTH = 2

N_HEADS = 16
HEAD_DIM = D_MODEL // N_HEADS
MOBA_HEADS = 4
NSA_HEADS = 6
SB_HEADS = N_HEADS - MOBA_HEADS - NSA_HEADS
MOBA_W = MOBA_HEADS * HEAD_DIM
NSA_W = NSA_HEADS * HEAD_DIM
SB_W = SB_HEADS * HEAD_DIM
ROPE_DIM = HEAD_DIM // 4
ROPE_THETA = 500000.0

MOBA_BLOCK = 256
MOBA_TOPK = 3
MOBA_CHUNK = 32

NSA_CMP_LEN = 32
NSA_CMP_STRIDE = 16
NSA_SLC_BLOCK = 64
NSA_SLC_TOPK = 16
NSA_WINDOW = 512
NSA_CHUNK = 64
NSA_N_KV = 6

SB_CHUNK = 128

N_EXPERTS = 32
TOP_K = 4
D_EXPERT = D_MODEL
SWIGLU_LIMIT = 7.0
SWIGLU_ALPHA = 1.702
MOE_BLOCK = 128

RMS_EPS = 1e-6
NEG_INF = -1e30
SEL_FORCE = 1e4

IN_WIDTHS = (MOBA_W, MOBA_W, MOBA_W, NSA_W, NSA_N_KV * HEAD_DIM, 3 * NSA_HEADS, SB_W, SB_W, SB_W)
IN_W = sum(IN_WIDTHS)

kernel_name = 'hybrid_moba_nsa_stickbreak_moe_layer'


def rms_norm(x, g):
    xf = x.astype(jnp.float32)
    y = xf * lax.rsqrt(jnp.mean(xf * xf, axis=-1, keepdims=True) + RMS_EPS)
    return (y * g.astype(jnp.float32)).astype(x.dtype)


def rope_tables(seq):
    inv_freq = ROPE_THETA ** (-jnp.arange(0, ROPE_DIM, 2, dtype=jnp.float32) / ROPE_DIM)
    ang = jnp.arange(seq, dtype=jnp.float32)[:, None] * inv_freq[None, :]
    return jnp.cos(ang), jnp.sin(ang)


def partial_rope(x, cos, sin):
    half = ROPE_DIM // 2
    xf = x.astype(jnp.float32)
    x1, x2, rest = xf[..., :half], xf[..., half:ROPE_DIM], xf[..., ROPE_DIM:]
    c = cos[None, :, None, :]
    s = sin[None, :, None, :]
    return jnp.concatenate([x1 * c - x2 * s, x2 * c + x1 * s, rest], axis=-1).astype(x.dtype)


def masked_softmax(s, mask):
    s = jnp.where(mask, s, NEG_INF)
    m = jnp.max(s, axis=-1, keepdims=True)
    e = jnp.where(mask, jnp.exp(s - m), 0.0)
    return e / jnp.maximum(jnp.sum(e, axis=-1, keepdims=True), 1e-30)


def moba_attention(q, k, v):
    b, h, s, dh = q.shape
    nb = -(-s // MOBA_BLOCK)
    pad = nb * MOBA_BLOCK - s
    kb = jnp.pad(k, ((0, 0), (0, 0), (0, pad), (0, 0))).reshape(b, h, nb, MOBA_BLOCK, dh)
    vb = jnp.pad(v, ((0, 0), (0, 0), (0, pad), (0, 0))).reshape(b, h, nb, MOBA_BLOCK, dh)
    kmean = jnp.mean(kb.astype(jnp.float32), axis=3)
    n_sel = min(MOBA_TOPK, nb - 1)
    scale = dh ** -0.5
    bi = jnp.arange(b)[:, None, None, None]
    hi = jnp.arange(h)[None, :, None, None]
    blk = jnp.arange(nb)
    koff = jnp.arange(MOBA_BLOCK)

    def chunk(ci):
        t0 = ci * MOBA_CHUNK
        tq = t0 + jnp.arange(MOBA_CHUNK)
        qc = lax.dynamic_slice_in_dim(q, t0, MOBA_CHUNK, axis=2)
        own = t0 // MOBA_BLOCK
        ko = lax.dynamic_index_in_dim(kb, own, axis=2, keepdims=False)
        vo = lax.dynamic_index_in_dim(vb, own, axis=2, keepdims=False)
        s_own = jnp.einsum('bhqd,bhkd->bhqk', qc, ko, preferred_element_type=jnp.float32) * scale
        m_own = jnp.broadcast_to((own * MOBA_BLOCK + koff)[None, :] <= tq[:, None], s_own.shape)
        if n_sel == 0:
            p = masked_softmax(s_own, m_own)
            return jnp.einsum('bhqk,bhkd->bhqd', p.astype(v.dtype), vo)
        gate = jnp.einsum('bhqd,bhnd->bhqn', qc.astype(jnp.float32), kmean)
        gate = jnp.where(blk < own, gate, NEG_INF)
        g_val, g_idx = lax.top_k(gate, n_sel)
        ks = kb[bi, hi, g_idx]
        vs = vb[bi, hi, g_idx]
        s_sel = jnp.einsum('bhqd,bhqnkd->bhqnk', qc, ks, preferred_element_type=jnp.float32) * scale
        m_sel = jnp.broadcast_to((g_val > 0.5 * NEG_INF)[..., None], s_sel.shape)
        cl = n_sel * MOBA_BLOCK
        p = masked_softmax(
            jnp.concatenate([s_sel.reshape(b, h, MOBA_CHUNK, cl), s_own], axis=-1),
            jnp.concatenate([m_sel.reshape(b, h, MOBA_CHUNK, cl), m_own], axis=-1)).astype(v.dtype)
        o_sel = jnp.einsum('bhqnk,bhqnkd->bhqd', p[..., :cl].reshape(b, h, MOBA_CHUNK, n_sel, MOBA_BLOCK), vs)
        return o_sel + jnp.einsum('bhqk,bhkd->bhqd', p[..., cl:], vo)

    out = lax.map(chunk, jnp.arange(s // MOBA_CHUNK))
    return out.transpose(1, 2, 0, 3, 4).reshape(b, h, s, dh)


def nsa_attention(q, k_cmp, v_cmp, k_slc, v_slc, k_win, v_win, gates, cmp_pe, cmp_w1, cmp_w2):
    b, s, hq, dh = q.shape
    scale = dh ** -0.5
    n_cmp = (s - NSA_CMP_LEN) // NSA_CMP_STRIDE + 1
    cstart = jnp.arange(n_cmp) * NSA_CMP_STRIDE
    cend = cstart + NSA_CMP_LEN - 1
    cidx = cstart[:, None] + jnp.arange(NSA_CMP_LEN)[None, :]

    def compress(t, i):
        blocks = (t[:, cidx] + cmp_pe[i]).reshape(b, n_cmp, NSA_CMP_LEN * dh)
        return jax.nn.silu(blocks @ cmp_w1[i]) @ cmp_w2[i]

    kc = compress(k_cmp, 0)
    vc = compress(v_cmp, 1)
    n_slc = s // NSA_SLC_BLOCK
    n_sel = min(NSA_SLC_TOPK, n_slc)
    sstart = jnp.arange(n_slc) * NSA_SLC_BLOCK
    overlap = ((cstart[:, None] <= sstart[None, :] + NSA_SLC_BLOCK - 1)
               & (cend[:, None] >= sstart[None, :])).astype(jnp.float32)
    ks_b = k_slc.reshape(b, n_slc, NSA_SLC_BLOCK, dh)
    vs_b = v_slc.reshape(b, n_slc, NSA_SLC_BLOCK, dh)
    kw_p = jnp.pad(k_win, ((0, 0), (NSA_WINDOW, 0), (0, 0)))
    vw_p = jnp.pad(v_win, ((0, 0), (NSA_WINDOW, 0), (0, 0)))
    bi = jnp.arange(b)[:, None, None]
    slc_off = jnp.arange(NSA_SLC_BLOCK)
    win_off = jnp.arange(NSA_WINDOW + NSA_CHUNK)
    blk = jnp.arange(n_slc)
    ls = n_sel * NSA_SLC_BLOCK

    def chunk(ci):
        t0 = ci * NSA_CHUNK
        tq = t0 + jnp.arange(NSA_CHUNK)
        qc = lax.dynamic_slice_in_dim(q, t0, NSA_CHUNK, axis=1)
        gc = lax.dynamic_slice_in_dim(gates, t0, NSA_CHUNK, axis=1)
        s_c = jnp.einsum('bqhd,bnd->bhqn', qc, kc, preferred_element_type=jnp.float32) * scale
        p_c = masked_softmax(s_c, cend[None, :] <= tq[:, None])
        o_c = jnp.einsum('bhqn,bnd->bqhd', p_c.astype(vc.dtype), vc)
        imp = jnp.einsum('bhqn,nm->bqm', p_c, overlap)
        own_b = tq // NSA_SLC_BLOCK
        forced = (blk[None, :] == 0) | (blk[None, :] == own_b[:, None]) | (blk[None, :] == own_b[:, None] - 1)
        imp = jnp.where(forced, SEL_FORCE, imp)
        imp = jnp.where(sstart[None, :] <= tq[:, None], imp, NEG_INF)
        sel_val, sel_idx = lax.top_k(imp, n_sel)
        ks = ks_b[bi, sel_idx]
        vs = vs_b[bi, sel_idx]
        kpos = sel_idx[..., None] * NSA_SLC_BLOCK + slc_off
        m_s = (sel_val[..., None] > 0.5 * NEG_INF) & (kpos <= tq[None, :, None, None])
        s_s = jnp.einsum('bqhd,bqnkd->bhqnk', qc, ks, preferred_element_type=jnp.float32) * scale
        p_s = masked_softmax(s_s.reshape(b, hq, NSA_CHUNK, ls), m_s.reshape(b, 1, NSA_CHUNK, ls))
        o_s = jnp.einsum('bhqnk,bqnkd->bqhd',
                         p_s.reshape(b, hq, NSA_CHUNK, n_sel, NSA_SLC_BLOCK).astype(vs.dtype), vs)
        kw = lax.dynamic_slice_in_dim(kw_p, t0, NSA_WINDOW + NSA_CHUNK, axis=1)
        vw = lax.dynamic_slice_in_dim(vw_p, t0, NSA_WINDOW + NSA_CHUNK, axis=1)
        wpos = t0 - NSA_WINDOW + win_off
        m_w = ((wpos[None, :] <= tq[:, None]) & (wpos[None, :] > tq[:, None] - NSA_WINDOW)
               & (wpos[None, :] >= 0))
        s_w = jnp.einsum('bqhd,bkd->bhqk', qc, kw, preferred_element_type=jnp.float32) * scale
        p_w = masked_softmax(s_w, m_w)
        o_w = jnp.einsum('bhqk,bkd->bqhd', p_w.astype(vw.dtype), vw)
        return gc[..., 0:1] * o_c + gc[..., 1:2] * o_s + gc[..., 2:3] * o_w

    out = lax.map(chunk, jnp.arange(s // NSA_CHUNK))
    return out.transpose(1, 0, 2, 3, 4).reshape(b, s, hq, dh)


def stick_breaking_attention(q, k, v):
    b, h, s, dh = q.shape
    scale = dh ** -0.5
    kpos = jnp.arange(s)

    def chunk(ci):
        t0 = ci * SB_CHUNK
        tq = t0 + jnp.arange(SB_CHUNK)
        qc = lax.dynamic_slice_in_dim(q, t0, SB_CHUNK, axis=2)
        z = jnp.einsum('bhqd,bhkd->bhqk', qc, k, preferred_element_type=jnp.float32) * scale
        mask = kpos[None, :] < tq[:, None]
        log_keep = jnp.where(mask, jax.nn.log_sigmoid(-z), 0.0)
        later = lax.cumsum(log_keep, axis=3, reverse=True) - log_keep
        a = jnp.where(mask, jnp.exp(jax.nn.log_sigmoid(z) + later), 0.0)
        return jnp.einsum('bhqk,bhkd->bhqd', a.astype(v.dtype), v)

    out = lax.map(chunk, jnp.arange(s // SB_CHUNK))
    return out.transpose(1, 2, 0, 3, 4).reshape(b, h, s, dh)


def token_mixer(h, w_in, cmp_pe, cmp_w1, cmp_w2, grp_g, w_out, cos, sin):
    b, s, _ = h.shape
    proj = h @ w_in
    offs = [int(o) for o in np.cumsum(IN_WIDTHS)[:-1]]
    qa, ka, va, qb, kvb, gb, qc, kc, vc = jnp.split(proj, offs, axis=-1)
    hd = lambda t, n: t.reshape(b, s, n, HEAD_DIM)
    bhsd = lambda t: t.transpose(0, 2, 1, 3)
    oa = moba_attention(bhsd(partial_rope(hd(qa, MOBA_HEADS), cos, sin)),
                        bhsd(partial_rope(hd(ka, MOBA_HEADS), cos, sin)),
                        bhsd(hd(va, MOBA_HEADS)))
    oa = bhsd(oa).reshape(b, s, MOBA_W)
    kvb = hd(kvb, NSA_N_KV)
    keys = partial_rope(kvb[:, :, 0::2], cos, sin)
    vals = kvb[:, :, 1::2]
    gates = jax.nn.sigmoid(gb).reshape(b, s, NSA_HEADS, 3)
    ob = nsa_attention(partial_rope(hd(qb, NSA_HEADS), cos, sin),
                       keys[:, :, 0], vals[:, :, 0], keys[:, :, 1], vals[:, :, 1],
                       keys[:, :, 2], vals[:, :, 2], gates, cmp_pe, cmp_w1, cmp_w2)
    ob = ob.reshape(b, s, NSA_W)
    oc = stick_breaking_attention(bhsd(hd(qc, SB_HEADS)), bhsd(hd(kc, SB_HEADS)), bhsd(hd(vc, SB_HEADS)))
    oc = bhsd(oc).reshape(b, s, SB_W)
    g_a, g_b, g_c = jnp.split(grp_g, [MOBA_W, MOBA_W + NSA_W])
    y = jnp.concatenate([rms_norm(oa, g_a), rms_norm(ob, g_b), rms_norm(oc, g_c)], axis=-1)
    return y @ w_out


def clamped_swiglu(hgu):
    x_glu, x_lin = jnp.split(hgu, 2, axis=-1)
    x_glu = jnp.minimum(x_glu, SWIGLU_LIMIT)
    x_lin = jnp.clip(x_lin, -SWIGLU_LIMIT, SWIGLU_LIMIT)
    return x_glu * jax.nn.sigmoid(SWIGLU_ALPHA * x_glu) * (x_lin + 1.0)


def moe_ffn(h, router_w, router_b, w_gu, b_gu, w_dn, b_dn):
    b, s, d = h.shape
    n = b * s
    xt = h.reshape(n, d)
    logits = jnp.dot(xt, router_w, preferred_element_type=jnp.float32) + router_b.astype(jnp.float32)
    top_val, top_idx = lax.top_k(logits, TOP_K)
    gate = jax.nn.softmax(top_val, axis=-1)
    e = top_idx.reshape(-1)
    tok = jnp.arange(n * TOP_K, dtype=jnp.int32) // TOP_K
    onehot = (e[:, None] == jnp.arange(N_EXPERTS, dtype=e.dtype)[None, :]).astype(jnp.int32)
    rank = jnp.take_along_axis(jnp.cumsum(onehot, axis=0), e[:, None], axis=1)[:, 0] - 1
    counts = jnp.sum(onehot, axis=0)
    padded = (counts + MOE_BLOCK - 1) // MOE_BLOCK * MOE_BLOCK
    pad_end = jnp.cumsum(padded)
    dest = (pad_end - padded)[e] + rank
    n_rows = -(-(n * TOP_K + N_EXPERTS * (MOE_BLOCK - 1)) // MOE_BLOCK) * MOE_BLOCK
    n_blk = n_rows // MOE_BLOCK
    row_tok = jnp.zeros((n_rows,), jnp.int32).at[dest].set(tok)
    blk_exp = jnp.minimum(jnp.searchsorted(pad_end, jnp.arange(n_blk, dtype=jnp.int32) * MOE_BLOCK,
                                           side='right'), N_EXPERTS - 1)

    def expert_block(args):
        rows, eid = args
        xb = xt[rows]
        hgu = xb @ w_gu[eid] + b_gu[eid]
        return clamped_swiglu(hgu) @ w_dn[eid] + b_dn[eid]

    y_rows = lax.map(expert_block, (row_tok.reshape(n_blk, MOE_BLOCK), blk_exp)).reshape(n_rows, d)
    y = jnp.sum(y_rows[dest].reshape(n, TOP_K, d) * gate[..., None].astype(h.dtype), axis=1)
    return y.reshape(b, s, d)


def setup_inputs(seed: int = 0) -> dict:
    key = jax.random.key(seed)
    ks = jax.random.split(key, 17)
    f32 = jnp.float32
    nrm = lambda k, shape, sc: jax.random.normal(k, shape, f32) * sc
    L = DEPTH
    D = D_MODEL
    return {
        'x': nrm(ks[0], (BATCH, SEQ, D), 1.0),
        'c': nrm(ks[1], (BATCH, D), 1.0),
        'ada_w': nrm(ks[2], (L, D, 6 * D), 0.5 * D ** -0.5),
        'ada_b': nrm(ks[3], (L, 6 * D), 0.02),
        'norm_g': 1.0 + nrm(ks[4], (L, 4, D), 0.05),
        'w_in': nrm(ks[5], (L, D, IN_W), D ** -0.5),
        'nsa_cmp_pe': nrm(ks[6], (L, 2, NSA_CMP_LEN, HEAD_DIM), 0.02),
        'nsa_cmp_w1': nrm(ks[7], (L, 2, NSA_CMP_LEN * HEAD_DIM, HEAD_DIM), (NSA_CMP_LEN * HEAD_DIM) ** -0.5),
        'nsa_cmp_w2': nrm(ks[8], (L, 2, HEAD_DIM, HEAD_DIM), HEAD_DIM ** -0.5),
        'mix_out_g': 1.0 + nrm(ks[9], (L, D), 0.05),
        'w_out': nrm(ks[10], (L, D, D), D ** -0.5),
        'router_w': nrm(ks[11], (L, D, N_EXPERTS), D ** -0.5),
        'router_b': nrm(ks[12], (L, N_EXPERTS), 0.01),
        'exp_w_gu': nrm(ks[13], (L, N_EXPERTS, D, 2 * D_EXPERT), D ** -0.5),
        'exp_b_gu': nrm(ks[14], (L, N_EXPERTS, 2 * D_EXPERT), 0.01),
        'exp_w_dn': nrm(ks[15], (L, N_EXPERTS, D_EXPERT, D), D_EXPERT ** -0.5),
        'exp_b_dn': nrm(ks[16], (L, N_EXPERTS, D), 0.01),
    }


def reference(x, c, ada_w, ada_b, norm_g, w_in, nsa_cmp_pe, nsa_cmp_w1, nsa_cmp_w2, mix_out_g,
              w_out, router_w, router_b, exp_w_gu, exp_b_gu, exp_w_dn, exp_b_dn):
    cos, sin = rope_tables(x.shape[1])
    c_act = jax.nn.silu(c)
    for l in range(DEPTH):
        mod = c_act @ ada_w[l] + ada_b[l]
        sh1, sc1, g1, sh2, sc2, g2 = (m[:, None, :] for m in jnp.split(mod, 6, axis=-1))
        hm = rms_norm(x, norm_g[l, 0]) * (1.0 + sc1) + sh1
        y = token_mixer(hm, w_in[l], nsa_cmp_pe[l], nsa_cmp_w1[l], nsa_cmp_w2[l], mix_out_g[l],
                        w_out[l], cos, sin)
        x = x + g1 * rms_norm(y, norm_g[l, 1])
        hf = rms_norm(x, norm_g[l, 2]) * (1.0 + sc2) + sh2
        y = moe_ffn(hf, router_w[l], router_b[l], exp_w_gu[l], exp_b_gu[l], exp_w_dn[l], exp_b_dn[l])
        x = x + g2 * rms_norm(y, norm_g[l, 3])
    return x
```

```cpp
#include <hip/hip_runtime.h>
#include <cstdio>
#include <cstdint>
namespace pg8 {
#define PG8_LAS __attribute__((address_space(3)))
typedef unsigned short bf16_t;
typedef short bf16x8 __attribute__((ext_vector_type(8)));
typedef float f32x4 __attribute__((ext_vector_type(4)));
typedef unsigned u32x4 __attribute__((ext_vector_type(4)));
constexpr int BM = 256, BK = 64, HALF = 128, HTB = HALF * BK * 2  , STAGE_BYTES = 8 * HTB, NXCD = 8, WGM = 8;

__host__ __device__ __forceinline__ int lds_byte(int r, int c) { const int st = (r >> 4) * 2 + (c >> 5), rr = r & 15, cc = c & 31, ob = rr * 64 + cc * 2; return st * 1024 + (ob ^ (((ob >> 9) & 1) << 5)); }
__host__ __device__ __forceinline__ void stage_rc(int b, int& R, int& C) { const int st = b / 1024, sb = b % 1024, swz = sb ^ (((sb >> 9) & 1) << 5); R = (st >> 1) * 16 + swz / 64; C = (st & 1) * 32 + (swz % 64) / 2; }
__host__ __device__ __forceinline__ int perm32(int rho) { const int n = rho >> 4, i = rho & 15; return 8 * (i >> 2) + 4 * n + (i & 3); }

struct Unit { int pm, pn; };
struct Gemm { const bf16_t* A; const bf16_t* Bt; int M, N, K; };

struct StaticOrder {
    int nM, nN, nwg, G, c;
    __host__ __device__ void init(int M, int N, int G_, int c_) { nM = M / BM; nN = N / BM; nwg = nM * nN; G = G_; c = c_; }
    __host__ __device__ bool next(int i, Unit& u) const {
        const long L = (long)i * G + c; if (L >= nwg) return false;
        int wgid = (int)L; { const int q = nwg / NXCD, r = nwg % NXCD, xcd = wgid % NXCD, off = wgid / NXCD; wgid = (xcd < r ? xcd * (q + 1) : r * (q + 1) + (xcd - r) * q) + off; }
        const int nig = WGM * nN, gid = wgid / nig, fm = gid * WGM, gsz = (nM - fm) < WGM ? (nM - fm) : WGM;
        u.pm = fm + ((wgid % nig) % gsz); u.pn = (wgid % nig) / gsz; return true;
    }
    __device__ __forceinline__ void a_ready(const Unit&) const {}
    __device__ __forceinline__ void done(const Unit&) const {}
};

__device__ __forceinline__ unsigned cvt_pk_bf16(float lo, float hi) { unsigned r; asm volatile("v_cvt_pk_bf16_f32 %0, %1, %2" : "=v"(r) : "v"(lo), "v"(hi)); return r; }
struct EpiBf16 {
    static constexpr bool PERM = true, AFTER_DRAIN = false;
    bf16_t* O; int ldc; const float* bias; int split_cols; size_t split_stride;
    __device__ __forceinline__ void operator()(const f32x4 (&acc)[2][2][4][2], const Unit& u, int wr, int wc, int fr, int fq) const {
        const int row0 = u.pm * BM + wr * 64 + fr; int colt = u.pn * BM; bf16_t* base = O;
        if (split_cols) { const int t = colt / split_cols; base += (size_t)t * split_stride; colt -= t * split_cols; }
        const int col0 = colt + wc * 32 + 8 * fq, bcol0 = u.pn * BM + wc * 32 + 8 * fq;
        f32x4 bv[2][2];
#pragma unroll
        for (int bj = 0; bj < 2; ++bj)
#pragma unroll
            for (int n = 0; n < 2; ++n) bv[bj][n] = bias ? *(const f32x4*)(bias + bcol0 + bj * HALF + 4 * n) : (f32x4){0.f, 0.f, 0.f, 0.f};
#pragma unroll
        for (int ai = 0; ai < 2; ++ai)
#pragma unroll
            for (int m = 0; m < 4; ++m) { bf16_t* rowp = base + (size_t)(row0 + ai * HALF + m * 16) * ldc + col0;
#pragma unroll
                for (int bj = 0; bj < 2; ++bj) { f32x4 v0 = acc[ai][bj][m][0] + bv[bj][0], v1 = acc[ai][bj][m][1] + bv[bj][1];
                    u32x4 w; w.x = cvt_pk_bf16(v0[0], v0[1]); w.y = cvt_pk_bf16(v0[2], v0[3]); w.z = cvt_pk_bf16(v1[0], v1[1]); w.w = cvt_pk_bf16(v1[2], v1[3]);
                    *(u32x4*)(rowp + bj * HALF) = w; } }
    }
};
struct EpiProj {
    static constexpr bool PERM = true, AFTER_DRAIN = false;
    bf16_t* O; int ldc; const float* ropec; const float* ropes; float* kmean;
    __device__ __forceinline__ void operator()(const f32x4 (&acc)[2][2][4][2], const Unit& u, int wr, int wc, int fr, int fq) const {
        const int row0 = u.pm * BM + wr * 64 + fr; const int colt = u.pn * BM;
        const int col0 = colt + wc * 32 + 8 * fq;
        constexpr unsigned ROPEM = 0xFFu | (0x3Fu << 12) | (1u << 18) | (1u << 20) | (1u << 22);
        float ks[2][8];
#pragma unroll
        for (int bj = 0; bj < 2; ++bj)
#pragma unroll
            for (int q = 0; q < 8; ++q) ks[bj][q] = 0.f;
#pragma unroll
        for (int ai = 0; ai < 2; ++ai)
#pragma unroll
            for (int m = 0; m < 4; ++m) { const int row = row0 + ai * HALF + m * 16; bf16_t* rowp = O + (size_t)row * ldc + col0;
#pragma unroll
                for (int bj = 0; bj < 2; ++bj) { f32x4 v0 = acc[ai][bj][m][0], v1 = acc[ai][bj][m][1];
                    const int head = (colt + bj * HALF + wc * 32) >> 6;
                    if (((wc & 1) == 0) && head < 32 && ((ROPEM >> head) & 1u)) {
                        float x[8] = {v0[0], v0[1], v0[2], v0[3], v1[0], v1[1], v1[2], v1[3]}, y[8];
#pragma unroll
                        for (int q = 0; q < 8; ++q) y[q] = __shfl_xor(x[q], 16);
                        if (fq < 2) { const int t = row & 4095; const f32x4 c0 = *(const f32x4*)(ropec + t * 8), c1 = *(const f32x4*)(ropec + t * 8 + 4), s0 = *(const f32x4*)(ropes + t * 8), s1 = *(const f32x4*)(ropes + t * 8 + 4);
                            const float cs[8] = {c0[0], c0[1], c0[2], c0[3], c1[0], c1[1], c1[2], c1[3]}, sn[8] = {s0[0], s0[1], s0[2], s0[3], s1[0], s1[1], s1[2], s1[3]};
#pragma unroll
                            for (int q = 0; q < 8; ++q) x[q] = (fq == 0) ? x[q] * cs[q] - y[q] * sn[q] : x[q] * cs[q] + y[q] * sn[q];
                            v0 = (f32x4){x[0], x[1], x[2], x[3]}; v1 = (f32x4){x[4], x[5], x[6], x[7]}; } }
                    if (u.pn == 1) {
#pragma unroll
                        for (int q = 0; q < 4; ++q) { ks[bj][q] += v0[q]; ks[bj][4 + q] += v1[q]; } }
                    u32x4 w; w.x = cvt_pk_bf16(v0[0], v0[1]); w.y = cvt_pk_bf16(v0[2], v0[3]); w.z = cvt_pk_bf16(v1[0], v1[1]); w.w = cvt_pk_bf16(v1[2], v1[3]);
                    *(u32x4*)(rowp + bj * HALF) = w; } }
        if (u.pn == 1) {
#pragma unroll
            for (int bj = 0; bj < 2; ++bj)
#pragma unroll
                for (int q = 0; q < 8; ++q) { float s = ks[bj][q]; s += __shfl_xor(s, 1); s += __shfl_xor(s, 2); s += __shfl_xor(s, 4); s += __shfl_xor(s, 8); ks[bj][q] = s; }
            if (fr == 0) { const int b = u.pm >> 4, blk = u.pm & 15;
#pragma unroll
                for (int bj = 0; bj < 2; ++bj) { const int c = bj * HALF + wc * 32 + 8 * fq, h = c >> 6, d = c & 63;
#pragma unroll
                    for (int q = 0; q < 8; ++q) atomicAdd(kmean + ((size_t)(b * 4 + h) * 16 + blk) * 64 + d + q, ks[bj][q] * (1.f / 256.f)); } }
        }
    }
};
struct EpiSwiglu {
    static constexpr bool PERM = true, AFTER_DRAIN = false;
    bf16_t* O; const float* bias;
    __device__ __forceinline__ void operator()(const f32x4 (&acc)[2][2][4][2], const Unit& u, int wr, int wc, int fr, int fq) const {
        const int row0 = u.pm * BM + wr * 64 + fr; const int e = u.pn >> 3, j = u.pn & 7;
        const int cc = wc * 32 + 8 * fq;
        const float* bg = bias + (size_t)e * 2048 + j * 128 + cc; const float* bl = bg + 1024;
        f32x4 bgv[2], blv[2];
#pragma unroll
        for (int n = 0; n < 2; ++n) { bgv[n] = *(const f32x4*)(bg + 4 * n); blv[n] = *(const f32x4*)(bl + 4 * n); }
#pragma unroll
        for (int ai = 0; ai < 2; ++ai)
#pragma unroll
            for (int m = 0; m < 4; ++m) { bf16_t* rowp = O + (size_t)(row0 + ai * HALF + m * 16) * 1024 + j * 128 + cc;
                float r[8];
#pragma unroll
                for (int n = 0; n < 2; ++n) { const f32x4 g4 = acc[ai][0][m][n] + bgv[n], l4 = acc[ai][1][m][n] + blv[n];
#pragma unroll
                    for (int q = 0; q < 4; ++q) { float g = fminf(g4[q], 7.0f); float l = fminf(fmaxf(l4[q], -7.0f), 7.0f);
                        const float sg = 1.0f / (1.0f + __expf(-1.702f * g)); r[4 * n + q] = g * sg * (l + 1.0f); } }
                u32x4 w; w.x = cvt_pk_bf16(r[0], r[1]); w.y = cvt_pk_bf16(r[2], r[3]); w.z = cvt_pk_bf16(r[4], r[5]); w.w = cvt_pk_bf16(r[6], r[7]);
                *(u32x4*)rowp = w; }
    }
};
__device__ __forceinline__ unsigned pk4_fp8(float a, float b, float c, float d) { const int r = __builtin_amdgcn_cvt_pk_fp8_f32(a, b, 0, false); return (unsigned)__builtin_amdgcn_cvt_pk_fp8_f32(c, d, r, true); }
constexpr float W8_SCALE = 64.f, W8_INV = 1.f / 64.f, ACT8_SCALE = 4.f, DN8_INV = 1.f / 256.f, YT8_SCALE = 16.f;
struct EpiSwiglu8 {
    static constexpr bool PERM = true, AFTER_DRAIN = false;
    unsigned char* O; const float* bias; PG8_LAS float* tab;
    __device__ __forceinline__ void prefetch(const Unit& u, int par, int wid, int lane) const {
        if (wid < 4) { const int e = u.pn >> 3, j = u.pn & 7, idx = wid * 64 + lane;
            __builtin_amdgcn_global_load_lds((const unsigned*)(bias + (size_t)e * 2048 + (idx >> 7) * 1024 + j * 128 + (idx & 127)), (PG8_LAS unsigned*)(tab + par * 256 + wid * 64), 4, 0, 0); }
    }
    __device__ __forceinline__ void operator()(const f32x4 (&acc)[2][2][4][2], const Unit& u, int wr, int wc, int fr, int fq, int par) const {
        const int row0 = u.pm * BM + wr * 64 + fr; const int j = u.pn & 7;
        const int cc = wc * 32 + 8 * fq;
        const PG8_LAS float* bg = tab + par * 256 + cc; const PG8_LAS float* bl = bg + 128;
        f32x4 bgv[2], blv[2];
#pragma unroll
        for (int n = 0; n < 2; ++n) { bgv[n] = *(const PG8_LAS f32x4*)(bg + 4 * n); blv[n] = *(const PG8_LAS f32x4*)(bl + 4 * n); }
#pragma unroll
        for (int ai = 0; ai < 2; ++ai)
#pragma unroll
            for (int m = 0; m < 4; ++m) { unsigned char* rowp = O + (size_t)(row0 + ai * HALF + m * 16) * 1024 + j * 128 + cc;
                float r[8];
#pragma unroll
                for (int n = 0; n < 2; ++n) { const f32x4 g4 = acc[ai][0][m][n] * W8_INV + bgv[n], l4 = acc[ai][1][m][n] * W8_INV + blv[n];
#pragma unroll
                    for (int q = 0; q < 4; ++q) { float g = fminf(g4[q], 7.0f); float l = fminf(fmaxf(l4[q], -7.0f), 7.0f);
                        const float sg = __builtin_amdgcn_rcpf(1.0f + __builtin_amdgcn_exp2f(-2.4554669595930156f * g)); r[4 * n + q] = g * sg * (l + 1.0f) * ACT8_SCALE; } }
                typedef unsigned u32x2_ __attribute__((ext_vector_type(2)));
                u32x2_ w; w.x = pk4_fp8(r[0], r[1], r[2], r[3]); w.y = pk4_fp8(r[4], r[5], r[6], r[7]);
                *(u32x2_*)rowp = w; }
    }
};
struct EpiDn {
    static constexpr bool PERM = true, AFTER_DRAIN = false;
    unsigned char* O; const float* bias; const PG8_LAS int* rowbase; const PG8_LAS int* ecnt; const int* list; int cap; const float* lgate; PG8_LAS float* tab;
    __device__ __forceinline__ void prefetch(const Unit& u, int par, int wid, int lane) const {
        const int e = u.pn >> 2, j = u.pn & 3; const int pb = u.pm * BM - rowbase[e]; PG8_LAS float* t = tab + par * 768;
        if (wid < 4) { const int r = wid * 64 + lane;
            __builtin_amdgcn_global_load_lds((const unsigned*)(list + (size_t)e * cap + pb + r), (PG8_LAS unsigned*)(t + wid * 64), 4, 0, 0);
            __builtin_amdgcn_global_load_lds((const unsigned*)(bias + (size_t)e * 1024 + j * BM + r), (PG8_LAS unsigned*)(t + 512 + wid * 64), 4, 0, 0); }
        else { const int r = (wid - 4) * 64 + lane;
            __builtin_amdgcn_global_load_lds((const unsigned*)(lgate + (size_t)e * cap + pb + r), (PG8_LAS unsigned*)(t + 256 + (wid - 4) * 64), 4, 0, 0); }
    }
    __device__ __forceinline__ void operator()(const f32x4 (&acc)[2][2][4][2], const Unit& u, int wr, int wc, int fr, int fq, int par) const {
        const int e = u.pn >> 2, j = u.pn & 3; const int pl0 = wr * 64 + fr; const int p0 = u.pm * BM - rowbase[e] + pl0, cnt = ecnt[e];
        const int col0 = j * BM + wc * 64 + 16 * fq; const PG8_LAS float* t = tab + par * 768; const PG8_LAS float* bp = t + 512 + wc * 64 + 16 * fq;
        f32x4 bv[2][2];
#pragma unroll
        for (int bj = 0; bj < 2; ++bj)
#pragma unroll
            for (int n = 0; n < 2; ++n) bv[bj][n] = *(const PG8_LAS f32x4*)(bp + 8 * bj + 4 * n);
        int id[2][4]; float gt[2][4];
#pragma unroll
        for (int ai = 0; ai < 2; ++ai)
#pragma unroll
            for (int m = 0; m < 4; ++m) { const int q = ai * HALF + m * 16; id[ai][m] = (p0 + q < cnt) ? ((const PG8_LAS int*)t)[pl0 + q] : -1; gt[ai][m] = t[256 + pl0 + q]; }
#pragma unroll
        for (int ai = 0; ai < 2; ++ai)
#pragma unroll
            for (int m = 0; m < 4; ++m) { if (id[ai][m] < 0) continue; unsigned char* rowp = O + (size_t)id[ai][m] * 1024 + col0; const float g = gt[ai][m] * YT8_SCALE;
                unsigned wq[4];
#pragma unroll
                for (int bj = 0; bj < 2; ++bj) { const f32x4 v0 = (acc[ai][bj][m][0] * DN8_INV + bv[bj][0]) * g, v1 = (acc[ai][bj][m][1] * DN8_INV + bv[bj][1]) * g;
                    wq[2 * bj] = pk4_fp8(v0[0], v0[1], v0[2], v0[3]); wq[2 * bj + 1] = pk4_fp8(v1[0], v1[1], v1[2], v1[3]); }
                *(u32x4*)rowp = (u32x4){wq[0], wq[1], wq[2], wq[3]}; }
    }
};
struct MoeOrder {
    int NJ, ntiles, G, vcu; const PG8_LAS unsigned char* texp; const PG8_LAS int* rowbase; const PG8_LAS int* ecnt; const int* list; int cap;
    __device__ __forceinline__ int rowtok(const Unit& u, int r) const { const int e = u.pn / NJ; const int p = u.pm * 256 - rowbase[e] + r; return p < ecnt[e] ? (list[(size_t)e * cap + p] >> 2) : 0; }
    __device__ __forceinline__ bool next(int i, Unit& u) const {
        const int L = i * G + vcu; const int pm = L / NJ; if (pm >= ntiles) return false;
        const int j = L - pm * NJ; const int e = texp[pm]; u.pm = pm; u.pn = e * NJ + j; return true; }
    __device__ __forceinline__ void a_ready(const Unit&) const {}
    __device__ __forceinline__ void done(const Unit&) const {}
};
template <class Epi, class Sched, bool ALIGN_EPI = false, bool SP2 = false>
__device__ __forceinline__ void gemm_phase(PG8_LAS unsigned char* lds, const Gemm g, const Sched& S, const Epi& E) {
    int tid_ = threadIdx.x; asm volatile("" : "+v"(tid_));
    const int tid = tid_, wid = __builtin_amdgcn_readfirstlane(tid >> 6), lane = tid & 63, wr = wid >> 2, wc = wid & 3, fr = lane & 15, fq = lane >> 4;
    const int K = g.K, nt = K / BK;
    unsigned voffA[2], voffB[2];
#pragma unroll
    for (int i = 0; i < 2; ++i) { int R, C; stage_rc(tid * 16 + i * 8192, R, C); const int Rb = Epi::PERM ? ((R & ~31) + perm32(R & 31)) : R;
        voffA[i] = (unsigned)(R * K + C) * 2u; voffB[i] = (unsigned)(Rb * K + C) * 2u; }
    const size_t kstep = (size_t)(BK * 2);
    const size_t hstep = (size_t)HALF * K * 2;
    const size_t tstep = 2 * hstep;
    const unsigned ldsw = (unsigned)wid * 1024u;
    const int aoff = lds_byte(wr * 64 + fr, fq * 8), boff = lds_byte(wc * 32 + fr, fq * 8);
#define PG8_SA(b, h) (((b) * 2 + (h)) * HTB)
#define PG8_SB(b, h) ((4 + (b) * 2 + (h)) * HTB)
#define PG8_STAGE(bufoff, gbase, voff) do { _Pragma("unroll") for (int _i = 0; _i < 2; ++_i) \
        __builtin_amdgcn_global_load_lds((const unsigned*)((const char*)(gbase) + (voff)[_i]), (PG8_LAS unsigned*)(lds + (bufoff) + ldsw + _i * 8192), 16, 0, 0); } while (0)
#define PG8_LDA(dst, b, h) do { _Pragma("unroll") for (int m = 0; m < 4; ++m) _Pragma("unroll") for (int k = 0; k < 2; ++k) dst[m][k] = *(const PG8_LAS bf16x8*)(lds + PG8_SA(b, h) + aoff + m * 2048 + k * 1024); } while (0)
#define PG8_LDB(dst, b, h) do { _Pragma("unroll") for (int n = 0; n < 2; ++n) _Pragma("unroll") for (int k = 0; k < 2; ++k) dst[n][k] = *(const PG8_LAS bf16x8*)(lds + PG8_SB(b, h) + boff + n * 2048 + k * 1024); } while (0)
#define PG8_MMA(ai, bj, At, Bt) do { __builtin_amdgcn_s_setprio(1); _Pragma("unroll") for (int m = 0; m < 4; ++m) _Pragma("unroll") for (int n = 0; n < 2; ++n) _Pragma("unroll") for (int k = 0; k < 2; ++k) \
        acc[ai][bj][m][n] = __builtin_amdgcn_mfma_f32_16x16x32_bf16(Bt[n][k], At[m][k], acc[ai][bj][m][n], 0, 0, 0); __builtin_amdgcn_s_setprio(0); } while (0)
#define PG8_WAIT_V(n) asm volatile("s_waitcnt vmcnt(" #n ")" ::: "memory")
#define PG8_WAIT_L(n) asm volatile("s_waitcnt lgkmcnt(" #n ")" ::: "memory")
#define PG8_BAR __builtin_amdgcn_s_barrier()
#define PG8_SCHED __builtin_amdgcn_sched_barrier(0)
    Unit cur, nxt; int ui = 0;
    if (!S.next(0, cur)) return;
    f32x4 acc[2][2][4][2];
#pragma unroll
    for (int a = 0; a < 2; ++a)
#pragma unroll
        for (int b = 0; b < 2; ++b)
#pragma unroll
            for (int m = 0; m < 4; ++m)
#pragma unroll
                for (int n = 0; n < 2; ++n) acc[a][b][m][n] = (f32x4){0.f, 0.f, 0.f, 0.f};
    bf16x8 At[4][2], B0[2][2], B1[2][2];
    const char* cA = (const char*)g.A + (size_t)cur.pm * tstep; const char* cB = (const char*)g.Bt + (size_t)cur.pn * tstep;
    S.a_ready(cur);
    if constexpr (SP2) {
        PG8_STAGE(PG8_SB(0, 0), cB, voffB); PG8_STAGE(PG8_SB(0, 1), cB + hstep, voffB); PG8_STAGE(PG8_SA(0, 0), cA, voffA); PG8_STAGE(PG8_SA(0, 1), cA + hstep, voffA);
        if (wr == 1) PG8_BAR;
        PG8_WAIT_V(2); PG8_BAR;
        PG8_STAGE(PG8_SB(1, 0), cB + kstep, voffB); PG8_STAGE(PG8_SA(1, 0), cA + kstep, voffA); PG8_STAGE(PG8_SB(1, 1), cB + hstep + kstep, voffB);
        PG8_WAIT_V(6); PG8_BAR;
    } else {
        PG8_STAGE(PG8_SB(0, 0), cB, voffB); PG8_STAGE(PG8_SA(0, 0), cA, voffA); PG8_STAGE(PG8_SB(0, 1), cB + hstep, voffB); PG8_STAGE(PG8_SA(0, 1), cA + hstep, voffA);
        if (wr == 1) PG8_BAR;
        PG8_WAIT_V(4); PG8_BAR;
        PG8_STAGE(PG8_SB(1, 0), cB + kstep, voffB); PG8_STAGE(PG8_SA(1, 0), cA + kstep, voffA); PG8_STAGE(PG8_SB(1, 1), cB + hstep + kstep, voffB);
        PG8_WAIT_V(6); PG8_BAR;
    }
    for (;;) {
        const bool has_next = S.next(ui + 1, nxt);
        const char* nA = has_next ? (const char*)g.A + (size_t)nxt.pm * tstep : cA; const char* nB = has_next ? (const char*)g.Bt + (size_t)nxt.pn * tstep : cB;
        for (int t = 0; t < nt; t += 2) {
            const bool last = (t == nt - 2);
            const char* a1 = cA + (size_t)(t + 1) * kstep;
            const char* a2 = last ? nA : cA + (size_t)(t + 2) * kstep; const char* b2 = last ? nB : cB + (size_t)(t + 2) * kstep;
            const char* a3 = a2 + kstep; const char* b3 = b2 + kstep;
            if (last && has_next) S.a_ready(nxt);
            if constexpr (SP2) {
            PG8_LDB(B0, 0, 0); PG8_LDB(B1, 0, 1); PG8_SCHED; PG8_LDA(At, 0, 0); PG8_STAGE(PG8_SA(1, 1), a1 + hstep, voffA);
            PG8_WAIT_V(8); PG8_WAIT_L(0); PG8_BAR; PG8_MMA(0, 0, At, B0); PG8_MMA(0, 1, At, B1); PG8_BAR; PG8_SCHED;
            PG8_LDA(At, 0, 1); PG8_STAGE(PG8_SB(0, 0), b2, voffB); PG8_STAGE(PG8_SB(0, 1), b2 + hstep, voffB); PG8_STAGE(PG8_SA(0, 0), a2, voffA);
            PG8_WAIT_V(8); PG8_WAIT_L(0); PG8_BAR; PG8_MMA(1, 0, At, B0); PG8_MMA(1, 1, At, B1); PG8_BAR; PG8_SCHED;
            PG8_LDB(B0, 1, 0); PG8_LDB(B1, 1, 1); PG8_SCHED; PG8_LDA(At, 1, 0); PG8_STAGE(PG8_SA(0, 1), a2 + hstep, voffA);
            PG8_WAIT_V(8); PG8_WAIT_L(0); PG8_BAR; PG8_MMA(0, 0, At, B0); PG8_MMA(0, 1, At, B1); PG8_BAR; PG8_SCHED;
            PG8_LDA(At, 1, 1); PG8_STAGE(PG8_SB(1, 0), b3, voffB); PG8_STAGE(PG8_SB(1, 1), b3 + hstep, voffB); PG8_STAGE(PG8_SA(1, 0), a3, voffA);
            PG8_WAIT_V(8); PG8_WAIT_L(0); PG8_BAR; PG8_MMA(1, 0, At, B0); PG8_MMA(1, 1, At, B1); PG8_BAR; PG8_SCHED;
            } else {
            PG8_LDB(B0, 0, 0); PG8_SCHED; PG8_LDA(At, 0, 0); PG8_STAGE(PG8_SA(1, 1), a1 + hstep, voffA);
            PG8_WAIT_L(8); PG8_BAR; PG8_WAIT_L(0); PG8_MMA(0, 0, At, B0); PG8_BAR; PG8_SCHED;
            PG8_LDB(B1, 0, 1); PG8_STAGE(PG8_SB(0, 0), b2, voffB);
            PG8_BAR; PG8_WAIT_L(0); PG8_MMA(0, 1, At, B1); PG8_BAR;
            PG8_LDA(At, 0, 1); PG8_STAGE(PG8_SA(0, 0), a2, voffA);
            PG8_BAR; PG8_WAIT_L(0); PG8_MMA(1, 0, At, B0); PG8_BAR; PG8_SCHED;
            PG8_STAGE(PG8_SB(0, 1), b2 + hstep, voffB);
            PG8_WAIT_V(6); PG8_BAR; PG8_MMA(1, 1, At, B1); PG8_BAR;
            PG8_LDB(B0, 1, 0); PG8_SCHED; PG8_LDA(At, 1, 0); PG8_STAGE(PG8_SA(0, 1), a2 + hstep, voffA);
            PG8_WAIT_L(8); PG8_BAR; PG8_WAIT_L(0); PG8_MMA(0, 0, At, B0); PG8_BAR; PG8_SCHED;
            PG8_LDB(B1, 1, 1); PG8_STAGE(PG8_SB(1, 0), b3, voffB);
            PG8_BAR; PG8_WAIT_L(0); PG8_MMA(0, 1, At, B1); PG8_BAR;
            PG8_LDA(At, 1, 1); PG8_STAGE(PG8_SA(1, 0), a3, voffA);
            PG8_BAR; PG8_WAIT_L(0); PG8_MMA(1, 0, At, B0); PG8_BAR; PG8_SCHED;
            PG8_STAGE(PG8_SB(1, 1), b3 + hstep, voffB);
            PG8_WAIT_V(6); PG8_BAR; PG8_MMA(1, 1, At, B1); PG8_BAR;
            }
        }
        if constexpr (ALIGN_EPI) { if (wr == 0) PG8_BAR; }
        if constexpr (!Epi::AFTER_DRAIN) { E(acc, cur, wr, wc, fr, fq); S.done(cur); }
        if (!has_next) break;
#pragma unroll
        for (int a = 0; a < 2; ++a)
#pragma unroll
            for (int b = 0; b < 2; ++b)
#pragma unroll
                for (int m = 0; m < 4; ++m)
#pragma unroll
                    for (int n = 0; n < 2; ++n) acc[a][b][m][n] = (f32x4){0.f, 0.f, 0.f, 0.f};
        cur = nxt; cA = nA; cB = nB; ++ui;
        if constexpr (ALIGN_EPI) { if (wr == 1) PG8_BAR; }
    }
    PG8_WAIT_V(0);
    if constexpr (!ALIGN_EPI) { if (wr == 0) PG8_BAR; }
    PG8_BAR;
    if constexpr (Epi::AFTER_DRAIN) { E.fused(acc, cur, wr, wc, fr, fq, lds, wid, lane); S.done(cur); }
#undef PG8_SA
#undef PG8_SB
#undef PG8_STAGE
#undef PG8_LDA
#undef PG8_LDB
#undef PG8_MMA
#ifdef PG8_MMAI
#undef PG8_MMAI
#endif
#undef PG8_WAIT_V
#undef PG8_WAIT_L
#undef PG8_BAR
#undef PG8_SCHED
}
template <class Epi, class Sched, bool ALIGN_EPI = false, bool SP2 = false>
__device__ __forceinline__ void gemm_phase_gn(PG8_LAS unsigned char* lds, const Gemm g, const Sched& S, const Epi& E, const PG8_LAS float* rt) {
    int tid_ = threadIdx.x; asm volatile("" : "+v"(tid_));
    const int tid = tid_, wid = __builtin_amdgcn_readfirstlane(tid >> 6), lane = tid & 63, wr = wid >> 2, wc = wid & 3, fr = lane & 15, fq = lane >> 4;
    const int K = g.K, nt = K / BK;
    unsigned voffA[2], voffB[2];
#pragma unroll
    for (int i = 0; i < 2; ++i) { int R, C; stage_rc(tid * 16 + i * 8192, R, C); const int Rb = Epi::PERM ? ((R & ~31) + perm32(R & 31)) : R;
        voffA[i] = (unsigned)(R * K + C) * 2u; voffB[i] = (unsigned)(Rb * K + C) * 2u; }
    const size_t kstep = (size_t)(BK * 2);
    const size_t hstep = (size_t)HALF * K * 2;
    const size_t tstep = 2 * hstep;
    const unsigned ldsw = (unsigned)wid * 1024u;
    const int aoff = lds_byte(wr * 64 + fr, fq * 8), boff = lds_byte(wc * 32 + fr, fq * 8);
#define PG8_SA(b, h) (((b) * 2 + (h)) * HTB)
#define PG8_SB(b, h) ((4 + (b) * 2 + (h)) * HTB)
#define PG8_STAGE(bufoff, gbase, voff) do { _Pragma("unroll") for (int _i = 0; _i < 2; ++_i) \
        __builtin_amdgcn_global_load_lds((const unsigned*)((const char*)(gbase) + (voff)[_i]), (PG8_LAS unsigned*)(lds + (bufoff) + ldsw + _i * 8192), 16, 0, 0); } while (0)
#define PG8_LDA(dst, b, h) do { _Pragma("unroll") for (int m = 0; m < 4; ++m) _Pragma("unroll") for (int k = 0; k < 2; ++k) dst[m][k] = *(const PG8_LAS bf16x8*)(lds + PG8_SA(b, h) + aoff + m * 2048 + k * 1024); } while (0)
#define PG8_LDB(dst, b, h) do { _Pragma("unroll") for (int n = 0; n < 2; ++n) _Pragma("unroll") for (int k = 0; k < 2; ++k) dst[n][k] = *(const PG8_LAS bf16x8*)(lds + PG8_SB(b, h) + boff + n * 2048 + k * 1024); } while (0)
#define PG8_MMA(ai, bj, At, Bt) do { __builtin_amdgcn_s_setprio(1); _Pragma("unroll") for (int m = 0; m < 4; ++m) _Pragma("unroll") for (int n = 0; n < 2; ++n) _Pragma("unroll") for (int k = 0; k < 2; ++k) \
        acc[ai][bj][m][n] = __builtin_amdgcn_mfma_f32_16x16x32_bf16(Bt[n][k], At[m][k], acc[ai][bj][m][n], 0, 0, 0); __builtin_amdgcn_s_setprio(0); } while (0)
#define PG8_WAIT_V(n) asm volatile("s_waitcnt vmcnt(" #n ")" ::: "memory")
#define PG8_WAIT_L(n) asm volatile("s_waitcnt lgkmcnt(" #n ")" ::: "memory")
#define PG8_BAR __builtin_amdgcn_s_barrier()
#define PG8_SCHED __builtin_amdgcn_sched_barrier(0)
    Unit cur, nxt; int ui = 0;
    if (!S.next(0, cur)) return;
    f32x4 acc[2][2][4][2];
#pragma unroll
    for (int a = 0; a < 2; ++a)
#pragma unroll
        for (int b = 0; b < 2; ++b)
#pragma unroll
            for (int m = 0; m < 4; ++m)
#pragma unroll
                for (int n = 0; n < 2; ++n) acc[a][b][m][n] = (f32x4){0.f, 0.f, 0.f, 0.f};
    bf16x8 At[4][2], B0[2][2], B1[2][2];
    const char* cA = (const char*)g.A + (size_t)cur.pm * tstep; const char* cB = (const char*)g.Bt + (size_t)cur.pn * tstep;
    S.a_ready(cur);
    if constexpr (SP2) {
        PG8_STAGE(PG8_SB(0, 0), cB, voffB); PG8_STAGE(PG8_SB(0, 1), cB + hstep, voffB); PG8_STAGE(PG8_SA(0, 0), cA, voffA); PG8_STAGE(PG8_SA(0, 1), cA + hstep, voffA);
        if (wr == 1) PG8_BAR;
        PG8_WAIT_V(2); PG8_BAR;
        PG8_STAGE(PG8_SB(1, 0), cB + kstep, voffB); PG8_STAGE(PG8_SA(1, 0), cA + kstep, voffA); PG8_STAGE(PG8_SB(1, 1), cB + hstep + kstep, voffB);
        PG8_WAIT_V(6); PG8_BAR;
    } else {
        PG8_STAGE(PG8_SB(0, 0), cB, voffB); PG8_STAGE(PG8_SA(0, 0), cA, voffA); PG8_STAGE(PG8_SB(0, 1), cB + hstep, voffB); PG8_STAGE(PG8_SA(0, 1), cA + hstep, voffA);
        if (wr == 1) PG8_BAR;
        PG8_WAIT_V(4); PG8_BAR;
        PG8_STAGE(PG8_SB(1, 0), cB + kstep, voffB); PG8_STAGE(PG8_SA(1, 0), cA + kstep, voffA); PG8_STAGE(PG8_SB(1, 1), cB + hstep + kstep, voffB);
        PG8_WAIT_V(6); PG8_BAR;
    }
    for (;;) {
        const bool has_next = S.next(ui + 1, nxt);
        const char* nA = has_next ? (const char*)g.A + (size_t)nxt.pm * tstep : cA; const char* nB = has_next ? (const char*)g.Bt + (size_t)nxt.pn * tstep : cB;
        for (int t = 0; t < nt; t += 2) {
            if (t == 4 || t == 10) { const int w_ = (t == 4) ? 0 : 1;
#pragma unroll
                for (int a = 0; a < 2; ++a)
#pragma unroll
                    for (int m = 0; m < 4; ++m) { const float f_ = rt[((ui & 1) * 256 + a * HALF + wr * 64 + m * 16 + fr) * 4 + w_];
#pragma unroll
                        for (int b = 0; b < 2; ++b)
#pragma unroll
                            for (int n = 0; n < 2; ++n) acc[a][b][m][n] = acc[a][b][m][n] * f_; } }
            const bool last = (t == nt - 2);
            const char* a1 = cA + (size_t)(t + 1) * kstep;
            const char* a2 = last ? nA : cA + (size_t)(t + 2) * kstep; const char* b2 = last ? nB : cB + (size_t)(t + 2) * kstep;
            const char* a3 = a2 + kstep; const char* b3 = b2 + kstep;
            if (last && has_next) S.a_ready(nxt);
            if constexpr (SP2) {
            PG8_LDB(B0, 0, 0); PG8_LDB(B1, 0, 1); PG8_SCHED; PG8_LDA(At, 0, 0); PG8_STAGE(PG8_SA(1, 1), a1 + hstep, voffA);
            PG8_WAIT_V(8); PG8_WAIT_L(0); PG8_BAR; PG8_MMA(0, 0, At, B0); PG8_MMA(0, 1, At, B1); PG8_BAR; PG8_SCHED;
            PG8_LDA(At, 0, 1); PG8_STAGE(PG8_SB(0, 0), b2, voffB); PG8_STAGE(PG8_SB(0, 1), b2 + hstep, voffB); PG8_STAGE(PG8_SA(0, 0), a2, voffA);
            PG8_WAIT_V(8); PG8_WAIT_L(0); PG8_BAR; PG8_MMA(1, 0, At, B0); PG8_MMA(1, 1, At, B1); PG8_BAR; PG8_SCHED;
            PG8_LDB(B0, 1, 0); PG8_LDB(B1, 1, 1); PG8_SCHED; PG8_LDA(At, 1, 0); PG8_STAGE(PG8_SA(0, 1), a2 + hstep, voffA);
            PG8_WAIT_V(8); PG8_WAIT_L(0); PG8_BAR; PG8_MMA(0, 0, At, B0); PG8_MMA(0, 1, At, B1); PG8_BAR; PG8_SCHED;
            PG8_LDA(At, 1, 1); PG8_STAGE(PG8_SB(1, 0), b3, voffB); PG8_STAGE(PG8_SB(1, 1), b3 + hstep, voffB); PG8_STAGE(PG8_SA(1, 0), a3, voffA);
            PG8_WAIT_V(8); PG8_WAIT_L(0); PG8_BAR; PG8_MMA(1, 0, At, B0); PG8_MMA(1, 1, At, B1); PG8_BAR; PG8_SCHED;
            } else {
            PG8_LDB(B0, 0, 0); PG8_SCHED; PG8_LDA(At, 0, 0); PG8_STAGE(PG8_SA(1, 1), a1 + hstep, voffA);
            PG8_WAIT_L(8); PG8_BAR; PG8_WAIT_L(0); PG8_MMA(0, 0, At, B0); PG8_BAR; PG8_SCHED;
            PG8_LDB(B1, 0, 1); PG8_STAGE(PG8_SB(0, 0), b2, voffB);
            PG8_BAR; PG8_WAIT_L(0); PG8_MMA(0, 1, At, B1); PG8_BAR;
            PG8_LDA(At, 0, 1); PG8_STAGE(PG8_SA(0, 0), a2, voffA);
            PG8_BAR; PG8_WAIT_L(0); PG8_MMA(1, 0, At, B0); PG8_BAR; PG8_SCHED;
            PG8_STAGE(PG8_SB(0, 1), b2 + hstep, voffB);
            PG8_WAIT_V(6); PG8_BAR; PG8_MMA(1, 1, At, B1); PG8_BAR;
            PG8_LDB(B0, 1, 0); PG8_SCHED; PG8_LDA(At, 1, 0); PG8_STAGE(PG8_SA(0, 1), a2 + hstep, voffA);
            PG8_WAIT_L(8); PG8_BAR; PG8_WAIT_L(0); PG8_MMA(0, 0, At, B0); PG8_BAR; PG8_SCHED;
            PG8_LDB(B1, 1, 1); PG8_STAGE(PG8_SB(1, 0), b3, voffB);
            PG8_BAR; PG8_WAIT_L(0); PG8_MMA(0, 1, At, B1); PG8_BAR;
            PG8_LDA(At, 1, 1); PG8_STAGE(PG8_SA(1, 0), a3, voffA);
            PG8_BAR; PG8_WAIT_L(0); PG8_MMA(1, 0, At, B0); PG8_BAR; PG8_SCHED;
            PG8_STAGE(PG8_SB(1, 1), b3 + hstep, voffB);
            PG8_WAIT_V(6); PG8_BAR; PG8_MMA(1, 1, At, B1); PG8_BAR;
            }
        }
        if constexpr (ALIGN_EPI) { if (wr == 0) PG8_BAR; }
        {
#pragma unroll
            for (int a = 0; a < 2; ++a)
#pragma unroll
                for (int m = 0; m < 4; ++m) { const float f_ = rt[((ui & 1) * 256 + a * HALF + wr * 64 + m * 16 + fr) * 4 + 2];
#pragma unroll
                    for (int b = 0; b < 2; ++b)
#pragma unroll
                        for (int n = 0; n < 2; ++n) acc[a][b][m][n] = acc[a][b][m][n] * f_; } }
        if constexpr (!Epi::AFTER_DRAIN) { E(acc, cur, wr, wc, fr, fq); S.done(cur); }
        if (!has_next) break;
#pragma unroll
        for (int a = 0; a < 2; ++a)
#pragma unroll
            for (int b = 0; b < 2; ++b)
#pragma unroll
                for (int m = 0; m < 4; ++m)
#pragma unroll
                    for (int n = 0; n < 2; ++n) acc[a][b][m][n] = (f32x4){0.f, 0.f, 0.f, 0.f};
        cur = nxt; cA = nA; cB = nB; ++ui;
        if constexpr (ALIGN_EPI) { if (wr == 1) PG8_BAR; }
    }
    PG8_WAIT_V(0);
    if constexpr (!ALIGN_EPI) { if (wr == 0) PG8_BAR; }
    PG8_BAR;
    if constexpr (Epi::AFTER_DRAIN) { E.fused(acc, cur, wr, wc, fr, fq, lds, wid, lane); S.done(cur); }
#undef PG8_SA
#undef PG8_SB
#undef PG8_STAGE
#undef PG8_LDA
#undef PG8_LDB
#undef PG8_MMA
#ifdef PG8_MMAI
#undef PG8_MMAI
#endif
#undef PG8_WAIT_V
#undef PG8_WAIT_L
#undef PG8_BAR
#undef PG8_SCHED
}
template <class Epi, class Sched, bool ALIGN_EPI = false, bool SP2 = false>
__device__ __forceinline__ void gemm_phase_g(PG8_LAS unsigned char* lds, const Gemm g, const Sched& S, const Epi& E) {
    int tid_ = threadIdx.x; asm volatile("" : "+v"(tid_));
    const int tid = tid_, wid = __builtin_amdgcn_readfirstlane(tid >> 6), lane = tid & 63, wr = wid >> 2, wc = wid & 3, fr = lane & 15, fq = lane >> 4;
    const int K = g.K, nt = K / BK;
    unsigned voffA[2], voffB[2];
#pragma unroll
    for (int i = 0; i < 2; ++i) { int R, C; stage_rc(tid * 16 + i * 8192, R, C); const int Rb = Epi::PERM ? ((R & ~31) + perm32(R & 31)) : R;
        voffA[i] = (unsigned)(R * K + C) * 2u; voffB[i] = (unsigned)(Rb * K + C) * 2u; }
    const size_t kstep = (size_t)(BK * 2);
    const size_t hstep = (size_t)HALF * K * 2;
    const size_t tstep = 2 * hstep;
    const unsigned ldsw = (unsigned)wid * 1024u;
    const int aoff = lds_byte(wr * 64 + fr, fq * 8), boff = lds_byte(wc * 32 + fr, fq * 8);
#define PG8_SA(b, h) (((b) * 2 + (h)) * HTB)
#define PG8_SB(b, h) ((4 + (b) * 2 + (h)) * HTB)
#define PG8_STAGE(bufoff, gbase, voff) do { _Pragma("unroll") for (int _i = 0; _i < 2; ++_i) \
        __builtin_amdgcn_global_load_lds((const unsigned*)((const char*)(gbase) + (voff)[_i]), (PG8_LAS unsigned*)(lds + (bufoff) + ldsw + _i * 8192), 16, 0, 0); } while (0)
#define PG8_STAGE_A(bufoff, OFF, h, kb) do { _Pragma("unroll") for (int _i = 0; _i < 2; ++_i) \
        __builtin_amdgcn_global_load_lds((const unsigned*)((const char*)g.A + (OFF)[h][_i] + (kb)), (PG8_LAS unsigned*)(lds + (bufoff) + ldsw + _i * 8192), 16, 0, 0); } while (0)
#define PG8_LDA(dst, b, h) do { _Pragma("unroll") for (int m = 0; m < 4; ++m) _Pragma("unroll") for (int k = 0; k < 2; ++k) dst[m][k] = *(const PG8_LAS bf16x8*)(lds + PG8_SA(b, h) + aoff + m * 2048 + k * 1024); } while (0)
#define PG8_LDB(dst, b, h) do { _Pragma("unroll") for (int n = 0; n < 2; ++n) _Pragma("unroll") for (int k = 0; k < 2; ++k) dst[n][k] = *(const PG8_LAS bf16x8*)(lds + PG8_SB(b, h) + boff + n * 2048 + k * 1024); } while (0)
#define PG8_MMA(ai, bj, At, Bt) do { __builtin_amdgcn_s_setprio(1); _Pragma("unroll") for (int m = 0; m < 4; ++m) _Pragma("unroll") for (int n = 0; n < 2; ++n) _Pragma("unroll") for (int k = 0; k < 2; ++k) \
        acc[ai][bj][m][n] = __builtin_amdgcn_mfma_f32_16x16x32_bf16(Bt[n][k], At[m][k], acc[ai][bj][m][n], 0, 0, 0); __builtin_amdgcn_s_setprio(0); } while (0)
#define PG8_WAIT_V(n) asm volatile("s_waitcnt vmcnt(" #n ")" ::: "memory")
#define PG8_WAIT_L(n) asm volatile("s_waitcnt lgkmcnt(" #n ")" ::: "memory")
#define PG8_BAR __builtin_amdgcn_s_barrier()
#define PG8_SCHED __builtin_amdgcn_sched_barrier(0)
    Unit cur, nxt; int ui = 0;
    if (!S.next(0, cur)) return;
    f32x4 acc[2][2][4][2];
#pragma unroll
    for (int a = 0; a < 2; ++a)
#pragma unroll
        for (int b = 0; b < 2; ++b)
#pragma unroll
            for (int m = 0; m < 4; ++m)
#pragma unroll
                for (int n = 0; n < 2; ++n) acc[a][b][m][n] = (f32x4){0.f, 0.f, 0.f, 0.f};
    bf16x8 At[4][2], B0[2][2], B1[2][2];
    const char* cB = (const char*)g.Bt + (size_t)cur.pn * tstep;
    unsigned go[2][2], ngo[2][2]; int Rr[2], Cc[2];
#pragma unroll
    for (int i = 0; i < 2; ++i) stage_rc(tid * 16 + i * 8192, Rr[i], Cc[i]);
#pragma unroll
    for (int h = 0; h < 2; ++h)
#pragma unroll
        for (int i = 0; i < 2; ++i) go[h][i] = (unsigned)S.rowtok(cur, h * HALF + Rr[i]) * (unsigned)(K * 2) + (unsigned)Cc[i] * 2u;
    S.a_ready(cur);
    if constexpr (SP2) {
        PG8_STAGE(PG8_SB(0, 0), cB, voffB); PG8_STAGE(PG8_SB(0, 1), cB + hstep, voffB); PG8_STAGE_A(PG8_SA(0, 0), go, 0, 0); PG8_STAGE_A(PG8_SA(0, 1), go, 1, 0);
        if (wr == 1) PG8_BAR;
        PG8_WAIT_V(2); PG8_BAR;
        PG8_STAGE(PG8_SB(1, 0), cB + kstep, voffB); PG8_STAGE_A(PG8_SA(1, 0), go, 0, kstep); PG8_STAGE(PG8_SB(1, 1), cB + hstep + kstep, voffB);
        PG8_WAIT_V(6); PG8_BAR;
    } else {
        PG8_STAGE(PG8_SB(0, 0), cB, voffB); PG8_STAGE_A(PG8_SA(0, 0), go, 0, 0); PG8_STAGE(PG8_SB(0, 1), cB + hstep, voffB); PG8_STAGE_A(PG8_SA(0, 1), go, 1, 0);
        if (wr == 1) PG8_BAR;
        PG8_WAIT_V(4); PG8_BAR;
        PG8_STAGE(PG8_SB(1, 0), cB + kstep, voffB); PG8_STAGE_A(PG8_SA(1, 0), go, 0, kstep); PG8_STAGE(PG8_SB(1, 1), cB + hstep + kstep, voffB);
        PG8_WAIT_V(6); PG8_BAR;
    }
    for (;;) {
        const bool has_next = S.next(ui + 1, nxt);
        const char* nB = has_next ? (const char*)g.Bt + (size_t)nxt.pn * tstep : cB;
#pragma unroll
        for (int h = 0; h < 2; ++h)
#pragma unroll
            for (int i = 0; i < 2; ++i) ngo[h][i] = has_next ? (unsigned)S.rowtok(nxt, h * HALF + Rr[i]) * (unsigned)(K * 2) + (unsigned)Cc[i] * 2u : go[h][i];
        for (int t = 0; t < nt; t += 2) {
            const bool last = (t == nt - 2);
            const size_t ka1 = (size_t)(t + 1) * kstep;
            const size_t k2 = last ? 0 : (size_t)(t + 2) * kstep; const char* b2 = last ? nB : cB + (size_t)(t + 2) * kstep;
            unsigned o2[2][2];
#pragma unroll
            for (int h = 0; h < 2; ++h)
#pragma unroll
                for (int i = 0; i < 2; ++i) o2[h][i] = last ? ngo[h][i] : go[h][i];
            const char* b3 = b2 + kstep;
            if (last && has_next) S.a_ready(nxt);
            if constexpr (SP2) {
            PG8_LDB(B0, 0, 0); PG8_LDB(B1, 0, 1); PG8_SCHED; PG8_LDA(At, 0, 0); PG8_STAGE_A(PG8_SA(1, 1), go, 1, ka1);
            PG8_WAIT_V(8); PG8_WAIT_L(0); PG8_BAR; PG8_MMA(0, 0, At, B0); PG8_MMA(0, 1, At, B1); PG8_BAR; PG8_SCHED;
            PG8_LDA(At, 0, 1); PG8_STAGE(PG8_SB(0, 0), b2, voffB); PG8_STAGE(PG8_SB(0, 1), b2 + hstep, voffB); PG8_STAGE_A(PG8_SA(0, 0), o2, 0, k2);
            PG8_WAIT_V(8); PG8_WAIT_L(0); PG8_BAR; PG8_MMA(1, 0, At, B0); PG8_MMA(1, 1, At, B1); PG8_BAR; PG8_SCHED;
            PG8_LDB(B0, 1, 0); PG8_LDB(B1, 1, 1); PG8_SCHED; PG8_LDA(At, 1, 0); PG8_STAGE_A(PG8_SA(0, 1), o2, 1, k2);
            PG8_WAIT_V(8); PG8_WAIT_L(0); PG8_BAR; PG8_MMA(0, 0, At, B0); PG8_MMA(0, 1, At, B1); PG8_BAR; PG8_SCHED;
            PG8_LDA(At, 1, 1); PG8_STAGE(PG8_SB(1, 0), b3, voffB); PG8_STAGE(PG8_SB(1, 1), b3 + hstep, voffB); PG8_STAGE_A(PG8_SA(1, 0), o2, 0, k2 + kstep);
            PG8_WAIT_V(8); PG8_WAIT_L(0); PG8_BAR; PG8_MMA(1, 0, At, B0); PG8_MMA(1, 1, At, B1); PG8_BAR; PG8_SCHED;
            } else {
            PG8_LDB(B0, 0, 0); PG8_SCHED; PG8_LDA(At, 0, 0); PG8_STAGE_A(PG8_SA(1, 1), go, 1, ka1);
            PG8_WAIT_L(8); PG8_BAR; PG8_WAIT_L(0); PG8_MMA(0, 0, At, B0); PG8_BAR; PG8_SCHED;
            PG8_LDB(B1, 0, 1); PG8_STAGE(PG8_SB(0, 0), b2, voffB);
            PG8_BAR; PG8_WAIT_L(0); PG8_MMA(0, 1, At, B1); PG8_BAR;
            PG8_LDA(At, 0, 1); PG8_STAGE_A(PG8_SA(0, 0), o2, 0, k2);
            PG8_BAR; PG8_WAIT_L(0); PG8_MMA(1, 0, At, B0); PG8_BAR; PG8_SCHED;
            PG8_STAGE(PG8_SB(0, 1), b2 + hstep, voffB);
            PG8_WAIT_V(6); PG8_BAR; PG8_MMA(1, 1, At, B1); PG8_BAR;
            PG8_LDB(B0, 1, 0); PG8_SCHED; PG8_LDA(At, 1, 0); PG8_STAGE_A(PG8_SA(0, 1), o2, 1, k2);
            PG8_WAIT_L(8); PG8_BAR; PG8_WAIT_L(0); PG8_MMA(0, 0, At, B0); PG8_BAR; PG8_SCHED;
            PG8_LDB(B1, 1, 1); PG8_STAGE(PG8_SB(1, 0), b3, voffB);
            PG8_BAR; PG8_WAIT_L(0); PG8_MMA(0, 1, At, B1); PG8_BAR;
            PG8_LDA(At, 1, 1); PG8_STAGE_A(PG8_SA(1, 0), o2, 0, k2 + kstep);
            PG8_BAR; PG8_WAIT_L(0); PG8_MMA(1, 0, At, B0); PG8_BAR; PG8_SCHED;
            PG8_STAGE(PG8_SB(1, 1), b3 + hstep, voffB);
            PG8_WAIT_V(6); PG8_BAR; PG8_MMA(1, 1, At, B1); PG8_BAR;
            }
        }
        if constexpr (ALIGN_EPI) { if (wr == 0) PG8_BAR; }
        if constexpr (!Epi::AFTER_DRAIN) { E(acc, cur, wr, wc, fr, fq); S.done(cur); }
        if (!has_next) break;
#pragma unroll
        for (int a = 0; a < 2; ++a)
#pragma unroll
            for (int b = 0; b < 2; ++b)
#pragma unroll
                for (int m = 0; m < 4; ++m)
#pragma unroll
                    for (int n = 0; n < 2; ++n) acc[a][b][m][n] = (f32x4){0.f, 0.f, 0.f, 0.f};
        cur = nxt; cB = nB; ++ui;
#pragma unroll
        for (int h = 0; h < 2; ++h)
#pragma unroll
            for (int i = 0; i < 2; ++i) go[h][i] = ngo[h][i];
        if constexpr (ALIGN_EPI) { if (wr == 1) PG8_BAR; }
    }
    PG8_WAIT_V(0);
    if constexpr (!ALIGN_EPI) { if (wr == 0) PG8_BAR; }
    PG8_BAR;
    if constexpr (Epi::AFTER_DRAIN) { E.fused(acc, cur, wr, wc, fr, fq, lds, wid, lane); S.done(cur); }
#undef PG8_SA
#undef PG8_SB
#undef PG8_STAGE
#undef PG8_STAGE_A
#undef PG8_LDA
#undef PG8_LDB
#undef PG8_MMA
#ifdef PG8_MMAI
#undef PG8_MMAI
#endif
#undef PG8_WAIT_V
#undef PG8_WAIT_L
#undef PG8_BAR
#undef PG8_SCHED
}

typedef int i32x8 __attribute__((ext_vector_type(8)));
__device__ __forceinline__ void mfma8(f32x4& c, const i32x8& a, const i32x8& b, int sc) { asm volatile("v_mfma_scale_f32_16x16x128_f8f6f4 %0, %1, %2, %0, %3, %3 op_sel_hi:[0,0,0]" : "+v"(c) : "v"(a), "v"(b), "v"(sc)); }
template <class Epi, class Sched, bool ALIGN_EPI = false, bool SP2 = false>
__device__ __forceinline__ void gemm_phase8(PG8_LAS unsigned char* lds, const Gemm g, const Sched& S, const Epi& E) {
    int tid_ = threadIdx.x; asm volatile("" : "+v"(tid_));
    const int tid = tid_, wid = __builtin_amdgcn_readfirstlane(tid >> 6), lane = tid & 63, wr = wid >> 2, wc = wid & 3, fr = lane & 15, fq = lane >> 4;
    int sc8 = 0x7F7F7F7F; asm volatile("" : "+v"(sc8));
    const int K = g.K, nt = K / 128;
    unsigned voffA[2], voffB[2];
#pragma unroll
    for (int i = 0; i < 2; ++i) { int R, C; stage_rc(tid * 16 + i * 8192, R, C); const int Rb = Epi::PERM ? ((R & ~31) + perm32(R & 31)) : R;
        voffA[i] = (unsigned)(R * K + C * 2); voffB[i] = (unsigned)(Rb * K + C * 2); }
    const size_t kstep = (size_t)(BK * 2);
    const size_t hstep = (size_t)HALF * K;
    const size_t tstep = 2 * hstep;
    const unsigned ldsw = (unsigned)wid * 1024u;
    const int aoff = lds_byte(wr * 64 + fr, fq * 8), boff = lds_byte(wc * 32 + fr, fq * 8);
#define PG8_SA(b, h) (((b) * 2 + (h)) * HTB)
#define PG8_SB(b, h) ((4 + (b) * 2 + (h)) * HTB)
#define PG8_STAGE(bufoff, gbase, voff) do { _Pragma("unroll") for (int _i = 0; _i < 2; ++_i) \
        __builtin_amdgcn_global_load_lds((const unsigned*)((const char*)(gbase) + (voff)[_i]), (PG8_LAS unsigned*)(lds + (bufoff) + ldsw + _i * 8192), 16, 0, 0); } while (0)
#define PG8_LDA(dst, b, h) do { _Pragma("unroll") for (int m = 0; m < 4; ++m) { const u32x4 lo_ = *(const PG8_LAS u32x4*)(lds + PG8_SA(b, h) + aoff + m * 2048), hi_ = *(const PG8_LAS u32x4*)(lds + PG8_SA(b, h) + aoff + m * 2048 + 1024); \
        dst[m] = (i32x8){(int)lo_.x, (int)lo_.y, (int)lo_.z, (int)lo_.w, (int)hi_.x, (int)hi_.y, (int)hi_.z, (int)hi_.w}; } } while (0)
#define PG8_LDB(dst, b, h) do { _Pragma("unroll") for (int n = 0; n < 2; ++n) { const u32x4 lo_ = *(const PG8_LAS u32x4*)(lds + PG8_SB(b, h) + boff + n * 2048), hi_ = *(const PG8_LAS u32x4*)(lds + PG8_SB(b, h) + boff + n * 2048 + 1024); \
        dst[n] = (i32x8){(int)lo_.x, (int)lo_.y, (int)lo_.z, (int)lo_.w, (int)hi_.x, (int)hi_.y, (int)hi_.z, (int)hi_.w}; } } while (0)
#define PG8_MMA(ai, bj, At, Bt) do { __builtin_amdgcn_s_setprio(1); _Pragma("unroll") for (int m = 0; m < 4; ++m) _Pragma("unroll") for (int n = 0; n < 2; ++n) \
        mfma8(acc[ai][bj][m][n], Bt[n], At[m], sc8); __builtin_amdgcn_s_setprio(0); } while (0)
#define PG8_MMAI(ai, At, ST1, ST2, ST3) do { __builtin_amdgcn_s_setprio(1); \
        mfma8(acc[ai][0][0][0], B0[0], At[0], sc8); mfma8(acc[ai][0][0][1], B0[1], At[0], sc8); __builtin_amdgcn_sched_barrier(0); ST1; __builtin_amdgcn_sched_barrier(0); \
        mfma8(acc[ai][0][1][0], B0[0], At[1], sc8); mfma8(acc[ai][0][1][1], B0[1], At[1], sc8); mfma8(acc[ai][0][2][0], B0[0], At[2], sc8); mfma8(acc[ai][0][2][1], B0[1], At[2], sc8); __builtin_amdgcn_sched_barrier(0); ST2; __builtin_amdgcn_sched_barrier(0); \
        mfma8(acc[ai][0][3][0], B0[0], At[3], sc8); mfma8(acc[ai][0][3][1], B0[1], At[3], sc8); mfma8(acc[ai][1][0][0], B1[0], At[0], sc8); mfma8(acc[ai][1][0][1], B1[1], At[0], sc8); __builtin_amdgcn_sched_barrier(0); ST3; __builtin_amdgcn_sched_barrier(0); \
        mfma8(acc[ai][1][1][0], B1[0], At[1], sc8); mfma8(acc[ai][1][1][1], B1[1], At[1], sc8); mfma8(acc[ai][1][2][0], B1[0], At[2], sc8); mfma8(acc[ai][1][2][1], B1[1], At[2], sc8); \
        mfma8(acc[ai][1][3][0], B1[0], At[3], sc8); mfma8(acc[ai][1][3][1], B1[1], At[3], sc8); __builtin_amdgcn_s_setprio(0); } while (0)
#define PG8_WAIT_V(n) asm volatile("s_waitcnt vmcnt(" #n ")" ::: "memory")
#define PG8_WAIT_L(n) asm volatile("s_waitcnt lgkmcnt(" #n ")" ::: "memory")
#define PG8_BAR __builtin_amdgcn_s_barrier()
#define PG8_SCHED __builtin_amdgcn_sched_barrier(0)
    Unit cur, nxt; int ui = 0;
    if (!S.next(0, cur)) return;
    f32x4 acc[2][2][4][2];
#pragma unroll
    for (int a = 0; a < 2; ++a)
#pragma unroll
        for (int b = 0; b < 2; ++b)
#pragma unroll
            for (int m = 0; m < 4; ++m)
#pragma unroll
                for (int n = 0; n < 2; ++n) acc[a][b][m][n] = (f32x4){0.f, 0.f, 0.f, 0.f};
    i32x8 At[4], B0[2], B1[2];
    const char* cA = (const char*)g.A + (size_t)cur.pm * tstep; const char* cB = (const char*)g.Bt + (size_t)cur.pn * tstep;
    S.a_ready(cur);
    if constexpr (SP2) {
        PG8_STAGE(PG8_SB(0, 0), cB, voffB); PG8_STAGE(PG8_SB(0, 1), cB + hstep, voffB); PG8_STAGE(PG8_SA(0, 0), cA, voffA); PG8_STAGE(PG8_SA(0, 1), cA + hstep, voffA);
        if (wr == 1) PG8_BAR;
        PG8_WAIT_V(2); PG8_BAR;
        PG8_STAGE(PG8_SB(1, 0), cB + kstep, voffB); PG8_STAGE(PG8_SA(1, 0), cA + kstep, voffA); PG8_STAGE(PG8_SB(1, 1), cB + hstep + kstep, voffB);
        PG8_WAIT_V(6); PG8_BAR;
    } else {
        PG8_STAGE(PG8_SB(0, 0), cB, voffB); PG8_STAGE(PG8_SA(0, 0), cA, voffA); PG8_STAGE(PG8_SB(0, 1), cB + hstep, voffB); PG8_STAGE(PG8_SA(0, 1), cA + hstep, voffA);
        if (wr == 1) PG8_BAR;
        PG8_WAIT_V(4); PG8_BAR;
        PG8_STAGE(PG8_SB(1, 0), cB + kstep, voffB); PG8_STAGE(PG8_SA(1, 0), cA + kstep, voffA); PG8_STAGE(PG8_SB(1, 1), cB + hstep + kstep, voffB);
        PG8_WAIT_V(6); PG8_BAR;
    }
    for (;;) {
        const bool has_next = S.next(ui + 1, nxt);
        E.prefetch(cur, ui & 1, wid, lane);
        const char* nA = has_next ? (const char*)g.A + (size_t)nxt.pm * tstep : cA; const char* nB = has_next ? (const char*)g.Bt + (size_t)nxt.pn * tstep : cB;
        _Pragma("nounroll") for (int t = 0; t < nt; t += 2) {
            const bool last = (t == nt - 2);
            const char* a1 = cA + (size_t)(t + 1) * kstep;
            const char* a2 = last ? nA : cA + (size_t)(t + 2) * kstep; const char* b2 = last ? nB : cB + (size_t)(t + 2) * kstep;
            const char* a3 = a2 + kstep; const char* b3 = b2 + kstep;
            if (last && has_next) S.a_ready(nxt);
            if constexpr (SP2) {
            PG8_LDB(B0, 0, 0); PG8_LDB(B1, 0, 1); PG8_SCHED; PG8_LDA(At, 0, 0);
            PG8_WAIT_V(6); PG8_WAIT_L(0); PG8_BAR; PG8_MMAI(0, At, PG8_STAGE(PG8_SA(1, 1), a1 + hstep, voffA), (void)0, (void)0); PG8_BAR; PG8_SCHED;
            PG8_LDA(At, 0, 1);
            PG8_WAIT_V(2); PG8_WAIT_L(0); PG8_BAR; PG8_MMAI(1, At, PG8_STAGE(PG8_SB(0, 0), b2, voffB), PG8_STAGE(PG8_SB(0, 1), b2 + hstep, voffB), PG8_STAGE(PG8_SA(0, 0), a2, voffA)); PG8_BAR; PG8_SCHED;
            PG8_LDB(B0, 1, 0); PG8_LDB(B1, 1, 1); PG8_SCHED; PG8_LDA(At, 1, 0);
            PG8_WAIT_V(6); PG8_WAIT_L(0); PG8_BAR; PG8_MMAI(0, At, PG8_STAGE(PG8_SA(0, 1), a2 + hstep, voffA), (void)0, (void)0); PG8_BAR; PG8_SCHED;
            PG8_LDA(At, 1, 1);
            PG8_WAIT_V(2); PG8_WAIT_L(0); PG8_BAR; PG8_MMAI(1, At, PG8_STAGE(PG8_SB(1, 0), b3, voffB), PG8_STAGE(PG8_SB(1, 1), b3 + hstep, voffB), PG8_STAGE(PG8_SA(1, 0), a3, voffA)); PG8_BAR; PG8_SCHED;
            } else {
            PG8_LDB(B0, 0, 0); PG8_SCHED; PG8_LDA(At, 0, 0); PG8_STAGE(PG8_SA(1, 1), a1 + hstep, voffA);
            PG8_WAIT_L(8); PG8_BAR; PG8_WAIT_L(0); PG8_MMA(0, 0, At, B0); PG8_BAR; PG8_SCHED;
            PG8_LDB(B1, 0, 1); PG8_STAGE(PG8_SB(0, 0), b2, voffB);
            PG8_BAR; PG8_WAIT_L(0); PG8_MMA(0, 1, At, B1); PG8_BAR;
            PG8_LDA(At, 0, 1); PG8_STAGE(PG8_SA(0, 0), a2, voffA);
            PG8_BAR; PG8_WAIT_L(0); PG8_MMA(1, 0, At, B0); PG8_BAR; PG8_SCHED;
            PG8_STAGE(PG8_SB(0, 1), b2 + hstep, voffB);
            PG8_WAIT_V(6); PG8_BAR; PG8_MMA(1, 1, At, B1); PG8_BAR;
            PG8_LDB(B0, 1, 0); PG8_SCHED; PG8_LDA(At, 1, 0); PG8_STAGE(PG8_SA(0, 1), a2 + hstep, voffA);
            PG8_WAIT_L(8); PG8_BAR; PG8_WAIT_L(0); PG8_MMA(0, 0, At, B0); PG8_BAR; PG8_SCHED;
            PG8_LDB(B1, 1, 1); PG8_STAGE(PG8_SB(1, 0), b3, voffB);
            PG8_BAR; PG8_WAIT_L(0); PG8_MMA(0, 1, At, B1); PG8_BAR;
            PG8_LDA(At, 1, 1); PG8_STAGE(PG8_SA(1, 0), a3, voffA);
            PG8_BAR; PG8_WAIT_L(0); PG8_MMA(1, 0, At, B0); PG8_BAR; PG8_SCHED;
            PG8_STAGE(PG8_SB(1, 1), b3 + hstep, voffB);
            PG8_WAIT_V(6); PG8_BAR; PG8_MMA(1, 1, At, B1); PG8_BAR;
            }
        }
        if constexpr (ALIGN_EPI) { if (wr == 0) PG8_BAR; }
        asm volatile("s_nop 15\n\ts_nop 15" ::: "memory");
        if constexpr (!Epi::AFTER_DRAIN) { E(acc, cur, wr, wc, fr, fq, ui & 1); S.done(cur); }
        if (!has_next) break;
#pragma unroll
        for (int a = 0; a < 2; ++a)
#pragma unroll
            for (int b = 0; b < 2; ++b)
#pragma unroll
                for (int m = 0; m < 4; ++m)
#pragma unroll
                    for (int n = 0; n < 2; ++n) acc[a][b][m][n] = (f32x4){0.f, 0.f, 0.f, 0.f};
        cur = nxt; cA = nA; cB = nB; ++ui;
        if constexpr (ALIGN_EPI) { if (wr == 1) PG8_BAR; }
    }
    PG8_WAIT_V(0);
    if constexpr (!ALIGN_EPI) { if (wr == 0) PG8_BAR; }
    PG8_BAR;
    if constexpr (Epi::AFTER_DRAIN) { E.fused(acc, cur, wr, wc, fr, fq, lds, wid, lane); S.done(cur); }
#undef PG8_SA
#undef PG8_SB
#undef PG8_STAGE
#undef PG8_LDA
#undef PG8_LDB
#undef PG8_MMA
#ifdef PG8_MMAI
#undef PG8_MMAI
#endif
#undef PG8_MMAI
#undef PG8_WAIT_V
#undef PG8_WAIT_L
#undef PG8_BAR
#undef PG8_SCHED
}

template <class Epi, class Sched, bool ALIGN_EPI = false, bool SP2 = false>
__device__ __forceinline__ void gemm_phase_g8(PG8_LAS unsigned char* lds, const Gemm g, const Sched& S, const Epi& E) {
    int tid_ = threadIdx.x; asm volatile("" : "+v"(tid_));
    const int tid = tid_, wid = __builtin_amdgcn_readfirstlane(tid >> 6), lane = tid & 63, wr = wid >> 2, wc = wid & 3, fr = lane & 15, fq = lane >> 4;
    int sc8 = 0x7F7F7F7F; asm volatile("" : "+v"(sc8));
    const int K = g.K, nt = K / 128;
    unsigned voffA[2], voffB[2];
#pragma unroll
    for (int i = 0; i < 2; ++i) { int R, C; stage_rc(tid * 16 + i * 8192, R, C); const int Rb = Epi::PERM ? ((R & ~31) + perm32(R & 31)) : R;
        voffA[i] = (unsigned)(R * K + C * 2); voffB[i] = (unsigned)(Rb * K + C * 2); }
    const size_t kstep = (size_t)(BK * 2);
    const size_t hstep = (size_t)HALF * K;
    const size_t tstep = 2 * hstep;
    const unsigned ldsw = (unsigned)wid * 1024u;
    const int aoff = lds_byte(wr * 64 + fr, fq * 8), boff = lds_byte(wc * 32 + fr, fq * 8);
#define PG8_SA(b, h) (((b) * 2 + (h)) * HTB)
#define PG8_SB(b, h) ((4 + (b) * 2 + (h)) * HTB)
#define PG8_STAGE(bufoff, gbase, voff) do { _Pragma("unroll") for (int _i = 0; _i < 2; ++_i) \
        __builtin_amdgcn_global_load_lds((const unsigned*)((const char*)(gbase) + (voff)[_i]), (PG8_LAS unsigned*)(lds + (bufoff) + ldsw + _i * 8192), 16, 0, 0); } while (0)
#define PG8_STAGE_A(bufoff, OFF, h, kb) do { _Pragma("unroll") for (int _i = 0; _i < 2; ++_i) \
        __builtin_amdgcn_global_load_lds((const unsigned*)((const char*)g.A + (OFF)[h][_i] + (kb)), (PG8_LAS unsigned*)(lds + (bufoff) + ldsw + _i * 8192), 16, 0, 0); } while (0)
#define PG8_LDA(dst, b, h) do { _Pragma("unroll") for (int m = 0; m < 4; ++m) { const u32x4 lo_ = *(const PG8_LAS u32x4*)(lds + PG8_SA(b, h) + aoff + m * 2048), hi_ = *(const PG8_LAS u32x4*)(lds + PG8_SA(b, h) + aoff + m * 2048 + 1024); \
        dst[m] = (i32x8){(int)lo_.x, (int)lo_.y, (int)lo_.z, (int)lo_.w, (int)hi_.x, (int)hi_.y, (int)hi_.z, (int)hi_.w}; } } while (0)
#define PG8_LDB(dst, b, h) do { _Pragma("unroll") for (int n = 0; n < 2; ++n) { const u32x4 lo_ = *(const PG8_LAS u32x4*)(lds + PG8_SB(b, h) + boff + n * 2048), hi_ = *(const PG8_LAS u32x4*)(lds + PG8_SB(b, h) + boff + n * 2048 + 1024); \
        dst[n] = (i32x8){(int)lo_.x, (int)lo_.y, (int)lo_.z, (int)lo_.w, (int)hi_.x, (int)hi_.y, (int)hi_.z, (int)hi_.w}; } } while (0)
#define PG8_MMA(ai, bj, At, Bt) do { __builtin_amdgcn_s_setprio(1); _Pragma("unroll") for (int m = 0; m < 4; ++m) _Pragma("unroll") for (int n = 0; n < 2; ++n) \
        mfma8(acc[ai][bj][m][n], Bt[n], At[m], sc8); __builtin_amdgcn_s_setprio(0); } while (0)
#define PG8_MMAI(ai, At, ST1, ST2, ST3) do { __builtin_amdgcn_s_setprio(1); \
        mfma8(acc[ai][0][0][0], B0[0], At[0], sc8); mfma8(acc[ai][0][0][1], B0[1], At[0], sc8); __builtin_amdgcn_sched_barrier(0); ST1; __builtin_amdgcn_sched_barrier(0); \
        mfma8(acc[ai][0][1][0], B0[0], At[1], sc8); mfma8(acc[ai][0][1][1], B0[1], At[1], sc8); mfma8(acc[ai][0][2][0], B0[0], At[2], sc8); mfma8(acc[ai][0][2][1], B0[1], At[2], sc8); __builtin_amdgcn_sched_barrier(0); ST2; __builtin_amdgcn_sched_barrier(0); \
        mfma8(acc[ai][0][3][0], B0[0], At[3], sc8); mfma8(acc[ai][0][3][1], B0[1], At[3], sc8); mfma8(acc[ai][1][0][0], B1[0], At[0], sc8); mfma8(acc[ai][1][0][1], B1[1], At[0], sc8); __builtin_amdgcn_sched_barrier(0); ST3; __builtin_amdgcn_sched_barrier(0); \
        mfma8(acc[ai][1][1][0], B1[0], At[1], sc8); mfma8(acc[ai][1][1][1], B1[1], At[1], sc8); mfma8(acc[ai][1][2][0], B1[0], At[2], sc8); mfma8(acc[ai][1][2][1], B1[1], At[2], sc8); \
        mfma8(acc[ai][1][3][0], B1[0], At[3], sc8); mfma8(acc[ai][1][3][1], B1[1], At[3], sc8); __builtin_amdgcn_s_setprio(0); } while (0)
#define PG8_WAIT_V(n) asm volatile("s_waitcnt vmcnt(" #n ")" ::: "memory")
#define PG8_WAIT_L(n) asm volatile("s_waitcnt lgkmcnt(" #n ")" ::: "memory")
#define PG8_BAR __builtin_amdgcn_s_barrier()
#define PG8_SCHED __builtin_amdgcn_sched_barrier(0)
    Unit cur, nxt; int ui = 0;
    if (!S.next(0, cur)) return;
    f32x4 acc[2][2][4][2];
#pragma unroll
    for (int a = 0; a < 2; ++a)
#pragma unroll
        for (int b = 0; b < 2; ++b)
#pragma unroll
            for (int m = 0; m < 4; ++m)
#pragma unroll
                for (int n = 0; n < 2; ++n) acc[a][b][m][n] = (f32x4){0.f, 0.f, 0.f, 0.f};
    i32x8 At[4], B0[2], B1[2];
    const char* cB = (const char*)g.Bt + (size_t)cur.pn * tstep;
    unsigned go[2][2], ngo[2][2]; int Rr[2], Cc[2];
#pragma unroll
    for (int i = 0; i < 2; ++i) stage_rc(tid * 16 + i * 8192, Rr[i], Cc[i]);
#pragma unroll
    for (int h = 0; h < 2; ++h)
#pragma unroll
        for (int i = 0; i < 2; ++i) go[h][i] = (unsigned)S.rowtok(cur, h * HALF + Rr[i]) * (unsigned)K + (unsigned)Cc[i] * 2u;
    S.a_ready(cur);
    if constexpr (SP2) {
        PG8_STAGE(PG8_SB(0, 0), cB, voffB); PG8_STAGE(PG8_SB(0, 1), cB + hstep, voffB); PG8_STAGE_A(PG8_SA(0, 0), go, 0, 0); PG8_STAGE_A(PG8_SA(0, 1), go, 1, 0);
        if (wr == 1) PG8_BAR;
        PG8_WAIT_V(2); PG8_BAR;
        PG8_STAGE(PG8_SB(1, 0), cB + kstep, voffB); PG8_STAGE_A(PG8_SA(1, 0), go, 0, kstep); PG8_STAGE(PG8_SB(1, 1), cB + hstep + kstep, voffB);
        PG8_WAIT_V(6); PG8_BAR;
    } else {
        PG8_STAGE(PG8_SB(0, 0), cB, voffB); PG8_STAGE_A(PG8_SA(0, 0), go, 0, 0); PG8_STAGE(PG8_SB(0, 1), cB + hstep, voffB); PG8_STAGE_A(PG8_SA(0, 1), go, 1, 0);
        if (wr == 1) PG8_BAR;
        PG8_WAIT_V(4); PG8_BAR;
        PG8_STAGE(PG8_SB(1, 0), cB + kstep, voffB); PG8_STAGE_A(PG8_SA(1, 0), go, 0, kstep); PG8_STAGE(PG8_SB(1, 1), cB + hstep + kstep, voffB);
        PG8_WAIT_V(6); PG8_BAR;
    }
    for (;;) {
        const bool has_next = S.next(ui + 1, nxt);
        E.prefetch(cur, ui & 1, wid, lane);
        const char* nB = has_next ? (const char*)g.Bt + (size_t)nxt.pn * tstep : cB;
#pragma unroll
        for (int h = 0; h < 2; ++h)
#pragma unroll
            for (int i = 0; i < 2; ++i) ngo[h][i] = has_next ? (unsigned)S.rowtok(nxt, h * HALF + Rr[i]) * (unsigned)K + (unsigned)Cc[i] * 2u : go[h][i];
        _Pragma("nounroll") for (int t = 0; t < nt; t += 2) {
            const bool last = (t == nt - 2);
            const size_t ka1 = (size_t)(t + 1) * kstep;
            const size_t k2 = last ? 0 : (size_t)(t + 2) * kstep; const char* b2 = last ? nB : cB + (size_t)(t + 2) * kstep;
            unsigned o2[2][2];
#pragma unroll
            for (int h = 0; h < 2; ++h)
#pragma unroll
                for (int i = 0; i < 2; ++i) o2[h][i] = last ? ngo[h][i] : go[h][i];
            const char* b3 = b2 + kstep;
            if (last && has_next) S.a_ready(nxt);
            if constexpr (SP2) {
            PG8_LDB(B0, 0, 0); PG8_LDB(B1, 0, 1); PG8_SCHED; PG8_LDA(At, 0, 0);
            PG8_WAIT_V(6); PG8_WAIT_L(0); PG8_BAR; PG8_MMAI(0, At, PG8_STAGE_A(PG8_SA(1, 1), go, 1, ka1), (void)0, (void)0); PG8_BAR; PG8_SCHED;
            PG8_LDA(At, 0, 1);
            PG8_WAIT_V(2); PG8_WAIT_L(0); PG8_BAR; PG8_MMAI(1, At, PG8_STAGE(PG8_SB(0, 0), b2, voffB), PG8_STAGE(PG8_SB(0, 1), b2 + hstep, voffB), PG8_STAGE_A(PG8_SA(0, 0), o2, 0, k2)); PG8_BAR; PG8_SCHED;
            PG8_LDB(B0, 1, 0); PG8_LDB(B1, 1, 1); PG8_SCHED; PG8_LDA(At, 1, 0);
            PG8_WAIT_V(6); PG8_WAIT_L(0); PG8_BAR; PG8_MMAI(0, At, PG8_STAGE_A(PG8_SA(0, 1), o2, 1, k2), (void)0, (void)0); PG8_BAR; PG8_SCHED;
            PG8_LDA(At, 1, 1);
            PG8_WAIT_V(2); PG8_WAIT_L(0); PG8_BAR; PG8_MMAI(1, At, PG8_STAGE(PG8_SB(1, 0), b3, voffB), PG8_STAGE(PG8_SB(1, 1), b3 + hstep, voffB), PG8_STAGE_A(PG8_SA(1, 0), o2, 0, k2 + kstep)); PG8_BAR; PG8_SCHED;
            } else {
            PG8_LDB(B0, 0, 0); PG8_SCHED; PG8_LDA(At, 0, 0); PG8_STAGE_A(PG8_SA(1, 1), go, 1, ka1);
            PG8_WAIT_L(8); PG8_BAR; PG8_WAIT_L(0); PG8_MMA(0, 0, At, B0); PG8_BAR; PG8_SCHED;
            PG8_LDB(B1, 0, 1); PG8_STAGE(PG8_SB(0, 0), b2, voffB);
            PG8_BAR; PG8_WAIT_L(0); PG8_MMA(0, 1, At, B1); PG8_BAR;
            PG8_LDA(At, 0, 1); PG8_STAGE_A(PG8_SA(0, 0), o2, 0, k2);
            PG8_BAR; PG8_WAIT_L(0); PG8_MMA(1, 0, At, B0); PG8_BAR; PG8_SCHED;
            PG8_STAGE(PG8_SB(0, 1), b2 + hstep, voffB);
            PG8_WAIT_V(6); PG8_BAR; PG8_MMA(1, 1, At, B1); PG8_BAR;
            PG8_LDB(B0, 1, 0); PG8_SCHED; PG8_LDA(At, 1, 0); PG8_STAGE_A(PG8_SA(0, 1), o2, 1, k2);
            PG8_WAIT_L(8); PG8_BAR; PG8_WAIT_L(0); PG8_MMA(0, 0, At, B0); PG8_BAR; PG8_SCHED;
            PG8_LDB(B1, 1, 1); PG8_STAGE(PG8_SB(1, 0), b3, voffB);
            PG8_BAR; PG8_WAIT_L(0); PG8_MMA(0, 1, At, B1); PG8_BAR;
            PG8_LDA(At, 1, 1); PG8_STAGE_A(PG8_SA(1, 0), o2, 0, k2 + kstep);
            PG8_BAR; PG8_WAIT_L(0); PG8_MMA(1, 0, At, B0); PG8_BAR; PG8_SCHED;
            PG8_STAGE(PG8_SB(1, 1), b3 + hstep, voffB);
            PG8_WAIT_V(6); PG8_BAR; PG8_MMA(1, 1, At, B1); PG8_BAR;
            }
        }
        if constexpr (ALIGN_EPI) { if (wr == 0) PG8_BAR; }
        asm volatile("s_nop 15\n\ts_nop 15" ::: "memory");
        if constexpr (!Epi::AFTER_DRAIN) { E(acc, cur, wr, wc, fr, fq, ui & 1); S.done(cur); }
        if (!has_next) break;
#pragma unroll
        for (int a = 0; a < 2; ++a)
#pragma unroll
            for (int b = 0; b < 2; ++b)
#pragma unroll
                for (int m = 0; m < 4; ++m)
#pragma unroll
                    for (int n = 0; n < 2; ++n) acc[a][b][m][n] = (f32x4){0.f, 0.f, 0.f, 0.f};
        cur = nxt; cB = nB; ++ui;
#pragma unroll
        for (int h = 0; h < 2; ++h)
#pragma unroll
            for (int i = 0; i < 2; ++i) go[h][i] = ngo[h][i];
        if constexpr (ALIGN_EPI) { if (wr == 1) PG8_BAR; }
    }
    PG8_WAIT_V(0);
    if constexpr (!ALIGN_EPI) { if (wr == 0) PG8_BAR; }
    PG8_BAR;
    if constexpr (Epi::AFTER_DRAIN) { E.fused(acc, cur, wr, wc, fr, fq, lds, wid, lane); S.done(cur); }
#undef PG8_SA
#undef PG8_SB
#undef PG8_STAGE
#undef PG8_STAGE_A
#undef PG8_LDA
#undef PG8_LDB
#undef PG8_MMA
#ifdef PG8_MMAI
#undef PG8_MMAI
#endif
#undef PG8_MMAI
#undef PG8_WAIT_V
#undef PG8_WAIT_L
#undef PG8_BAR
#undef PG8_SCHED
}


}
constexpr int NB = 8, S = 4096, D = 1024, NTOK = NB * S, NL = 2, NE = 32, PW = 2816, INW = 2706;
constexpr int MAXROWS = NTOK * 4 + NE * 256, MAXTILES = MAXROWS / 256;
constexpr float RMS_EPS = 1e-6f;
constexpr int C_QA = 0, C_KA = 256, C_VA = 512, C_QB = 768, C_KVB = 1152, C_QC = 1536, C_KC = 1920, C_VC = 2304, C_GB = 2688;
constexpr int NWAVES = 8;
constexpr size_t MiB = 1u << 20;
constexpr size_t WS_CTL = 0, CTL_ZERO_BYTES = 1 * MiB;
constexpr size_t WS_ROPE = 1 * MiB;
constexpr size_t WS_MOD = 1 * MiB + 512 * 1024;
constexpr size_t WS_KMEAN = 2 * MiB;
constexpr size_t WS_KC = 2 * MiB + 256 * 1024, WS_VC = 2 * MiB + 768 * 1024;
constexpr size_t WS_ASG_E = 4 * MiB, WS_ASG_POS = 4 * MiB + 512 * 1024, WS_ASG_GATE = 5 * MiB, WS_ASG_ROW = 5 * MiB + 512 * 1024;
constexpr size_t WS_SELM = 6 * MiB, WS_KCB = 6 * MiB + 512 * 1024, WS_VCB = 7 * MiB;
constexpr size_t WS_WIN = 8 * MiB;
constexpr size_t WS_WOUT = 20 * MiB;
constexpr size_t WS_CW1T = 28 * MiB, WS_CW2T = 29 * MiB, WS_CCONST = 29 * MiB + 64 * 1024;
constexpr size_t WS_RWT = 29 * MiB + 128 * 1024, WS_RCONST = 31 * MiB + 512 * 1024;
constexpr size_t WS_LIST = 24 * MiB;
constexpr size_t WS_WGU = 32 * MiB;
constexpr size_t WS_WDN = 288 * MiB;
constexpr size_t WS_ACT = 416 * MiB;
constexpr size_t WS_PROJ = 480 * MiB;
constexpr size_t WS_O = 656 * MiB;
constexpr size_t WS_Y = 720 * MiB;
constexpr size_t WS_X1 = 784 * MiB;
constexpr size_t WS_SA = 912 * MiB;
constexpr size_t WS_SACT = 1184 * MiB;
constexpr size_t WS_OCP = 1456 * MiB;
constexpr size_t WS_ACT8 = 1484 * MiB;
constexpr size_t WS_OSS = 1516 * MiB;
constexpr size_t WS_LGATE = 1518 * MiB;
constexpr size_t WS_RW3 = 1522 * MiB;
constexpr size_t WS_END = 1526 * MiB;
static_assert(WS_SA + (size_t)MAXROWS * D * 2 <= WS_SACT && WS_SACT + (size_t)MAXROWS * D * 2 <= WS_END, "ws map");
constexpr int CW_TMO = 0, CW_CODE = 1, CW_CNT = 1024, CW_WQ = 2048, CW_BAR = 4096;
constexpr int NPHASE = 21, MAX_LAUNCHES = 21;
constexpr int RING_BYTES = 131072, LDSCTL_OFF = RING_BYTES, MISC_OFF = LDSCTL_OFF + 320, TAB_OFF = LDSCTL_OFF + 512;
constexpr int LDS_BYTES = 147456;
#define GAS __attribute__((address_space(1)))
#define LAS __attribute__((address_space(3)))
typedef unsigned short bf16;
typedef unsigned v4u __attribute__((ext_vector_type(4)));
typedef unsigned v2u __attribute__((ext_vector_type(2)));
typedef float f32x4 __attribute__((ext_vector_type(4)));
typedef GAS unsigned gu32;
#define RLX_AGENT __ATOMIC_RELAXED, __HIP_MEMORY_SCOPE_AGENT
#define LDS_WAIT() asm volatile("s_waitcnt lgkmcnt(0)" ::: "memory")
#define VM_WAIT() asm volatile("s_waitcnt vmcnt(0)" ::: "memory")
__device__ __forceinline__ unsigned f2bf(float f) { unsigned u = __builtin_bit_cast(unsigned, f); return (u + 0x7fffu + ((u >> 16) & 1u)) >> 16; }
__device__ __forceinline__ unsigned pk2(float lo, float hi) { return pg8::cvt_pk_bf16(lo, hi); }
__device__ __forceinline__ float bflo(unsigned v) { return __builtin_bit_cast(float, v << 16); }
__device__ __forceinline__ float bfhi(unsigned v) { return __builtin_bit_cast(float, v & 0xffff0000u); }
__device__ __forceinline__ float bf1(bf16 v) { return __builtin_bit_cast(float, (unsigned)v << 16); }
#define XB_TMO      128
#define XB_XCNT(j)  (256  + 64 * (j))
#define XB_XSUB(j)  (1280 + 64 * (j))
#define XB_XGEN(j)  (2304 + 64 * (j))
#define XB_TOP      3328
#define XB_TOPGEN   3392
#define XCD_BAR_WORDS 3456
#define XB_SPIN_CAP (1u << 18)

__device__ __forceinline__ unsigned xb_ld(unsigned* p)              { return __hip_atomic_load(p, __ATOMIC_RELAXED, __HIP_MEMORY_SCOPE_AGENT); }
__device__ __forceinline__ unsigned xb_add(unsigned* p, unsigned v) { return __hip_atomic_fetch_add(p, v, __ATOMIC_RELAXED, __HIP_MEMORY_SCOPE_AGENT); }
__device__ __forceinline__ unsigned xb_xcc_id() { return (unsigned)__builtin_amdgcn_s_getreg((3 << 11) | 20) & 0xFu; }
#define XB_SPIN(cond, bar) do { unsigned _sp = 0; while (cond) { __builtin_amdgcn_s_sleep(1); \
    if ((++_sp & 255u) == 0u) { if (xb_ld(&(bar)[XB_TMO])) break; if (_sp > XB_SPIN_CAP) { atomicAdd(&(bar)[XB_TMO], 1u); break; } } } } while (0)

struct XcdBarrier {
    unsigned* bar; unsigned x;
    volatile LAS unsigned* st;
};

__device__ __forceinline__ XcdBarrier xcd_barrier_post(unsigned* bar, volatile LAS unsigned* st) {
    XcdBarrier b; b.bar = bar; b.x = xb_xcc_id(); b.st = st;
    if (threadIdx.x == 0) (void)xb_add(&bar[XB_XCNT(b.x)], 1u);
    return b;
}
__device__ __forceinline__ void xcd_barrier_complete(unsigned* bar, unsigned x, unsigned& nloc, unsigned& nx) {
    const unsigned G = gridDim.x * gridDim.y * gridDim.z;
    unsigned sum, cnt, mine, sp = 0u;
    for (;;) {
        sum = 0u; cnt = 0u; mine = 0u;
#pragma unroll
        for (unsigned j = 0; j < 16; ++j) { const unsigned c = xb_ld(&bar[XB_XCNT(j)]); sum += c; cnt += (c > 0u) ? 1u : 0u; mine = (j == x) ? c : mine; }
        if (sum == G) break;
        __builtin_amdgcn_s_sleep(1);
        if ((++sp & 255u) == 0u) { if (xb_ld(&bar[XB_TMO])) break; if (sp > XB_SPIN_CAP) { atomicAdd(&bar[XB_TMO], 1u); break; } }
    }
    nloc = mine > 0u ? mine : 1u; nx = cnt > 0u ? cnt : 1u;
}

__device__ __forceinline__ void xcd_barrier(const XcdBarrier& b) {
    asm volatile("s_waitcnt vmcnt(0)" ::: "memory");
    __syncthreads();
    if (threadIdx.x == 0) {
        unsigned* bar = b.bar;
        __builtin_amdgcn_s_waitcnt(0);
        unsigned nloc = b.st[0], nx = b.st[1];
        if (nloc == 0u) { xcd_barrier_complete(bar, b.x, nloc, nx); b.st[0] = nloc; b.st[1] = nx; }
        const unsigned old = xb_add(&bar[XB_XSUB(b.x)], 1u);
        const unsigned gen = old / nloc;
        if (old + 1u == (gen + 1u) * nloc) {
            __builtin_amdgcn_fence(__ATOMIC_RELEASE, "agent");
            asm volatile("s_waitcnt vmcnt(0)" ::: "memory");
            const unsigned og = xb_add(&bar[XB_TOP], 1u);
            const unsigned tg = og / nx;
            if (og + 1u == (tg + 1u) * nx) xb_add(&bar[XB_TOPGEN], 1u);
            else XB_SPIN(xb_ld(&bar[XB_TOPGEN]) == tg, bar);
            __builtin_amdgcn_fence(__ATOMIC_ACQUIRE, "agent");
            xb_add(&bar[XB_XGEN(b.x)], 1u);
            asm volatile("s_waitcnt vmcnt(0)" ::: "memory");
        } else {
            XB_SPIN(xb_ld(&bar[XB_XGEN(b.x)]) == gen, bar);
            __builtin_amdgcn_fence(__ATOMIC_ACQUIRE, "agent");
            asm volatile("s_waitcnt vmcnt(0)" ::: "memory");
        }
    }
    __syncthreads();
}
struct Args { const float* in[17]; float* out; unsigned char* ws; int ph_lo, ph_hi, li, pad; };
struct Frame {
    LAS unsigned char* lds;
    volatile LAS unsigned* MISC;
    gu32* ctl;
    int tid, lane, wave, vcu, G;
    gu32* qctr; unsigned tk;
};
#define F_x (A.in[0])
#define F_c (A.in[1])
#define F_ada_w (A.in[2])
#define F_ada_b (A.in[3])
#define F_norm_g (A.in[4])
#define F_w_in (A.in[5])
#define F_cmp_pe (A.in[6])
#define F_cmp_w1 (A.in[7])
#define F_cmp_w2 (A.in[8])
#define F_mix_g (A.in[9])
#define F_w_out (A.in[10])
#define F_router_w (A.in[11])
#define F_router_b (A.in[12])
#define F_w_gu (A.in[13])
#define F_b_gu (A.in[14])
#define F_w_dn (A.in[15])
#define F_b_dn (A.in[16])
#define F_out (A.out)
#define F_oss ((float*)(A.ws + WS_OSS))
#define F_x1b ((bf16*)(A.ws + WS_X1))
#define F_xmid ((bf16*)(A.ws + WS_X1 + (size_t)64 * MiB))
#define F_yt8 ((unsigned char*)(A.ws + WS_SA))
#define F_Wgu8 ((unsigned char*)(A.ws + WS_WGU))
#define F_Wdn8 ((unsigned char*)(A.ws + WS_WDN))
#define F_act8 ((unsigned char*)(A.ws + WS_ACT8))
#define F_sact8 ((unsigned char*)(A.ws + WS_SACT))
#define F_rwT ((float*)(A.ws + WS_RWT))
#define F_rw3 ((unsigned short*)(A.ws + WS_RW3))
#define F_rconst ((float*)(A.ws + WS_RCONST))
#define F_ocp ((bf16*)(A.ws + WS_OCP))
#define F_cw1T ((bf16*)(A.ws + WS_CW1T))
#define F_cw2T ((bf16*)(A.ws + WS_CW2T))
#define F_cconst ((float*)(A.ws + WS_CCONST))
#define F_list ((int*)(A.ws + WS_LIST))
#define F_lgate ((float*)(A.ws + WS_LGATE))
#define F_selm ((unsigned*)(A.ws + WS_SELM))
#define F_kcb ((bf16*)(A.ws + WS_KCB))
#define F_vcb ((bf16*)(A.ws + WS_VCB))
#define F_ropec ((float*)(A.ws + WS_ROPE))
#define F_ropes ((float*)(A.ws + WS_ROPE + (size_t)S * 8 * 4))
#define F_mod ((float*)(A.ws + WS_MOD))
#define F_kmean ((float*)(A.ws + WS_KMEAN))
#define F_kc ((float*)(A.ws + WS_KC))
#define F_vc ((float*)(A.ws + WS_VC))
#define F_x1 ((float*)(A.ws + WS_X1))
#define F_asg_gate ((float*)(A.ws + WS_ASG_GATE))
#define F_asg_e ((int*)(A.ws + WS_ASG_E))
#define F_asg_pos ((int*)(A.ws + WS_ASG_POS))
#define F_asg_row ((int*)(A.ws + WS_ASG_ROW))
#define F_WinT ((bf16*)(A.ws + WS_WIN))
#define F_WoutT ((bf16*)(A.ws + WS_WOUT))
#define F_WguT ((bf16*)(A.ws + WS_WGU))
#define F_WdnT ((bf16*)(A.ws + WS_WDN))
#define F_act ((bf16*)(A.ws + WS_ACT))
#define F_proj ((bf16*)(A.ws + WS_PROJ))
#define F_o ((bf16*)(A.ws + WS_O))
#define F_y ((bf16*)(A.ws + WS_Y))
#define F_sa ((bf16*)(A.ws + WS_SA))
#define F_sact ((bf16*)(A.ws + WS_SACT))

template <int CTRL> __device__ __forceinline__ float dpp_mov(float v) { return __builtin_bit_cast(float, __builtin_amdgcn_update_dpp(0, __builtin_bit_cast(int, v), CTRL, 0xF, 0xF, true)); }
__device__ __forceinline__ float rdl(float v, int l) { return __builtin_bit_cast(float, __builtin_amdgcn_readlane(__builtin_bit_cast(int, v), l)); }
__device__ __forceinline__ float wave_sum(float v) {
    v += dpp_mov<0xB1>(v); v += dpp_mov<0x4E>(v); v += dpp_mov<0x124>(v); v += dpp_mov<0x128>(v);
    return (rdl(v, 0) + rdl(v, 16)) + (rdl(v, 32) + rdl(v, 48));
}
__device__ __forceinline__ float wave_max(float v) {
#pragma unroll
    for (int o = 1; o < 64; o <<= 1) v = fmaxf(v, __shfl_xor(v, o));
    return v;
}
__device__ __forceinline__ void wave_argmax(float& v, int& i) {
#pragma unroll
    for (int o = 32; o >= 1; o >>= 1) { const float ov = __shfl_xor(v, o); const int oi = __shfl_xor(i, o); if (ov > v || (ov == v && oi < i)) { v = ov; i = oi; } }
}
__device__ __forceinline__ void loadq(float (&q)[64], const bf16* qp) {
    const v4u* p = (const v4u*)qp;
#pragma unroll
    for (int c = 0; c < 8; ++c) { const v4u v = p[c]; q[8*c+0] = bflo(v.x); q[8*c+1] = bfhi(v.x); q[8*c+2] = bflo(v.y); q[8*c+3] = bfhi(v.y); q[8*c+4] = bflo(v.z); q[8*c+5] = bfhi(v.z); q[8*c+6] = bflo(v.w); q[8*c+7] = bfhi(v.w); }
}
__device__ __forceinline__ float dot64(const float (&q)[64], const bf16* kp) {
    const v4u* p = (const v4u*)kp; float s = 0.f;
#pragma unroll
    for (int c = 0; c < 8; ++c) { const v4u v = p[c];
        s += q[8*c+0] * bflo(v.x); s += q[8*c+1] * bfhi(v.x); s += q[8*c+2] * bflo(v.y); s += q[8*c+3] * bfhi(v.y);
        s += q[8*c+4] * bflo(v.z); s += q[8*c+5] * bfhi(v.z); s += q[8*c+6] * bflo(v.w); s += q[8*c+7] * bfhi(v.w); }
    return s;
}
__device__ __forceinline__ float dot64l(const float (&q)[64], const LAS float* kp) {
    const LAS f32x4* p = (const LAS f32x4*)kp; float s = 0.f;
#pragma unroll
    for (int c = 0; c < 16; ++c) { const f32x4 v = p[c]; s += q[4*c+0] * v.x; s += q[4*c+1] * v.y; s += q[4*c+2] * v.z; s += q[4*c+3] * v.w; }
    return s;
}
__device__ __forceinline__ float dot64f(const float (&q)[64], const float* kp) {
    const f32x4* p = (const f32x4*)kp; float s = 0.f;
#pragma unroll
    for (int c = 0; c < 16; ++c) { const f32x4 v = p[c]; s += q[4*c+0] * v.x; s += q[4*c+1] * v.y; s += q[4*c+2] * v.z; s += q[4*c+3] * v.w; }
    return s;
}
__device__ __forceinline__ void acc8(float (&a)[8], float p, const v4u v) {
    a[0] += p * bflo(v.x); a[1] += p * bfhi(v.x); a[2] += p * bflo(v.y); a[3] += p * bfhi(v.y); a[4] += p * bflo(v.z); a[5] += p * bfhi(v.z); a[6] += p * bflo(v.w); a[7] += p * bfhi(v.w);
}
__device__ __forceinline__ void red8(float (&a)[8]) {
#pragma unroll
    for (int j = 0; j < 8; ++j) { a[j] += __shfl_xor(a[j], 8); a[j] += __shfl_xor(a[j], 16); a[j] += __shfl_xor(a[j], 32); }
}
__device__ __forceinline__ void list_attn(const float (&q)[64], int n, LAS float* P, const LAS int* KR, const bf16* Kb, const bf16* Vb, int lane, float (&o)[8]) {
    float mx = -3e38f;
    for (int i = lane; i < n; i += 64) { const float s = dot64(q, Kb + (size_t)KR[i] * PW) * 0.125f; P[i] = s; mx = fmaxf(mx, s); }
    mx = wave_max(mx);
    float sum = 0.f;
    for (int i = lane; i < n; i += 64) { const float e = __expf(P[i] - mx); P[i] = e; sum += e; }
    sum = wave_sum(sum);
    const float inv = (n > 0) ? 1.f / sum : 0.f;
    LDS_WAIT();
    const int kg = lane >> 3, dg = lane & 7;
    float a[8];
#pragma unroll
    for (int j = 0; j < 8; ++j) a[j] = 0.f;
    for (int i = kg; i < n; i += 8) { const float p = P[i]; const v4u v = *(const v4u*)(Vb + (size_t)KR[i] * PW + dg * 8); acc8(a, p, v); }
    red8(a);
#pragma unroll
    for (int j = 0; j < 8; ++j) o[j] = a[j] * inv;
    LDS_WAIT();
}
__device__ __forceinline__ float sigmoidf_(float v) { return 1.f / (1.f + __expf(-v)); }
template <class RM> __device__ __forceinline__ void tr_item(const float* W, int K, int N, bf16* WT, LAS float* scr, int kb, int nb, int lane, RM rm) {
    const int k0 = 64 * kb, n0 = 32 * nb; const int n = n0 + (lane & 31);
#pragma unroll 8
    for (int i = 0; i < 32; ++i) { const int kk = 2 * i + (lane >> 5); scr[kk * 33 + (lane & 31)] = (n < N) ? W[(size_t)(k0 + kk) * N + n] : 0.f; }
    LDS_WAIT(); asm volatile("" ::: "memory");
    const int c = lane & 7;
#pragma unroll
    for (int j = 0; j < 4; ++j) { const int nn = (lane >> 3) + 8 * j; const LAS float* s = scr + (8 * c) * 33 + nn;
        v4u o; o.x = pk2(s[0 * 33], s[1 * 33]); o.y = pk2(s[2 * 33], s[3 * 33]); o.z = pk2(s[4 * 33], s[5 * 33]); o.w = pk2(s[6 * 33], s[7 * 33]);
        if (n0 + nn < N) *(v4u*)(WT + (size_t)rm(n0 + nn) * K + k0 + 8 * c) = o; }
    LDS_WAIT(); asm volatile("" ::: "memory");
}
template <class RM> __device__ __forceinline__ void tr_item64(const float* W, int K, int N, bf16* WT, LAS float* scr, int kb, int nb, int lane, RM rm, const float* kgain = nullptr) {
    const int k0 = 64 * kb, n0 = 64 * nb; const float* src = W + (size_t)(k0 + (lane >> 4)) * N + n0 + (lane & 15) * 4;
    f32x4 v[16];
#pragma unroll
    for (int i = 0; i < 16; ++i) v[i] = *(const f32x4*)(src + (size_t)(4 * i) * N);
#pragma unroll
    for (int i = 0; i < 16; ++i) *(LAS f32x4*)(scr + ((lane >> 4) + 4 * i) * 64 + (lane & 15) * 4) = v[i];
    LDS_WAIT(); asm volatile("" ::: "memory");
#pragma unroll
    for (int j = 0; j < 2; ++j)
#pragma unroll
        for (int c = 0; c < 4; ++c) { const int n = (lane & 31) + 32 * j, kc = (lane >> 5) + 2 * c; const LAS float* s = scr + (8 * kc) * 64 + n;
            f32x4 g0 = {1.f, 1.f, 1.f, 1.f}, g1 = g0; if (kgain) { g0 = *(const f32x4*)(kgain + k0 + 8 * kc); g1 = *(const f32x4*)(kgain + k0 + 8 * kc + 4); }
            v4u o; o.x = pk2(s[0 * 64] * g0.x, s[1 * 64] * g0.y); o.y = pk2(s[2 * 64] * g0.z, s[3 * 64] * g0.w); o.z = pk2(s[4 * 64] * g1.x, s[5 * 64] * g1.y); o.w = pk2(s[6 * 64] * g1.z, s[7 * 64] * g1.w);
            *(v4u*)(WT + (size_t)rm(n0 + n) * K + k0 + 8 * kc) = o; }
    LDS_WAIT(); asm volatile("" ::: "memory");
}
template <class RM> __device__ __forceinline__ void tr_item64_f8(const float* W, int K, int N, unsigned char* WT, LAS float* scr, int kb, int nb, int lane, RM rm) {
    const int k0 = 64 * kb, n0 = 64 * nb; const float* src = W + (size_t)(k0 + (lane >> 4)) * N + n0 + (lane & 15) * 4;
    f32x4 v[16];
#pragma unroll
    for (int i = 0; i < 16; ++i) v[i] = __builtin_nontemporal_load((const f32x4*)(src + (size_t)(4 * i) * N));
#pragma unroll
    for (int i = 0; i < 16; ++i) *(LAS f32x4*)(scr + ((lane >> 4) + 4 * i) * 64 + (lane & 15) * 4) = v[i];
    LDS_WAIT(); asm volatile("" ::: "memory");
    v2u o[2][4];
#pragma unroll
    for (int j = 0; j < 2; ++j)
#pragma unroll
        for (int c = 0; c < 4; ++c) { const int n = (lane & 31) + 32 * j, kc = (lane >> 5) + 2 * c; const LAS float* s = scr + (8 * kc) * 64 + n;
            o[j][c].x = pg8::pk4_fp8(s[0 * 64] * pg8::W8_SCALE, s[1 * 64] * pg8::W8_SCALE, s[2 * 64] * pg8::W8_SCALE, s[3 * 64] * pg8::W8_SCALE);
            o[j][c].y = pg8::pk4_fp8(s[4 * 64] * pg8::W8_SCALE, s[5 * 64] * pg8::W8_SCALE, s[6 * 64] * pg8::W8_SCALE, s[7 * 64] * pg8::W8_SCALE); }
    LDS_WAIT(); asm volatile("" ::: "memory");
    LAS unsigned char* ob = (LAS unsigned char*)scr;
#pragma unroll
    for (int j = 0; j < 2; ++j)
#pragma unroll
        for (int c = 0; c < 4; ++c) { const int n = (lane & 31) + 32 * j, kc = (lane >> 5) + 2 * c; *(LAS v2u*)(ob + n * 80 + kc * 8) = o[j][c]; }
    LDS_WAIT(); asm volatile("" ::: "memory");
#pragma unroll
    for (int r = 0; r < 4; ++r) { const int row = (lane >> 2) + 16 * r, ch = lane & 3; const v4u w = *(const LAS v4u*)(ob + row * 80 + ch * 16);
        *(v4u*)(WT + (size_t)rm(n0 + row) * K + k0 + ch * 16) = w; }
    LDS_WAIT(); asm volatile("" ::: "memory");
}
template <class RM> __device__ __forceinline__ void tr_item128_f8(const float* W, int K, int N, unsigned char* WT, LAS float* scr, int kb, int nb, int lane, RM rm) {
    const int k0 = 128 * kb, n0 = 32 * nb; const float* src = W + (size_t)(k0 + (lane >> 3)) * N + n0 + (lane & 7) * 4;
    f32x4 v[16];
#pragma unroll
    for (int i = 0; i < 16; ++i) v[i] = __builtin_nontemporal_load((const f32x4*)(src + (size_t)(8 * i) * N));
#pragma unroll
    for (int i = 0; i < 16; ++i) *(LAS f32x4*)(scr + ((lane >> 3) + 8 * i) * 32 + (lane & 7) * 4) = v[i];
    LDS_WAIT(); asm volatile("" ::: "memory");
    v2u o[8];
#pragma unroll
    for (int c = 0; c < 8; ++c) { const int n = lane & 31, kc = (lane >> 5) + 2 * c; const LAS float* s = scr + (8 * kc) * 32 + n;
        o[c].x = pg8::pk4_fp8(s[0 * 32] * pg8::W8_SCALE, s[1 * 32] * pg8::W8_SCALE, s[2 * 32] * pg8::W8_SCALE, s[3 * 32] * pg8::W8_SCALE);
        o[c].y = pg8::pk4_fp8(s[4 * 32] * pg8::W8_SCALE, s[5 * 32] * pg8::W8_SCALE, s[6 * 32] * pg8::W8_SCALE, s[7 * 32] * pg8::W8_SCALE); }
    LDS_WAIT(); asm volatile("" ::: "memory");
    LAS unsigned char* ob = (LAS unsigned char*)scr;
#pragma unroll
    for (int c = 0; c < 8; ++c) { const int n = lane & 31, kc = (lane >> 5) + 2 * c; *(LAS v2u*)(ob + n * 144 + kc * 8) = o[c]; }
    LDS_WAIT(); asm volatile("" ::: "memory");
#pragma unroll
    for (int r = 0; r < 4; ++r) { const int row = (lane >> 3) + 8 * r, ch = lane & 7; const v4u w = *(const LAS v4u*)(ob + row * 144 + ch * 16);
        *(v4u*)(WT + (size_t)rm(n0 + row) * K + k0 + ch * 16) = w; }
    LDS_WAIT(); asm volatile("" ::: "memory");
}
struct RmId { __device__ __forceinline__ int operator()(int n) const { return n; } };
struct RmDn { __device__ __forceinline__ int operator()(int n) const { const int c = n & 255; return (n & ~255) + ((c >> 3) & 1) * 128 + (c >> 6) * 32 + ((c >> 4) & 3) * 8 + (c & 7); } };
struct RmWin { __device__ __forceinline__ int operator()(int n) const { return n < 1536 ? n : (n < 1554 ? C_GB + (n - 1536) : n - 18); } };
struct RmGu { __device__ __forceinline__ int operator()(int n) const { const int h = n >> 10, r = n & 1023; return (r >> 7) * 256 + h * 128 + (r & 127); } };

__device__ __forceinline__ void p0_prologue(Frame& F, const Args& A) {
    LAS float* scr = (LAS float*)(F.lds + F.wave * 16384);
    const int gw = F.vcu * NWAVES + F.wave, NGW = F.G * NWAVES, lane = F.lane;
    constexpr int I_GU = NL * NE * 16 * 32, I_DN = NL * NE * 16 * 16, I_IN = NL * 16 * 85, I_OUT = NL * 16 * 16, I_MOD = NL * 96, I_C1 = NL * 2 * 32 * 2, I_C2 = NL * 2 * 2, I_CC = NL * 2 * 16;
    constexpr int NITEMS = I_GU + I_DN + I_IN + I_OUT + I_C1 + I_C2;
    for (int wi = F.vcu; wi < I_MOD + I_CC; wi += F.G) {
        LAS float* red = (LAS float*)F.lds;
        if (wi < I_MOD) {
            const int l = wi / 96, cb = (wi % 96) * 64, col = cb + lane; const float* w = F_ada_w + (size_t)l * D * 6 * D + col;
            float a[NB];
#pragma unroll
            for (int b = 0; b < NB; ++b) a[b] = 0.f;
#pragma unroll 1
            for (int k0 = 128 * F.wave; k0 < 128 * F.wave + 128; k0 += 64) {
                float wv[64]; float sv[8];
#pragma unroll
                for (int kk = 0; kk < 64; ++kk) wv[kk] = w[(size_t)(k0 + kk) * 6 * D];
#pragma unroll
                for (int g = 0; g < 8; ++g) { const float cv = F_c[(lane >> 3) * D + k0 + 8 * g + (lane & 7)]; sv[g] = cv / (1.f + __expf(-cv)); }
#pragma unroll
                for (int g = 0; g < 8; ++g)
#pragma unroll
                    for (int kk = 0; kk < 8; ++kk)
#pragma unroll
                        for (int b = 0; b < NB; ++b) a[b] += __builtin_bit_cast(float, __builtin_amdgcn_readlane(__builtin_bit_cast(int, sv[g]), b * 8 + kk)) * wv[8 * g + kk]; }
#pragma unroll
            for (int b = 0; b < NB; ++b) red[(F.wave * NB + b) * 64 + lane] = a[b];
            __syncthreads();
            { const int b = F.tid >> 6; float t = 0.f;
#pragma unroll
              for (int w8 = 0; w8 < 8; ++w8) t += red[(w8 * NB + b) * 64 + lane];
              F_mod[((size_t)l * NB + b) * 6 * D + col] = t + F_ada_b[l * 6 * D + col]; }
            __syncthreads();
        } else {
            const int r = wi - I_MOD, lw = r >> 4, part = r & 15; const float* pe = F_cmp_pe + (size_t)lw * 2048 + part * 128 + 16 * F.wave; const float* w1 = F_cmp_w1 + ((size_t)lw * 2048 + part * 128 + 16 * F.wave) * 64 + lane; float a = 0.f;
#pragma unroll
            for (int k = 0; k < 16; ++k) a += pe[k] * w1[(size_t)k * 64];
            red[F.wave * 64 + lane] = a;
            __syncthreads();
            if (F.tid < 64) { float t = 0.f;
#pragma unroll
              for (int w8 = 0; w8 < 8; ++w8) t += red[w8 * 64 + lane];
              F_cconst[(size_t)r * 64 + lane] = t; }
            __syncthreads();
        }
    }
    for (int it = gw; it < NITEMS; it += NGW) {
        int r = it;
        if (r < I_GU) { const int le = r >> 9, q = r & 511; tr_item128_f8(F_w_gu + (size_t)le * D * 2048, D, 2048, F_Wgu8 + (size_t)le * 2048 * D, scr, q >> 6, q & 63, lane, RmGu()); continue; } r -= I_GU;
        if (r < I_DN) { const int le = r >> 8, q = r & 255; tr_item128_f8(F_w_dn + (size_t)le * D * D, D, D, F_Wdn8 + (size_t)le * D * D, scr, q >> 5, q & 31, lane, RmDn()); continue; } r -= I_DN;
        if (r < I_IN) { const int l = r / (16 * 85), q = r % (16 * 85); tr_item(F_w_in + (size_t)l * D * INW, D, INW, F_WinT + (size_t)l * PW * D, scr, q / 85, q % 85, lane, RmWin()); continue; } r -= I_IN;
        if (r < I_OUT) { const int l = r >> 8, q = r & 255; tr_item64(F_w_out + (size_t)l * D * D, D, D, F_WoutT + (size_t)l * D * D, scr, q >> 4, q & 15, lane, RmId(), F_mix_g + (size_t)l * D); continue; } r -= I_OUT;
        if (r < I_C1) { const int lw = r >> 6, q = r & 63; tr_item(F_cmp_w1 + (size_t)lw * 2048 * 64, 2048, 64, F_cw1T + (size_t)lw * 64 * 2048, scr, q >> 1, q & 1, lane, RmId()); continue; } r -= I_C1;
        if (r < I_C2) { const int lw = r >> 1, q = r & 1; tr_item(F_cmp_w2 + (size_t)lw * 64 * 64, 64, 64, F_cw2T + (size_t)lw * 64 * 64, scr, 0, q, lane, RmId()); continue; } r -= I_C2;
    }
    const int gt = F.vcu * (NWAVES * 64) + F.tid, NGT = F.G * NWAVES * 64;
    for (int i = gt; i < NL * (PW - INW) * (D / 8); i += NGT) { const int l = i / ((PW - INW) * (D / 8)), q = i % ((PW - INW) * (D / 8));
        *(v4u*)(F_WinT + ((size_t)l * PW + INW + q / (D / 8)) * D + (q % (D / 8)) * 8) = (v4u){0u, 0u, 0u, 0u}; }
    for (int i = gt; i < NL * NB * 4 * 16 * 64; i += NGT) F_kmean[i] = 0.f;
    for (int i = gt; i < S * 8; i += NGT) { const int t = i >> 3, f = i & 7; const double inv = pow(500000.0, -(double)f / 8.0); const double ang = (double)t * inv;
        F_ropec[i] = (float)cos(ang); F_ropes[i] = (float)sin(ang); }
}
__device__ __forceinline__ void mod_norm_row(const f32x4 (&v)[4], const float* g, const float* sc, const float* sh, bf16* orow, int lane) {
    float ss = 0.f;
#pragma unroll
    for (int j = 0; j < 4; ++j) ss += (v[j].x * v[j].x + v[j].y * v[j].y) + (v[j].z * v[j].z + v[j].w * v[j].w);
    const float rs = __builtin_amdgcn_rsqf(wave_sum(ss) * (1.f / D) + RMS_EPS);
#pragma unroll
    for (int j = 0; j < 4; ++j) { const int c = 4 * lane + 256 * j; const f32x4 gg = *(const f32x4*)(g + c), s1 = *(const f32x4*)(sc + c), s0 = *(const f32x4*)(sh + c);
        const f32x4 r = v[j] * rs * gg * (s1 + 1.f) + s0; v2u w; w.x = pk2(r.x, r.y); w.y = pk2(r.z, r.w); *(v2u*)(orow + c) = w; }
}
__device__ __forceinline__ void mod_norm_row_l(const f32x4 (&v)[4], const LAS float* cA, const LAS float* cS, bf16* orow, int lane) {
    float ss = 0.f;
#pragma unroll
    for (int j = 0; j < 4; ++j) ss += (v[j].x * v[j].x + v[j].y * v[j].y) + (v[j].z * v[j].z + v[j].w * v[j].w);
    const float rs = __builtin_amdgcn_rsqf(wave_sum(ss) * (1.f / D) + RMS_EPS);
#pragma unroll
    for (int j = 0; j < 4; ++j) { const int c = 4 * lane + 256 * j; const f32x4 a = *(const LAS f32x4*)(cA + c), s0 = *(const LAS f32x4*)(cS + c);
        const f32x4 r = v[j] * rs * a + s0; v2u w; w.x = pk2(r.x, r.y); w.y = pk2(r.z, r.w); *(v2u*)(orow + c) = w; }
}
__device__ __forceinline__ void router_tables(Frame& F, const Args& A, int q, int nq) {
    for (int it = q * NWAVES + F.wave; it < NL * NB * NE; it += nq * NWAVES) { const int e = it & 31, b = (it >> 5) & 7, l = it >> 8; const float* md = F_mod + ((size_t)l * NB + b) * 6 * D; const float* g2 = F_norm_g + ((size_t)l * 4 + 2) * D;
        const float* rw = F_router_w + (size_t)l * D * NE + e; float cs = 0.f;
#pragma unroll
        for (int j = 0; j < 16; ++j) { const int k = F.lane + 64 * j; const float w = rw[(size_t)k * NE]; const float v = g2[k] * (1.f + md[4 * D + k]) * w; cs += md[3 * D + k] * w;
            const unsigned h0 = f2bf(v); const float r1 = v - bflo(h0); const unsigned h1 = f2bf(r1); const unsigned h2 = f2bf(r1 - bflo(h1));
            unsigned short* pl = F_rw3 + (size_t)it * 3 * D + k; pl[0] = (unsigned short)h0; pl[D] = (unsigned short)h1; pl[2 * D] = (unsigned short)h2; }
        cs = wave_sum(cs); if (F.lane == 0) F_rconst[it] = cs + F_router_b[l * NE + e]; }
}
__device__ __forceinline__ void phase_hm0(Frame& F, const Args& A) {
    const int gw = F.vcu * NWAVES + F.wave, NGW = F.G * NWAVES;
    for (int chunk = blockIdx.x; chunk < NTOK / 128; chunk += F.G) {
        f32x4 va[4], vb[4]; const int tok0 = chunk * 128 + F.wave * 16; const float* md_ = F_mod + (size_t)(tok0 >> 12) * 6 * D;
        LAS float* cA = (LAS float*)(F.lds + 65536); LAS float* cS = cA + D;
#define HM_LOAD(V, T) { const f32x4* xr_ = (const f32x4*)(F_x + (size_t)(T) * D) + F.lane; _Pragma("unroll") for (int j = 0; j < 4; ++j) V[j] = __builtin_nontemporal_load(xr_ + 64 * j); }
#define HM_DO(V, T) mod_norm_row_l(V, cA, cS, F_act + (size_t)(T) * D, F.lane)
        HM_LOAD(va, tok0);
        __syncthreads();
        for (int i = F.tid; i < D; i += NWAVES * 64) { cA[i] = F_norm_g[i] * (md_[D + i] + 1.f); cS[i] = md_[i]; }
        __syncthreads();
        for (int i = 0; i < 16; i += 2) {
            HM_LOAD(vb, tok0 + i + 1);
            HM_DO(va, tok0 + i);
            if (i + 2 < 16) HM_LOAD(va, tok0 + i + 2);
            HM_DO(vb, tok0 + i + 1);
        }
#undef HM_LOAD
#undef HM_DO
    }
}
typedef short c16x8 __attribute__((ext_vector_type(8)));
__device__ __forceinline__ void phase_compress(Frame& F, const Args& A, int l) {
    const int lane = F.lane, fr = lane & 15, fq = lane >> 4;
    LAS unsigned short* h1s = (LAS unsigned short*)F.lds;
    LAS f32x4* red = (LAS f32x4*)(F.lds + 16384);
    for (int it = blockIdx.x; it < NB * 2 * 16; it += F.G) { const int nt = it & 15, which = (it >> 4) & 1, b = it >> 5;
        const bf16* w1t = F_cw1T + ((size_t)l * 2 + which) * 64 * 2048; const bf16* w2t = F_cw2T + ((size_t)l * 2 + which) * 64 * 64; const float* cc = F_cconst + ((size_t)l * 2 + which) * 16 * 64;
        const int n = 16 * nt + fr;
        f32x4 acc[4];
#pragma unroll
        for (int jt = 0; jt < 4; ++jt) acc[jt] = (f32x4){0.f, 0.f, 0.f, 0.f};
#pragma unroll
        for (int k8 = 0; k8 < 8; ++k8) { const int ks = 8 * F.wave + k8; int tokn = 16 * n + (ks >> 1); if (tokn > S - 1) tokn = S - 1;
            const c16x8 a = *(const c16x8*)(F_proj + ((size_t)b * S + tokn) * PW + C_KVB + which * 64 + 32 * (ks & 1) + 8 * fq);
#pragma unroll
            for (int jt = 0; jt < 4; ++jt) { const c16x8 bb = *(const c16x8*)(w1t + (size_t)(jt * 16 + fr) * 2048 + 32 * ks + 8 * fq); acc[jt] = __builtin_amdgcn_mfma_f32_16x16x32_bf16(a, bb, acc[jt], 0, 0, 0); } }
        __syncthreads();
#pragma unroll
        for (int jt = 0; jt < 4; ++jt) red[(F.wave * 4 + jt) * 64 + lane] = acc[jt];
        __syncthreads();
        if (F.wave == 0) {
#pragma unroll
        for (int jt = 0; jt < 4; ++jt) { f32x4 t = red[jt * 64 + lane];
#pragma unroll
            for (int w8 = 1; w8 < 8; ++w8) t = t + red[(w8 * 4 + jt) * 64 + lane];
            acc[jt] = t; }
#pragma unroll
        for (int jt = 0; jt < 4; ++jt) { float cj = 0.f;
#pragma unroll
            for (int part = 0; part < 16; ++part) cj += cc[part * 64 + jt * 16 + fr];
#pragma unroll
            for (int r = 0; r < 4; ++r) { const float v = acc[jt][r] + cj; h1s[(4 * fq + r) * 72 + jt * 16 + fr] = (unsigned short)f2bf(v / (1.f + __expf(-v))); } }
        LDS_WAIT(); asm volatile("" ::: "memory");
        f32x4 o2[4];
#pragma unroll
        for (int jt = 0; jt < 4; ++jt) o2[jt] = (f32x4){0.f, 0.f, 0.f, 0.f};
#pragma unroll
        for (int ks = 0; ks < 2; ++ks) { const c16x8 a = *(const LAS c16x8*)(h1s + fr * 72 + 32 * ks + 8 * fq);
#pragma unroll
            for (int jt = 0; jt < 4; ++jt) { const c16x8 bb = *(const c16x8*)(w2t + (size_t)(jt * 16 + fr) * 64 + 32 * ks + 8 * fq); o2[jt] = __builtin_amdgcn_mfma_f32_16x16x32_bf16(a, bb, o2[jt], 0, 0, 0); } }
        bf16* dst = (which ? F_vcb : F_kcb) + (size_t)b * 256 * 64;
#pragma unroll
        for (int jt = 0; jt < 4; ++jt)
#pragma unroll
            for (int r = 0; r < 4; ++r) { const int nn = 16 * nt + 4 * fq + r; dst[(size_t)nn * 64 + jt * 16 + fr] = (bf16)f2bf(nn < 255 ? o2[jt][r] : 0.f); }
        LDS_WAIT(); asm volatile("" ::: "memory");
        }
    }
    __syncthreads();
}
typedef float f32x16 __attribute__((ext_vector_type(16)));
typedef short s16x8 __attribute__((ext_vector_type(8)));
typedef short s16x4 __attribute__((ext_vector_type(4)));
constexpr int KP = 144, VP = 192, KT_BYTES = 64 * KP, VT_BYTES = 64 * VP, TB_BYTES = KT_BYTES + VT_BYTES;
constexpr float QSCALE_LOG2 = 0.125f * 1.4426950408889634f;
#define NEGINF (-__builtin_inff())
struct TileRegs { v4u k, v; };
__device__ __forceinline__ void tile_load(TileRegs& R, const bf16* Kg, const bf16* Vg, size_t pitch, int tid) {
    const int r = tid >> 3, c = tid & 7; R.k = *(const v4u*)(Kg + (size_t)r * pitch + c * 8); R.v = *(const v4u*)(Vg + (size_t)r * pitch + c * 8); }
__device__ __forceinline__ void tile_store(const TileRegs& R, LAS unsigned char* buf, int tid) {
    const int r = tid >> 3, c = tid & 7; *(LAS v4u*)(buf + r * KP + c * 16) = R.k; *(LAS v4u*)(buf + KT_BYTES + r * VP + c * 16) = R.v; }
__device__ __forceinline__ s16x8 pack8(float a0, float a1, float a2, float a3, float a4, float a5, float a6, float a7) {
    v4u w; w.x = pg8::cvt_pk_bf16(a0, a1); w.y = pg8::cvt_pk_bf16(a2, a3); w.z = pg8::cvt_pk_bf16(a4, a5); w.w = pg8::cvt_pk_bf16(a6, a7); return __builtin_bit_cast(s16x8, w); }
__device__ __forceinline__ void load_qfrags(s16x8 (&qf)[4], const bf16* qrow, float sc, int lane) {
#pragma unroll
    for (int ks = 0; ks < 4; ++ks) { const v4u v = *(const v4u*)(qrow + 16 * ks + 8 * (lane >> 5));
        qf[ks] = pack8(bflo(v.x) * sc, bfhi(v.x) * sc, bflo(v.y) * sc, bfhi(v.y) * sc, bflo(v.z) * sc, bfhi(v.z) * sc, bflo(v.w) * sc, bfhi(v.w) * sc); }
}
__device__ __forceinline__ void qk_tile(f32x16 (&p)[2], const LAS unsigned char* kb, const s16x8 (&qf)[4], int lane) {
    const LAS unsigned char* a = kb + (lane & 31) * KP + (lane >> 5) * 16;
    s16x8 kf[2][4];
#pragma unroll
    for (int T = 0; T < 2; ++T)
#pragma unroll
        for (int ks = 0; ks < 4; ++ks) kf[T][ks] = *(const LAS s16x8*)(a + T * 32 * KP + ks * 32);
#pragma unroll
    for (int T = 0; T < 2; ++T) {
#pragma unroll
        for (int j = 0; j < 16; ++j) p[T][j] = 0.f;
#pragma unroll
        for (int ks = 0; ks < 4; ++ks) p[T] = __builtin_amdgcn_mfma_f32_32x32x16_bf16(kf[T][ks], qf[ks], p[T], 0, 0, 0); }
}
__device__ __forceinline__ void pv_tile(f32x16 (&o)[2], const LAS unsigned char* vb, const s16x8 (&pf)[4], int lane) {
    const LAS unsigned char* base = vb + (4 * (lane >> 5) + ((lane & 15) >> 2)) * VP + (16 * ((lane >> 4) & 1) + 4 * (lane & 3)) * 2;
    v2u lo[2][4], hi[2][4];
#pragma unroll
    for (int dt = 0; dt < 2; ++dt)
#pragma unroll
        for (int c = 0; c < 4; ++c) {
            lo[dt][c] = __builtin_bit_cast(v2u, __builtin_amdgcn_ds_read_tr16_b64_v4i16((LAS s16x4*)(base + c * 16 * VP + dt * 64)));
            hi[dt][c] = __builtin_bit_cast(v2u, __builtin_amdgcn_ds_read_tr16_b64_v4i16((LAS s16x4*)(base + c * 16 * VP + 8 * VP + dt * 64))); }
#pragma unroll
    for (int dt = 0; dt < 2; ++dt)
#pragma unroll
        for (int c = 0; c < 4; ++c) { const s16x8 vf = __builtin_bit_cast(s16x8, (v4u){lo[dt][c].x, lo[dt][c].y, hi[dt][c].x, hi[dt][c].y});
            o[dt] = __builtin_amdgcn_mfma_f32_32x32x16_bf16(vf, pf[c], o[dt], 0, 0, 0); }
}
__device__ __forceinline__ float half_max(float v) { const unsigned u = __builtin_bit_cast(unsigned, v); auto rr = __builtin_amdgcn_permlane32_swap(u, u, false, false);
    return fmaxf(__builtin_bit_cast(float, rr[0]), __builtin_bit_cast(float, rr[1])); }
__device__ __forceinline__ void softmax_step(f32x16 (&p)[2], f32x16 (&o)[2], float& m, float& l, s16x8 (&pf)[4], bool keep) {
    float tm = fmaxf(p[0][0], p[1][0]);
#pragma unroll
    for (int j = 1; j < 16; ++j) tm = fmaxf(tm, fmaxf(p[0][j], p[1][j]));
    tm = keep ? half_max(tm) : NEGINF;
    if (__builtin_amdgcn_ballot_w64(tm > m + 8.f) != 0ull) {
        const float mn = fmaxf(m, tm), mu0 = (mn == NEGINF) ? 0.f : mn; const float alpha = __builtin_amdgcn_exp2f(m - mu0);
        m = mn; l *= alpha;
#pragma unroll
        for (int dt = 0; dt < 2; ++dt)
#pragma unroll
            for (int j = 0; j < 16; ++j) o[dt][j] *= alpha; }
    const float mu = keep ? ((m == NEGINF) ? 0.f : m) : __builtin_inff();
    float s = 0.f;
#pragma unroll
    for (int T = 0; T < 2; ++T)
#pragma unroll
        for (int j = 0; j < 16; ++j) { p[T][j] = __builtin_amdgcn_exp2f(p[T][j] - mu); s += p[T][j]; }
    l += s;
#pragma unroll
    for (int c = 0; c < 4; ++c) { const int T = c >> 1, b8 = (c & 1) * 8;
        pf[c] = pack8(p[T][b8 + 0], p[T][b8 + 1], p[T][b8 + 2], p[T][b8 + 3], p[T][b8 + 4], p[T][b8 + 5], p[T][b8 + 6], p[T][b8 + 7]); }
}
#define EOFF(T, j) (32 * (T) + 8 * ((j) >> 2) + ((j) & 3))
__device__ __forceinline__ void mask_le(f32x16 (&p)[2], int lim) {
#pragma unroll
    for (int T = 0; T < 2; ++T)
#pragma unroll
        for (int j = 0; j < 16; ++j) p[T][j] = (EOFF(T, j) <= lim) ? p[T][j] : NEGINF;
}
__device__ __forceinline__ void mask_ge(f32x16 (&p)[2], int lim) {
#pragma unroll
    for (int T = 0; T < 2; ++T)
#pragma unroll
        for (int j = 0; j < 16; ++j) p[T][j] = (EOFF(T, j) >= lim) ? p[T][j] : NEGINF;
}
__device__ __forceinline__ void mask_all(f32x16 (&p)[2], bool keep) {
#pragma unroll
    for (int T = 0; T < 2; ++T)
#pragma unroll
        for (int j = 0; j < 16; ++j) p[T][j] = keep ? p[T][j] : NEGINF;
}
__device__ __forceinline__ void store_o(const f32x16 (&o)[2], float sc, bf16* orow, int lane, float* stat = nullptr) {
    float ss = 0.f;
#pragma unroll
    for (int dt = 0; dt < 2; ++dt)
#pragma unroll
        for (int g = 0; g < 4; ++g) { const float a0 = o[dt][4 * g] * sc, a1 = o[dt][4 * g + 1] * sc, a2 = o[dt][4 * g + 2] * sc, a3 = o[dt][4 * g + 3] * sc; ss += (a0 * a0 + a1 * a1) + (a2 * a2 + a3 * a3);
            v2u w; w.x = pg8::cvt_pk_bf16(a0, a1); w.y = pg8::cvt_pk_bf16(a2, a3);
            *(v2u*)(orow + 32 * dt + 8 * g + 4 * (lane >> 5)) = w; }
    if (stat) { ss += __shfl_xor(ss, 32); if (lane < 32) *stat = ss; }
}
__device__ __forceinline__ int wq_next(Frame& F, gu32* ctr) {
    __syncthreads(); if (F.tid == 0) F.MISC[0] = __hip_atomic_fetch_add(ctr, 1u, RLX_AGENT); __syncthreads(); return (int)F.MISC[0]; }
__device__ __forceinline__ void wq_prefetch(Frame& F) { if (F.tid == 0) F.tk = __hip_atomic_fetch_add(F.qctr, 1u, RLX_AGENT); }

__device__ __forceinline__ void sb_unit(Frame& F, const Args& A, int u) {
    const int qt = 15 - (u & 15), bh = u >> 4, h = bh % 6, b = bh / 6, lane = F.lane, w = F.wave, hi = lane >> 5;
    const int t0 = 256 * qt + 32 * w, tq = t0 + (lane & 31); const size_t tok = (size_t)b * S + tq;
    s16x8 qf[4]; load_qfrags(qf, F_proj + tok * PW + C_QC + h * 64, QSCALE_LOG2, lane);
    f32x16 o[2];
#pragma unroll
    for (int dt = 0; dt < 2; ++dt)
#pragma unroll
        for (int j = 0; j < 16; ++j) o[dt][j] = 0.f;
    float carry = 0.f; bool wdone = false;
    const bf16* Kb = F_proj + (size_t)b * S * PW + C_KC + h * 64; const bf16* Vb = F_proj + (size_t)b * S * PW + C_VC + h * 64;
    volatile LAS unsigned* flag = F.MISC + 16;
    TileRegs R;
    int kt = 4 * qt + 3;
    __syncthreads();
    tile_load(R, Kb + (size_t)kt * 64 * PW, Vb + (size_t)kt * 64 * PW, PW, F.tid); tile_store(R, F.lds, F.tid);
    __syncthreads();
    for (int i = 0;; ++i, --kt) {
        const bool more = kt > 0;
        if (more) tile_load(R, Kb + (size_t)(kt - 1) * 64 * PW, Vb + (size_t)(kt - 1) * 64 * PW, PW, F.tid);
        const LAS unsigned char* buf = F.lds + (i & 1) * TB_BYTES;
        if (!wdone && 64 * kt <= t0 + 30) {
            f32x16 z[2]; qk_tile(z, buf, qf, lane);
            const int lim = tq - 64 * kt - 4 * hi - 1;
            f32x16 lk[2];
#pragma unroll
            for (int T = 0; T < 2; ++T)
#pragma unroll
                for (int j = 0; j < 16; ++j) { const float zz = z[T][j]; const float L = fmaxf(zz, 0.f) + __builtin_amdgcn_logf(1.f + __builtin_amdgcn_exp2f(-fabsf(zz)));
                    const bool valid = EOFF(T, j) <= lim; lk[T][j] = valid ? -L : 0.f; z[T][j] = valid ? zz - L : NEGINF; }
            float gs[2][4]; f32x16 inl[2];
#pragma unroll
            for (int T = 0; T < 2; ++T)
#pragma unroll
                for (int g = 0; g < 4; ++g) { const float s3 = lk[T][4 * g + 3], s2 = s3 + lk[T][4 * g + 2], s1 = s2 + lk[T][4 * g + 1]; gs[T][g] = s1 + lk[T][4 * g];
                    inl[T][4 * g + 3] = 0.f; inl[T][4 * g + 2] = s3; inl[T][4 * g + 1] = s2; inl[T][4 * g] = s1; }
            float run = carry;
#pragma unroll
            for (int T = 1; T >= 0; --T)
#pragma unroll
                for (int g = 3; g >= 0; --g) { const float gp = __shfl_xor(gs[T][g], 32); const float base = run + (hi == 0 ? gp : 0.f);
#pragma unroll
                    for (int r = 0; r < 4; ++r) z[T][4 * g + r] = __builtin_amdgcn_exp2f(z[T][4 * g + r] + base + inl[T][4 * g + r]);
                    run += gs[T][g] + gp; }
            carry = run;
            s16x8 pf[4];
#pragma unroll
            for (int c = 0; c < 4; ++c) { const int T = c >> 1, b8 = (c & 1) * 8;
                pf[c] = pack8(z[T][b8 + 0], z[T][b8 + 1], z[T][b8 + 2], z[T][b8 + 3], z[T][b8 + 4], z[T][b8 + 5], z[T][b8 + 6], z[T][b8 + 7]); }
            pv_tile(o, buf + KT_BYTES, pf, lane);
            wdone = __builtin_amdgcn_ballot_w64(carry >= -58.f) == 0ull;
        }
        if (lane == 0) flag[(i & 1) * 8 + w] = (wdone || !more) ? 1u : 0u;
        if (more) tile_store(R, F.lds + ((i + 1) & 1) * TB_BYTES, F.tid);
        __syncthreads();
        if (!more) break;
        unsigned alld = 1u;
#pragma unroll
        for (int k = 0; k < 8; ++k) alld &= flag[(i & 1) * 8 + k];
        if (alld) break;
    }
    wq_prefetch(F);
    store_o(o, 1.f, F_o + tok * D + 640 + h * 64, lane, F_oss + tok * 16 + 10 + h);
}
template <class Pol> __device__ __forceinline__ void flash_pass(Frame& F, const Pol& P, int ntile, const bf16* Kb, const bf16* Vb, const s16x8 (&qf)[4], f32x16 (&o)[2], float& m, float& l) {
    TileRegs R0, R1, R2; const int lane = F.lane;
    int tid = F.tid; asm volatile("" : "+v"(tid));
    __syncthreads();
    tile_load(R0, Kb + (size_t)P.row0(0) * PW, Vb + (size_t)P.row0(0) * PW, PW, tid);
    if (ntile > 1) tile_load(R1, Kb + (size_t)P.row0(1) * PW, Vb + (size_t)P.row0(1) * PW, PW, tid);
    if (ntile > 2) tile_load(R2, Kb + (size_t)P.row0(2) * PW, Vb + (size_t)P.row0(2) * PW, PW, tid);
    tile_store(R0, F.lds, tid);
    __syncthreads();
#define FSTEP(I, RL, RS) { const int i_ = (I); if (i_ < ntile) { \
        if (i_ + 3 < ntile) tile_load(RL, Kb + (size_t)P.row0(i_ + 3) * PW, Vb + (size_t)P.row0(i_ + 3) * PW, PW, tid); \
        const LAS unsigned char* buf = F.lds + (i_ & 1) * TB_BYTES; \
        if (P.active(i_)) { f32x16 p[2]; qk_tile(p, buf, qf, lane); const bool keep = P.mask(i_, p); s16x8 pf[4]; softmax_step(p, o, m, l, pf, keep); pv_tile(o, buf + KT_BYTES, pf, lane); } \
        if (i_ + 1 < ntile) tile_store(RS, F.lds + ((i_ + 1) & 1) * TB_BYTES, tid); \
        __syncthreads(); } }
    for (int i = 0; i < ntile; i += 3) { FSTEP(i, R0, R1); FSTEP(i + 1, R1, R2); FSTEP(i + 2, R2, R0); }
#undef FSTEP
}
struct PolMoba { unsigned selm; int own, w, qrel  ;
    __device__ __forceinline__ int row0(int i) const { return 64 * i; }
    __device__ __forceinline__ bool active(int i) const { const int blk = i >> 2; return blk < own ? (__builtin_amdgcn_ballot_w64((selm >> blk) & 1u) != 0ull) : ((64 * (i & 3)) <= 32 * w + 31); }
    __device__ __forceinline__ bool mask(int i, f32x16 (&p)[2]) const { const int blk = i >> 2; if (blk < own) return ((selm >> blk) & 1u) != 0u; mask_le(p, qrel - 64 * (i & 3)); return true; } };
struct PolSlc { unsigned sl, sh; int ownw, lim_own  ;
    __device__ __forceinline__ int row0(int i) const { return 64 * i; }
    __device__ __forceinline__ bool bit(int i) const { return ((i < 32 ? sl >> i : sh >> (i - 32)) & 1u) != 0u; }
    __device__ __forceinline__ bool active(int i) const { return i <= ownw && __builtin_amdgcn_ballot_w64(bit(i)) != 0ull; }
    __device__ __forceinline__ bool mask(int i, f32x16 (&p)[2]) const { if (i == ownw) { mask_le(p, lim_own); return true; } return bit(i); } };
struct PolWin { int klo, t0, trel  ;
    __device__ __forceinline__ int row0(int i) const { return 64 * (klo + i); }
    __device__ __forceinline__ bool active(int i) const { const int k0 = 64 * (klo + i); return k0 + 63 >= t0 - 511 && k0 <= t0 + 31; }
    __device__ __forceinline__ bool mask(int i, f32x16 (&p)[2]) const { const int k0 = 64 * (klo + i);
        if (k0 + 63 > t0) mask_le(p, trel - k0);
        if (k0 < t0 + 31 - 511) mask_ge(p, trel - 511 - k0);
        return true; } };
__device__ __forceinline__ void nsa_sw_unit(Frame& F, const Args& A, int u) {
    const int qt = 15 - (u / 48), bh = u % 48, h = bh % 6, b = bh / 6, lane = F.lane, w = F.wave, hi = lane >> 5;
    const int t0 = 256 * qt + 32 * w, tq = t0 + (lane & 31); const size_t tok = (size_t)b * S + tq;
    const bf16* prow = F_proj + tok * PW;
    s16x8 qf[4]; load_qfrags(qf, prow + C_QB + h * 64, QSCALE_LOG2, lane);
    const bf16* Pb = F_proj + (size_t)b * S * PW;
    f32x16 os[2], ow[2];
#pragma unroll
    for (int dt = 0; dt < 2; ++dt)
#pragma unroll
        for (int j = 0; j < 16; ++j) { os[dt][j] = 0.f; ow[dt][j] = 0.f; }
    float ms = NEGINF, ls = 0.f, mw = NEGINF, lw = 0.f;
    { const v2u sm = *(const v2u*)(F_selm + tok * 2); PolSlc P{sm.x, sm.y, t0 >> 6, tq - 64 * (t0 >> 6) - 4 * hi};
      flash_pass(F, P, 4 * qt + 4, Pb + C_KVB + 128, Pb + C_KVB + 192, qf, os, ms, ls); }
    { int klo = (256 * qt - 511) >> 6; if (klo < 0) klo = 0; PolWin P{klo, t0, tq - 4 * hi};
      flash_pass(F, P, 4 * qt + 4 - klo, Pb + C_KVB + 256, Pb + C_KVB + 320, qf, ow, mw, lw); }
    wq_prefetch(F);
    const float lst = ls + __shfl_xor(ls, 32), lwt = lw + __shfl_xor(lw, 32);
    const float gs = sigmoidf_(bf1(prow[C_GB + h * 3 + 1])) * (lst > 0.f ? 1.f / lst : 0.f), gw = sigmoidf_(bf1(prow[C_GB + h * 3 + 2])) * (lwt > 0.f ? 1.f / lwt : 0.f);
    bf16* orow = F_o + tok * D + 256 + h * 64; float ssq = 0.f;
#pragma unroll
    for (int dt = 0; dt < 2; ++dt)
#pragma unroll
        for (int g = 0; g < 4; ++g) { bf16* op = orow + 32 * dt + 8 * g + 4 * hi; const v2u c = *(const v2u*)(F_ocp + tok * 384 + h * 64 + 32 * dt + 8 * g + 4 * hi);
            const float r0 = bflo(c.x) + gs * os[dt][4 * g] + gw * ow[dt][4 * g], r1 = bfhi(c.x) + gs * os[dt][4 * g + 1] + gw * ow[dt][4 * g + 1];
            const float r2 = bflo(c.y) + gs * os[dt][4 * g + 2] + gw * ow[dt][4 * g + 2], r3 = bfhi(c.y) + gs * os[dt][4 * g + 3] + gw * ow[dt][4 * g + 3];
            ssq += (r0 * r0 + r1 * r1) + (r2 * r2 + r3 * r3); v2u wv; wv.x = pg8::cvt_pk_bf16(r0, r1); wv.y = pg8::cvt_pk_bf16(r2, r3); *(v2u*)op = wv; }
    ssq += __shfl_xor(ssq, 32); if (lane < 32) F_oss[tok * 16 + 4 + h] = ssq;
}
__device__ __forceinline__ void nsa_cmp_unit(Frame& F, const Args& A, int u) {
    const int qt = u & 15, b = u >> 4, lane = F.lane, w = F.wave, hi = lane >> 5;
    const int t0 = 256 * qt + 32 * w, tq = t0 + (lane & 31); const size_t tok = (size_t)b * S + tq;
    const bf16* prow = F_proj + tok * PW;
    __syncthreads();
    { const bf16* kc = F_kcb + (size_t)b * 256 * 64; const bf16* vc = F_vcb + (size_t)b * 256 * 64;
#pragma unroll
      for (int q = 0; q < 4; ++q) { const int idx = F.tid + 512 * q, r = idx >> 3, c = idx & 7;
          *(LAS v4u*)(F.lds + (r >> 6) * KT_BYTES + (r & 63) * KP + c * 16) = *(const v4u*)(kc + (size_t)r * 64 + c * 8);
          *(LAS v4u*)(F.lds + 4 * KT_BYTES + (r >> 6) * VT_BYTES + (r & 63) * VP + c * 16) = *(const v4u*)(vc + (size_t)r * 64 + c * 8); } }
    __syncthreads();
    const int nmax = tq >= 31 ? (tq - 31) >> 4 : -1;
    const int nmax_w = (t0 + 31) >= 31 ? (t0 + 31 - 31) >> 4 : -1;
    float IM[4][2][4];
#pragma unroll
    for (int a = 0; a < 4; ++a)
#pragma unroll
        for (int T = 0; T < 2; ++T)
#pragma unroll
            for (int g = 0; g < 4; ++g) IM[a][T][g] = 0.f;
    for (int h = 0; h < 6; ++h) {
        s16x8 qf[4]; load_qfrags(qf, prow + C_QB + h * 64, QSCALE_LOG2, lane);
        float m = NEGINF, l = 0.f;
#pragma unroll
        for (int kt = 0; kt < 4; ++kt) { if (64 * kt > nmax_w) continue;
            f32x16 p[2]; qk_tile(p, F.lds + kt * KT_BYTES, qf, lane); mask_le(p, nmax - 64 * kt - 4 * hi);
            float tm = p[0][0];
#pragma unroll
            for (int j = 1; j < 16; ++j) tm = fmaxf(tm, p[0][j]);
#pragma unroll
            for (int j = 0; j < 16; ++j) tm = fmaxf(tm, p[1][j]);
            const float mn = fmaxf(m, tm), mu = (mn == NEGINF) ? 0.f : mn; l *= __builtin_amdgcn_exp2f(m - mu); m = mn;
#pragma unroll
            for (int T = 0; T < 2; ++T)
#pragma unroll
                for (int j = 0; j < 16; ++j) l += __builtin_amdgcn_exp2f(p[T][j] - mu); }
        { const float mo = __shfl_xor(m, 32), lo = __shfl_xor(l, 32); const float M = fmaxf(m, mo), Mu = (M == NEGINF) ? 0.f : M;
          l = l * __builtin_amdgcn_exp2f(m - Mu) + lo * __builtin_amdgcn_exp2f(mo - Mu); m = Mu; }
        const float inv = l > 0.f ? 1.f / l : 0.f;
        f32x16 o[2];
#pragma unroll
        for (int dt = 0; dt < 2; ++dt)
#pragma unroll
            for (int j = 0; j < 16; ++j) o[dt][j] = 0.f;
        float carry = 0.f;
#pragma unroll
        for (int kt = 0; kt < 4; ++kt) { if (64 * kt > nmax_w) continue;
            f32x16 p[2]; qk_tile(p, F.lds + kt * KT_BYTES, qf, lane); mask_le(p, nmax - 64 * kt - 4 * hi);
#pragma unroll
            for (int T = 0; T < 2; ++T)
#pragma unroll
                for (int j = 0; j < 16; ++j) p[T][j] = __builtin_amdgcn_exp2f(p[T][j] - m) * inv;
            float x[2][4];
#pragma unroll
            for (int T = 0; T < 2; ++T)
#pragma unroll
                for (int g = 0; g < 4; ++g) x[T][g] = __shfl_xor(p[T][4 * g + 3], 32);
#pragma unroll
            for (int T = 0; T < 2; ++T)
#pragma unroll
                for (int g = 0; g < 4; ++g) { const float prev = g > 0 ? x[T][g - 1] : (T > 0 ? x[0][3] : carry);
                    IM[kt][T][g] += ((p[T][4 * g] + p[T][4 * g + 1]) + (p[T][4 * g + 2] + p[T][4 * g + 3])) + (hi ? x[T][g] : prev); }
            carry = x[1][3];
            s16x8 pf[4];
#pragma unroll
            for (int c = 0; c < 4; ++c) { const int T = c >> 1, b8 = (c & 1) * 8;
                pf[c] = pack8(p[T][b8 + 0], p[T][b8 + 1], p[T][b8 + 2], p[T][b8 + 3], p[T][b8 + 4], p[T][b8 + 5], p[T][b8 + 6], p[T][b8 + 7]); }
            pv_tile(o, F.lds + 4 * KT_BYTES + kt * VT_BYTES, pf, lane); }
        store_o(o, sigmoidf_(bf1(prow[C_GB + h * 3 + 0])), F_ocp + tok * 384 + h * 64, lane);
    }
    wq_prefetch(F);
    const int ownb = tq >> 6;
#pragma unroll
    for (int a = 0; a < 4; ++a)
#pragma unroll
        for (int T = 0; T < 2; ++T)
#pragma unroll
            for (int g = 0; g < 4; ++g) { const int mm = 16 * a + 8 * T + 2 * g + hi; float v = IM[a][T][g];
                if (mm == 0 || mm == ownb || mm == ownb - 1) v = 1e4f; if (64 * mm > tq) v = -1e30f; IM[a][T][g] = v; }
    unsigned sl = 0u, sh = 0u;
    for (int r = 0; r < 16; ++r) { float bv = -3.4e38f; int bm = 0;
#pragma unroll
        for (int a = 0; a < 4; ++a)
#pragma unroll
            for (int T = 0; T < 2; ++T)
#pragma unroll
                for (int g = 0; g < 4; ++g) { const int mm = 16 * a + 8 * T + 2 * g + hi; if (IM[a][T][g] > bv) { bv = IM[a][T][g]; bm = mm; } }
        const float ov = __shfl_xor(bv, 32); const int om = __shfl_xor(bm, 32);
        if (ov > bv || (ov == bv && om < bm)) { bv = ov; bm = om; }
        if (bv > -5e29f) { if (bm < 32) sl |= 1u << bm; else sh |= 1u << (bm - 32); }
#pragma unroll
        for (int a = 0; a < 4; ++a)
#pragma unroll
            for (int T = 0; T < 2; ++T)
#pragma unroll
                for (int g = 0; g < 4; ++g) { const int mm = 16 * a + 8 * T + 2 * g + hi; IM[a][T][g] = (mm == bm) ? -3.4e38f : IM[a][T][g]; }
    }
    if (hi == 0) { v2u sm; sm.x = sl; sm.y = sh; *(v2u*)(F_selm + tok * 2) = sm; }
}
__device__ __forceinline__ void moba_unit(Frame& F, const Args& A, int u, int layer) {
    const int own = 15 - (u >> 5), bh = u & 31, b = bh >> 2, h = bh & 3, lane = F.lane, w = F.wave, hi = lane >> 5;
    const int tq = own * 256 + 32 * w + (lane & 31); const size_t tok = (size_t)b * S + tq;
    const bf16* qrow = F_proj + tok * PW + C_QA + h * 64;
    unsigned selm = 0u;
    {   float q[64]; loadq(q, qrow);
        const float* km = F_kmean + (size_t)layer * NB * 4 * 16 * 64 + (size_t)(b * 4 + h) * 16 * 64;
        LAS float* kmL = (LAS float*)(F.lds + 98304);
        if (F.tid < 256) *(LAS f32x4*)(kmL + 4 * F.tid) = *(const f32x4*)(km + 4 * F.tid);
        __syncthreads();
        float v1 = -3e38f, v2 = -3e38f, v3 = -3e38f; int i1 = -1, i2 = -1, i3 = -1;
        for (int n = 0; n < own; ++n) { const float g = dot64l(q, kmL + n * 64);
            if (g > v1) { v3 = v2; i3 = i2; v2 = v1; i2 = i1; v1 = g; i1 = n; } else if (g > v2) { v3 = v2; i3 = i2; v2 = g; i2 = n; } else if (g > v3) { v3 = g; i3 = n; } }
        if (i1 >= 0) selm |= 1u << i1; if (i2 >= 0) selm |= 1u << i2; if (i3 >= 0) selm |= 1u << i3;
    }
    s16x8 qf[4]; load_qfrags(qf, qrow, QSCALE_LOG2, lane);
    f32x16 o[2];
#pragma unroll
    for (int dt = 0; dt < 2; ++dt)
#pragma unroll
        for (int j = 0; j < 16; ++j) o[dt][j] = 0.f;
    float m = NEGINF, l = 0.f;
    const bf16* Kb = F_proj + (size_t)b * S * PW + C_KA + h * 64; const bf16* Vb = F_proj + (size_t)b * S * PW + C_VA + h * 64;
    { PolMoba P{selm, own, w, 32 * w + (lane & 31) - 4 * hi}; flash_pass(F, P, 4 * own + 4, Kb, Vb, qf, o, m, l); }
    wq_prefetch(F);
    const float lt = l + __shfl_xor(l, 32);
    store_o(o, lt > 0.f ? 1.f / lt : 0.f, F_o + tok * D + h * 64, lane, F_oss + tok * 16 + h);
}
#ifndef PROBE_PHASE
#define PROBE_PHASE -1
#endif
#define QREPS(g) ((PROBE_PHASE == (g)) ? 2 : 1)
#define WQ_LOOP(CTR, NUNITS, CALL) do { { int z_ = 0; asm volatile("" : "+v"(z_)); F.qctr = (CTR) + z_; } F.tk = 0u; \
    int u = __builtin_amdgcn_readfirstlane(wq_next(F, F.qctr)); \
    while (u < (NUNITS)) { CALL; __syncthreads(); if (F.tid == 0) F.MISC[0] = F.tk; __syncthreads(); u = __builtin_amdgcn_readfirstlane((int)F.MISC[0]); } } while (0)
__device__ __forceinline__ void phase_attn_a(Frame& F0, const Args& A, int l, int rep) {
    Frame F = F0; asm volatile("" : "+v"(F.tid)); F.lane = F.tid & 63;
    WQ_LOOP(F.ctl + CW_WQ + 64 * (l * 4 + 2) + 8 * rep, NB * 16, nsa_cmp_unit(F, A, u));
    WQ_LOOP(F.ctl + CW_WQ + 64 * (l * 4 + 0) + 8 * rep, NB * 4 * 16, moba_unit(F, A, u, l));
    WQ_LOOP(F.ctl + CW_WQ + 64 * (l * 4 + 1) + 8 * rep, NB * 6 * 16, sb_unit(F, A, u));
    __syncthreads();
}
__device__ __forceinline__ void phase_attn_b(Frame& F0, const Args& A, int l, int rep) {
    Frame F = F0; asm volatile("" : "+v"(F.tid)); F.lane = F.tid & 63;
    WQ_LOOP(F.ctl + CW_WQ + 64 * (l * 4 + 3) + 8 * rep, NB * 6 * 16, nsa_sw_unit(F, A, u));
    __syncthreads();
}
struct GnIn { v4u w0, w1; };
__device__ __forceinline__ void gn_load(GnIn& I, const Args& A, int tok, int lane) { const bf16* orow = F_o + (size_t)tok * D; I.w0 = __builtin_nontemporal_load((const v4u*)(orow + lane * 8)); I.w1 = __builtin_nontemporal_load((const v4u*)(orow + 512 + lane * 8)); }
__device__ __forceinline__ void gn_compute(const GnIn& I, const Args& A, int tok, int lane, const float* gg) {
    const v4u w0 = I.w0, w1 = I.w1;
    float v0[8] = {bflo(w0.x), bfhi(w0.x), bflo(w0.y), bfhi(w0.y), bflo(w0.z), bfhi(w0.z), bflo(w0.w), bfhi(w0.w)};
    float v1[8] = {bflo(w1.x), bfhi(w1.x), bflo(w1.y), bfhi(w1.y), bflo(w1.z), bfhi(w1.z), bflo(w1.w), bfhi(w1.w)};
    float s0 = 0.f, s1 = 0.f;
#pragma unroll
    for (int j = 0; j < 8; ++j) { s0 += v0[j] * v0[j]; s1 += v1[j] * v1[j]; }
    const float ssA = wave_sum(lane < 32 ? s0 : 0.f), ssB = wave_sum((lane >= 32 ? s0 : 0.f) + (lane < 16 ? s1 : 0.f)), ssC = wave_sum(lane >= 16 ? s1 : 0.f);
    const float rA = __builtin_amdgcn_rsqf(ssA * (1.f / 256.f) + RMS_EPS), rB = __builtin_amdgcn_rsqf(ssB * (1.f / 384.f) + RMS_EPS), rC = __builtin_amdgcn_rsqf(ssC * (1.f / 384.f) + RMS_EPS);
    const float r0 = lane < 32 ? rA : rB, r1 = lane < 16 ? rB : rC;
    const f32x4 g00 = *(const f32x4*)(gg + lane * 8), g01 = *(const f32x4*)(gg + lane * 8 + 4), g10 = *(const f32x4*)(gg + 512 + lane * 8), g11 = *(const f32x4*)(gg + 512 + lane * 8 + 4);
    v4u o0, o1;
    o0.x = pk2(v0[0] * r0 * g00.x, v0[1] * r0 * g00.y); o0.y = pk2(v0[2] * r0 * g00.z, v0[3] * r0 * g00.w); o0.z = pk2(v0[4] * r0 * g01.x, v0[5] * r0 * g01.y); o0.w = pk2(v0[6] * r0 * g01.z, v0[7] * r0 * g01.w);
    o1.x = pk2(v1[0] * r1 * g10.x, v1[1] * r1 * g10.y); o1.y = pk2(v1[2] * r1 * g10.z, v1[3] * r1 * g10.w); o1.z = pk2(v1[4] * r1 * g11.x, v1[5] * r1 * g11.y); o1.w = pk2(v1[6] * r1 * g11.z, v1[7] * r1 * g11.w);
    bf16* arow = F_act + (size_t)tok * D; *(v4u*)(arow + lane * 8) = o0; *(v4u*)(arow + 512 + lane * 8) = o1;
}
__device__ __forceinline__ void phase_gnorm(Frame& F, const Args& A, int l) {
    const int gw = F.vcu * NWAVES + F.wave, NGW = F.G * NWAVES, lane = F.lane; const float* gg = F_mix_g + (size_t)l * D;
    GnIn Ia, Ib; int tok = gw;
    if (tok < NTOK) gn_load(Ia, A, tok, lane);
    for (; tok < NTOK; tok += 2 * NGW) {
        if (tok + NGW < NTOK) gn_load(Ib, A, tok + NGW, lane);
        gn_compute(Ia, A, tok, lane, gg);
        if (tok + 2 * NGW < NTOK) gn_load(Ia, A, tok + 2 * NGW, lane);
        if (tok + NGW < NTOK) gn_compute(Ib, A, tok + NGW, lane, gg);
    }
}
struct PmIn { f32x4 x[4]; v2u xb[4]; v2u y[4]; };
__device__ __forceinline__ void pm_load(PmIn& I, const Args& A, int tok, int lane, int l) {
    const f32x4* xr = (const f32x4*)(F_x + (size_t)tok * D) + lane; const bf16* xm = F_xmid + (size_t)tok * D; const bf16* yr = F_y + (size_t)tok * D;
#pragma unroll
    for (int j = 0; j < 4; ++j) { if (l == 0) I.x[j] = __builtin_nontemporal_load(xr + 64 * j); else I.xb[j] = __builtin_nontemporal_load((const v2u*)(xm + 4 * lane + 256 * j)); I.y[j] = __builtin_nontemporal_load((const v2u*)(yr + 4 * lane + 256 * j)); } }
__device__ __forceinline__ void pm_compute(const PmIn& I, const Args& A, int tok, int lane, int l, const LAS float* cA1, const LAS float* cA2, const LAS float* cS0, LAS float* rs2out) {
    f32x4 xv[4], yv[4]; float ss = 0.f;
#pragma unroll
    for (int j = 0; j < 4; ++j) { if (l == 0) xv[j] = I.x[j]; else { const v2u xw = I.xb[j]; xv[j] = (f32x4){bflo(xw.x), bfhi(xw.x), bflo(xw.y), bfhi(xw.y)}; } const v2u w = I.y[j]; yv[j] = (f32x4){bflo(w.x), bfhi(w.x), bflo(w.y), bfhi(w.y)};
        ss += (yv[j].x * yv[j].x + yv[j].y * yv[j].y) + (yv[j].z * yv[j].z + yv[j].w * yv[j].w); }
    const float rs = __builtin_amdgcn_rsqf(wave_sum(ss) * (1.f / D) + RMS_EPS);
    bf16* x1r = F_x1b + (size_t)tok * D;
#pragma unroll
    for (int j = 0; j < 4; ++j) { const int c = 4 * lane + 256 * j; const f32x4 a1 = *(const LAS f32x4*)(cA1 + c);
        xv[j] = xv[j] + a1 * (yv[j] * rs); v2u xw; xw.x = pk2(xv[j].x, xv[j].y); xw.y = pk2(xv[j].z, xv[j].w); *(v2u*)(x1r + c) = xw; }
    float s2 = 0.f;
#pragma unroll
    for (int j = 0; j < 4; ++j) s2 += (xv[j].x * xv[j].x + xv[j].y * xv[j].y) + (xv[j].z * xv[j].z + xv[j].w * xv[j].w);
    const float rs2 = __builtin_amdgcn_rsqf(wave_sum(s2) * (1.f / D) + RMS_EPS);
    if (lane == 0) *rs2out = rs2;
    unsigned char* arow8 = F_act8 + (size_t)tok * D;
#pragma unroll
    for (int j = 0; j < 4; ++j) { const int c = 4 * lane + 256 * j; const f32x4 a2 = *(const LAS f32x4*)(cA2 + c), s0 = *(const LAS f32x4*)(cS0 + c);
        const f32x4 r = xv[j] * rs2 * a2 + s0; *(unsigned*)(arow8 + c) = pg8::pk4_fp8(r.x, r.y, r.z, r.w); }
}
__device__ __forceinline__ void phase_postmix(Frame& F, const Args& A, int l, int bank) {
    const int lane = F.lane, wave = F.wave;
    LAS float* lgt = (LAS float*)(F.lds + wave * 4096);
    LAS float* rsv = lgt + 512;
    LAS int* tE = (LAS int*)(F.lds + 32768); LAS int* tR = tE + 512; LAS unsigned* lcnt = (LAS unsigned*)(tR + 512); LAS unsigned* lbase = lcnt + 32; LAS float* tG = (LAS float*)(lbase + 32);
    const float* g1n = F_norm_g + ((size_t)l * 4 + 1) * D; const float* g2n = F_norm_g + ((size_t)l * 4 + 2) * D;
    for (int chunk = blockIdx.x; chunk < NTOK / 128; chunk += F.G) {
        __syncthreads();
        if (F.tid < 32) lcnt[F.tid] = 0u;
        __syncthreads();
        const int tok0 = chunk * 128 + wave * 16, b = tok0 >> 12; const float* md = F_mod + ((size_t)l * NB + b) * 6 * D;
        PmIn Ia, Ib; pm_load(Ia, A, tok0, lane, l);
        LAS float* cA1 = (LAS float*)(F.lds + 65536); LAS float* cA2 = cA1 + D; LAS float* cS0 = cA2 + D;
        for (int i = F.tid; i < D; i += NWAVES * 64) { cA1[i] = md[2 * D + i] * g1n[i]; cA2[i] = g2n[i] * (md[4 * D + i] + 1.f); cS0[i] = md[3 * D + i]; }
        __syncthreads();
        for (int i = 0; i < 16; i += 2) {
            pm_load(Ib, A, tok0 + i + 1, lane, l);
            pm_compute(Ia, A, tok0 + i, lane, l, cA1, cA2, cS0, rsv + i);
            if (i + 2 < 16) pm_load(Ia, A, tok0 + i + 2, lane, l);
            pm_compute(Ib, A, tok0 + i + 1, lane, l, cA1, cA2, cS0, rsv + i + 1);
        }
        VM_WAIT();
        {
            const int m16 = lane & 15, kg = lane >> 4; constexpr int BPB = 272;
            const bf16* ap = F_x1b + (size_t)(tok0 + m16) * D + 8 * kg;
            const unsigned short* bsrc = F_rw3 + ((size_t)l * NB + b) * NE * 3 * D + (size_t)(F.tid >> 4) * 3 * D + (F.tid & 15) * 8;
            LAS unsigned char* bl = F.lds + 77824; LAS unsigned char* bw = bl + (F.tid >> 4) * BPB + (F.tid & 15) * 16;
            f32x4 c0 = (f32x4){0.f, 0.f, 0.f, 0.f}, c1 = c0;
            v4u g[3]; c16x8 ac[4], an[4];
#pragma unroll
            for (int p = 0; p < 3; ++p) g[p] = *(const v4u*)(bsrc + p * D);
#pragma unroll
            for (int q4 = 0; q4 < 4; ++q4) ac[q4] = *(const c16x8*)(ap + 32 * q4);
#pragma unroll
            for (int p = 0; p < 3; ++p) *(LAS v4u*)(bw + p * 32 * BPB) = g[p];
            __syncthreads();
#pragma unroll
            for (int kc = 0; kc < 8; ++kc) { const LAS unsigned char* br = bl + (kc & 1) * 3 * 32 * BPB + m16 * BPB + 16 * kg;
                if (kc + 1 < 8) {
#pragma unroll
                    for (int p = 0; p < 3; ++p) g[p] = *(const v4u*)(bsrc + p * D + 128 * (kc + 1));
#pragma unroll
                    for (int q4 = 0; q4 < 4; ++q4) an[q4] = *(const c16x8*)(ap + 128 * (kc + 1) + 32 * q4); }
#pragma unroll
                for (int q4 = 0; q4 < 4; ++q4)
#pragma unroll
                    for (int p = 0; p < 3; ++p) { const c16x8 b0 = *(const LAS c16x8*)(br + p * 32 * BPB + 64 * q4), b1 = *(const LAS c16x8*)(br + p * 32 * BPB + 16 * BPB + 64 * q4);
                        c0 = __builtin_amdgcn_mfma_f32_16x16x32_bf16(ac[q4], b0, c0, 0, 0, 0); c1 = __builtin_amdgcn_mfma_f32_16x16x32_bf16(ac[q4], b1, c1, 0, 0, 0); }
                if (kc + 1 < 8) { LAS unsigned char* bn = bw + ((kc + 1) & 1) * 3 * 32 * BPB;
#pragma unroll
                    for (int p = 0; p < 3; ++p) *(LAS v4u*)(bn + p * 32 * BPB) = g[p];
#pragma unroll
                    for (int q4 = 0; q4 < 4; ++q4) ac[q4] = an[q4]; }
                __syncthreads(); }
#pragma unroll
            for (int r = 0; r < 4; ++r) { lgt[(4 * kg + r) * 32 + m16] = c0[r]; lgt[(4 * kg + r) * 32 + 16 + m16] = c1[r]; } }
        LDS_WAIT(); asm volatile("" ::: "memory");
        if (lane < 16) { const int tl = wave * 16 + lane, tok = tok0 + lane; const float rs2 = rsv[lane]; const float* rc = F_rconst + ((size_t)l * NB + b) * NE;
            float v0 = -3e38f, v1 = -3e38f, v2 = -3e38f, v3 = -3e38f; int i0 = 0, i1 = 0, i2 = 0, i3 = 0;
#pragma unroll 8
            for (int e = 0; e < NE; ++e) { const float g = lgt[lane * 32 + e] * rs2 + rc[e];
                if (g > v3) { if (g > v1) { v3 = v2; i3 = i2; v2 = v1; i2 = i1; if (g > v0) { v1 = v0; i1 = i0; v0 = g; i0 = e; } else { v1 = g; i1 = e; } }
                              else { if (g > v2) { v3 = v2; i3 = i2; v2 = g; i2 = e; } else { v3 = g; i3 = e; } } } }
            const float e1 = __expf(v1 - v0), e2 = __expf(v2 - v0), e3 = __expf(v3 - v0); const float inv = 1.f / (1.f + e1 + e2 + e3);
            const int ei[4] = {i0, i1, i2, i3}; const float gt[4] = {inv, e1 * inv, e2 * inv, e3 * inv};
#pragma unroll
            for (int s = 0; s < 4; ++s) { const unsigned rk = __hip_atomic_fetch_add(&lcnt[ei[s]], 1u, __ATOMIC_RELAXED, __HIP_MEMORY_SCOPE_WORKGROUP); tE[tl * 4 + s] = ei[s]; tR[tl * 4 + s] = (int)rk; tG[tl * 4 + s] = gt[s]; } }
        LDS_WAIT(); asm volatile("" ::: "memory");
        __syncthreads();
        if (F.tid < 32) lbase[F.tid] = atomicAdd((unsigned*)(F.ctl + CW_CNT + 64 * bank + F.tid), lcnt[F.tid]);
        __syncthreads();
        { const int tok = chunk * 128 + (F.tid >> 2), s = F.tid & 3, e = tE[F.tid]; const int pos = (int)lbase[e] + tR[F.tid]; F_list[(size_t)e * NTOK + pos] = tok * 4 + s; F_lgate[(size_t)e * NTOK + pos] = tG[F.tid]; }
    }
    __syncthreads();
}
__device__ __forceinline__ int moe_tables(Frame& F, const Args& A, int l) {
    LAS int* rowbase = (LAS int*)(F.lds + TAB_OFF); LAS unsigned char* texp = (LAS unsigned char*)(F.lds + TAB_OFF + 256); LAS int* ecnt = (LAS int*)(F.lds + TAB_OFF + 896);
    __syncthreads();
    if (F.tid < 64) { const int ln = F.tid;
        const int c = ln < NE ? (int)__hip_atomic_load(F.ctl + CW_CNT + 64 * l + ln, RLX_AGENT) : 0; const int nt = (c + 255) >> 8;
        int incl = nt;
#pragma unroll
        for (int o = 1; o < 64; o <<= 1) { const int t = __shfl_up(incl, o); if (ln >= o) incl += t; }
        const int excl = incl - nt;
        if (ln < NE) { rowbase[ln] = excl << 8; ecnt[ln] = c; for (int k = 0; k < nt; ++k) texp[excl + k] = (unsigned char)ln; }
        if (ln == NE - 1) rowbase[NE] = incl << 8; }
    __syncthreads();
    return rowbase[NE] >> 8;
}
struct CbIn { unsigned yb[4][4]; v2u x1[4]; };
__device__ __forceinline__ void cb_load(CbIn& I, const Args& A, int tok, int lane) { const unsigned char* yr = F_yt8 + (size_t)tok * 4 * D; const bf16* x1r = F_x1b + (size_t)tok * D;
#pragma unroll
    for (int s = 0; s < 4; ++s)
#pragma unroll
        for (int j = 0; j < 4; ++j) I.yb[s][j] = __builtin_nontemporal_load((const unsigned*)(yr + (size_t)s * D + 4 * lane + 256 * j));
#pragma unroll
    for (int j = 0; j < 4; ++j) I.x1[j] = __builtin_nontemporal_load((const v2u*)(x1r + 4 * lane + 256 * j)); }
__device__ __forceinline__ void cb_compute(const CbIn& I, const Args& A, int tok, int lane, int l, const LAS float* cA3, const LAS float* cA4, const LAS float* cS4) {
    f32x4 xv[4], yv[4];
#pragma unroll
    for (int j = 0; j < 4; ++j) { const v2u xw = I.x1[j]; xv[j] = (f32x4){bflo(xw.x), bfhi(xw.x), bflo(xw.y), bfhi(xw.y)}; yv[j] = (f32x4){0.f, 0.f, 0.f, 0.f};
#pragma unroll
        for (int s = 0; s < 4; ++s) { typedef float f32x2_ __attribute__((ext_vector_type(2))); const f32x2_ lo = __builtin_amdgcn_cvt_pk_f32_fp8((int)I.yb[s][j], false), hi2 = __builtin_amdgcn_cvt_pk_f32_fp8((int)I.yb[s][j], true); yv[j] = yv[j] + (f32x4){lo.x, lo.y, hi2.x, hi2.y}; } }
    float ss = 0.f;
#pragma unroll
    for (int j = 0; j < 4; ++j) ss += (yv[j].x * yv[j].x + yv[j].y * yv[j].y) + (yv[j].z * yv[j].z + yv[j].w * yv[j].w);
    const float rs = __builtin_amdgcn_rsqf(wave_sum(ss) * (1.f / D) + RMS_EPS * (pg8::YT8_SCALE * pg8::YT8_SCALE));
    f32x4* outr = (f32x4*)(F_out + (size_t)tok * D) + lane; bf16* xmr = F_xmid + (size_t)tok * D;
#pragma unroll
    for (int j = 0; j < 4; ++j) { const int c = 4 * lane + 256 * j; const f32x4 a3 = *(const LAS f32x4*)(cA3 + c);
        xv[j] = xv[j] + a3 * (yv[j] * rs);
        if (l + 1 < NL) { v2u xw; xw.x = pk2(xv[j].x, xv[j].y); xw.y = pk2(xv[j].z, xv[j].w); *(v2u*)(xmr + c) = xw; } else outr[64 * j] = xv[j]; }
    if (l + 1 < NL) mod_norm_row_l(xv, cA4, cS4, F_act + (size_t)tok * D, lane);
}
__device__ __forceinline__ void phase_combine(Frame& F, const Args& A, int l) {
    const int lane = F.lane; const float* g3n = F_norm_g + ((size_t)l * 4 + 3) * D;
    LAS float* cA3 = (LAS float*)(F.lds + 65536); LAS float* cA4 = cA3 + D; LAS float* cS4 = cA4 + D;
    for (int chunk = blockIdx.x; chunk < NTOK / 128; chunk += F.G) {
        const int tok0 = chunk * 128 + F.wave * 16, b = tok0 >> 12; const float* md = F_mod + ((size_t)l * NB + b) * 6 * D;
        CbIn Ia, Ib; cb_load(Ia, A, tok0, lane);
        __syncthreads();
        for (int i = F.tid; i < D; i += NWAVES * 64) { cA3[i] = md[5 * D + i] * g3n[i];
            if (l + 1 < NL) { const float* md2 = F_mod + ((size_t)(l + 1) * NB + b) * 6 * D; cA4[i] = F_norm_g[(size_t)(l + 1) * 4 * D + i] * (md2[D + i] + 1.f); cS4[i] = md2[i]; } }
        __syncthreads();
        for (int i = 0; i < 16; i += 2) {
            cb_load(Ib, A, tok0 + i + 1, lane);
            cb_compute(Ia, A, tok0 + i, lane, l, cA3, cA4, cS4);
            if (i + 2 < 16) cb_load(Ia, A, tok0 + i + 2, lane);
            cb_compute(Ib, A, tok0 + i + 1, lane, l, cA3, cA4, cS4);
        }
    }
}
#ifndef MK_SINGLE
#define MK_SINGLE 1
#endif
#ifndef DUPMASK
#define DUPMASK 0
#endif
#define REPS(g) ((PROBE_PHASE == (g)) ? 2 : 1)
#define IN(k) (lo <= (k) && (k) < hi)
#define SEAM(k) do { if (IN((k) + 1)) xcd_barrier(bar); } while (0)
template <int l> __device__ __forceinline__ void layer_phases(Frame& F, const Args& A, const int lo, const int hi, const XcdBarrier& bar) {
        enum { P_HM = 0, P_PROJ, P_CMPR, P_ATTA, P_ATTB, P_OUT, P_POST, P_GU, P_DN, P_COMB, NPL };
        const int pb = 1 + NPL * l;
        if (IN(pb + P_HM) && l == 0) { _Pragma("nounroll") for (int rep = 0; rep < REPS(1); ++rep) phase_hm0(F, A); SEAM(pb + P_HM); }
        if (IN(pb + P_PROJ)) {
            pg8::Gemm g{F_act, F_WinT + (size_t)l * PW * D, NTOK, PW, D}; pg8::StaticOrder So; So.init(NTOK, PW, F.G, (int)blockIdx.x);
            pg8::EpiProj E{F_proj, PW, F_ropec, F_ropes, F_kmean + (size_t)l * NB * 4 * 16 * 64};
            pg8::gemm_phase<pg8::EpiProj, pg8::StaticOrder, true, true>(F.lds, g, So, E);
            if (l == 0) { const int rem = ((NTOK / 256) * (PW / 256)) % F.G, c = (int)blockIdx.x;
                if (rem == 0) router_tables(F, A, c, F.G); else if (c >= rem) router_tables(F, A, c - rem, F.G - rem); }
            SEAM(pb + P_PROJ); }
        if (IN(pb + P_CMPR)) { _Pragma("nounroll") for (int rep = 0; rep < REPS(3); ++rep) phase_compress(F, A, l); SEAM(pb + P_CMPR); }
        if (IN(pb + P_ATTA)) { _Pragma("nounroll") for (int rep = 0; rep < REPS(4); ++rep) phase_attn_a(F, A, l, rep); SEAM(pb + P_ATTA); }
        if (IN(pb + P_ATTB)) { _Pragma("nounroll") for (int rep = 0; rep < REPS(5); ++rep) phase_attn_b(F, A, l, rep); SEAM(pb + P_ATTB); }
        if (IN(pb + P_OUT)) {
            pg8::Gemm g{F_o, F_WoutT + (size_t)l * D * D, NTOK, D, D}; pg8::StaticOrder So; So.init(NTOK, D, F.G, (int)blockIdx.x);
            LAS float* rt = (LAS float*)(F.lds + TAB_OFF + 2048);
            { const int ui = F.tid >> 8, r = F.tid & 255; pg8::Unit uu; if (So.next(ui, uu)) { const f32x4* sp = (const f32x4*)(F_oss + ((size_t)uu.pm * 256 + r) * 16);
                  const f32x4 a = sp[0], b1 = sp[1], c1 = sp[2], d1 = sp[3];
                  const float ssA = (a.x + a.y) + (a.z + a.w), ssB = ((b1.x + b1.y) + (b1.z + b1.w)) + (c1.x + c1.y), ssC = (c1.z + c1.w) + ((d1.x + d1.y) + (d1.z + d1.w));
                  const float rA = __builtin_amdgcn_rsqf(ssA * (1.f / 256.f) + RMS_EPS), rB = __builtin_amdgcn_rsqf(ssB * (1.f / 384.f) + RMS_EPS), rC = __builtin_amdgcn_rsqf(ssC * (1.f / 384.f) + RMS_EPS);
                  *(LAS f32x4*)(rt + (ui * 256 + r) * 4) = (f32x4){rA * __builtin_amdgcn_rcpf(rB), rB * __builtin_amdgcn_rcpf(rC), rC, 0.f}; } }
            __syncthreads();
            pg8::EpiBf16 E{F_y, D, nullptr, 0, 0};
            pg8::gemm_phase_gn<pg8::EpiBf16, pg8::StaticOrder, true, true>(F.lds, g, So, E, (const LAS float*)rt);
            SEAM(pb + P_OUT); }
        if (IN(pb + P_POST)) { _Pragma("nounroll") for (int rep = 0; rep < REPS(8); ++rep) phase_postmix(F, A, l, l + 2 * rep); SEAM(pb + P_POST); }
        if (IN(pb + P_GU)) {
            const int nt = moe_tables(F, A, l);
            pg8::Gemm g{(const pg8::bf16_t*)F_act8, (const pg8::bf16_t*)(F_Wgu8 + (size_t)l * NE * 2048 * D), MAXROWS, NE * 2048, D};
            pg8::MoeOrder So{8, nt, F.G, F.vcu, (const LAS unsigned char*)(F.lds + TAB_OFF + 256), (const LAS int*)(F.lds + TAB_OFF), (const LAS int*)(F.lds + TAB_OFF + 896), F_list, NTOK};
            pg8::EpiSwiglu8 E{F_sact8, F_b_gu + (size_t)l * NE * 2048, (LAS float*)(F.lds + TAB_OFF + 2048)};
            _Pragma("nounroll") for (int rep = 0; rep < REPS(9); ++rep) pg8::gemm_phase_g8<pg8::EpiSwiglu8, pg8::MoeOrder, true, true>(F.lds, g, So, E);
            SEAM(pb + P_GU); }
        if (IN(pb + P_DN)) {
            const int nt = moe_tables(F, A, l);
            pg8::Gemm g{(const pg8::bf16_t*)F_sact8, (const pg8::bf16_t*)(F_Wdn8 + (size_t)l * NE * D * D), MAXROWS, NE * D, D};
            pg8::MoeOrder So{4, nt, F.G, F.vcu, (const LAS unsigned char*)(F.lds + TAB_OFF + 256), (const LAS int*)(F.lds + TAB_OFF), (const LAS int*)(F.lds + TAB_OFF + 896), F_list, NTOK};
            pg8::EpiDn E{F_yt8, F_b_dn + (size_t)l * NE * D, (const LAS int*)(F.lds + TAB_OFF), (const LAS int*)(F.lds + TAB_OFF + 896), F_list, NTOK, F_lgate, (LAS float*)(F.lds + TAB_OFF + 2048)};
            _Pragma("nounroll") for (int rep = 0; rep < REPS(10); ++rep) pg8::gemm_phase8<pg8::EpiDn, pg8::MoeOrder, true, true>(F.lds, g, So, E);
            SEAM(pb + P_DN); }
        if (IN(pb + P_COMB)) { _Pragma("nounroll") for (int rep = 0; rep < REPS(11); ++rep) phase_combine(F, A, l); SEAM(pb + P_COMB); }
    }
#undef IN
#undef SEAM
__global__ void __launch_bounds__(NWAVES * 64, 2) mk_fwd(Args A) {
    extern __shared__ __attribute__((aligned(16))) unsigned char lds[];
    Frame F;
    F.lds = (LAS unsigned char*)lds; F.MISC = (volatile LAS unsigned*)(F.lds + MISC_OFF);
    F.tid = threadIdx.x; F.lane = F.tid & 63; F.wave = __builtin_amdgcn_readfirstlane(F.tid >> 6);
    F.G = gridDim.x; { const int bx = blockIdx.x; F.vcu = (F.G % 8 == 0) ? (bx % 8) * (F.G / 8) + bx / 8 : bx; }
    F.ctl = (gu32*)(A.ws + WS_CTL);
    for (int u = F.tid; u < (LDS_BYTES - LDSCTL_OFF) / 4; u += NWAVES * 64) ((LAS unsigned*)(F.lds + LDSCTL_OFF))[u] = 0u;
    __syncthreads();
    const int lo = A.ph_lo, hi = A.ph_hi;
    XcdBarrier bar; bar.bar = (unsigned*)(F.ctl + CW_BAR) + A.li * XCD_BAR_WORDS; bar.x = 0; bar.st = nullptr;
    if (hi - lo > 1) bar = xcd_barrier_post((unsigned*)(F.ctl + CW_BAR) + A.li * XCD_BAR_WORDS, F.MISC + 8);
#define IN(k) (lo <= (k) && (k) < hi)
#define SEAM(k) do { if (IN((k) + 1)) xcd_barrier(bar); } while (0)
    if (IN(0)) { _Pragma("nounroll") for (int rep = 0; rep < REPS(0); ++rep) p0_prologue(F, A); SEAM(0); }
    layer_phases<0>(F, A, lo, hi, bar);
    layer_phases<1>(F, A, lo, hi, bar);
#undef IN
#undef SEAM
}

extern "C" void kernel_launch(void* const* d_in, const int* in_sizes, int n_in, void* d_out, int out_size, void* d_ws, size_t ws_size, hipStream_t stream) {
    static int grid = 0;
    if (grid == 0) {
        if (n_in != 17 || in_sizes[0] != NTOK * D || out_size != NTOK * D || ws_size < WS_END) { fprintf(stderr, "kernel_launch: unexpected shapes (n_in %d, in0 %d, out %d, ws %zu); nothing launched\n", n_in, n_in > 0 ? in_sizes[0] : -1, out_size, ws_size); grid = -1; return; }
        int dev = 0, cus = 0, per_cu = 0;
        if (hipGetDevice(&dev) != hipSuccess || hipDeviceGetAttribute(&cus, hipDeviceAttributeMultiprocessorCount, dev) != hipSuccess) { grid = -1; return; }
        if (hipFuncSetAttribute((const void*)mk_fwd, hipFuncAttributeMaxDynamicSharedMemorySize, LDS_BYTES) != hipSuccess) { fprintf(stderr, "kernel_launch: hipFuncSetAttribute failed\n"); grid = -1; return; }
        if (hipOccupancyMaxActiveBlocksPerMultiprocessor(&per_cu, (const void*)mk_fwd, NWAVES * 64, LDS_BYTES) != hipSuccess || per_cu < 1) { fprintf(stderr, "kernel_launch: occupancy query says %d blocks per CU\n", per_cu); }
        (void)hipGetLastError();
        grid = cus;
    }
    if (grid < 0) return;
    if (hipMemsetAsync((char*)d_ws + WS_CTL, 0, CTL_ZERO_BYTES, stream) != hipSuccess) return;
    Args a{};
    for (int i = 0; i < 17; ++i) a.in[i] = (const float*)d_in[i];
        a.out = (float*)d_out; a.ws = (unsigned char*)d_ws; a.pad = 0;
#if MK_SINGLE
    a.ph_lo = 0; a.ph_hi = NPHASE; a.li = 0;
    hipLaunchKernelGGL(mk_fwd, dim3(grid), dim3(NWAVES * 64), LDS_BYTES, stream, a);
#else
    int li = 0;
    for (int p = 0; p < NPHASE; ++p) { if (p == 11) continue;
        a.ph_lo = p; a.ph_hi = p + 1; a.li = li++;
        hipLaunchKernelGGL(mk_fwd, dim3(grid), dim3(NWAVES * 64), LDS_BYTES, stream, a); }
#endif
    const hipError_t le = hipPeekAtLastError();
    if (le != hipSuccess) fprintf(stderr, "kernel_launch: launch failed: %s\n", hipGetErrorName(le));
}
```

```cpp
#include <hip/hip_runtime.h>
#include <cstdio>
#include <cstdint>
namespace pg8 {
#define PG8_LAS __attribute__((address_space(3)))
typedef unsigned short bf16_t;
typedef short bf16x8 __attribute__((ext_vector_type(8)));
typedef float f32x4 __attribute__((ext_vector_type(4)));
typedef unsigned u32x4 __attribute__((ext_vector_type(4)));
constexpr int BM = 256, BK = 64, HALF = 128, HTB = HALF * BK * 2  , STAGE_BYTES = 8 * HTB, NXCD = 8, WGM = 8;

__host__ __device__ __forceinline__ int lds_byte(int r, int c) { const int st = (r >> 4) * 2 + (c >> 5), rr = r & 15, cc = c & 31, ob = rr * 64 + cc * 2; return st * 1024 + (ob ^ (((ob >> 9) & 1) << 5)); }
__host__ __device__ __forceinline__ void stage_rc(int b, int& R, int& C) { const int st = b / 1024, sb = b % 1024, swz = sb ^ (((sb >> 9) & 1) << 5); R = (st >> 1) * 16 + swz / 64; C = (st & 1) * 32 + (swz % 64) / 2; }
__host__ __device__ __forceinline__ int perm32(int rho) { const int n = rho >> 4, i = rho & 15; return 8 * (i >> 2) + 4 * n + (i & 3); }

struct Unit { int pm, pn; };
struct Gemm { const bf16_t* A; const bf16_t* Bt; int M, N, K; };

struct StaticOrder {
    int nM, nN, nwg, G, c;
    __host__ __device__ void init(int M, int N, int G_, int c_) { nM = M / BM; nN = N / BM; nwg = nM * nN; G = G_; c = c_; }
    __host__ __device__ bool next(int i, Unit& u) const {
        const long L = (long)i * G + c; if (L >= nwg) return false;
        int wgid = (int)L; { const int q = nwg / NXCD, r = nwg % NXCD, xcd = wgid % NXCD, off = wgid / NXCD; wgid = (xcd < r ? xcd * (q + 1) : r * (q + 1) + (xcd - r) * q) + off; }
        const int nig = WGM * nN, gid = wgid / nig, fm = gid * WGM, gsz = (nM - fm) < WGM ? (nM - fm) : WGM;
        u.pm = fm + ((wgid % nig) % gsz); u.pn = (wgid % nig) / gsz; return true;
    }
    __device__ __forceinline__ void a_ready(const Unit&) const {}
    __device__ __forceinline__ void done(const Unit&) const {}
};

__device__ __forceinline__ unsigned cvt_pk_bf16(float lo, float hi) { unsigned r; asm volatile("v_cvt_pk_bf16_f32 %0, %1, %2" : "=v"(r) : "v"(lo), "v"(hi)); return r; }
struct EpiBf16 {
    static constexpr bool PERM = true, AFTER_DRAIN = false;
    bf16_t* O; int ldc; const float* bias; int split_cols; size_t split_stride;
    __device__ __forceinline__ void operator()(const f32x4 (&acc)[2][2][4][2], const Unit& u, int wr, int wc, int fr, int fq) const {
        const int row0 = u.pm * BM + wr * 64 + fr; int colt = u.pn * BM; bf16_t* base = O;
        if (split_cols) { const int t = colt / split_cols; base += (size_t)t * split_stride; colt -= t * split_cols; }
        const int col0 = colt + wc * 32 + 8 * fq, bcol0 = u.pn * BM + wc * 32 + 8 * fq;
        f32x4 bv[2][2];
#pragma unroll
        for (int bj = 0; bj < 2; ++bj)
#pragma unroll
            for (int n = 0; n < 2; ++n) bv[bj][n] = bias ? *(const f32x4*)(bias + bcol0 + bj * HALF + 4 * n) : (f32x4){0.f, 0.f, 0.f, 0.f};
#pragma unroll
        for (int ai = 0; ai < 2; ++ai)
#pragma unroll
            for (int m = 0; m < 4; ++m) { bf16_t* rowp = base + (size_t)(row0 + ai * HALF + m * 16) * ldc + col0;
#pragma unroll
                for (int bj = 0; bj < 2; ++bj) { f32x4 v0 = acc[ai][bj][m][0] + bv[bj][0], v1 = acc[ai][bj][m][1] + bv[bj][1];
                    u32x4 w; w.x = cvt_pk_bf16(v0[0], v0[1]); w.y = cvt_pk_bf16(v0[2], v0[3]); w.z = cvt_pk_bf16(v1[0], v1[1]); w.w = cvt_pk_bf16(v1[2], v1[3]);
                    *(u32x4*)(rowp + bj * HALF) = w; } }
    }
};
struct EpiProj {
    static constexpr bool PERM = true, AFTER_DRAIN = false;
    bf16_t* O; int ldc; const float* ropec; const float* ropes; float* kmean;
    __device__ __forceinline__ void operator()(const f32x4 (&acc)[2][2][4][2], const Unit& u, int wr, int wc, int fr, int fq) const {
        const int row0 = u.pm * BM + wr * 64 + fr; const int colt = u.pn * BM;
        const int col0 = colt + wc * 32 + 8 * fq;
        constexpr unsigned ROPEM = 0xFFu | (0x3Fu << 12) | (1u << 18) | (1u << 20) | (1u << 22);
        float ks[2][8];
#pragma unroll
        for (int bj = 0; bj < 2; ++bj)
#pragma unroll
            for (int q = 0; q < 8; ++q) ks[bj][q] = 0.f;
#pragma unroll
        for (int ai = 0; ai < 2; ++ai)
#pragma unroll
            for (int m = 0; m < 4; ++m) { const int row = row0 + ai * HALF + m * 16; bf16_t* rowp = O + (size_t)row * ldc + col0;
#pragma unroll
                for (int bj = 0; bj < 2; ++bj) { f32x4 v0 = acc[ai][bj][m][0], v1 = acc[ai][bj][m][1];
                    const int head = (colt + bj * HALF + wc * 32) >> 6;
                    if (((wc & 1) == 0) && head < 32 && ((ROPEM >> head) & 1u)) {
                        float x[8] = {v0[0], v0[1], v0[2], v0[3], v1[0], v1[1], v1[2], v1[3]}, y[8];
#pragma unroll
                        for (int q = 0; q < 8; ++q) y[q] = __shfl_xor(x[q], 16);
                        if (fq < 2) { const int t = row & 4095; const f32x4 c0 = *(const f32x4*)(ropec + t * 8), c1 = *(const f32x4*)(ropec + t * 8 + 4), s0 = *(const f32x4*)(ropes + t * 8), s1 = *(const f32x4*)(ropes + t * 8 + 4);
                            const float cs[8] = {c0[0], c0[1], c0[2], c0[3], c1[0], c1[1], c1[2], c1[3]}, sn[8] = {s0[0], s0[1], s0[2], s0[3], s1[0], s1[1], s1[2], s1[3]};
#pragma unroll
                            for (int q = 0; q < 8; ++q) x[q] = (fq == 0) ? x[q] * cs[q] - y[q] * sn[q] : x[q] * cs[q] + y[q] * sn[q];
                            v0 = (f32x4){x[0], x[1], x[2], x[3]}; v1 = (f32x4){x[4], x[5], x[6], x[7]}; } }
                    if (u.pn == 1) {
#pragma unroll
                        for (int q = 0; q < 4; ++q) { ks[bj][q] += v0[q]; ks[bj][4 + q] += v1[q]; } }
                    u32x4 w; w.x = cvt_pk_bf16(v0[0], v0[1]); w.y = cvt_pk_bf16(v0[2], v0[3]); w.z = cvt_pk_bf16(v1[0], v1[1]); w.w = cvt_pk_bf16(v1[2], v1[3]);
                    *(u32x4*)(rowp + bj * HALF) = w; } }
        if (u.pn == 1) {
#pragma unroll
            for (int bj = 0; bj < 2; ++bj)
#pragma unroll
                for (int q = 0; q < 8; ++q) { float s = ks[bj][q]; s += __shfl_xor(s, 1); s += __shfl_xor(s, 2); s += __shfl_xor(s, 4); s += __shfl_xor(s, 8); ks[bj][q] = s; }
            if (fr == 0) { const int b = u.pm >> 4, blk = u.pm & 15;
#pragma unroll
                for (int bj = 0; bj < 2; ++bj) { const int c = bj * HALF + wc * 32 + 8 * fq, h = c >> 6, d = c & 63;
#pragma unroll
                    for (int q = 0; q < 8; ++q) atomicAdd(kmean + ((size_t)(b * 4 + h) * 16 + blk) * 64 + d + q, ks[bj][q] * (1.f / 256.f)); } }
        }
    }
};
struct EpiSwiglu {
    static constexpr bool PERM = true, AFTER_DRAIN = false;
    bf16_t* O; const float* bias;
    __device__ __forceinline__ void operator()(const f32x4 (&acc)[2][2][4][2], const Unit& u, int wr, int wc, int fr, int fq) const {
        const int row0 = u.pm * BM + wr * 64 + fr; const int e = u.pn >> 3, j = u.pn & 7;
        const int cc = wc * 32 + 8 * fq;
        const float* bg = bias + (size_t)e * 2048 + j * 128 + cc; const float* bl = bg + 1024;
        f32x4 bgv[2], blv[2];
#pragma unroll
        for (int n = 0; n < 2; ++n) { bgv[n] = *(const f32x4*)(bg + 4 * n); blv[n] = *(const f32x4*)(bl + 4 * n); }
#pragma unroll
        for (int ai = 0; ai < 2; ++ai)
#pragma unroll
            for (int m = 0; m < 4; ++m) { bf16_t* rowp = O + (size_t)(row0 + ai * HALF + m * 16) * 1024 + j * 128 + cc;
                float r[8];
#pragma unroll
                for (int n = 0; n < 2; ++n) { const f32x4 g4 = acc[ai][0][m][n] + bgv[n], l4 = acc[ai][1][m][n] + blv[n];
#pragma unroll
                    for (int q = 0; q < 4; ++q) { float g = fminf(g4[q], 7.0f); float l = fminf(fmaxf(l4[q], -7.0f), 7.0f);
                        const float sg = 1.0f / (1.0f + __expf(-1.702f * g)); r[4 * n + q] = g * sg * (l + 1.0f); } }
                u32x4 w; w.x = cvt_pk_bf16(r[0], r[1]); w.y = cvt_pk_bf16(r[2], r[3]); w.z = cvt_pk_bf16(r[4], r[5]); w.w = cvt_pk_bf16(r[6], r[7]);
                *(u32x4*)rowp = w; }
    }
};
__device__ __forceinline__ unsigned pk4_fp8(float a, float b, float c, float d) { const int r = __builtin_amdgcn_cvt_pk_fp8_f32(a, b, 0, false); return (unsigned)__builtin_amdgcn_cvt_pk_fp8_f32(c, d, r, true); }
constexpr float W8_SCALE = 64.f, W8_INV = 1.f / 64.f, ACT8_SCALE = 4.f, DN8_INV = 1.f / 256.f, YT8_SCALE = 16.f;
struct EpiSwiglu8 {
    static constexpr bool PERM = true, AFTER_DRAIN = false;
    unsigned char* O; const float* bias; PG8_LAS float* tab;
    __device__ __forceinline__ void prefetch(const Unit& u, int par, int wid, int lane) const {
        if (wid < 4) { const int e = u.pn >> 3, j = u.pn & 7, idx = wid * 64 + lane;
            __builtin_amdgcn_global_load_lds((const unsigned*)(bias + (size_t)e * 2048 + (idx >> 7) * 1024 + j * 128 + (idx & 127)), (PG8_LAS unsigned*)(tab + par * 256 + wid * 64), 4, 0, 0); }
    }
    __device__ __forceinline__ void operator()(const f32x4 (&acc)[2][2][4][2], const Unit& u, int wr, int wc, int fr, int fq, int par) const {
        const int row0 = u.pm * BM + wr * 64 + fr; const int j = u.pn & 7;
        const int cc = wc * 32 + 8 * fq;
        const PG8_LAS float* bg = tab + par * 256 + cc; const PG8_LAS float* bl = bg + 128;
        typedef _Float16 h2_ __attribute__((ext_vector_type(2))); typedef short s2_ __attribute__((ext_vector_type(2)));
#define PG8_PKH(a, b) __builtin_bit_cast(h2_, __builtin_amdgcn_cvt_pkrtz((a), (b)))
        h2_ bg2[2][2], bl2[2][2];
#pragma unroll
        for (int n = 0; n < 2; ++n) { const f32x4 a = *(const PG8_LAS f32x4*)(bg + 4 * n), b = *(const PG8_LAS f32x4*)(bl + 4 * n);
            bg2[n][0] = PG8_PKH(a.x, a.y); bg2[n][1] = PG8_PKH(a.z, a.w); bl2[n][0] = PG8_PKH(b.x, b.y); bl2[n][1] = PG8_PKH(b.z, b.w); }
        const h2_ hinv = {(_Float16)W8_INV, (_Float16)W8_INV}, h7 = {(_Float16)7.0f, (_Float16)7.0f}, hm7 = {(_Float16)-7.0f, (_Float16)-7.0f}, hk = {(_Float16)-2.4554669595930156f, (_Float16)-2.4554669595930156f},
                  h1 = {(_Float16)1.0f, (_Float16)1.0f}, h4 = {(_Float16)ACT8_SCALE, (_Float16)ACT8_SCALE};
#pragma unroll
        for (int ai = 0; ai < 2; ++ai)
#pragma unroll
            for (int m = 0; m < 4; ++m) { unsigned char* rowp = O + (size_t)(row0 + ai * HALF + m * 16) * 1024 + j * 128 + cc;
                s2_ wv[2];
#pragma unroll
                for (int n = 0; n < 2; ++n) { wv[n] = (s2_){0, 0};
#pragma unroll
                    for (int hq = 0; hq < 2; ++hq) {
                        const h2_ G = PG8_PKH(acc[ai][0][m][n][2 * hq], acc[ai][0][m][n][2 * hq + 1]) * hinv + bg2[n][hq];
                        const h2_ L = PG8_PKH(acc[ai][1][m][n][2 * hq], acc[ai][1][m][n][2 * hq + 1]) * hinv + bl2[n][hq];
                        const h2_ g = __builtin_elementwise_min(G, h7), l = __builtin_elementwise_max(__builtin_elementwise_min(L, h7), hm7);
                        const h2_ t = g * hk; h2_ e; e.x = __builtin_exp2f16(t.x); e.y = __builtin_exp2f16(t.y);
                        const h2_ d = e + h1; h2_ rr; rr.x = __builtin_amdgcn_rcph(d.x); rr.y = __builtin_amdgcn_rcph(d.y);
                        const h2_ o = (g * rr) * (l * h4 + h4);
                        wv[n] = hq == 0 ? __builtin_amdgcn_cvt_scalef32_pk_fp8_f16(wv[n], o, 1.0f, false) : __builtin_amdgcn_cvt_scalef32_pk_fp8_f16(wv[n], o, 1.0f, true); } }
                typedef unsigned u32x2_ __attribute__((ext_vector_type(2)));
                u32x2_ w; w.x = __builtin_bit_cast(unsigned, wv[0]); w.y = __builtin_bit_cast(unsigned, wv[1]);
                *(u32x2_*)rowp = w; }
#undef PG8_PKH
    }
};
struct EpiDn {
    static constexpr bool PERM = true, AFTER_DRAIN = false;
    unsigned char* O; const float* bias; const PG8_LAS int* rowbase; const PG8_LAS int* ecnt; const int* list; int cap; const float* lgate; PG8_LAS float* tab;
    __device__ __forceinline__ void prefetch(const Unit& u, int par, int wid, int lane) const {
        const int e = u.pn >> 2, j = u.pn & 3; const int pb = u.pm * BM - rowbase[e]; PG8_LAS float* t = tab + par * 768;
        if (wid < 4) { const int r = wid * 64 + lane;
            __builtin_amdgcn_global_load_lds((const unsigned*)(list + (size_t)e * cap + pb + r), (PG8_LAS unsigned*)(t + wid * 64), 4, 0, 0);
            __builtin_amdgcn_global_load_lds((const unsigned*)(bias + (size_t)e * 1024 + j * BM + r), (PG8_LAS unsigned*)(t + 512 + wid * 64), 4, 0, 0); }
        else { const int r = (wid - 4) * 64 + lane;
            __builtin_amdgcn_global_load_lds((const unsigned*)(lgate + (size_t)e * cap + pb + r), (PG8_LAS unsigned*)(t + 256 + (wid - 4) * 64), 4, 0, 0); }
    }
    __device__ __forceinline__ void operator()(const f32x4 (&acc)[2][2][4][2], const Unit& u, int wr, int wc, int fr, int fq, int par) const {
        const int e = u.pn >> 2, j = u.pn & 3; const int pl0 = wr * 64 + fr; const int p0 = u.pm * BM - rowbase[e] + pl0, cnt = ecnt[e];
        const int col0 = j * BM + wc * 64 + 16 * fq; const PG8_LAS float* t = tab + par * 768; const PG8_LAS float* bp = t + 512 + wc * 64 + 16 * fq;
        f32x4 bv[2][2];
#pragma unroll
        for (int bj = 0; bj < 2; ++bj)
#pragma unroll
            for (int n = 0; n < 2; ++n) bv[bj][n] = *(const PG8_LAS f32x4*)(bp + 8 * bj + 4 * n);
        int id[2][4]; float gt[2][4];
#pragma unroll
        for (int ai = 0; ai < 2; ++ai)
#pragma unroll
            for (int m = 0; m < 4; ++m) { const int q = ai * HALF + m * 16; id[ai][m] = (p0 + q < cnt) ? ((const PG8_LAS int*)t)[pl0 + q] : -1; gt[ai][m] = t[256 + pl0 + q]; }
#pragma unroll
        for (int ai = 0; ai < 2; ++ai)
#pragma unroll
            for (int m = 0; m < 4; ++m) { if (id[ai][m] < 0) continue; unsigned char* rowp = O + (size_t)id[ai][m] * 1024 + col0; const float g = gt[ai][m] * YT8_SCALE;
                unsigned wq[4];
#pragma unroll
                for (int bj = 0; bj < 2; ++bj) { const f32x4 v0 = (acc[ai][bj][m][0] * DN8_INV + bv[bj][0]) * g, v1 = (acc[ai][bj][m][1] * DN8_INV + bv[bj][1]) * g;
                    wq[2 * bj] = pk4_fp8(v0[0], v0[1], v0[2], v0[3]); wq[2 * bj + 1] = pk4_fp8(v1[0], v1[1], v1[2], v1[3]); }
                *(u32x4*)rowp = (u32x4){wq[0], wq[1], wq[2], wq[3]}; }
    }
};
struct MoeOrder {
    int NJ, ntiles, G, vcu; const PG8_LAS unsigned char* texp; const PG8_LAS int* rowbase; const PG8_LAS int* ecnt; const int* list; int cap;
    __device__ __forceinline__ int rowtok(const Unit& u, int r) const { const int e = u.pn / NJ; const int p = u.pm * 256 - rowbase[e] + r; return p < ecnt[e] ? (list[(size_t)e * cap + p] >> 2) : 0; }
    __device__ __forceinline__ bool next(int i, Unit& u) const {
        const int L = i * G + vcu; const int pm = L / NJ; if (pm >= ntiles) return false;
        const int j = L - pm * NJ; const int e = texp[pm]; u.pm = pm; u.pn = e * NJ + j; return true; }
    __device__ __forceinline__ void a_ready(const Unit&) const {}
    __device__ __forceinline__ void done(const Unit&) const {}
};
template <class Epi, class Sched, bool ALIGN_EPI = false, bool SP2 = false>
__device__ __forceinline__ void gemm_phase(PG8_LAS unsigned char* lds, const Gemm g, const Sched& S, const Epi& E) {
    int tid_ = threadIdx.x; asm volatile("" : "+v"(tid_));
    const int tid = tid_, wid = __builtin_amdgcn_readfirstlane(tid >> 6), lane = tid & 63, wr = wid >> 2, wc = wid & 3, fr = lane & 15, fq = lane >> 4;
    const int K = g.K, nt = K / BK;
    unsigned voffA[2], voffB[2];
#pragma unroll
    for (int i = 0; i < 2; ++i) { int R, C; stage_rc(tid * 16 + i * 8192, R, C); const int Rb = Epi::PERM ? ((R & ~31) + perm32(R & 31)) : R;
        voffA[i] = (unsigned)(R * K + C) * 2u; voffB[i] = (unsigned)(Rb * K + C) * 2u; }
    const size_t kstep = (size_t)(BK * 2);
    const size_t hstep = (size_t)HALF * K * 2;
    const size_t tstep = 2 * hstep;
    const unsigned ldsw = (unsigned)wid * 1024u;
    const int aoff = lds_byte(wr * 64 + fr, fq * 8), boff = lds_byte(wc * 32 + fr, fq * 8);
#define PG8_SA(b, h) (((b) * 2 + (h)) * HTB)
#define PG8_SB(b, h) ((4 + (b) * 2 + (h)) * HTB)
#define PG8_STAGE(bufoff, gbase, voff) do { _Pragma("unroll") for (int _i = 0; _i < 2; ++_i) \
        __builtin_amdgcn_global_load_lds((const unsigned*)((const char*)(gbase) + (voff)[_i]), (PG8_LAS unsigned*)(lds + (bufoff) + ldsw + _i * 8192), 16, 0, 0); } while (0)
#define PG8_LDA(dst, b, h) do { _Pragma("unroll") for (int m = 0; m < 4; ++m) _Pragma("unroll") for (int k = 0; k < 2; ++k) dst[m][k] = *(const PG8_LAS bf16x8*)(lds + PG8_SA(b, h) + aoff + m * 2048 + k * 1024); } while (0)
#define PG8_LDB(dst, b, h) do { _Pragma("unroll") for (int n = 0; n < 2; ++n) _Pragma("unroll") for (int k = 0; k < 2; ++k) dst[n][k] = *(const PG8_LAS bf16x8*)(lds + PG8_SB(b, h) + boff + n * 2048 + k * 1024); } while (0)
#define PG8_MMA(ai, bj, At, Bt) do { __builtin_amdgcn_s_setprio(1); _Pragma("unroll") for (int m = 0; m < 4; ++m) _Pragma("unroll") for (int n = 0; n < 2; ++n) _Pragma("unroll") for (int k = 0; k < 2; ++k) \
        acc[ai][bj][m][n] = __builtin_amdgcn_mfma_f32_16x16x32_bf16(Bt[n][k], At[m][k], acc[ai][bj][m][n], 0, 0, 0); __builtin_amdgcn_s_setprio(0); } while (0)
#define PG8_WAIT_V(n) asm volatile("s_waitcnt vmcnt(" #n ")" ::: "memory")
#define PG8_WAIT_L(n) asm volatile("s_waitcnt lgkmcnt(" #n ")" ::: "memory")
#define PG8_BAR __builtin_amdgcn_s_barrier()
#define PG8_SCHED __builtin_amdgcn_sched_barrier(0)
    Unit cur, nxt; int ui = 0;
    if (!S.next(0, cur)) return;
    f32x4 acc[2][2][4][2];
#pragma unroll
    for (int a = 0; a < 2; ++a)
#pragma unroll
        for (int b = 0; b < 2; ++b)
#pragma unroll
            for (int m = 0; m < 4; ++m)
#pragma unroll
                for (int n = 0; n < 2; ++n) acc[a][b][m][n] = (f32x4){0.f, 0.f, 0.f, 0.f};
    bf16x8 At[4][2], B0[2][2], B1[2][2];
    const char* cA = (const char*)g.A + (size_t)cur.pm * tstep; const char* cB = (const char*)g.Bt + (size_t)cur.pn * tstep;
    S.a_ready(cur);
    if constexpr (SP2) {
        PG8_STAGE(PG8_SB(0, 0), cB, voffB); PG8_STAGE(PG8_SB(0, 1), cB + hstep, voffB); PG8_STAGE(PG8_SA(0, 0), cA, voffA); PG8_STAGE(PG8_SA(0, 1), cA + hstep, voffA);
        if (wr == 1) PG8_BAR;
        PG8_WAIT_V(2); PG8_BAR;
        PG8_STAGE(PG8_SB(1, 0), cB + kstep, voffB); PG8_STAGE(PG8_SA(1, 0), cA + kstep, voffA); PG8_STAGE(PG8_SB(1, 1), cB + hstep + kstep, voffB);
        PG8_WAIT_V(6); PG8_BAR;
    } else {
        PG8_STAGE(PG8_SB(0, 0), cB, voffB); PG8_STAGE(PG8_SA(0, 0), cA, voffA); PG8_STAGE(PG8_SB(0, 1), cB + hstep, voffB); PG8_STAGE(PG8_SA(0, 1), cA + hstep, voffA);
        if (wr == 1) PG8_BAR;
        PG8_WAIT_V(4); PG8_BAR;
        PG8_STAGE(PG8_SB(1, 0), cB + kstep, voffB); PG8_STAGE(PG8_SA(1, 0), cA + kstep, voffA); PG8_STAGE(PG8_SB(1, 1), cB + hstep + kstep, voffB);
        PG8_WAIT_V(6); PG8_BAR;
    }
    for (;;) {
        const bool has_next = S.next(ui + 1, nxt);
        const char* nA = has_next ? (const char*)g.A + (size_t)nxt.pm * tstep : cA; const char* nB = has_next ? (const char*)g.Bt + (size_t)nxt.pn * tstep : cB;
        for (int t = 0; t < nt; t += 2) {
            const bool last = (t == nt - 2);
            const char* a1 = cA + (size_t)(t + 1) * kstep;
            const char* a2 = last ? nA : cA + (size_t)(t + 2) * kstep; const char* b2 = last ? nB : cB + (size_t)(t + 2) * kstep;
            const char* a3 = a2 + kstep; const char* b3 = b2 + kstep;
            if (last && has_next) S.a_ready(nxt);
            if constexpr (SP2) {
            PG8_LDB(B0, 0, 0); PG8_LDB(B1, 0, 1); PG8_SCHED; PG8_LDA(At, 0, 0); PG8_STAGE(PG8_SA(1, 1), a1 + hstep, voffA);
            PG8_WAIT_V(8); PG8_WAIT_L(0); PG8_BAR; PG8_MMA(0, 0, At, B0); PG8_MMA(0, 1, At, B1); PG8_BAR; PG8_SCHED;
            PG8_LDA(At, 0, 1); PG8_STAGE(PG8_SB(0, 0), b2, voffB); PG8_STAGE(PG8_SB(0, 1), b2 + hstep, voffB); PG8_STAGE(PG8_SA(0, 0), a2, voffA);
            PG8_WAIT_V(8); PG8_WAIT_L(0); PG8_BAR; PG8_MMA(1, 0, At, B0); PG8_MMA(1, 1, At, B1); PG8_BAR; PG8_SCHED;
            PG8_LDB(B0, 1, 0); PG8_LDB(B1, 1, 1); PG8_SCHED; PG8_LDA(At, 1, 0); PG8_STAGE(PG8_SA(0, 1), a2 + hstep, voffA);
            PG8_WAIT_V(8); PG8_WAIT_L(0); PG8_BAR; PG8_MMA(0, 0, At, B0); PG8_MMA(0, 1, At, B1); PG8_BAR; PG8_SCHED;
            PG8_LDA(At, 1, 1); PG8_STAGE(PG8_SB(1, 0), b3, voffB); PG8_STAGE(PG8_SB(1, 1), b3 + hstep, voffB); PG8_STAGE(PG8_SA(1, 0), a3, voffA);
            PG8_WAIT_V(8); PG8_WAIT_L(0); PG8_BAR; PG8_MMA(1, 0, At, B0); PG8_MMA(1, 1, At, B1); PG8_BAR; PG8_SCHED;
            } else {
            PG8_LDB(B0, 0, 0); PG8_SCHED; PG8_LDA(At, 0, 0); PG8_STAGE(PG8_SA(1, 1), a1 + hstep, voffA);
            PG8_WAIT_L(8); PG8_BAR; PG8_WAIT_L(0); PG8_MMA(0, 0, At, B0); PG8_BAR; PG8_SCHED;
            PG8_LDB(B1, 0, 1); PG8_STAGE(PG8_SB(0, 0), b2, voffB);
            PG8_BAR; PG8_WAIT_L(0); PG8_MMA(0, 1, At, B1); PG8_BAR;
            PG8_LDA(At, 0, 1); PG8_STAGE(PG8_SA(0, 0), a2, voffA);
            PG8_BAR; PG8_WAIT_L(0); PG8_MMA(1, 0, At, B0); PG8_BAR; PG8_SCHED;
            PG8_STAGE(PG8_SB(0, 1), b2 + hstep, voffB);
            PG8_WAIT_V(6); PG8_BAR; PG8_MMA(1, 1, At, B1); PG8_BAR;
            PG8_LDB(B0, 1, 0); PG8_SCHED; PG8_LDA(At, 1, 0); PG8_STAGE(PG8_SA(0, 1), a2 + hstep, voffA);
            PG8_WAIT_L(8); PG8_BAR; PG8_WAIT_L(0); PG8_MMA(0, 0, At, B0); PG8_BAR; PG8_SCHED;
            PG8_LDB(B1, 1, 1); PG8_STAGE(PG8_SB(1, 0), b3, voffB);
            PG8_BAR; PG8_WAIT_L(0); PG8_MMA(0, 1, At, B1); PG8_BAR;
            PG8_LDA(At, 1, 1); PG8_STAGE(PG8_SA(1, 0), a3, voffA);
            PG8_BAR; PG8_WAIT_L(0); PG8_MMA(1, 0, At, B0); PG8_BAR; PG8_SCHED;
            PG8_STAGE(PG8_SB(1, 1), b3 + hstep, voffB);
            PG8_WAIT_V(6); PG8_BAR; PG8_MMA(1, 1, At, B1); PG8_BAR;
            }
        }
        if constexpr (ALIGN_EPI) { if (wr == 0) PG8_BAR; }
        if constexpr (!Epi::AFTER_DRAIN) { E(acc, cur, wr, wc, fr, fq); S.done(cur); }
        if (!has_next) break;
#pragma unroll
        for (int a = 0; a < 2; ++a)
#pragma unroll
            for (int b = 0; b < 2; ++b)
#pragma unroll
                for (int m = 0; m < 4; ++m)
#pragma unroll
                    for (int n = 0; n < 2; ++n) acc[a][b][m][n] = (f32x4){0.f, 0.f, 0.f, 0.f};
        cur = nxt; cA = nA; cB = nB; ++ui;
        if constexpr (ALIGN_EPI) { if (wr == 1) PG8_BAR; }
    }
    PG8_WAIT_V(0);
    if constexpr (!ALIGN_EPI) { if (wr == 0) PG8_BAR; }
    PG8_BAR;
    if constexpr (Epi::AFTER_DRAIN) { E.fused(acc, cur, wr, wc, fr, fq, lds, wid, lane); S.done(cur); }
#undef PG8_SA
#undef PG8_SB
#undef PG8_STAGE
#undef PG8_LDA
#undef PG8_LDB
#undef PG8_MMA
#ifdef PG8_MMAI
#undef PG8_MMAI
#endif
#undef PG8_WAIT_V
#undef PG8_WAIT_L
#undef PG8_BAR
#undef PG8_SCHED
}
template <class Epi, class Sched, bool ALIGN_EPI = false, bool SP2 = false>
__device__ __forceinline__ void gemm_phase_gn(PG8_LAS unsigned char* lds, const Gemm g, const Sched& S, const Epi& E, const PG8_LAS float* rt) {
    int tid_ = threadIdx.x; asm volatile("" : "+v"(tid_));
    const int tid = tid_, wid = __builtin_amdgcn_readfirstlane(tid >> 6), lane = tid & 63, wr = wid >> 2, wc = wid & 3, fr = lane & 15, fq = lane >> 4;
    const int K = g.K, nt = K / BK;
    unsigned voffA[2], voffB[2];
#pragma unroll
    for (int i = 0; i < 2; ++i) { int R, C; stage_rc(tid * 16 + i * 8192, R, C); const int Rb = Epi::PERM ? ((R & ~31) + perm32(R & 31)) : R;
        voffA[i] = (unsigned)(R * K + C) * 2u; voffB[i] = (unsigned)(Rb * K + C) * 2u; }
    const size_t kstep = (size_t)(BK * 2);
    const size_t hstep = (size_t)HALF * K * 2;
    const size_t tstep = 2 * hstep;
    const unsigned ldsw = (unsigned)wid * 1024u;
    const int aoff = lds_byte(wr * 64 + fr, fq * 8), boff = lds_byte(wc * 32 + fr, fq * 8);
#define PG8_SA(b, h) (((b) * 2 + (h)) * HTB)
#define PG8_SB(b, h) ((4 + (b) * 2 + (h)) * HTB)
#define PG8_STAGE(bufoff, gbase, voff) do { _Pragma("unroll") for (int _i = 0; _i < 2; ++_i) \
        __builtin_amdgcn_global_load_lds((const unsigned*)((const char*)(gbase) + (voff)[_i]), (PG8_LAS unsigned*)(lds + (bufoff) + ldsw + _i * 8192), 16, 0, 0); } while (0)
#define PG8_LDA(dst, b, h) do { _Pragma("unroll") for (int m = 0; m < 4; ++m) _Pragma("unroll") for (int k = 0; k < 2; ++k) dst[m][k] = *(const PG8_LAS bf16x8*)(lds + PG8_SA(b, h) + aoff + m * 2048 + k * 1024); } while (0)
#define PG8_LDB(dst, b, h) do { _Pragma("unroll") for (int n = 0; n < 2; ++n) _Pragma("unroll") for (int k = 0; k < 2; ++k) dst[n][k] = *(const PG8_LAS bf16x8*)(lds + PG8_SB(b, h) + boff + n * 2048 + k * 1024); } while (0)
#define PG8_MMA(ai, bj, At, Bt) do { __builtin_amdgcn_s_setprio(1); _Pragma("unroll") for (int m = 0; m < 4; ++m) _Pragma("unroll") for (int n = 0; n < 2; ++n) _Pragma("unroll") for (int k = 0; k < 2; ++k) \
        acc[ai][bj][m][n] = __builtin_amdgcn_mfma_f32_16x16x32_bf16(Bt[n][k], At[m][k], acc[ai][bj][m][n], 0, 0, 0); __builtin_amdgcn_s_setprio(0); } while (0)
#define PG8_WAIT_V(n) asm volatile("s_waitcnt vmcnt(" #n ")" ::: "memory")
#define PG8_WAIT_L(n) asm volatile("s_waitcnt lgkmcnt(" #n ")" ::: "memory")
#define PG8_BAR __builtin_amdgcn_s_barrier()
#define PG8_SCHED __builtin_amdgcn_sched_barrier(0)
    Unit cur, nxt; int ui = 0;
    if (!S.next(0, cur)) return;
    f32x4 acc[2][2][4][2];
#pragma unroll
    for (int a = 0; a < 2; ++a)
#pragma unroll
        for (int b = 0; b < 2; ++b)
#pragma unroll
            for (int m = 0; m < 4; ++m)
#pragma unroll
                for (int n = 0; n < 2; ++n) acc[a][b][m][n] = (f32x4){0.f, 0.f, 0.f, 0.f};
    bf16x8 At[4][2], B0[2][2], B1[2][2];
    const char* cA = (const char*)g.A + (size_t)cur.pm * tstep; const char* cB = (const char*)g.Bt + (size_t)cur.pn * tstep;
    S.a_ready(cur);
    if constexpr (SP2) {
        PG8_STAGE(PG8_SB(0, 0), cB, voffB); PG8_STAGE(PG8_SB(0, 1), cB + hstep, voffB); PG8_STAGE(PG8_SA(0, 0), cA, voffA); PG8_STAGE(PG8_SA(0, 1), cA + hstep, voffA);
        if (wr == 1) PG8_BAR;
        PG8_WAIT_V(2); PG8_BAR;
        PG8_STAGE(PG8_SB(1, 0), cB + kstep, voffB); PG8_STAGE(PG8_SA(1, 0), cA + kstep, voffA); PG8_STAGE(PG8_SB(1, 1), cB + hstep + kstep, voffB);
        PG8_WAIT_V(6); PG8_BAR;
    } else {
        PG8_STAGE(PG8_SB(0, 0), cB, voffB); PG8_STAGE(PG8_SA(0, 0), cA, voffA); PG8_STAGE(PG8_SB(0, 1), cB + hstep, voffB); PG8_STAGE(PG8_SA(0, 1), cA + hstep, voffA);
        if (wr == 1) PG8_BAR;
        PG8_WAIT_V(4); PG8_BAR;
        PG8_STAGE(PG8_SB(1, 0), cB + kstep, voffB); PG8_STAGE(PG8_SA(1, 0), cA + kstep, voffA); PG8_STAGE(PG8_SB(1, 1), cB + hstep + kstep, voffB);
        PG8_WAIT_V(6); PG8_BAR;
    }
    for (;;) {
        const bool has_next = S.next(ui + 1, nxt);
        const char* nA = has_next ? (const char*)g.A + (size_t)nxt.pm * tstep : cA; const char* nB = has_next ? (const char*)g.Bt + (size_t)nxt.pn * tstep : cB;
        for (int t = 0; t < nt; t += 2) {
            if (t == 4 || t == 10) { const int w_ = (t == 4) ? 0 : 1;
#pragma unroll
                for (int a = 0; a < 2; ++a)
#pragma unroll
                    for (int m = 0; m < 4; ++m) { const float f_ = rt[((ui & 1) * 256 + a * HALF + wr * 64 + m * 16 + fr) * 4 + w_];
#pragma unroll
                        for (int b = 0; b < 2; ++b)
#pragma unroll
                            for (int n = 0; n < 2; ++n) acc[a][b][m][n] = acc[a][b][m][n] * f_; } }
            const bool last = (t == nt - 2);
            const char* a1 = cA + (size_t)(t + 1) * kstep;
            const char* a2 = last ? nA : cA + (size_t)(t + 2) * kstep; const char* b2 = last ? nB : cB + (size_t)(t + 2) * kstep;
            const char* a3 = a2 + kstep; const char* b3 = b2 + kstep;
            if (last && has_next) S.a_ready(nxt);
            if constexpr (SP2) {
            PG8_LDB(B0, 0, 0); PG8_LDB(B1, 0, 1); PG8_SCHED; PG8_LDA(At, 0, 0); PG8_STAGE(PG8_SA(1, 1), a1 + hstep, voffA);
            PG8_WAIT_V(8); PG8_WAIT_L(0); PG8_BAR; PG8_MMA(0, 0, At, B0); PG8_MMA(0, 1, At, B1); PG8_BAR; PG8_SCHED;
            PG8_LDA(At, 0, 1); PG8_STAGE(PG8_SB(0, 0), b2, voffB); PG8_STAGE(PG8_SB(0, 1), b2 + hstep, voffB); PG8_STAGE(PG8_SA(0, 0), a2, voffA);
            PG8_WAIT_V(8); PG8_WAIT_L(0); PG8_BAR; PG8_MMA(1, 0, At, B0); PG8_MMA(1, 1, At, B1); PG8_BAR; PG8_SCHED;
            PG8_LDB(B0, 1, 0); PG8_LDB(B1, 1, 1); PG8_SCHED; PG8_LDA(At, 1, 0); PG8_STAGE(PG8_SA(0, 1), a2 + hstep, voffA);
            PG8_WAIT_V(8); PG8_WAIT_L(0); PG8_BAR; PG8_MMA(0, 0, At, B0); PG8_MMA(0, 1, At, B1); PG8_BAR; PG8_SCHED;
            PG8_LDA(At, 1, 1); PG8_STAGE(PG8_SB(1, 0), b3, voffB); PG8_STAGE(PG8_SB(1, 1), b3 + hstep, voffB); PG8_STAGE(PG8_SA(1, 0), a3, voffA);
            PG8_WAIT_V(8); PG8_WAIT_L(0); PG8_BAR; PG8_MMA(1, 0, At, B0); PG8_MMA(1, 1, At, B1); PG8_BAR; PG8_SCHED;
            } else {
            PG8_LDB(B0, 0, 0); PG8_SCHED; PG8_LDA(At, 0, 0); PG8_STAGE(PG8_SA(1, 1), a1 + hstep, voffA);
            PG8_WAIT_L(8); PG8_BAR; PG8_WAIT_L(0); PG8_MMA(0, 0, At, B0); PG8_BAR; PG8_SCHED;
            PG8_LDB(B1, 0, 1); PG8_STAGE(PG8_SB(0, 0), b2, voffB);
            PG8_BAR; PG8_WAIT_L(0); PG8_MMA(0, 1, At, B1); PG8_BAR;
            PG8_LDA(At, 0, 1); PG8_STAGE(PG8_SA(0, 0), a2, voffA);
            PG8_BAR; PG8_WAIT_L(0); PG8_MMA(1, 0, At, B0); PG8_BAR; PG8_SCHED;
            PG8_STAGE(PG8_SB(0, 1), b2 + hstep, voffB);
            PG8_WAIT_V(6); PG8_BAR; PG8_MMA(1, 1, At, B1); PG8_BAR;
            PG8_LDB(B0, 1, 0); PG8_SCHED; PG8_LDA(At, 1, 0); PG8_STAGE(PG8_SA(0, 1), a2 + hstep, voffA);
            PG8_WAIT_L(8); PG8_BAR; PG8_WAIT_L(0); PG8_MMA(0, 0, At, B0); PG8_BAR; PG8_SCHED;
            PG8_LDB(B1, 1, 1); PG8_STAGE(PG8_SB(1, 0), b3, voffB);
            PG8_BAR; PG8_WAIT_L(0); PG8_MMA(0, 1, At, B1); PG8_BAR;
            PG8_LDA(At, 1, 1); PG8_STAGE(PG8_SA(1, 0), a3, voffA);
            PG8_BAR; PG8_WAIT_L(0); PG8_MMA(1, 0, At, B0); PG8_BAR; PG8_SCHED;
            PG8_STAGE(PG8_SB(1, 1), b3 + hstep, voffB);
            PG8_WAIT_V(6); PG8_BAR; PG8_MMA(1, 1, At, B1); PG8_BAR;
            }
        }
        if constexpr (ALIGN_EPI) { if (wr == 0) PG8_BAR; }
        {
#pragma unroll
            for (int a = 0; a < 2; ++a)
#pragma unroll
                for (int m = 0; m < 4; ++m) { const float f_ = rt[((ui & 1) * 256 + a * HALF + wr * 64 + m * 16 + fr) * 4 + 2];
#pragma unroll
                    for (int b = 0; b < 2; ++b)
#pragma unroll
                        for (int n = 0; n < 2; ++n) acc[a][b][m][n] = acc[a][b][m][n] * f_; } }
        if constexpr (!Epi::AFTER_DRAIN) { E(acc, cur, wr, wc, fr, fq); S.done(cur); }
        if (!has_next) break;
#pragma unroll
        for (int a = 0; a < 2; ++a)
#pragma unroll
            for (int b = 0; b < 2; ++b)
#pragma unroll
                for (int m = 0; m < 4; ++m)
#pragma unroll
                    for (int n = 0; n < 2; ++n) acc[a][b][m][n] = (f32x4){0.f, 0.f, 0.f, 0.f};
        cur = nxt; cA = nA; cB = nB; ++ui;
        if constexpr (ALIGN_EPI) { if (wr == 1) PG8_BAR; }
    }
    PG8_WAIT_V(0);
    if constexpr (!ALIGN_EPI) { if (wr == 0) PG8_BAR; }
    PG8_BAR;
    if constexpr (Epi::AFTER_DRAIN) { E.fused(acc, cur, wr, wc, fr, fq, lds, wid, lane); S.done(cur); }
#undef PG8_SA
#undef PG8_SB
#undef PG8_STAGE
#undef PG8_LDA
#undef PG8_LDB
#undef PG8_MMA
#ifdef PG8_MMAI
#undef PG8_MMAI
#endif
#undef PG8_WAIT_V
#undef PG8_WAIT_L
#undef PG8_BAR
#undef PG8_SCHED
}
template <class Epi, class Sched, bool ALIGN_EPI = false, bool SP2 = false>
__device__ __forceinline__ void gemm_phase_g(PG8_LAS unsigned char* lds, const Gemm g, const Sched& S, const Epi& E) {
    int tid_ = threadIdx.x; asm volatile("" : "+v"(tid_));
    const int tid = tid_, wid = __builtin_amdgcn_readfirstlane(tid >> 6), lane = tid & 63, wr = wid >> 2, wc = wid & 3, fr = lane & 15, fq = lane >> 4;
    const int K = g.K, nt = K / BK;
    unsigned voffA[2], voffB[2];
#pragma unroll
    for (int i = 0; i < 2; ++i) { int R, C; stage_rc(tid * 16 + i * 8192, R, C); const int Rb = Epi::PERM ? ((R & ~31) + perm32(R & 31)) : R;
        voffA[i] = (unsigned)(R * K + C) * 2u; voffB[i] = (unsigned)(Rb * K + C) * 2u; }
    const size_t kstep = (size_t)(BK * 2);
    const size_t hstep = (size_t)HALF * K * 2;
    const size_t tstep = 2 * hstep;
    const unsigned ldsw = (unsigned)wid * 1024u;
    const int aoff = lds_byte(wr * 64 + fr, fq * 8), boff = lds_byte(wc * 32 + fr, fq * 8);
#define PG8_SA(b, h) (((b) * 2 + (h)) * HTB)
#define PG8_SB(b, h) ((4 + (b) * 2 + (h)) * HTB)
#define PG8_STAGE(bufoff, gbase, voff) do { _Pragma("unroll") for (int _i = 0; _i < 2; ++_i) \
        __builtin_amdgcn_global_load_lds((const unsigned*)((const char*)(gbase) + (voff)[_i]), (PG8_LAS unsigned*)(lds + (bufoff) + ldsw + _i * 8192), 16, 0, 0); } while (0)
#define PG8_STAGE_A(bufoff, OFF, h, kb) do { _Pragma("unroll") for (int _i = 0; _i < 2; ++_i) \
        __builtin_amdgcn_global_load_lds((const unsigned*)((const char*)g.A + (OFF)[h][_i] + (kb)), (PG8_LAS unsigned*)(lds + (bufoff) + ldsw + _i * 8192), 16, 0, 0); } while (0)
#define PG8_LDA(dst, b, h) do { _Pragma("unroll") for (int m = 0; m < 4; ++m) _Pragma("unroll") for (int k = 0; k < 2; ++k) dst[m][k] = *(const PG8_LAS bf16x8*)(lds + PG8_SA(b, h) + aoff + m * 2048 + k * 1024); } while (0)
#define PG8_LDB(dst, b, h) do { _Pragma("unroll") for (int n = 0; n < 2; ++n) _Pragma("unroll") for (int k = 0; k < 2; ++k) dst[n][k] = *(const PG8_LAS bf16x8*)(lds + PG8_SB(b, h) + boff + n * 2048 + k * 1024); } while (0)
#define PG8_MMA(ai, bj, At, Bt) do { __builtin_amdgcn_s_setprio(1); _Pragma("unroll") for (int m = 0; m < 4; ++m) _Pragma("unroll") for (int n = 0; n < 2; ++n) _Pragma("unroll") for (int k = 0; k < 2; ++k) \
        acc[ai][bj][m][n] = __builtin_amdgcn_mfma_f32_16x16x32_bf16(Bt[n][k], At[m][k], acc[ai][bj][m][n], 0, 0, 0); __builtin_amdgcn_s_setprio(0); } while (0)
#define PG8_WAIT_V(n) asm volatile("s_waitcnt vmcnt(" #n ")" ::: "memory")
#define PG8_WAIT_L(n) asm volatile("s_waitcnt lgkmcnt(" #n ")" ::: "memory")
#define PG8_BAR __builtin_amdgcn_s_barrier()
#define PG8_SCHED __builtin_amdgcn_sched_barrier(0)
    Unit cur, nxt; int ui = 0;
    if (!S.next(0, cur)) return;
    f32x4 acc[2][2][4][2];
#pragma unroll
    for (int a = 0; a < 2; ++a)
#pragma unroll
        for (int b = 0; b < 2; ++b)
#pragma unroll
            for (int m = 0; m < 4; ++m)
#pragma unroll
                for (int n = 0; n < 2; ++n) acc[a][b][m][n] = (f32x4){0.f, 0.f, 0.f, 0.f};
    bf16x8 At[4][2], B0[2][2], B1[2][2];
    const char* cB = (const char*)g.Bt + (size_t)cur.pn * tstep;
    unsigned go[2][2], ngo[2][2]; int Rr[2], Cc[2];
#pragma unroll
    for (int i = 0; i < 2; ++i) stage_rc(tid * 16 + i * 8192, Rr[i], Cc[i]);
#pragma unroll
    for (int h = 0; h < 2; ++h)
#pragma unroll
        for (int i = 0; i < 2; ++i) go[h][i] = (unsigned)S.rowtok(cur, h * HALF + Rr[i]) * (unsigned)(K * 2) + (unsigned)Cc[i] * 2u;
    S.a_ready(cur);
    if constexpr (SP2) {
        PG8_STAGE(PG8_SB(0, 0), cB, voffB); PG8_STAGE(PG8_SB(0, 1), cB + hstep, voffB); PG8_STAGE_A(PG8_SA(0, 0), go, 0, 0); PG8_STAGE_A(PG8_SA(0, 1), go, 1, 0);
        if (wr == 1) PG8_BAR;
        PG8_WAIT_V(2); PG8_BAR;
        PG8_STAGE(PG8_SB(1, 0), cB + kstep, voffB); PG8_STAGE_A(PG8_SA(1, 0), go, 0, kstep); PG8_STAGE(PG8_SB(1, 1), cB + hstep + kstep, voffB);
        PG8_WAIT_V(6); PG8_BAR;
    } else {
        PG8_STAGE(PG8_SB(0, 0), cB, voffB); PG8_STAGE_A(PG8_SA(0, 0), go, 0, 0); PG8_STAGE(PG8_SB(0, 1), cB + hstep, voffB); PG8_STAGE_A(PG8_SA(0, 1), go, 1, 0);
        if (wr == 1) PG8_BAR;
        PG8_WAIT_V(4); PG8_BAR;
        PG8_STAGE(PG8_SB(1, 0), cB + kstep, voffB); PG8_STAGE_A(PG8_SA(1, 0), go, 0, kstep); PG8_STAGE(PG8_SB(1, 1), cB + hstep + kstep, voffB);
        PG8_WAIT_V(6); PG8_BAR;
    }
    for (;;) {
        const bool has_next = S.next(ui + 1, nxt);
        const char* nB = has_next ? (const char*)g.Bt + (size_t)nxt.pn * tstep : cB;
#pragma unroll
        for (int h = 0; h < 2; ++h)
#pragma unroll
            for (int i = 0; i < 2; ++i) ngo[h][i] = has_next ? (unsigned)S.rowtok(nxt, h * HALF + Rr[i]) * (unsigned)(K * 2) + (unsigned)Cc[i] * 2u : go[h][i];
        for (int t = 0; t < nt; t += 2) {
            const bool last = (t == nt - 2);
            const size_t ka1 = (size_t)(t + 1) * kstep;
            const size_t k2 = last ? 0 : (size_t)(t + 2) * kstep; const char* b2 = last ? nB : cB + (size_t)(t + 2) * kstep;
            unsigned o2[2][2];
#pragma unroll
            for (int h = 0; h < 2; ++h)
#pragma unroll
                for (int i = 0; i < 2; ++i) o2[h][i] = last ? ngo[h][i] : go[h][i];
            const char* b3 = b2 + kstep;
            if (last && has_next) S.a_ready(nxt);
            if constexpr (SP2) {
            PG8_LDB(B0, 0, 0); PG8_LDB(B1, 0, 1); PG8_SCHED; PG8_LDA(At, 0, 0); PG8_STAGE_A(PG8_SA(1, 1), go, 1, ka1);
            PG8_WAIT_V(8); PG8_WAIT_L(0); PG8_BAR; PG8_MMA(0, 0, At, B0); PG8_MMA(0, 1, At, B1); PG8_BAR; PG8_SCHED;
            PG8_LDA(At, 0, 1); PG8_STAGE(PG8_SB(0, 0), b2, voffB); PG8_STAGE(PG8_SB(0, 1), b2 + hstep, voffB); PG8_STAGE_A(PG8_SA(0, 0), o2, 0, k2);
            PG8_WAIT_V(8); PG8_WAIT_L(0); PG8_BAR; PG8_MMA(1, 0, At, B0); PG8_MMA(1, 1, At, B1); PG8_BAR; PG8_SCHED;
            PG8_LDB(B0, 1, 0); PG8_LDB(B1, 1, 1); PG8_SCHED; PG8_LDA(At, 1, 0); PG8_STAGE_A(PG8_SA(0, 1), o2, 1, k2);
            PG8_WAIT_V(8); PG8_WAIT_L(0); PG8_BAR; PG8_MMA(0, 0, At, B0); PG8_MMA(0, 1, At, B1); PG8_BAR; PG8_SCHED;
            PG8_LDA(At, 1, 1); PG8_STAGE(PG8_SB(1, 0), b3, voffB); PG8_STAGE(PG8_SB(1, 1), b3 + hstep, voffB); PG8_STAGE_A(PG8_SA(1, 0), o2, 0, k2 + kstep);
            PG8_WAIT_V(8); PG8_WAIT_L(0); PG8_BAR; PG8_MMA(1, 0, At, B0); PG8_MMA(1, 1, At, B1); PG8_BAR; PG8_SCHED;
            } else {
            PG8_LDB(B0, 0, 0); PG8_SCHED; PG8_LDA(At, 0, 0); PG8_STAGE_A(PG8_SA(1, 1), go, 1, ka1);
            PG8_WAIT_L(8); PG8_BAR; PG8_WAIT_L(0); PG8_MMA(0, 0, At, B0); PG8_BAR; PG8_SCHED;
            PG8_LDB(B1, 0, 1); PG8_STAGE(PG8_SB(0, 0), b2, voffB);
            PG8_BAR; PG8_WAIT_L(0); PG8_MMA(0, 1, At, B1); PG8_BAR;
            PG8_LDA(At, 0, 1); PG8_STAGE_A(PG8_SA(0, 0), o2, 0, k2);
            PG8_BAR; PG8_WAIT_L(0); PG8_MMA(1, 0, At, B0); PG8_BAR; PG8_SCHED;
            PG8_STAGE(PG8_SB(0, 1), b2 + hstep, voffB);
            PG8_WAIT_V(6); PG8_BAR; PG8_MMA(1, 1, At, B1); PG8_BAR;
            PG8_LDB(B0, 1, 0); PG8_SCHED; PG8_LDA(At, 1, 0); PG8_STAGE_A(PG8_SA(0, 1), o2, 1, k2);
            PG8_WAIT_L(8); PG8_BAR; PG8_WAIT_L(0); PG8_MMA(0, 0, At, B0); PG8_BAR; PG8_SCHED;
            PG8_LDB(B1, 1, 1); PG8_STAGE(PG8_SB(1, 0), b3, voffB);
            PG8_BAR; PG8_WAIT_L(0); PG8_MMA(0, 1, At, B1); PG8_BAR;
            PG8_LDA(At, 1, 1); PG8_STAGE_A(PG8_SA(1, 0), o2, 0, k2 + kstep);
            PG8_BAR; PG8_WAIT_L(0); PG8_MMA(1, 0, At, B0); PG8_BAR; PG8_SCHED;
            PG8_STAGE(PG8_SB(1, 1), b3 + hstep, voffB);
            PG8_WAIT_V(6); PG8_BAR; PG8_MMA(1, 1, At, B1); PG8_BAR;
            }
        }
        if constexpr (ALIGN_EPI) { if (wr == 0) PG8_BAR; }
        if constexpr (!Epi::AFTER_DRAIN) { E(acc, cur, wr, wc, fr, fq); S.done(cur); }
        if (!has_next) break;
#pragma unroll
        for (int a = 0; a < 2; ++a)
#pragma unroll
            for (int b = 0; b < 2; ++b)
#pragma unroll
                for (int m = 0; m < 4; ++m)
#pragma unroll
                    for (int n = 0; n < 2; ++n) acc[a][b][m][n] = (f32x4){0.f, 0.f, 0.f, 0.f};
        cur = nxt; cB = nB; ++ui;
#pragma unroll
        for (int h = 0; h < 2; ++h)
#pragma unroll
            for (int i = 0; i < 2; ++i) go[h][i] = ngo[h][i];
        if constexpr (ALIGN_EPI) { if (wr == 1) PG8_BAR; }
    }
    PG8_WAIT_V(0);
    if constexpr (!ALIGN_EPI) { if (wr == 0) PG8_BAR; }
    PG8_BAR;
    if constexpr (Epi::AFTER_DRAIN) { E.fused(acc, cur, wr, wc, fr, fq, lds, wid, lane); S.done(cur); }
#undef PG8_SA
#undef PG8_SB
#undef PG8_STAGE
#undef PG8_STAGE_A
#undef PG8_LDA
#undef PG8_LDB
#undef PG8_MMA
#ifdef PG8_MMAI
#undef PG8_MMAI
#endif
#undef PG8_WAIT_V
#undef PG8_WAIT_L
#undef PG8_BAR
#undef PG8_SCHED
}

typedef int i32x8 __attribute__((ext_vector_type(8)));
__device__ __forceinline__ void mfma8(f32x4& c, const i32x8& a, const i32x8& b, int sc) { asm volatile("v_mfma_scale_f32_16x16x128_f8f6f4 %0, %1, %2, %0, %3, %3 op_sel_hi:[0,0,0]" : "+v"(c) : "v"(a), "v"(b), "v"(sc)); }
template <class Epi, class Sched, bool ALIGN_EPI = false, bool SP2 = false>
__device__ __forceinline__ void gemm_phase8(PG8_LAS unsigned char* lds, const Gemm g, const Sched& S, const Epi& E) {
    int tid_ = threadIdx.x; asm volatile("" : "+v"(tid_));
    const int tid = tid_, wid = __builtin_amdgcn_readfirstlane(tid >> 6), lane = tid & 63, wr = wid >> 2, wc = wid & 3, fr = lane & 15, fq = lane >> 4;
    int sc8 = 0x7F7F7F7F; asm volatile("" : "+v"(sc8));
    const int K = g.K, nt = K / 128;
    unsigned voffA[2], voffB[2];
#pragma unroll
    for (int i = 0; i < 2; ++i) { int R, C; stage_rc(tid * 16 + i * 8192, R, C); const int Rb = Epi::PERM ? ((R & ~31) + perm32(R & 31)) : R;
        voffA[i] = (unsigned)(R * K + C * 2); voffB[i] = (unsigned)(Rb * K + C * 2); }
    const size_t kstep = (size_t)(BK * 2);
    const size_t hstep = (size_t)HALF * K;
    const size_t tstep = 2 * hstep;
    const unsigned ldsw = (unsigned)wid * 1024u;
    const int aoff = lds_byte(wr * 64 + fr, fq * 8), boff = lds_byte(wc * 32 + fr, fq * 8);
#define PG8_SA(b, h) (((b) * 2 + (h)) * HTB)
#define PG8_SB(b, h) ((4 + (b) * 2 + (h)) * HTB)
#define PG8_STAGE(bufoff, gbase, voff) do { _Pragma("unroll") for (int _i = 0; _i < 2; ++_i) \
        __builtin_amdgcn_global_load_lds((const unsigned*)((const char*)(gbase) + (voff)[_i]), (PG8_LAS unsigned*)(lds + (bufoff) + ldsw + _i * 8192), 16, 0, 0); } while (0)
#define PG8_LDA(dst, b, h) do { _Pragma("unroll") for (int m = 0; m < 4; ++m) { const u32x4 lo_ = *(const PG8_LAS u32x4*)(lds + PG8_SA(b, h) + aoff + m * 2048), hi_ = *(const PG8_LAS u32x4*)(lds + PG8_SA(b, h) + aoff + m * 2048 + 1024); \
        dst[m] = (i32x8){(int)lo_.x, (int)lo_.y, (int)lo_.z, (int)lo_.w, (int)hi_.x, (int)hi_.y, (int)hi_.z, (int)hi_.w}; } } while (0)
#define PG8_LDB(dst, b, h) do { _Pragma("unroll") for (int n = 0; n < 2; ++n) { const u32x4 lo_ = *(const PG8_LAS u32x4*)(lds + PG8_SB(b, h) + boff + n * 2048), hi_ = *(const PG8_LAS u32x4*)(lds + PG8_SB(b, h) + boff + n * 2048 + 1024); \
        dst[n] = (i32x8){(int)lo_.x, (int)lo_.y, (int)lo_.z, (int)lo_.w, (int)hi_.x, (int)hi_.y, (int)hi_.z, (int)hi_.w}; } } while (0)
#define PG8_MMA(ai, bj, At, Bt) do { __builtin_amdgcn_s_setprio(1); _Pragma("unroll") for (int m = 0; m < 4; ++m) _Pragma("unroll") for (int n = 0; n < 2; ++n) \
        mfma8(acc[ai][bj][m][n], Bt[n], At[m], sc8); __builtin_amdgcn_s_setprio(0); } while (0)
#define PG8_MMAI(ai, At, ST1, ST2, ST3) do { __builtin_amdgcn_s_setprio(1); \
        mfma8(acc[ai][0][0][0], B0[0], At[0], sc8); mfma8(acc[ai][0][0][1], B0[1], At[0], sc8); __builtin_amdgcn_sched_barrier(0); ST1; __builtin_amdgcn_sched_barrier(0); \
        mfma8(acc[ai][0][1][0], B0[0], At[1], sc8); mfma8(acc[ai][0][1][1], B0[1], At[1], sc8); mfma8(acc[ai][0][2][0], B0[0], At[2], sc8); mfma8(acc[ai][0][2][1], B0[1], At[2], sc8); __builtin_amdgcn_sched_barrier(0); ST2; __builtin_amdgcn_sched_barrier(0); \
        mfma8(acc[ai][0][3][0], B0[0], At[3], sc8); mfma8(acc[ai][0][3][1], B0[1], At[3], sc8); mfma8(acc[ai][1][0][0], B1[0], At[0], sc8); mfma8(acc[ai][1][0][1], B1[1], At[0], sc8); __builtin_amdgcn_sched_barrier(0); ST3; __builtin_amdgcn_sched_barrier(0); \
        mfma8(acc[ai][1][1][0], B1[0], At[1], sc8); mfma8(acc[ai][1][1][1], B1[1], At[1], sc8); mfma8(acc[ai][1][2][0], B1[0], At[2], sc8); mfma8(acc[ai][1][2][1], B1[1], At[2], sc8); \
        mfma8(acc[ai][1][3][0], B1[0], At[3], sc8); mfma8(acc[ai][1][3][1], B1[1], At[3], sc8); __builtin_amdgcn_s_setprio(0); } while (0)
#define PG8_WAIT_V(n) asm volatile("s_waitcnt vmcnt(" #n ")" ::: "memory")
#define PG8_WAIT_L(n) asm volatile("s_waitcnt lgkmcnt(" #n ")" ::: "memory")
#define PG8_BAR __builtin_amdgcn_s_barrier()
#define PG8_SCHED __builtin_amdgcn_sched_barrier(0)
    Unit cur, nxt; int ui = 0;
    if (!S.next(0, cur)) return;
    f32x4 acc[2][2][4][2];
#pragma unroll
    for (int a = 0; a < 2; ++a)
#pragma unroll
        for (int b = 0; b < 2; ++b)
#pragma unroll
            for (int m = 0; m < 4; ++m)
#pragma unroll
                for (int n = 0; n < 2; ++n) acc[a][b][m][n] = (f32x4){0.f, 0.f, 0.f, 0.f};
    i32x8 At[4], B0[2], B1[2];
    const char* cA = (const char*)g.A + (size_t)cur.pm * tstep; const char* cB = (const char*)g.Bt + (size_t)cur.pn * tstep;
    S.a_ready(cur);
    if constexpr (SP2) {
        PG8_STAGE(PG8_SB(0, 0), cB, voffB); PG8_STAGE(PG8_SB(0, 1), cB + hstep, voffB); PG8_STAGE(PG8_SA(0, 0), cA, voffA); PG8_STAGE(PG8_SA(0, 1), cA + hstep, voffA);
        if (wr == 1) PG8_BAR;
        PG8_WAIT_V(2); PG8_BAR;
        PG8_STAGE(PG8_SB(1, 0), cB + kstep, voffB); PG8_STAGE(PG8_SA(1, 0), cA + kstep, voffA); PG8_STAGE(PG8_SB(1, 1), cB + hstep + kstep, voffB);
        PG8_WAIT_V(6); PG8_BAR;
    } else {
        PG8_STAGE(PG8_SB(0, 0), cB, voffB); PG8_STAGE(PG8_SA(0, 0), cA, voffA); PG8_STAGE(PG8_SB(0, 1), cB + hstep, voffB); PG8_STAGE(PG8_SA(0, 1), cA + hstep, voffA);
        if (wr == 1) PG8_BAR;
        PG8_WAIT_V(4); PG8_BAR;
        PG8_STAGE(PG8_SB(1, 0), cB + kstep, voffB); PG8_STAGE(PG8_SA(1, 0), cA + kstep, voffA); PG8_STAGE(PG8_SB(1, 1), cB + hstep + kstep, voffB);
        PG8_WAIT_V(6); PG8_BAR;
    }
    for (;;) {
        const bool has_next = S.next(ui + 1, nxt);
        E.prefetch(cur, ui & 1, wid, lane);
        const char* nA = has_next ? (const char*)g.A + (size_t)nxt.pm * tstep : cA; const char* nB = has_next ? (const char*)g.Bt + (size_t)nxt.pn * tstep : cB;
        _Pragma("nounroll") for (int t = 0; t < nt; t += 2) {
            const bool last = (t == nt - 2);
            const char* a1 = cA + (size_t)(t + 1) * kstep;
            const char* a2 = last ? nA : cA + (size_t)(t + 2) * kstep; const char* b2 = last ? nB : cB + (size_t)(t + 2) * kstep;
            const char* a3 = a2 + kstep; const char* b3 = b2 + kstep;
            if (last && has_next) S.a_ready(nxt);
            if constexpr (SP2) {
            PG8_LDB(B0, 0, 0); PG8_LDB(B1, 0, 1); PG8_SCHED; PG8_LDA(At, 0, 0);
            PG8_WAIT_V(6); PG8_WAIT_L(0); PG8_BAR; PG8_MMAI(0, At, PG8_STAGE(PG8_SA(1, 1), a1 + hstep, voffA), (void)0, (void)0); PG8_BAR; PG8_SCHED;
            PG8_LDA(At, 0, 1);
            PG8_WAIT_V(2); PG8_WAIT_L(0); PG8_BAR; PG8_MMAI(1, At, PG8_STAGE(PG8_SB(0, 0), b2, voffB), PG8_STAGE(PG8_SB(0, 1), b2 + hstep, voffB), PG8_STAGE(PG8_SA(0, 0), a2, voffA)); PG8_BAR; PG8_SCHED;
            PG8_LDB(B0, 1, 0); PG8_LDB(B1, 1, 1); PG8_SCHED; PG8_LDA(At, 1, 0);
            PG8_WAIT_V(6); PG8_WAIT_L(0); PG8_BAR; PG8_MMAI(0, At, PG8_STAGE(PG8_SA(0, 1), a2 + hstep, voffA), (void)0, (void)0); PG8_BAR; PG8_SCHED;
            PG8_LDA(At, 1, 1);
            PG8_WAIT_V(2); PG8_WAIT_L(0); PG8_BAR; PG8_MMAI(1, At, PG8_STAGE(PG8_SB(1, 0), b3, voffB), PG8_STAGE(PG8_SB(1, 1), b3 + hstep, voffB), PG8_STAGE(PG8_SA(1, 0), a3, voffA)); PG8_BAR; PG8_SCHED;
            } else {
            PG8_LDB(B0, 0, 0); PG8_SCHED; PG8_LDA(At, 0, 0); PG8_STAGE(PG8_SA(1, 1), a1 + hstep, voffA);
            PG8_WAIT_L(8); PG8_BAR; PG8_WAIT_L(0); PG8_MMA(0, 0, At, B0); PG8_BAR; PG8_SCHED;
            PG8_LDB(B1, 0, 1); PG8_STAGE(PG8_SB(0, 0), b2, voffB);
            PG8_BAR; PG8_WAIT_L(0); PG8_MMA(0, 1, At, B1); PG8_BAR;
            PG8_LDA(At, 0, 1); PG8_STAGE(PG8_SA(0, 0), a2, voffA);
            PG8_BAR; PG8_WAIT_L(0); PG8_MMA(1, 0, At, B0); PG8_BAR; PG8_SCHED;
            PG8_STAGE(PG8_SB(0, 1), b2 + hstep, voffB);
            PG8_WAIT_V(6); PG8_BAR; PG8_MMA(1, 1, At, B1); PG8_BAR;
            PG8_LDB(B0, 1, 0); PG8_SCHED; PG8_LDA(At, 1, 0); PG8_STAGE(PG8_SA(0, 1), a2 + hstep, voffA);
            PG8_WAIT_L(8); PG8_BAR; PG8_WAIT_L(0); PG8_MMA(0, 0, At, B0); PG8_BAR; PG8_SCHED;
            PG8_LDB(B1, 1, 1); PG8_STAGE(PG8_SB(1, 0), b3, voffB);
            PG8_BAR; PG8_WAIT_L(0); PG8_MMA(0, 1, At, B1); PG8_BAR;
            PG8_LDA(At, 1, 1); PG8_STAGE(PG8_SA(1, 0), a3, voffA);
            PG8_BAR; PG8_WAIT_L(0); PG8_MMA(1, 0, At, B0); PG8_BAR; PG8_SCHED;
            PG8_STAGE(PG8_SB(1, 1), b3 + hstep, voffB);
            PG8_WAIT_V(6); PG8_BAR; PG8_MMA(1, 1, At, B1); PG8_BAR;
            }
        }
        if constexpr (ALIGN_EPI) { if (wr == 0) PG8_BAR; }
        asm volatile("s_nop 15\n\ts_nop 15" ::: "memory");
        if constexpr (!Epi::AFTER_DRAIN) { E(acc, cur, wr, wc, fr, fq, ui & 1); S.done(cur); }
        if (!has_next) break;
#pragma unroll
        for (int a = 0; a < 2; ++a)
#pragma unroll
            for (int b = 0; b < 2; ++b)
#pragma unroll
                for (int m = 0; m < 4; ++m)
#pragma unroll
                    for (int n = 0; n < 2; ++n) acc[a][b][m][n] = (f32x4){0.f, 0.f, 0.f, 0.f};
        cur = nxt; cA = nA; cB = nB; ++ui;
        if constexpr (ALIGN_EPI) { if (wr == 1) PG8_BAR; }
    }
    PG8_WAIT_V(0);
    if constexpr (!ALIGN_EPI) { if (wr == 0) PG8_BAR; }
    PG8_BAR;
    if constexpr (Epi::AFTER_DRAIN) { E.fused(acc, cur, wr, wc, fr, fq, lds, wid, lane); S.done(cur); }
#undef PG8_SA
#undef PG8_SB
#undef PG8_STAGE
#undef PG8_LDA
#undef PG8_LDB
#undef PG8_MMA
#ifdef PG8_MMAI
#undef PG8_MMAI
#endif
#undef PG8_MMAI
#undef PG8_WAIT_V
#undef PG8_WAIT_L
#undef PG8_BAR
#undef PG8_SCHED
}

template <class Epi, class Sched, bool ALIGN_EPI = false, bool SP2 = false>
__device__ __forceinline__ void gemm_phase_g8(PG8_LAS unsigned char* lds, const Gemm g, const Sched& S, const Epi& E) {
    int tid_ = threadIdx.x; asm volatile("" : "+v"(tid_));
    const int tid = tid_, wid = __builtin_amdgcn_readfirstlane(tid >> 6), lane = tid & 63, wr = wid >> 2, wc = wid & 3, fr = lane & 15, fq = lane >> 4;
    int sc8 = 0x7F7F7F7F; asm volatile("" : "+v"(sc8));
    const int K = g.K, nt = K / 128;
    unsigned voffA[2], voffB[2];
#pragma unroll
    for (int i = 0; i < 2; ++i) { int R, C; stage_rc(tid * 16 + i * 8192, R, C); const int Rb = Epi::PERM ? ((R & ~31) + perm32(R & 31)) : R;
        voffA[i] = (unsigned)(R * K + C * 2); voffB[i] = (unsigned)(Rb * K + C * 2); }
    const size_t kstep = (size_t)(BK * 2);
    const size_t hstep = (size_t)HALF * K;
    const size_t tstep = 2 * hstep;
    const unsigned ldsw = (unsigned)wid * 1024u;
    const int aoff = lds_byte(wr * 64 + fr, fq * 8), boff = lds_byte(wc * 32 + fr, fq * 8);
#define PG8_SA(b, h) (((b) * 2 + (h)) * HTB)
#define PG8_SB(b, h) ((4 + (b) * 2 + (h)) * HTB)
#define PG8_STAGE(bufoff, gbase, voff) do { _Pragma("unroll") for (int _i = 0; _i < 2; ++_i) \
        __builtin_amdgcn_global_load_lds((const unsigned*)((const char*)(gbase) + (voff)[_i]), (PG8_LAS unsigned*)(lds + (bufoff) + ldsw + _i * 8192), 16, 0, 0); } while (0)
#define PG8_STAGE_A(bufoff, OFF, h, kb) do { _Pragma("unroll") for (int _i = 0; _i < 2; ++_i) \
        __builtin_amdgcn_global_load_lds((const unsigned*)((const char*)g.A + (OFF)[h][_i] + (kb)), (PG8_LAS unsigned*)(lds + (bufoff) + ldsw + _i * 8192), 16, 0, 0); } while (0)
#define PG8_LDA(dst, b, h) do { _Pragma("unroll") for (int m = 0; m < 4; ++m) { const u32x4 lo_ = *(const PG8_LAS u32x4*)(lds + PG8_SA(b, h) + aoff + m * 2048), hi_ = *(const PG8_LAS u32x4*)(lds + PG8_SA(b, h) + aoff + m * 2048 + 1024); \
        dst[m] = (i32x8){(int)lo_.x, (int)lo_.y, (int)lo_.z, (int)lo_.w, (int)hi_.x, (int)hi_.y, (int)hi_.z, (int)hi_.w}; } } while (0)
#define PG8_LDB(dst, b, h) do { _Pragma("unroll") for (int n = 0; n < 2; ++n) { const u32x4 lo_ = *(const PG8_LAS u32x4*)(lds + PG8_SB(b, h) + boff + n * 2048), hi_ = *(const PG8_LAS u32x4*)(lds + PG8_SB(b, h) + boff + n * 2048 + 1024); \
        dst[n] = (i32x8){(int)lo_.x, (int)lo_.y, (int)lo_.z, (int)lo_.w, (int)hi_.x, (int)hi_.y, (int)hi_.z, (int)hi_.w}; } } while (0)
#define PG8_MMA(ai, bj, At, Bt) do { __builtin_amdgcn_s_setprio(1); _Pragma("unroll") for (int m = 0; m < 4; ++m) _Pragma("unroll") for (int n = 0; n < 2; ++n) \
        mfma8(acc[ai][bj][m][n], Bt[n], At[m], sc8); __builtin_amdgcn_s_setprio(0); } while (0)
#define PG8_MMAI(ai, At, ST1, ST2, ST3) do { __builtin_amdgcn_s_setprio(1); \
        mfma8(acc[ai][0][0][0], B0[0], At[0], sc8); mfma8(acc[ai][0][0][1], B0[1], At[0], sc8); __builtin_amdgcn_sched_barrier(0); ST1; __builtin_amdgcn_sched_barrier(0); \
        mfma8(acc[ai][0][1][0], B0[0], At[1], sc8); mfma8(acc[ai][0][1][1], B0[1], At[1], sc8); mfma8(acc[ai][0][2][0], B0[0], At[2], sc8); mfma8(acc[ai][0][2][1], B0[1], At[2], sc8); __builtin_amdgcn_sched_barrier(0); ST2; __builtin_amdgcn_sched_barrier(0); \
        mfma8(acc[ai][0][3][0], B0[0], At[3], sc8); mfma8(acc[ai][0][3][1], B0[1], At[3], sc8); mfma8(acc[ai][1][0][0], B1[0], At[0], sc8); mfma8(acc[ai][1][0][1], B1[1], At[0], sc8); __builtin_amdgcn_sched_barrier(0); ST3; __builtin_amdgcn_sched_barrier(0); \
        mfma8(acc[ai][1][1][0], B1[0], At[1], sc8); mfma8(acc[ai][1][1][1], B1[1], At[1], sc8); mfma8(acc[ai][1][2][0], B1[0], At[2], sc8); mfma8(acc[ai][1][2][1], B1[1], At[2], sc8); \
        mfma8(acc[ai][1][3][0], B1[0], At[3], sc8); mfma8(acc[ai][1][3][1], B1[1], At[3], sc8); __builtin_amdgcn_s_setprio(0); } while (0)
#define PG8_WAIT_V(n) asm volatile("s_waitcnt vmcnt(" #n ")" ::: "memory")
#define PG8_WAIT_L(n) asm volatile("s_waitcnt lgkmcnt(" #n ")" ::: "memory")
#define PG8_BAR __builtin_amdgcn_s_barrier()
#define PG8_SCHED __builtin_amdgcn_sched_barrier(0)
    Unit cur, nxt; int ui = 0;
    if (!S.next(0, cur)) return;
    f32x4 acc[2][2][4][2];
#pragma unroll
    for (int a = 0; a < 2; ++a)
#pragma unroll
        for (int b = 0; b < 2; ++b)
#pragma unroll
            for (int m = 0; m < 4; ++m)
#pragma unroll
                for (int n = 0; n < 2; ++n) acc[a][b][m][n] = (f32x4){0.f, 0.f, 0.f, 0.f};
    i32x8 At[4], B0[2], B1[2];
    const char* cB = (const char*)g.Bt + (size_t)cur.pn * tstep;
    unsigned go[2][2], ngo[2][2]; int Rr[2], Cc[2];
#pragma unroll
    for (int i = 0; i < 2; ++i) stage_rc(tid * 16 + i * 8192, Rr[i], Cc[i]);
#pragma unroll
    for (int h = 0; h < 2; ++h)
#pragma unroll
        for (int i = 0; i < 2; ++i) go[h][i] = (unsigned)S.rowtok(cur, h * HALF + Rr[i]) * (unsigned)K + (unsigned)Cc[i] * 2u;
    S.a_ready(cur);
    if constexpr (SP2) {
        PG8_STAGE(PG8_SB(0, 0), cB, voffB); PG8_STAGE(PG8_SB(0, 1), cB + hstep, voffB); PG8_STAGE_A(PG8_SA(0, 0), go, 0, 0); PG8_STAGE_A(PG8_SA(0, 1), go, 1, 0);
        if (wr == 1) PG8_BAR;
        PG8_WAIT_V(2); PG8_BAR;
        PG8_STAGE(PG8_SB(1, 0), cB + kstep, voffB); PG8_STAGE_A(PG8_SA(1, 0), go, 0, kstep); PG8_STAGE(PG8_SB(1, 1), cB + hstep + kstep, voffB);
        PG8_WAIT_V(6); PG8_BAR;
    } else {
        PG8_STAGE(PG8_SB(0, 0), cB, voffB); PG8_STAGE_A(PG8_SA(0, 0), go, 0, 0); PG8_STAGE(PG8_SB(0, 1), cB + hstep, voffB); PG8_STAGE_A(PG8_SA(0, 1), go, 1, 0);
        if (wr == 1) PG8_BAR;
        PG8_WAIT_V(4); PG8_BAR;
        PG8_STAGE(PG8_SB(1, 0), cB + kstep, voffB); PG8_STAGE_A(PG8_SA(1, 0), go, 0, kstep); PG8_STAGE(PG8_SB(1, 1), cB + hstep + kstep, voffB);
        PG8_WAIT_V(6); PG8_BAR;
    }
    for (;;) {
        const bool has_next = S.next(ui + 1, nxt);
        E.prefetch(cur, ui & 1, wid, lane);
        const char* nB = has_next ? (const char*)g.Bt + (size_t)nxt.pn * tstep : cB;
#pragma unroll
        for (int h = 0; h < 2; ++h)
#pragma unroll
            for (int i = 0; i < 2; ++i) ngo[h][i] = has_next ? (unsigned)S.rowtok(nxt, h * HALF + Rr[i]) * (unsigned)K + (unsigned)Cc[i] * 2u : go[h][i];
        _Pragma("nounroll") for (int t = 0; t < nt; t += 2) {
            const bool last = (t == nt - 2);
            const size_t ka1 = (size_t)(t + 1) * kstep;
            const size_t k2 = last ? 0 : (size_t)(t + 2) * kstep; const char* b2 = last ? nB : cB + (size_t)(t + 2) * kstep;
            unsigned o2[2][2];
#pragma unroll
            for (int h = 0; h < 2; ++h)
#pragma unroll
                for (int i = 0; i < 2; ++i) o2[h][i] = last ? ngo[h][i] : go[h][i];
            const char* b3 = b2 + kstep;
            if (last && has_next) S.a_ready(nxt);
            if constexpr (SP2) {
            PG8_LDB(B0, 0, 0); PG8_LDB(B1, 0, 1); PG8_SCHED; PG8_LDA(At, 0, 0);
            PG8_WAIT_V(6); PG8_WAIT_L(0); PG8_BAR; PG8_MMAI(0, At, PG8_STAGE_A(PG8_SA(1, 1), go, 1, ka1), (void)0, (void)0); PG8_BAR; PG8_SCHED;
            PG8_LDA(At, 0, 1);
            PG8_WAIT_V(2); PG8_WAIT_L(0); PG8_BAR; PG8_MMAI(1, At, PG8_STAGE(PG8_SB(0, 0), b2, voffB), PG8_STAGE(PG8_SB(0, 1), b2 + hstep, voffB), PG8_STAGE_A(PG8_SA(0, 0), o2, 0, k2)); PG8_BAR; PG8_SCHED;
            PG8_LDB(B0, 1, 0); PG8_LDB(B1, 1, 1); PG8_SCHED; PG8_LDA(At, 1, 0);
            PG8_WAIT_V(6); PG8_WAIT_L(0); PG8_BAR; PG8_MMAI(0, At, PG8_STAGE_A(PG8_SA(0, 1), o2, 1, k2), (void)0, (void)0); PG8_BAR; PG8_SCHED;
            PG8_LDA(At, 1, 1);
            PG8_WAIT_V(2); PG8_WAIT_L(0); PG8_BAR; PG8_MMAI(1, At, PG8_STAGE(PG8_SB(1, 0), b3, voffB), PG8_STAGE(PG8_SB(1, 1), b3 + hstep, voffB), PG8_STAGE_A(PG8_SA(1, 0), o2, 0, k2 + kstep)); PG8_BAR; PG8_SCHED;
            } else {
            PG8_LDB(B0, 0, 0); PG8_SCHED; PG8_LDA(At, 0, 0); PG8_STAGE_A(PG8_SA(1, 1), go, 1, ka1);
            PG8_WAIT_L(8); PG8_BAR; PG8_WAIT_L(0); PG8_MMA(0, 0, At, B0); PG8_BAR; PG8_SCHED;
            PG8_LDB(B1, 0, 1); PG8_STAGE(PG8_SB(0, 0), b2, voffB);
            PG8_BAR; PG8_WAIT_L(0); PG8_MMA(0, 1, At, B1); PG8_BAR;
            PG8_LDA(At, 0, 1); PG8_STAGE_A(PG8_SA(0, 0), o2, 0, k2);
            PG8_BAR; PG8_WAIT_L(0); PG8_MMA(1, 0, At, B0); PG8_BAR; PG8_SCHED;
            PG8_STAGE(PG8_SB(0, 1), b2 + hstep, voffB);
            PG8_WAIT_V(6); PG8_BAR; PG8_MMA(1, 1, At, B1); PG8_BAR;
            PG8_LDB(B0, 1, 0); PG8_SCHED; PG8_LDA(At, 1, 0); PG8_STAGE_A(PG8_SA(0, 1), o2, 1, k2);
            PG8_WAIT_L(8); PG8_BAR; PG8_WAIT_L(0); PG8_MMA(0, 0, At, B0); PG8_BAR; PG8_SCHED;
            PG8_LDB(B1, 1, 1); PG8_STAGE(PG8_SB(1, 0), b3, voffB);
            PG8_BAR; PG8_WAIT_L(0); PG8_MMA(0, 1, At, B1); PG8_BAR;
            PG8_LDA(At, 1, 1); PG8_STAGE_A(PG8_SA(1, 0), o2, 0, k2 + kstep);
            PG8_BAR; PG8_WAIT_L(0); PG8_MMA(1, 0, At, B0); PG8_BAR; PG8_SCHED;
            PG8_STAGE(PG8_SB(1, 1), b3 + hstep, voffB);
            PG8_WAIT_V(6); PG8_BAR; PG8_MMA(1, 1, At, B1); PG8_BAR;
            }
        }
        if constexpr (ALIGN_EPI) { if (wr == 0) PG8_BAR; }
        asm volatile("s_nop 15\n\ts_nop 15" ::: "memory");
        if constexpr (!Epi::AFTER_DRAIN) { E(acc, cur, wr, wc, fr, fq, ui & 1); S.done(cur); }
        if (!has_next) break;
#pragma unroll
        for (int a = 0; a < 2; ++a)
#pragma unroll
            for (int b = 0; b < 2; ++b)
#pragma unroll
                for (int m = 0; m < 4; ++m)
#pragma unroll
                    for (int n = 0; n < 2; ++n) acc[a][b][m][n] = (f32x4){0.f, 0.f, 0.f, 0.f};
        cur = nxt; cB = nB; ++ui;
#pragma unroll
        for (int h = 0; h < 2; ++h)
#pragma unroll
            for (int i = 0; i < 2; ++i) go[h][i] = ngo[h][i];
        if constexpr (ALIGN_EPI) { if (wr == 1) PG8_BAR; }
    }
    PG8_WAIT_V(0);
    if constexpr (!ALIGN_EPI) { if (wr == 0) PG8_BAR; }
    PG8_BAR;
    if constexpr (Epi::AFTER_DRAIN) { E.fused(acc, cur, wr, wc, fr, fq, lds, wid, lane); S.done(cur); }
#undef PG8_SA
#undef PG8_SB
#undef PG8_STAGE
#undef PG8_STAGE_A
#undef PG8_LDA
#undef PG8_LDB
#undef PG8_MMA
#ifdef PG8_MMAI
#undef PG8_MMAI
#endif
#undef PG8_MMAI
#undef PG8_WAIT_V
#undef PG8_WAIT_L
#undef PG8_BAR
#undef PG8_SCHED
}


}
constexpr int NB = 8, S = 4096, D = 1024, NTOK = NB * S, NL = 2, NE = 32, PW = 2816, INW = 2706;
constexpr int MAXROWS = NTOK * 4 + NE * 256, MAXTILES = MAXROWS / 256;
constexpr float RMS_EPS = 1e-6f;
constexpr int C_QA = 0, C_KA = 256, C_VA = 512, C_QB = 768, C_KVB = 1152, C_QC = 1536, C_KC = 1920, C_VC = 2304, C_GB = 2688;
constexpr int NWAVES = 8;
constexpr size_t MiB = 1u << 20;
constexpr size_t WS_CTL = 0, CTL_ZERO_BYTES = 1 * MiB;
constexpr size_t WS_ROPE = 1 * MiB;
constexpr size_t WS_MOD = 1 * MiB + 512 * 1024;
constexpr size_t WS_KMEAN = 2 * MiB;
constexpr size_t WS_KC = 2 * MiB + 256 * 1024, WS_VC = 2 * MiB + 768 * 1024;
constexpr size_t WS_ASG_E = 4 * MiB, WS_ASG_POS = 4 * MiB + 512 * 1024, WS_ASG_GATE = 5 * MiB, WS_ASG_ROW = 5 * MiB + 512 * 1024;
constexpr size_t WS_SELM = 6 * MiB, WS_KCB = 6 * MiB + 512 * 1024, WS_VCB = 7 * MiB;
constexpr size_t WS_WIN = 8 * MiB;
constexpr size_t WS_WOUT = 20 * MiB;
constexpr size_t WS_CW1T = 28 * MiB, WS_CW2T = 29 * MiB, WS_CCONST = 29 * MiB + 64 * 1024;
constexpr size_t WS_RWT = 29 * MiB + 128 * 1024, WS_RCONST = 31 * MiB + 512 * 1024;
constexpr size_t WS_LIST = 24 * MiB;
constexpr size_t WS_WGU = 32 * MiB;
constexpr size_t WS_WDN = 288 * MiB;
constexpr size_t WS_ACT = 416 * MiB;
constexpr size_t WS_PROJ = 480 * MiB;
constexpr size_t WS_O = 656 * MiB;
constexpr size_t WS_Y = 720 * MiB;
constexpr size_t WS_X1 = 784 * MiB;
constexpr size_t WS_SA = 912 * MiB;
constexpr size_t WS_SACT = 1184 * MiB;
constexpr size_t WS_OCP = 1456 * MiB;
constexpr size_t WS_ACT8 = 1484 * MiB;
constexpr size_t WS_OSS = 1516 * MiB;
constexpr size_t WS_LGATE = 1518 * MiB;
constexpr size_t WS_RW3 = 1522 * MiB;
constexpr size_t WS_END = 1526 * MiB;
static_assert(WS_SA + (size_t)MAXROWS * D * 2 <= WS_SACT && WS_SACT + (size_t)MAXROWS * D * 2 <= WS_END, "ws map");
constexpr int CW_TMO = 0, CW_CODE = 1, CW_CNT = 1024, CW_WQ = 2048, CW_BAR = 4096;
constexpr int NPHASE = 21, MAX_LAUNCHES = 21;
constexpr int RING_BYTES = 131072, LDSCTL_OFF = RING_BYTES, MISC_OFF = LDSCTL_OFF + 320, TAB_OFF = LDSCTL_OFF + 512;
constexpr int LDS_BYTES = 147456;
#define GAS __attribute__((address_space(1)))
#define LAS __attribute__((address_space(3)))
typedef unsigned short bf16;
typedef unsigned v4u __attribute__((ext_vector_type(4)));
typedef unsigned v2u __attribute__((ext_vector_type(2)));
typedef float f32x4 __attribute__((ext_vector_type(4)));
typedef GAS unsigned gu32;
#define RLX_AGENT __ATOMIC_RELAXED, __HIP_MEMORY_SCOPE_AGENT
#define LDS_WAIT() asm volatile("s_waitcnt lgkmcnt(0)" ::: "memory")
#define VM_WAIT() asm volatile("s_waitcnt vmcnt(0)" ::: "memory")
__device__ __forceinline__ unsigned f2bf(float f) { unsigned u = __builtin_bit_cast(unsigned, f); return (u + 0x7fffu + ((u >> 16) & 1u)) >> 16; }
__device__ __forceinline__ unsigned pk2(float lo, float hi) { return pg8::cvt_pk_bf16(lo, hi); }
__device__ __forceinline__ float bflo(unsigned v) { return __builtin_bit_cast(float, v << 16); }
__device__ __forceinline__ float bfhi(unsigned v) { return __builtin_bit_cast(float, v & 0xffff0000u); }
__device__ __forceinline__ float bf1(bf16 v) { return __builtin_bit_cast(float, (unsigned)v << 16); }
#define XB_TMO      128
#define XB_XCNT(j)  (256  + 64 * (j))
#define XB_XSUB(j)  (1280 + 64 * (j))
#define XB_XGEN(j)  (2304 + 64 * (j))
#define XB_TOP      3328
#define XB_TOPGEN   3392
#define XCD_BAR_WORDS 3456
#define XB_SPIN_CAP (1u << 18)

__device__ __forceinline__ unsigned xb_ld(unsigned* p)              { return __hip_atomic_load(p, __ATOMIC_RELAXED, __HIP_MEMORY_SCOPE_AGENT); }
__device__ __forceinline__ unsigned xb_add(unsigned* p, unsigned v) { return __hip_atomic_fetch_add(p, v, __ATOMIC_RELAXED, __HIP_MEMORY_SCOPE_AGENT); }
__device__ __forceinline__ unsigned xb_xcc_id() { return (unsigned)__builtin_amdgcn_s_getreg((3 << 11) | 20) & 0xFu; }
#define XB_SPIN(cond, bar) do { unsigned _sp = 0; while (cond) { __builtin_amdgcn_s_sleep(1); \
    if ((++_sp & 255u) == 0u) { if (xb_ld(&(bar)[XB_TMO])) break; if (_sp > XB_SPIN_CAP) { atomicAdd(&(bar)[XB_TMO], 1u); break; } } } } while (0)

struct XcdBarrier {
    unsigned* bar; unsigned x;
    volatile LAS unsigned* st;
};

__device__ __forceinline__ XcdBarrier xcd_barrier_post(unsigned* bar, volatile LAS unsigned* st) {
    XcdBarrier b; b.bar = bar; b.x = xb_xcc_id(); b.st = st;
    if (threadIdx.x == 0) (void)xb_add(&bar[XB_XCNT(b.x)], 1u);
    return b;
}
__device__ __forceinline__ void xcd_barrier_complete(unsigned* bar, unsigned x, unsigned& nloc, unsigned& nx) {
    const unsigned G = gridDim.x * gridDim.y * gridDim.z;
    unsigned sum, cnt, mine, sp = 0u;
    for (;;) {
        sum = 0u; cnt = 0u; mine = 0u;
#pragma unroll
        for (unsigned j = 0; j < 16; ++j) { const unsigned c = xb_ld(&bar[XB_XCNT(j)]); sum += c; cnt += (c > 0u) ? 1u : 0u; mine = (j == x) ? c : mine; }
        if (sum == G) break;
        __builtin_amdgcn_s_sleep(1);
        if ((++sp & 255u) == 0u) { if (xb_ld(&bar[XB_TMO])) break; if (sp > XB_SPIN_CAP) { atomicAdd(&bar[XB_TMO], 1u); break; } }
    }
    nloc = mine > 0u ? mine : 1u; nx = cnt > 0u ? cnt : 1u;
}

__device__ __forceinline__ void xcd_barrier(const XcdBarrier& b) {
    asm volatile("s_waitcnt vmcnt(0)" ::: "memory");
    __syncthreads();
    if (threadIdx.x == 0) {
        unsigned* bar = b.bar;
        __builtin_amdgcn_s_waitcnt(0);
        unsigned nloc = b.st[0], nx = b.st[1];
        if (nloc == 0u) { xcd_barrier_complete(bar, b.x, nloc, nx); b.st[0] = nloc; b.st[1] = nx; }
        const unsigned old = xb_add(&bar[XB_XSUB(b.x)], 1u);
        const unsigned gen = old / nloc;
        if (old + 1u == (gen + 1u) * nloc) {
            __builtin_amdgcn_fence(__ATOMIC_RELEASE, "agent");
            asm volatile("s_waitcnt vmcnt(0)" ::: "memory");
            const unsigned og = xb_add(&bar[XB_TOP], 1u);
            const unsigned tg = og / nx;
            if (og + 1u == (tg + 1u) * nx) xb_add(&bar[XB_TOPGEN], 1u);
            else XB_SPIN(xb_ld(&bar[XB_TOPGEN]) == tg, bar);
            __builtin_amdgcn_fence(__ATOMIC_ACQUIRE, "agent");
            xb_add(&bar[XB_XGEN(b.x)], 1u);
            asm volatile("s_waitcnt vmcnt(0)" ::: "memory");
        } else {
            XB_SPIN(xb_ld(&bar[XB_XGEN(b.x)]) == gen, bar);
            __builtin_amdgcn_fence(__ATOMIC_ACQUIRE, "agent");
            asm volatile("s_waitcnt vmcnt(0)" ::: "memory");
        }
    }
    __syncthreads();
}
struct Args { const float* in[17]; float* out; unsigned char* ws; int ph_lo, ph_hi, li, pad; };
struct Frame {
    LAS unsigned char* lds;
    volatile LAS unsigned* MISC;
    gu32* ctl;
    int tid, lane, wave, vcu, G;
    gu32* qctr; unsigned tk;
};
#define F_x (A.in[0])
#define F_c (A.in[1])
#define F_ada_w (A.in[2])
#define F_ada_b (A.in[3])
#define F_norm_g (A.in[4])
#define F_w_in (A.in[5])
#define F_cmp_pe (A.in[6])
#define F_cmp_w1 (A.in[7])
#define F_cmp_w2 (A.in[8])
#define F_mix_g (A.in[9])
#define F_w_out (A.in[10])
#define F_router_w (A.in[11])
#define F_router_b (A.in[12])
#define F_w_gu (A.in[13])
#define F_b_gu (A.in[14])
#define F_w_dn (A.in[15])
#define F_b_dn (A.in[16])
#define F_out (A.out)
#define F_oss ((float*)(A.ws + WS_OSS))
#define F_x1b ((bf16*)(A.ws + WS_X1))
#define F_xmid ((bf16*)(A.ws + WS_X1 + (size_t)64 * MiB))
#define F_yt8 ((unsigned char*)(A.ws + WS_SA))
#define F_Wgu8 ((unsigned char*)(A.ws + WS_WGU))
#define F_Wdn8 ((unsigned char*)(A.ws + WS_WDN))
#define F_act8 ((unsigned char*)(A.ws + WS_ACT8))
#define F_sact8 ((unsigned char*)(A.ws + WS_SACT))
#define F_rwT ((float*)(A.ws + WS_RWT))
#define F_rw3 ((unsigned short*)(A.ws + WS_RW3))
#define F_rconst ((float*)(A.ws + WS_RCONST))
#define F_ocp ((bf16*)(A.ws + WS_OCP))
#define F_cw1T ((bf16*)(A.ws + WS_CW1T))
#define F_cw2T ((bf16*)(A.ws + WS_CW2T))
#define F_cconst ((float*)(A.ws + WS_CCONST))
#define F_list ((int*)(A.ws + WS_LIST))
#define F_lgate ((float*)(A.ws + WS_LGATE))
#define F_selm ((unsigned*)(A.ws + WS_SELM))
#define F_kcb ((bf16*)(A.ws + WS_KCB))
#define F_vcb ((bf16*)(A.ws + WS_VCB))
#define F_ropec ((float*)(A.ws + WS_ROPE))
#define F_ropes ((float*)(A.ws + WS_ROPE + (size_t)S * 8 * 4))
#define F_mod ((float*)(A.ws + WS_MOD))
#define F_kmean ((float*)(A.ws + WS_KMEAN))
#define F_kc ((float*)(A.ws + WS_KC))
#define F_vc ((float*)(A.ws + WS_VC))
#define F_x1 ((float*)(A.ws + WS_X1))
#define F_asg_gate ((float*)(A.ws + WS_ASG_GATE))
#define F_asg_e ((int*)(A.ws + WS_ASG_E))
#define F_asg_pos ((int*)(A.ws + WS_ASG_POS))
#define F_asg_row ((int*)(A.ws + WS_ASG_ROW))
#define F_WinT ((bf16*)(A.ws + WS_WIN))
#define F_WoutT ((bf16*)(A.ws + WS_WOUT))
#define F_WguT ((bf16*)(A.ws + WS_WGU))
#define F_WdnT ((bf16*)(A.ws + WS_WDN))
#define F_act ((bf16*)(A.ws + WS_ACT))
#define F_proj ((bf16*)(A.ws + WS_PROJ))
#define F_o ((bf16*)(A.ws + WS_O))
#define F_y ((bf16*)(A.ws + WS_Y))
#define F_sa ((bf16*)(A.ws + WS_SA))
#define F_sact ((bf16*)(A.ws + WS_SACT))

template <int CTRL> __device__ __forceinline__ float dpp_mov(float v) { return __builtin_bit_cast(float, __builtin_amdgcn_update_dpp(0, __builtin_bit_cast(int, v), CTRL, 0xF, 0xF, true)); }
__device__ __forceinline__ float rdl(float v, int l) { return __builtin_bit_cast(float, __builtin_amdgcn_readlane(__builtin_bit_cast(int, v), l)); }
__device__ __forceinline__ float wave_sum(float v) {
    v += dpp_mov<0xB1>(v); v += dpp_mov<0x4E>(v); v += dpp_mov<0x124>(v); v += dpp_mov<0x128>(v);
    return (rdl(v, 0) + rdl(v, 16)) + (rdl(v, 32) + rdl(v, 48));
}
__device__ __forceinline__ float wave_max(float v) {
#pragma unroll
    for (int o = 1; o < 64; o <<= 1) v = fmaxf(v, __shfl_xor(v, o));
    return v;
}
__device__ __forceinline__ void wave_argmax(float& v, int& i) {
#pragma unroll
    for (int o = 32; o >= 1; o >>= 1) { const float ov = __shfl_xor(v, o); const int oi = __shfl_xor(i, o); if (ov > v || (ov == v && oi < i)) { v = ov; i = oi; } }
}
__device__ __forceinline__ void loadq(float (&q)[64], const bf16* qp) {
    const v4u* p = (const v4u*)qp;
#pragma unroll
    for (int c = 0; c < 8; ++c) { const v4u v = p[c]; q[8*c+0] = bflo(v.x); q[8*c+1] = bfhi(v.x); q[8*c+2] = bflo(v.y); q[8*c+3] = bfhi(v.y); q[8*c+4] = bflo(v.z); q[8*c+5] = bfhi(v.z); q[8*c+6] = bflo(v.w); q[8*c+7] = bfhi(v.w); }
}
__device__ __forceinline__ float dot64(const float (&q)[64], const bf16* kp) {
    const v4u* p = (const v4u*)kp; float s = 0.f;
#pragma unroll
    for (int c = 0; c < 8; ++c) { const v4u v = p[c];
        s += q[8*c+0] * bflo(v.x); s += q[8*c+1] * bfhi(v.x); s += q[8*c+2] * bflo(v.y); s += q[8*c+3] * bfhi(v.y);
        s += q[8*c+4] * bflo(v.z); s += q[8*c+5] * bfhi(v.z); s += q[8*c+6] * bflo(v.w); s += q[8*c+7] * bfhi(v.w); }
    return s;
}
__device__ __forceinline__ float dot64l(const float (&q)[64], const LAS float* kp) {
    const LAS f32x4* p = (const LAS f32x4*)kp; float s = 0.f;
#pragma unroll
    for (int c = 0; c < 16; ++c) { const f32x4 v = p[c]; s += q[4*c+0] * v.x; s += q[4*c+1] * v.y; s += q[4*c+2] * v.z; s += q[4*c+3] * v.w; }
    return s;
}
__device__ __forceinline__ float dot64f(const float (&q)[64], const float* kp) {
    const f32x4* p = (const f32x4*)kp; float s = 0.f;
#pragma unroll
    for (int c = 0; c < 16; ++c) { const f32x4 v = p[c]; s += q[4*c+0] * v.x; s += q[4*c+1] * v.y; s += q[4*c+2] * v.z; s += q[4*c+3] * v.w; }
    return s;
}
__device__ __forceinline__ void acc8(float (&a)[8], float p, const v4u v) {
    a[0] += p * bflo(v.x); a[1] += p * bfhi(v.x); a[2] += p * bflo(v.y); a[3] += p * bfhi(v.y); a[4] += p * bflo(v.z); a[5] += p * bfhi(v.z); a[6] += p * bflo(v.w); a[7] += p * bfhi(v.w);
}
__device__ __forceinline__ void red8(float (&a)[8]) {
#pragma unroll
    for (int j = 0; j < 8; ++j) { a[j] += __shfl_xor(a[j], 8); a[j] += __shfl_xor(a[j], 16); a[j] += __shfl_xor(a[j], 32); }
}
__device__ __forceinline__ void list_attn(const float (&q)[64], int n, LAS float* P, const LAS int* KR, const bf16* Kb, const bf16* Vb, int lane, float (&o)[8]) {
    float mx = -3e38f;
    for (int i = lane; i < n; i += 64) { const float s = dot64(q, Kb + (size_t)KR[i] * PW) * 0.125f; P[i] = s; mx = fmaxf(mx, s); }
    mx = wave_max(mx);
    float sum = 0.f;
    for (int i = lane; i < n; i += 64) { const float e = __expf(P[i] - mx); P[i] = e; sum += e; }
    sum = wave_sum(sum);
    const float inv = (n > 0) ? 1.f / sum : 0.f;
    LDS_WAIT();
    const int kg = lane >> 3, dg = lane & 7;
    float a[8];
#pragma unroll
    for (int j = 0; j < 8; ++j) a[j] = 0.f;
    for (int i = kg; i < n; i += 8) { const float p = P[i]; const v4u v = *(const v4u*)(Vb + (size_t)KR[i] * PW + dg * 8); acc8(a, p, v); }
    red8(a);
#pragma unroll
    for (int j = 0; j < 8; ++j) o[j] = a[j] * inv;
    LDS_WAIT();
}
__device__ __forceinline__ float sigmoidf_(float v) { return 1.f / (1.f + __expf(-v)); }
template <class RM> __device__ __forceinline__ void tr_item(const float* W, int K, int N, bf16* WT, LAS float* scr, int kb, int nb, int lane, RM rm) {
    const int k0 = 64 * kb, n0 = 32 * nb; const int n = n0 + (lane & 31);
#pragma unroll 8
    for (int i = 0; i < 32; ++i) { const int kk = 2 * i + (lane >> 5); scr[kk * 33 + (lane & 31)] = (n < N) ? W[(size_t)(k0 + kk) * N + n] : 0.f; }
    LDS_WAIT(); asm volatile("" ::: "memory");
    const int c = lane & 7;
#pragma unroll
    for (int j = 0; j < 4; ++j) { const int nn = (lane >> 3) + 8 * j; const LAS float* s = scr + (8 * c) * 33 + nn;
        v4u o; o.x = pk2(s[0 * 33], s[1 * 33]); o.y = pk2(s[2 * 33], s[3 * 33]); o.z = pk2(s[4 * 33], s[5 * 33]); o.w = pk2(s[6 * 33], s[7 * 33]);
        if (n0 + nn < N) *(v4u*)(WT + (size_t)rm(n0 + nn) * K + k0 + 8 * c) = o; }
    LDS_WAIT(); asm volatile("" ::: "memory");
}
template <class RM> __device__ __forceinline__ void tr_item64(const float* W, int K, int N, bf16* WT, LAS float* scr, int kb, int nb, int lane, RM rm, const float* kgain = nullptr) {
    const int k0 = 64 * kb, n0 = 64 * nb; const float* src = W + (size_t)(k0 + (lane >> 4)) * N + n0 + (lane & 15) * 4;
    f32x4 v[16];
#pragma unroll
    for (int i = 0; i < 16; ++i) v[i] = *(const f32x4*)(src + (size_t)(4 * i) * N);
#pragma unroll
    for (int i = 0; i < 16; ++i) *(LAS f32x4*)(scr + ((lane >> 4) + 4 * i) * 64 + (lane & 15) * 4) = v[i];
    LDS_WAIT(); asm volatile("" ::: "memory");
#pragma unroll
    for (int j = 0; j < 2; ++j)
#pragma unroll
        for (int c = 0; c < 4; ++c) { const int n = (lane & 31) + 32 * j, kc = (lane >> 5) + 2 * c; const LAS float* s = scr + (8 * kc) * 64 + n;
            f32x4 g0 = {1.f, 1.f, 1.f, 1.f}, g1 = g0; if (kgain) { g0 = *(const f32x4*)(kgain + k0 + 8 * kc); g1 = *(const f32x4*)(kgain + k0 + 8 * kc + 4); }
            v4u o; o.x = pk2(s[0 * 64] * g0.x, s[1 * 64] * g0.y); o.y = pk2(s[2 * 64] * g0.z, s[3 * 64] * g0.w); o.z = pk2(s[4 * 64] * g1.x, s[5 * 64] * g1.y); o.w = pk2(s[6 * 64] * g1.z, s[7 * 64] * g1.w);
            *(v4u*)(WT + (size_t)rm(n0 + n) * K + k0 + 8 * kc) = o; }
    LDS_WAIT(); asm volatile("" ::: "memory");
}
template <class RM> __device__ __forceinline__ void tr_item64_f8(const float* W, int K, int N, unsigned char* WT, LAS float* scr, int kb, int nb, int lane, RM rm) {
    const int k0 = 64 * kb, n0 = 64 * nb; const float* src = W + (size_t)(k0 + (lane >> 4)) * N + n0 + (lane & 15) * 4;
    f32x4 v[16];
#pragma unroll
    for (int i = 0; i < 16; ++i) v[i] = __builtin_nontemporal_load((const f32x4*)(src + (size_t)(4 * i) * N));
#pragma unroll
    for (int i = 0; i < 16; ++i) *(LAS f32x4*)(scr + ((lane >> 4) + 4 * i) * 64 + (lane & 15) * 4) = v[i];
    LDS_WAIT(); asm volatile("" ::: "memory");
    v2u o[2][4];
#pragma unroll
    for (int j = 0; j < 2; ++j)
#pragma unroll
        for (int c = 0; c < 4; ++c) { const int n = (lane & 31) + 32 * j, kc = (lane >> 5) + 2 * c; const LAS float* s = scr + (8 * kc) * 64 + n;
            o[j][c].x = pg8::pk4_fp8(s[0 * 64] * pg8::W8_SCALE, s[1 * 64] * pg8::W8_SCALE, s[2 * 64] * pg8::W8_SCALE, s[3 * 64] * pg8::W8_SCALE);
            o[j][c].y = pg8::pk4_fp8(s[4 * 64] * pg8::W8_SCALE, s[5 * 64] * pg8::W8_SCALE, s[6 * 64] * pg8::W8_SCALE, s[7 * 64] * pg8::W8_SCALE); }
    LDS_WAIT(); asm volatile("" ::: "memory");
    LAS unsigned char* ob = (LAS unsigned char*)scr;
#pragma unroll
    for (int j = 0; j < 2; ++j)
#pragma unroll
        for (int c = 0; c < 4; ++c) { const int n = (lane & 31) + 32 * j, kc = (lane >> 5) + 2 * c; *(LAS v2u*)(ob + n * 80 + kc * 8) = o[j][c]; }
    LDS_WAIT(); asm volatile("" ::: "memory");
#pragma unroll
    for (int r = 0; r < 4; ++r) { const int row = (lane >> 2) + 16 * r, ch = lane & 3; const v4u w = *(const LAS v4u*)(ob + row * 80 + ch * 16);
        *(v4u*)(WT + (size_t)rm(n0 + row) * K + k0 + ch * 16) = w; }
    LDS_WAIT(); asm volatile("" ::: "memory");
}
template <class RM> __device__ __forceinline__ void tr_item128_f8(const float* W, int K, int N, unsigned char* WT, LAS float* scr, int kb, int nb, int lane, RM rm) {
    const int k0 = 128 * kb, n0 = 32 * nb; const float* src = W + (size_t)(k0 + (lane >> 3)) * N + n0 + (lane & 7) * 4;
    f32x4 v[16];
#pragma unroll
    for (int i = 0; i < 16; ++i) v[i] = __builtin_nontemporal_load((const f32x4*)(src + (size_t)(8 * i) * N));
#pragma unroll
    for (int i = 0; i < 16; ++i) *(LAS f32x4*)(scr + ((lane >> 3) + 8 * i) * 32 + (lane & 7) * 4) = v[i];
    LDS_WAIT(); asm volatile("" ::: "memory");
    v2u o[8];
#pragma unroll
    for (int c = 0; c < 8; ++c) { const int n = lane & 31, kc = (lane >> 5) + 2 * c; const LAS float* s = scr + (8 * kc) * 32 + n;
        o[c].x = pg8::pk4_fp8(s[0 * 32] * pg8::W8_SCALE, s[1 * 32] * pg8::W8_SCALE, s[2 * 32] * pg8::W8_SCALE, s[3 * 32] * pg8::W8_SCALE);
        o[c].y = pg8::pk4_fp8(s[4 * 32] * pg8::W8_SCALE, s[5 * 32] * pg8::W8_SCALE, s[6 * 32] * pg8::W8_SCALE, s[7 * 32] * pg8::W8_SCALE); }
    LDS_WAIT(); asm volatile("" ::: "memory");
    LAS unsigned char* ob = (LAS unsigned char*)scr;
#pragma unroll
    for (int c = 0; c < 8; ++c) { const int n = lane & 31, kc = (lane >> 5) + 2 * c; *(LAS v2u*)(ob + n * 144 + kc * 8) = o[c]; }
    LDS_WAIT(); asm volatile("" ::: "memory");
#pragma unroll
    for (int r = 0; r < 4; ++r) { const int row = (lane >> 3) + 8 * r, ch = lane & 7; const v4u w = *(const LAS v4u*)(ob + row * 144 + ch * 16);
        *(v4u*)(WT + (size_t)rm(n0 + row) * K + k0 + ch * 16) = w; }
    LDS_WAIT(); asm volatile("" ::: "memory");
}
struct RmId { __device__ __forceinline__ int operator()(int n) const { return n; } };
struct RmDn { __device__ __forceinline__ int operator()(int n) const { const int c = n & 255; return (n & ~255) + ((c >> 3) & 1) * 128 + (c >> 6) * 32 + ((c >> 4) & 3) * 8 + (c & 7); } };
struct RmWin { __device__ __forceinline__ int operator()(int n) const { return n < 1536 ? n : (n < 1554 ? C_GB + (n - 1536) : n - 18); } };
struct RmGu { __device__ __forceinline__ int operator()(int n) const { const int h = n >> 10, r = n & 1023; return (r >> 7) * 256 + h * 128 + (r & 127); } };

__device__ __forceinline__ void p0_prologue(Frame& F, const Args& A) {
    LAS float* scr = (LAS float*)(F.lds + F.wave * 16384);
    const int gw = F.vcu * NWAVES + F.wave, NGW = F.G * NWAVES, lane = F.lane;
    constexpr int I_GU = NL * NE * 16 * 32, I_DN = NL * NE * 16 * 16, I_IN = NL * 16 * 85, I_OUT = NL * 16 * 16, I_MOD = NL * 96, I_C1 = NL * 2 * 32 * 2, I_C2 = NL * 2 * 2, I_CC = NL * 2 * 16;
    constexpr int NITEMS = I_GU + I_DN + I_IN + I_OUT + I_C1 + I_C2;
    for (int wi = F.vcu; wi < I_MOD + I_CC; wi += F.G) {
        LAS float* red = (LAS float*)F.lds;
        if (wi < I_MOD) {
            const int l = wi / 96, cb = (wi % 96) * 64, col = cb + lane; const float* w = F_ada_w + (size_t)l * D * 6 * D + col;
            float a[NB];
#pragma unroll
            for (int b = 0; b < NB; ++b) a[b] = 0.f;
#pragma unroll 1
            for (int k0 = 128 * F.wave; k0 < 128 * F.wave + 128; k0 += 64) {
                float wv[64]; float sv[8];
#pragma unroll
                for (int kk = 0; kk < 64; ++kk) wv[kk] = w[(size_t)(k0 + kk) * 6 * D];
#pragma unroll
                for (int g = 0; g < 8; ++g) { const float cv = F_c[(lane >> 3) * D + k0 + 8 * g + (lane & 7)]; sv[g] = cv / (1.f + __expf(-cv)); }
#pragma unroll
                for (int g = 0; g < 8; ++g)
#pragma unroll
                    for (int kk = 0; kk < 8; ++kk)
#pragma unroll
                        for (int b = 0; b < NB; ++b) a[b] += __builtin_bit_cast(float, __builtin_amdgcn_readlane(__builtin_bit_cast(int, sv[g]), b * 8 + kk)) * wv[8 * g + kk]; }
#pragma unroll
            for (int b = 0; b < NB; ++b) red[(F.wave * NB + b) * 64 + lane] = a[b];
            __syncthreads();
            { const int b = F.tid >> 6; float t = 0.f;
#pragma unroll
              for (int w8 = 0; w8 < 8; ++w8) t += red[(w8 * NB + b) * 64 + lane];
              F_mod[((size_t)l * NB + b) * 6 * D + col] = t + F_ada_b[l * 6 * D + col]; }
            __syncthreads();
        } else {
            const int r = wi - I_MOD, lw = r >> 4, part = r & 15; const float* pe = F_cmp_pe + (size_t)lw * 2048 + part * 128 + 16 * F.wave; const float* w1 = F_cmp_w1 + ((size_t)lw * 2048 + part * 128 + 16 * F.wave) * 64 + lane; float a = 0.f;
#pragma unroll
            for (int k = 0; k < 16; ++k) a += pe[k] * w1[(size_t)k * 64];
            red[F.wave * 64 + lane] = a;
            __syncthreads();
            if (F.tid < 64) { float t = 0.f;
#pragma unroll
              for (int w8 = 0; w8 < 8; ++w8) t += red[w8 * 64 + lane];
              F_cconst[(size_t)r * 64 + lane] = t; }
            __syncthreads();
        }
    }
    for (int it = gw; it < NITEMS; it += NGW) {
        int r = it;
        if (r < I_GU) { const int le = r >> 9, q = r & 511; tr_item128_f8(F_w_gu + (size_t)le * D * 2048, D, 2048, F_Wgu8 + (size_t)le * 2048 * D, scr, q >> 6, q & 63, lane, RmGu()); continue; } r -= I_GU;
        if (r < I_DN) { const int le = r >> 8, q = r & 255; tr_item128_f8(F_w_dn + (size_t)le * D * D, D, D, F_Wdn8 + (size_t)le * D * D, scr, q >> 5, q & 31, lane, RmDn()); continue; } r -= I_DN;
        if (r < I_IN) { const int l = r / (16 * 85), q = r % (16 * 85); tr_item(F_w_in + (size_t)l * D * INW, D, INW, F_WinT + (size_t)l * PW * D, scr, q / 85, q % 85, lane, RmWin()); continue; } r -= I_IN;
        if (r < I_OUT) { const int l = r >> 8, q = r & 255; tr_item64(F_w_out + (size_t)l * D * D, D, D, F_WoutT + (size_t)l * D * D, scr, q >> 4, q & 15, lane, RmId(), F_mix_g + (size_t)l * D); continue; } r -= I_OUT;
        if (r < I_C1) { const int lw = r >> 6, q = r & 63; tr_item(F_cmp_w1 + (size_t)lw * 2048 * 64, 2048, 64, F_cw1T + (size_t)lw * 64 * 2048, scr, q >> 1, q & 1, lane, RmId()); continue; } r -= I_C1;
        if (r < I_C2) { const int lw = r >> 1, q = r & 1; tr_item(F_cmp_w2 + (size_t)lw * 64 * 64, 64, 64, F_cw2T + (size_t)lw * 64 * 64, scr, 0, q, lane, RmId()); continue; } r -= I_C2;
    }
    const int gt = F.vcu * (NWAVES * 64) + F.tid, NGT = F.G * NWAVES * 64;
    for (int i = gt; i < NL * (PW - INW) * (D / 8); i += NGT) { const int l = i / ((PW - INW) * (D / 8)), q = i % ((PW - INW) * (D / 8));
        *(v4u*)(F_WinT + ((size_t)l * PW + INW + q / (D / 8)) * D + (q % (D / 8)) * 8) = (v4u){0u, 0u, 0u, 0u}; }
    for (int i = gt; i < NL * NB * 4 * 16 * 64; i += NGT) F_kmean[i] = 0.f;
    for (int i = gt; i < S * 8; i += NGT) { const int t = i >> 3, f = i & 7; const double inv = pow(500000.0, -(double)f / 8.0); const double ang = (double)t * inv;
        F_ropec[i] = (float)cos(ang); F_ropes[i] = (float)sin(ang); }
}
__device__ __forceinline__ void mod_norm_row(const f32x4 (&v)[4], const float* g, const float* sc, const float* sh, bf16* orow, int lane) {
    float ss = 0.f;
#pragma unroll
    for (int j = 0; j < 4; ++j) ss += (v[j].x * v[j].x + v[j].y * v[j].y) + (v[j].z * v[j].z + v[j].w * v[j].w);
    const float rs = __builtin_amdgcn_rsqf(wave_sum(ss) * (1.f / D) + RMS_EPS);
#pragma unroll
    for (int j = 0; j < 4; ++j) { const int c = 4 * lane + 256 * j; const f32x4 gg = *(const f32x4*)(g + c), s1 = *(const f32x4*)(sc + c), s0 = *(const f32x4*)(sh + c);
        const f32x4 r = v[j] * rs * gg * (s1 + 1.f) + s0; v2u w; w.x = pk2(r.x, r.y); w.y = pk2(r.z, r.w); *(v2u*)(orow + c) = w; }
}
__device__ __forceinline__ void mod_norm_row_l(const f32x4 (&v)[4], const LAS float* cA, const LAS float* cS, bf16* orow, int lane) {
    float ss = 0.f;
#pragma unroll
    for (int j = 0; j < 4; ++j) ss += (v[j].x * v[j].x + v[j].y * v[j].y) + (v[j].z * v[j].z + v[j].w * v[j].w);
    const float rs = __builtin_amdgcn_rsqf(wave_sum(ss) * (1.f / D) + RMS_EPS);
#pragma unroll
    for (int j = 0; j < 4; ++j) { const int c = 4 * lane + 256 * j; const f32x4 a = *(const LAS f32x4*)(cA + c), s0 = *(const LAS f32x4*)(cS + c);
        const f32x4 r = v[j] * rs * a + s0; v2u w; w.x = pk2(r.x, r.y); w.y = pk2(r.z, r.w); *(v2u*)(orow + c) = w; }
}
__device__ __forceinline__ void router_tables(Frame& F, const Args& A, int q, int nq) {
    for (int it = q * NWAVES + F.wave; it < NL * NB * NE; it += nq * NWAVES) { const int e = it & 31, b = (it >> 5) & 7, l = it >> 8; const float* md = F_mod + ((size_t)l * NB + b) * 6 * D; const float* g2 = F_norm_g + ((size_t)l * 4 + 2) * D;
        const float* rw = F_router_w + (size_t)l * D * NE + e; float cs = 0.f;
#pragma unroll
        for (int j = 0; j < 16; ++j) { const int k = F.lane + 64 * j; const float w = rw[(size_t)k * NE]; const float v = g2[k] * (1.f + md[4 * D + k]) * w; cs += md[3 * D + k] * w;
            const unsigned h0 = f2bf(v); const float r1 = v - bflo(h0); const unsigned h1 = f2bf(r1); const unsigned h2 = f2bf(r1 - bflo(h1));
            unsigned short* pl = F_rw3 + (size_t)it * 3 * D + k; pl[0] = (unsigned short)h0; pl[D] = (unsigned short)h1; pl[2 * D] = (unsigned short)h2; }
        cs = wave_sum(cs); if (F.lane == 0) F_rconst[it] = cs + F_router_b[l * NE + e]; }
}
__device__ __forceinline__ void phase_hm0(Frame& F, const Args& A) {
    const int gw = F.vcu * NWAVES + F.wave, NGW = F.G * NWAVES;
    for (int chunk = blockIdx.x; chunk < NTOK / 128; chunk += F.G) {
        f32x4 va[4], vb[4]; const int tok0 = chunk * 128 + F.wave * 16; const float* md_ = F_mod + (size_t)(tok0 >> 12) * 6 * D;
        LAS float* cA = (LAS float*)(F.lds + 65536); LAS float* cS = cA + D;
#define HM_LOAD(V, T) { const f32x4* xr_ = (const f32x4*)(F_x + (size_t)(T) * D) + F.lane; _Pragma("unroll") for (int j = 0; j < 4; ++j) V[j] = __builtin_nontemporal_load(xr_ + 64 * j); }
#define HM_DO(V, T) mod_norm_row_l(V, cA, cS, F_act + (size_t)(T) * D, F.lane)
        HM_LOAD(va, tok0);
        __syncthreads();
        for (int i = F.tid; i < D; i += NWAVES * 64) { cA[i] = F_norm_g[i] * (md_[D + i] + 1.f); cS[i] = md_[i]; }
        __syncthreads();
        for (int i = 0; i < 16; i += 2) {
            HM_LOAD(vb, tok0 + i + 1);
            HM_DO(va, tok0 + i);
            if (i + 2 < 16) HM_LOAD(va, tok0 + i + 2);
            HM_DO(vb, tok0 + i + 1);
        }
#undef HM_LOAD
#undef HM_DO
    }
}
typedef short c16x8 __attribute__((ext_vector_type(8)));
__device__ __forceinline__ void phase_compress(Frame& F, const Args& A, int l) {
    const int lane = F.lane, fr = lane & 15, fq = lane >> 4;
    LAS unsigned short* h1s = (LAS unsigned short*)F.lds;
    LAS f32x4* red = (LAS f32x4*)(F.lds + 16384);
    for (int it = blockIdx.x; it < NB * 2 * 16; it += F.G) { const int nt = it & 15, which = (it >> 4) & 1, b = it >> 5;
        const bf16* w1t = F_cw1T + ((size_t)l * 2 + which) * 64 * 2048; const bf16* w2t = F_cw2T + ((size_t)l * 2 + which) * 64 * 64; const float* cc = F_cconst + ((size_t)l * 2 + which) * 16 * 64;
        const int n = 16 * nt + fr;
        f32x4 acc[4];
#pragma unroll
        for (int jt = 0; jt < 4; ++jt) acc[jt] = (f32x4){0.f, 0.f, 0.f, 0.f};
#pragma unroll
        for (int k8 = 0; k8 < 8; ++k8) { const int ks = 8 * F.wave + k8; int tokn = 16 * n + (ks >> 1); if (tokn > S - 1) tokn = S - 1;
            const c16x8 a = *(const c16x8*)(F_proj + ((size_t)b * S + tokn) * PW + C_KVB + which * 64 + 32 * (ks & 1) + 8 * fq);
#pragma unroll
            for (int jt = 0; jt < 4; ++jt) { const c16x8 bb = *(const c16x8*)(w1t + (size_t)(jt * 16 + fr) * 2048 + 32 * ks + 8 * fq); acc[jt] = __builtin_amdgcn_mfma_f32_16x16x32_bf16(a, bb, acc[jt], 0, 0, 0); } }
        __syncthreads();
#pragma unroll
        for (int jt = 0; jt < 4; ++jt) red[(F.wave * 4 + jt) * 64 + lane] = acc[jt];
        __syncthreads();
        if (F.wave == 0) {
#pragma unroll
        for (int jt = 0; jt < 4; ++jt) { f32x4 t = red[jt * 64 + lane];
#pragma unroll
            for (int w8 = 1; w8 < 8; ++w8) t = t + red[(w8 * 4 + jt) * 64 + lane];
            acc[jt] = t; }
#pragma unroll
        for (int jt = 0; jt < 4; ++jt) { float cj = 0.f;
#pragma unroll
            for (int part = 0; part < 16; ++part) cj += cc[part * 64 + jt * 16 + fr];
#pragma unroll
            for (int r = 0; r < 4; ++r) { const float v = acc[jt][r] + cj; h1s[(4 * fq + r) * 72 + jt * 16 + fr] = (unsigned short)f2bf(v / (1.f + __expf(-v))); } }
        LDS_WAIT(); asm volatile("" ::: "memory");
        f32x4 o2[4];
#pragma unroll
        for (int jt = 0; jt < 4; ++jt) o2[jt] = (f32x4){0.f, 0.f, 0.f, 0.f};
#pragma unroll
        for (int ks = 0; ks < 2; ++ks) { const c16x8 a = *(const LAS c16x8*)(h1s + fr * 72 + 32 * ks + 8 * fq);
#pragma unroll
            for (int jt = 0; jt < 4; ++jt) { const c16x8 bb = *(const c16x8*)(w2t + (size_t)(jt * 16 + fr) * 64 + 32 * ks + 8 * fq); o2[jt] = __builtin_amdgcn_mfma_f32_16x16x32_bf16(a, bb, o2[jt], 0, 0, 0); } }
        bf16* dst = (which ? F_vcb : F_kcb) + (size_t)b * 256 * 64;
#pragma unroll
        for (int jt = 0; jt < 4; ++jt)
#pragma unroll
            for (int r = 0; r < 4; ++r) { const int nn = 16 * nt + 4 * fq + r; dst[(size_t)nn * 64 + jt * 16 + fr] = (bf16)f2bf(nn < 255 ? o2[jt][r] : 0.f); }
        LDS_WAIT(); asm volatile("" ::: "memory");
        }
    }
    __syncthreads();
}
typedef float f32x16 __attribute__((ext_vector_type(16)));
typedef short s16x8 __attribute__((ext_vector_type(8)));
typedef short s16x4 __attribute__((ext_vector_type(4)));
constexpr int KP = 144, VP = 192, KT_BYTES = 64 * KP, VT_BYTES = 64 * VP, TB_BYTES = KT_BYTES + VT_BYTES;
constexpr float QSCALE_LOG2 = 0.125f * 1.4426950408889634f;
#define NEGINF (-__builtin_inff())
struct TileRegs { v4u k, v; };
__device__ __forceinline__ void tile_load(TileRegs& R, const bf16* Kg, const bf16* Vg, size_t pitch, int tid) {
    const int r = tid >> 3, c = tid & 7; R.k = *(const v4u*)(Kg + (size_t)r * pitch + c * 8); R.v = *(const v4u*)(Vg + (size_t)r * pitch + c * 8); }
__device__ __forceinline__ void tile_store(const TileRegs& R, LAS unsigned char* buf, int tid) {
    const int r = tid >> 3, c = tid & 7; *(LAS v4u*)(buf + r * KP + c * 16) = R.k; *(LAS v4u*)(buf + KT_BYTES + r * VP + c * 16) = R.v; }
__device__ __forceinline__ s16x8 pack8(float a0, float a1, float a2, float a3, float a4, float a5, float a6, float a7) {
    v4u w; w.x = pg8::cvt_pk_bf16(a0, a1); w.y = pg8::cvt_pk_bf16(a2, a3); w.z = pg8::cvt_pk_bf16(a4, a5); w.w = pg8::cvt_pk_bf16(a6, a7); return __builtin_bit_cast(s16x8, w); }
__device__ __forceinline__ void load_qfrags(s16x8 (&qf)[4], const bf16* qrow, float sc, int lane) {
#pragma unroll
    for (int ks = 0; ks < 4; ++ks) { const v4u v = *(const v4u*)(qrow + 16 * ks + 8 * (lane >> 5));
        qf[ks] = pack8(bflo(v.x) * sc, bfhi(v.x) * sc, bflo(v.y) * sc, bfhi(v.y) * sc, bflo(v.z) * sc, bfhi(v.z) * sc, bflo(v.w) * sc, bfhi(v.w) * sc); }
}
__device__ __forceinline__ void qk_tile(f32x16 (&p)[2], const LAS unsigned char* kb, const s16x8 (&qf)[4], int lane) {
    const LAS unsigned char* a = kb + (lane & 31) * KP + (lane >> 5) * 16;
    s16x8 kf[2][4];
#pragma unroll
    for (int T = 0; T < 2; ++T)
#pragma unroll
        for (int ks = 0; ks < 4; ++ks) kf[T][ks] = *(const LAS s16x8*)(a + T * 32 * KP + ks * 32);
#pragma unroll
    for (int T = 0; T < 2; ++T) {
#pragma unroll
        for (int j = 0; j < 16; ++j) p[T][j] = 0.f;
#pragma unroll
        for (int ks = 0; ks < 4; ++ks) p[T] = __builtin_amdgcn_mfma_f32_32x32x16_bf16(kf[T][ks], qf[ks], p[T], 0, 0, 0); }
}
__device__ __forceinline__ void pv_tile(f32x16 (&o)[2], const LAS unsigned char* vb, const s16x8 (&pf)[4], int lane) {
    const LAS unsigned char* base = vb + (4 * (lane >> 5) + ((lane & 15) >> 2)) * VP + (16 * ((lane >> 4) & 1) + 4 * (lane & 3)) * 2;
    v2u lo[2][4], hi[2][4];
#pragma unroll
    for (int dt = 0; dt < 2; ++dt)
#pragma unroll
        for (int c = 0; c < 4; ++c) {
            lo[dt][c] = __builtin_bit_cast(v2u, __builtin_amdgcn_ds_read_tr16_b64_v4i16((LAS s16x4*)(base + c * 16 * VP + dt * 64)));
            hi[dt][c] = __builtin_bit_cast(v2u, __builtin_amdgcn_ds_read_tr16_b64_v4i16((LAS s16x4*)(base + c * 16 * VP + 8 * VP + dt * 64))); }
#pragma unroll
    for (int dt = 0; dt < 2; ++dt)
#pragma unroll
        for (int c = 0; c < 4; ++c) { const s16x8 vf = __builtin_bit_cast(s16x8, (v4u){lo[dt][c].x, lo[dt][c].y, hi[dt][c].x, hi[dt][c].y});
            o[dt] = __builtin_amdgcn_mfma_f32_32x32x16_bf16(vf, pf[c], o[dt], 0, 0, 0); }
}
__device__ __forceinline__ float half_max(float v) { const unsigned u = __builtin_bit_cast(unsigned, v); auto rr = __builtin_amdgcn_permlane32_swap(u, u, false, false);
    return fmaxf(__builtin_bit_cast(float, rr[0]), __builtin_bit_cast(float, rr[1])); }
__device__ __forceinline__ void softmax_step(f32x16 (&p)[2], f32x16 (&o)[2], float& m, float& l, s16x8 (&pf)[4], bool keep) {
    float tm = fmaxf(p[0][0], p[1][0]);
#pragma unroll
    for (int j = 1; j < 16; ++j) tm = fmaxf(tm, fmaxf(p[0][j], p[1][j]));
    tm = keep ? half_max(tm) : NEGINF;
    if (__builtin_amdgcn_ballot_w64(tm > m + 8.f) != 0ull) {
        const float mn = fmaxf(m, tm), mu0 = (mn == NEGINF) ? 0.f : mn; const float alpha = __builtin_amdgcn_exp2f(m - mu0);
        m = mn; l *= alpha;
#pragma unroll
        for (int dt = 0; dt < 2; ++dt)
#pragma unroll
            for (int j = 0; j < 16; ++j) o[dt][j] *= alpha; }
    const float mu = keep ? ((m == NEGINF) ? 0.f : m) : __builtin_inff();
    float s = 0.f;
#pragma unroll
    for (int T = 0; T < 2; ++T)
#pragma unroll
        for (int j = 0; j < 16; ++j) { p[T][j] = __builtin_amdgcn_exp2f(p[T][j] - mu); s += p[T][j]; }
    l += s;
#pragma unroll
    for (int c = 0; c < 4; ++c) { const int T = c >> 1, b8 = (c & 1) * 8;
        pf[c] = pack8(p[T][b8 + 0], p[T][b8 + 1], p[T][b8 + 2], p[T][b8 + 3], p[T][b8 + 4], p[T][b8 + 5], p[T][b8 + 6], p[T][b8 + 7]); }
}
#define EOFF(T, j) (32 * (T) + 8 * ((j) >> 2) + ((j) & 3))
__device__ __forceinline__ void mask_le(f32x16 (&p)[2], int lim) {
#pragma unroll
    for (int T = 0; T < 2; ++T)
#pragma unroll
        for (int j = 0; j < 16; ++j) p[T][j] = (EOFF(T, j) <= lim) ? p[T][j] : NEGINF;
}
__device__ __forceinline__ void mask_ge(f32x16 (&p)[2], int lim) {
#pragma unroll
    for (int T = 0; T < 2; ++T)
#pragma unroll
        for (int j = 0; j < 16; ++j) p[T][j] = (EOFF(T, j) >= lim) ? p[T][j] : NEGINF;
}
__device__ __forceinline__ void mask_all(f32x16 (&p)[2], bool keep) {
#pragma unroll
    for (int T = 0; T < 2; ++T)
#pragma unroll
        for (int j = 0; j < 16; ++j) p[T][j] = keep ? p[T][j] : NEGINF;
}
__device__ __forceinline__ void store_o(const f32x16 (&o)[2], float sc, bf16* orow, int lane, float* stat = nullptr) {
    float ss = 0.f;
#pragma unroll
    for (int dt = 0; dt < 2; ++dt)
#pragma unroll
        for (int g = 0; g < 4; ++g) { const float a0 = o[dt][4 * g] * sc, a1 = o[dt][4 * g + 1] * sc, a2 = o[dt][4 * g + 2] * sc, a3 = o[dt][4 * g + 3] * sc; ss += (a0 * a0 + a1 * a1) + (a2 * a2 + a3 * a3);
            v2u w; w.x = pg8::cvt_pk_bf16(a0, a1); w.y = pg8::cvt_pk_bf16(a2, a3);
            *(v2u*)(orow + 32 * dt + 8 * g + 4 * (lane >> 5)) = w; }
    if (stat) { ss += __shfl_xor(ss, 32); if (lane < 32) *stat = ss; }
}
__device__ __forceinline__ int wq_next(Frame& F, gu32* ctr) {
    __syncthreads(); if (F.tid == 0) F.MISC[0] = __hip_atomic_fetch_add(ctr, 1u, RLX_AGENT); __syncthreads(); return (int)F.MISC[0]; }
__device__ __forceinline__ void wq_prefetch(Frame& F) { if (F.tid == 0) F.tk = __hip_atomic_fetch_add(F.qctr, 1u, RLX_AGENT); }

__device__ __forceinline__ void sb_unit(Frame& F, const Args& A, int u) {
    const int qt = 15 - (u & 15), bh = u >> 4, h = bh % 6, b = bh / 6, lane = F.lane, w = F.wave, hi = lane >> 5;
    const int t0 = 256 * qt + 32 * w, tq = t0 + (lane & 31); const size_t tok = (size_t)b * S + tq;
    s16x8 qf[4]; load_qfrags(qf, F_proj + tok * PW + C_QC + h * 64, QSCALE_LOG2, lane);
    f32x16 o[2];
#pragma unroll
    for (int dt = 0; dt < 2; ++dt)
#pragma unroll
        for (int j = 0; j < 16; ++j) o[dt][j] = 0.f;
    float carry = 0.f; bool wdone = false;
    const bf16* Kb = F_proj + (size_t)b * S * PW + C_KC + h * 64; const bf16* Vb = F_proj + (size_t)b * S * PW + C_VC + h * 64;
    volatile LAS unsigned* flag = F.MISC + 16;
    TileRegs R;
    int kt = 4 * qt + 3;
    __syncthreads();
    tile_load(R, Kb + (size_t)kt * 64 * PW, Vb + (size_t)kt * 64 * PW, PW, F.tid); tile_store(R, F.lds, F.tid);
    __syncthreads();
    for (int i = 0;; ++i, --kt) {
        const bool more = kt > 0;
        if (more) tile_load(R, Kb + (size_t)(kt - 1) * 64 * PW, Vb + (size_t)(kt - 1) * 64 * PW, PW, F.tid);
        const LAS unsigned char* buf = F.lds + (i & 1) * TB_BYTES;
        if (!wdone && 64 * kt <= t0 + 30) {
            f32x16 z[2]; qk_tile(z, buf, qf, lane);
            const int lim = tq - 64 * kt - 4 * hi - 1;
            f32x16 lk[2];
#pragma unroll
            for (int T = 0; T < 2; ++T)
#pragma unroll
                for (int j = 0; j < 16; ++j) { const float zz = z[T][j]; const float L = fmaxf(zz, 0.f) + __builtin_amdgcn_logf(1.f + __builtin_amdgcn_exp2f(-fabsf(zz)));
                    const bool valid = EOFF(T, j) <= lim; lk[T][j] = valid ? -L : 0.f; z[T][j] = valid ? zz - L : NEGINF; }
            float gs[2][4]; f32x16 inl[2];
#pragma unroll
            for (int T = 0; T < 2; ++T)
#pragma unroll
                for (int g = 0; g < 4; ++g) { const float s3 = lk[T][4 * g + 3], s2 = s3 + lk[T][4 * g + 2], s1 = s2 + lk[T][4 * g + 1]; gs[T][g] = s1 + lk[T][4 * g];
                    inl[T][4 * g + 3] = 0.f; inl[T][4 * g + 2] = s3; inl[T][4 * g + 1] = s2; inl[T][4 * g] = s1; }
            float run = carry;
#pragma unroll
            for (int T = 1; T >= 0; --T)
#pragma unroll
                for (int g = 3; g >= 0; --g) { const float gp = __shfl_xor(gs[T][g], 32); const float base = run + (hi == 0 ? gp : 0.f);
#pragma unroll
                    for (int r = 0; r < 4; ++r) z[T][4 * g + r] = __builtin_amdgcn_exp2f(z[T][4 * g + r] + base + inl[T][4 * g + r]);
                    run += gs[T][g] + gp; }
            carry = run;
            s16x8 pf[4];
#pragma unroll
            for (int c = 0; c < 4; ++c) { const int T = c >> 1, b8 = (c & 1) * 8;
                pf[c] = pack8(z[T][b8 + 0], z[T][b8 + 1], z[T][b8 + 2], z[T][b8 + 3], z[T][b8 + 4], z[T][b8 + 5], z[T][b8 + 6], z[T][b8 + 7]); }
            pv_tile(o, buf + KT_BYTES, pf, lane);
            wdone = __builtin_amdgcn_ballot_w64(carry >= -58.f) == 0ull;
        }
        if (lane == 0) flag[(i & 1) * 8 + w] = (wdone || !more) ? 1u : 0u;
        if (more) tile_store(R, F.lds + ((i + 1) & 1) * TB_BYTES, F.tid);
        __syncthreads();
        if (!more) break;
        unsigned alld = 1u;
#pragma unroll
        for (int k = 0; k < 8; ++k) alld &= flag[(i & 1) * 8 + k];
        if (alld) break;
    }
    wq_prefetch(F);
    store_o(o, 1.f, F_o + tok * D + 640 + h * 64, lane, F_oss + tok * 16 + 10 + h);
}
template <class Pol> __device__ __forceinline__ void flash_pass(Frame& F, const Pol& P, int ntile, const bf16* Kb, const bf16* Vb, const s16x8 (&qf)[4], f32x16 (&o)[2], float& m, float& l) {
    TileRegs R0, R1, R2; const int lane = F.lane;
    int tid = F.tid; asm volatile("" : "+v"(tid));
    __syncthreads();
    tile_load(R0, Kb + (size_t)P.row0(0) * PW, Vb + (size_t)P.row0(0) * PW, PW, tid);
    if (ntile > 1) tile_load(R1, Kb + (size_t)P.row0(1) * PW, Vb + (size_t)P.row0(1) * PW, PW, tid);
    if (ntile > 2) tile_load(R2, Kb + (size_t)P.row0(2) * PW, Vb + (size_t)P.row0(2) * PW, PW, tid);
    tile_store(R0, F.lds, tid);
    __syncthreads();
#define FSTEP(I, RL, RS) { const int i_ = (I); if (i_ < ntile) { \
        if (i_ + 3 < ntile) tile_load(RL, Kb + (size_t)P.row0(i_ + 3) * PW, Vb + (size_t)P.row0(i_ + 3) * PW, PW, tid); \
        const LAS unsigned char* buf = F.lds + (i_ & 1) * TB_BYTES; \
        if (P.active(i_)) { f32x16 p[2]; qk_tile(p, buf, qf, lane); const bool keep = P.mask(i_, p); s16x8 pf[4]; softmax_step(p, o, m, l, pf, keep); pv_tile(o, buf + KT_BYTES, pf, lane); } \
        if (i_ + 1 < ntile) tile_store(RS, F.lds + ((i_ + 1) & 1) * TB_BYTES, tid); \
        __syncthreads(); } }
    for (int i = 0; i < ntile; i += 3) { FSTEP(i, R0, R1); FSTEP(i + 1, R1, R2); FSTEP(i + 2, R2, R0); }
#undef FSTEP
}
struct PolMoba { unsigned selm; int own, w, qrel  ;
    __device__ __forceinline__ int row0(int i) const { return 64 * i; }
    __device__ __forceinline__ bool active(int i) const { const int blk = i >> 2; return blk < own ? (__builtin_amdgcn_ballot_w64((selm >> blk) & 1u) != 0ull) : ((64 * (i & 3)) <= 32 * w + 31); }
    __device__ __forceinline__ bool mask(int i, f32x16 (&p)[2]) const { const int blk = i >> 2; if (blk < own) return ((selm >> blk) & 1u) != 0u; mask_le(p, qrel - 64 * (i & 3)); return true; } };
struct PolSlc { unsigned sl, sh; int ownw, lim_own  ;
    __device__ __forceinline__ int row0(int i) const { return 64 * i; }
    __device__ __forceinline__ bool bit(int i) const { return ((i < 32 ? sl >> i : sh >> (i - 32)) & 1u) != 0u; }
    __device__ __forceinline__ bool active(int i) const { return i <= ownw && __builtin_amdgcn_ballot_w64(bit(i)) != 0ull; }
    __device__ __forceinline__ bool mask(int i, f32x16 (&p)[2]) const { if (i == ownw) { mask_le(p, lim_own); return true; } return bit(i); } };
struct PolWin { int klo, t0, trel  ;
    __device__ __forceinline__ int row0(int i) const { return 64 * (klo + i); }
    __device__ __forceinline__ bool active(int i) const { const int k0 = 64 * (klo + i); return k0 + 63 >= t0 - 511 && k0 <= t0 + 31; }
    __device__ __forceinline__ bool mask(int i, f32x16 (&p)[2]) const { const int k0 = 64 * (klo + i);
        if (k0 + 63 > t0) mask_le(p, trel - k0);
        if (k0 < t0 + 31 - 511) mask_ge(p, trel - 511 - k0);
        return true; } };
__device__ __forceinline__ void nsa_sw_unit(Frame& F, const Args& A, int u) {
    const int qt = 15 - (u / 48), bh = u % 48, h = bh % 6, b = bh / 6, lane = F.lane, w = F.wave, hi = lane >> 5;
    const int t0 = 256 * qt + 32 * w, tq = t0 + (lane & 31); const size_t tok = (size_t)b * S + tq;
    const bf16* prow = F_proj + tok * PW;
    s16x8 qf[4]; load_qfrags(qf, prow + C_QB + h * 64, QSCALE_LOG2, lane);
    const bf16* Pb = F_proj + (size_t)b * S * PW;
    f32x16 os[2], ow[2];
#pragma unroll
    for (int dt = 0; dt < 2; ++dt)
#pragma unroll
        for (int j = 0; j < 16; ++j) { os[dt][j] = 0.f; ow[dt][j] = 0.f; }
    float ms = NEGINF, ls = 0.f, mw = NEGINF, lw = 0.f;
    { const v2u sm = *(const v2u*)(F_selm + tok * 2); PolSlc P{sm.x, sm.y, t0 >> 6, tq - 64 * (t0 >> 6) - 4 * hi};
      flash_pass(F, P, 4 * qt + 4, Pb + C_KVB + 128, Pb + C_KVB + 192, qf, os, ms, ls); }
    { int klo = (256 * qt - 511) >> 6; if (klo < 0) klo = 0; PolWin P{klo, t0, tq - 4 * hi};
      flash_pass(F, P, 4 * qt + 4 - klo, Pb + C_KVB + 256, Pb + C_KVB + 320, qf, ow, mw, lw); }
    wq_prefetch(F);
    const float lst = ls + __shfl_xor(ls, 32), lwt = lw + __shfl_xor(lw, 32);
    const float gs = sigmoidf_(bf1(prow[C_GB + h * 3 + 1])) * (lst > 0.f ? 1.f / lst : 0.f), gw = sigmoidf_(bf1(prow[C_GB + h * 3 + 2])) * (lwt > 0.f ? 1.f / lwt : 0.f);
    bf16* orow = F_o + tok * D + 256 + h * 64; float ssq = 0.f;
#pragma unroll
    for (int dt = 0; dt < 2; ++dt)
#pragma unroll
        for (int g = 0; g < 4; ++g) { bf16* op = orow + 32 * dt + 8 * g + 4 * hi; const v2u c = *(const v2u*)(F_ocp + tok * 384 + h * 64 + 32 * dt + 8 * g + 4 * hi);
            const float r0 = bflo(c.x) + gs * os[dt][4 * g] + gw * ow[dt][4 * g], r1 = bfhi(c.x) + gs * os[dt][4 * g + 1] + gw * ow[dt][4 * g + 1];
            const float r2 = bflo(c.y) + gs * os[dt][4 * g + 2] + gw * ow[dt][4 * g + 2], r3 = bfhi(c.y) + gs * os[dt][4 * g + 3] + gw * ow[dt][4 * g + 3];
            ssq += (r0 * r0 + r1 * r1) + (r2 * r2 + r3 * r3); v2u wv; wv.x = pg8::cvt_pk_bf16(r0, r1); wv.y = pg8::cvt_pk_bf16(r2, r3); *(v2u*)op = wv; }
    ssq += __shfl_xor(ssq, 32); if (lane < 32) F_oss[tok * 16 + 4 + h] = ssq;
}
__device__ __forceinline__ void nsa_cmp_unit(Frame& F, const Args& A, int u) {
    const int qt = u & 15, b = u >> 4, lane = F.lane, w = F.wave, hi = lane >> 5;
    const int t0 = 256 * qt + 32 * w, tq = t0 + (lane & 31); const size_t tok = (size_t)b * S + tq;
    const bf16* prow = F_proj + tok * PW;
    __syncthreads();
    { const bf16* kc = F_kcb + (size_t)b * 256 * 64; const bf16* vc = F_vcb + (size_t)b * 256 * 64;
#pragma unroll
      for (int q = 0; q < 4; ++q) { const int idx = F.tid + 512 * q, r = idx >> 3, c = idx & 7;
          *(LAS v4u*)(F.lds + (r >> 6) * KT_BYTES + (r & 63) * KP + c * 16) = *(const v4u*)(kc + (size_t)r * 64 + c * 8);
          *(LAS v4u*)(F.lds + 4 * KT_BYTES + (r >> 6) * VT_BYTES + (r & 63) * VP + c * 16) = *(const v4u*)(vc + (size_t)r * 64 + c * 8); } }
    __syncthreads();
    const int nmax = tq >= 31 ? (tq - 31) >> 4 : -1;
    const int nmax_w = (t0 + 31) >= 31 ? (t0 + 31 - 31) >> 4 : -1;
    float IM[4][2][4];
#pragma unroll
    for (int a = 0; a < 4; ++a)
#pragma unroll
        for (int T = 0; T < 2; ++T)
#pragma unroll
            for (int g = 0; g < 4; ++g) IM[a][T][g] = 0.f;
    for (int h = 0; h < 6; ++h) {
        s16x8 qf[4]; load_qfrags(qf, prow + C_QB + h * 64, QSCALE_LOG2, lane);
        float m = NEGINF, l = 0.f;
#pragma unroll
        for (int kt = 0; kt < 4; ++kt) { if (64 * kt > nmax_w) continue;
            f32x16 p[2]; qk_tile(p, F.lds + kt * KT_BYTES, qf, lane); mask_le(p, nmax - 64 * kt - 4 * hi);
            float tm = p[0][0];
#pragma unroll
            for (int j = 1; j < 16; ++j) tm = fmaxf(tm, p[0][j]);
#pragma unroll
            for (int j = 0; j < 16; ++j) tm = fmaxf(tm, p[1][j]);
            const float mn = fmaxf(m, tm), mu = (mn == NEGINF) ? 0.f : mn; l *= __builtin_amdgcn_exp2f(m - mu); m = mn;
#pragma unroll
            for (int T = 0; T < 2; ++T)
#pragma unroll
                for (int j = 0; j < 16; ++j) l += __builtin_amdgcn_exp2f(p[T][j] - mu); }
        { const float mo = __shfl_xor(m, 32), lo = __shfl_xor(l, 32); const float M = fmaxf(m, mo), Mu = (M == NEGINF) ? 0.f : M;
          l = l * __builtin_amdgcn_exp2f(m - Mu) + lo * __builtin_amdgcn_exp2f(mo - Mu); m = Mu; }
        const float inv = l > 0.f ? 1.f / l : 0.f;
        f32x16 o[2];
#pragma unroll
        for (int dt = 0; dt < 2; ++dt)
#pragma unroll
            for (int j = 0; j < 16; ++j) o[dt][j] = 0.f;
        float carry = 0.f;
#pragma unroll
        for (int kt = 0; kt < 4; ++kt) { if (64 * kt > nmax_w) continue;
            f32x16 p[2]; qk_tile(p, F.lds + kt * KT_BYTES, qf, lane); mask_le(p, nmax - 64 * kt - 4 * hi);
#pragma unroll
            for (int T = 0; T < 2; ++T)
#pragma unroll
                for (int j = 0; j < 16; ++j) p[T][j] = __builtin_amdgcn_exp2f(p[T][j] - m) * inv;
            float x[2][4];
#pragma unroll
            for (int T = 0; T < 2; ++T)
#pragma unroll
                for (int g = 0; g < 4; ++g) x[T][g] = __shfl_xor(p[T][4 * g + 3], 32);
#pragma unroll
            for (int T = 0; T < 2; ++T)
#pragma unroll
                for (int g = 0; g < 4; ++g) { const float prev = g > 0 ? x[T][g - 1] : (T > 0 ? x[0][3] : carry);
                    IM[kt][T][g] += ((p[T][4 * g] + p[T][4 * g + 1]) + (p[T][4 * g + 2] + p[T][4 * g + 3])) + (hi ? x[T][g] : prev); }
            carry = x[1][3];
            s16x8 pf[4];
#pragma unroll
            for (int c = 0; c < 4; ++c) { const int T = c >> 1, b8 = (c & 1) * 8;
                pf[c] = pack8(p[T][b8 + 0], p[T][b8 + 1], p[T][b8 + 2], p[T][b8 + 3], p[T][b8 + 4], p[T][b8 + 5], p[T][b8 + 6], p[T][b8 + 7]); }
            pv_tile(o, F.lds + 4 * KT_BYTES + kt * VT_BYTES, pf, lane); }
        store_o(o, sigmoidf_(bf1(prow[C_GB + h * 3 + 0])), F_ocp + tok * 384 + h * 64, lane);
    }
    wq_prefetch(F);
    const int ownb = tq >> 6;
#pragma unroll
    for (int a = 0; a < 4; ++a)
#pragma unroll
        for (int T = 0; T < 2; ++T)
#pragma unroll
            for (int g = 0; g < 4; ++g) { const int mm = 16 * a + 8 * T + 2 * g + hi; float v = IM[a][T][g];
                if (mm == 0 || mm == ownb || mm == ownb - 1) v = 1e4f; if (64 * mm > tq) v = -1e30f; IM[a][T][g] = v; }
    unsigned sl = 0u, sh = 0u;
    for (int r = 0; r < 16; ++r) { float bv = -3.4e38f; int bm = 0;
#pragma unroll
        for (int a = 0; a < 4; ++a)
#pragma unroll
            for (int T = 0; T < 2; ++T)
#pragma unroll
                for (int g = 0; g < 4; ++g) { const int mm = 16 * a + 8 * T + 2 * g + hi; if (IM[a][T][g] > bv) { bv = IM[a][T][g]; bm = mm; } }
        const float ov = __shfl_xor(bv, 32); const int om = __shfl_xor(bm, 32);
        if (ov > bv || (ov == bv && om < bm)) { bv = ov; bm = om; }
        if (bv > -5e29f) { if (bm < 32) sl |= 1u << bm; else sh |= 1u << (bm - 32); }
#pragma unroll
        for (int a = 0; a < 4; ++a)
#pragma unroll
            for (int T = 0; T < 2; ++T)
#pragma unroll
                for (int g = 0; g < 4; ++g) { const int mm = 16 * a + 8 * T + 2 * g + hi; IM[a][T][g] = (mm == bm) ? -3.4e38f : IM[a][T][g]; }
    }
    if (hi == 0) { v2u sm; sm.x = sl; sm.y = sh; *(v2u*)(F_selm + tok * 2) = sm; }
}
__device__ __forceinline__ void moba_unit(Frame& F, const Args& A, int u, int layer) {
    const int own = 15 - (u >> 5), bh = u & 31, b = bh >> 2, h = bh & 3, lane = F.lane, w = F.wave, hi = lane >> 5;
    const int tq = own * 256 + 32 * w + (lane & 31); const size_t tok = (size_t)b * S + tq;
    const bf16* qrow = F_proj + tok * PW + C_QA + h * 64;
    unsigned selm = 0u;
    {   float q[64]; loadq(q, qrow);
        const float* km = F_kmean + (size_t)layer * NB * 4 * 16 * 64 + (size_t)(b * 4 + h) * 16 * 64;
        LAS float* kmL = (LAS float*)(F.lds + 98304);
        if (F.tid < 256) *(LAS f32x4*)(kmL + 4 * F.tid) = *(const f32x4*)(km + 4 * F.tid);
        __syncthreads();
        float v1 = -3e38f, v2 = -3e38f, v3 = -3e38f; int i1 = -1, i2 = -1, i3 = -1;
        for (int n = 0; n < own; ++n) { const float g = dot64l(q, kmL + n * 64);
            if (g > v1) { v3 = v2; i3 = i2; v2 = v1; i2 = i1; v1 = g; i1 = n; } else if (g > v2) { v3 = v2; i3 = i2; v2 = g; i2 = n; } else if (g > v3) { v3 = g; i3 = n; } }
        if (i1 >= 0) selm |= 1u << i1; if (i2 >= 0) selm |= 1u << i2; if (i3 >= 0) selm |= 1u << i3;
    }
    s16x8 qf[4]; load_qfrags(qf, qrow, QSCALE_LOG2, lane);
    f32x16 o[2];
#pragma unroll
    for (int dt = 0; dt < 2; ++dt)
#pragma unroll
        for (int j = 0; j < 16; ++j) o[dt][j] = 0.f;
    float m = NEGINF, l = 0.f;
    const bf16* Kb = F_proj + (size_t)b * S * PW + C_KA + h * 64; const bf16* Vb = F_proj + (size_t)b * S * PW + C_VA + h * 64;
    { PolMoba P{selm, own, w, 32 * w + (lane & 31) - 4 * hi}; flash_pass(F, P, 4 * own + 4, Kb, Vb, qf, o, m, l); }
    wq_prefetch(F);
    const float lt = l + __shfl_xor(l, 32);
    store_o(o, lt > 0.f ? 1.f / lt : 0.f, F_o + tok * D + h * 64, lane, F_oss + tok * 16 + h);
}
#ifndef PROBE_PHASE
#define PROBE_PHASE -1
#endif
#define QREPS(g) ((PROBE_PHASE == (g)) ? 2 : 1)
#define WQ_LOOP(CTR, NUNITS, CALL) do { { int z_ = 0; asm volatile("" : "+v"(z_)); F.qctr = (CTR) + z_; } F.tk = 0u; \
    int u = __builtin_amdgcn_readfirstlane(wq_next(F, F.qctr)); \
    while (u < (NUNITS)) { CALL; __syncthreads(); if (F.tid == 0) F.MISC[0] = F.tk; __syncthreads(); u = __builtin_amdgcn_readfirstlane((int)F.MISC[0]); } } while (0)
__device__ __forceinline__ void phase_attn_a(Frame& F0, const Args& A, int l, int rep) {
    Frame F = F0; asm volatile("" : "+v"(F.tid)); F.lane = F.tid & 63;
    WQ_LOOP(F.ctl + CW_WQ + 64 * (l * 4 + 2) + 8 * rep, NB * 16, nsa_cmp_unit(F, A, u));
    WQ_LOOP(F.ctl + CW_WQ + 64 * (l * 4 + 0) + 8 * rep, NB * 4 * 16, moba_unit(F, A, u, l));
    WQ_LOOP(F.ctl + CW_WQ + 64 * (l * 4 + 1) + 8 * rep, NB * 6 * 16, sb_unit(F, A, u));
    __syncthreads();
}
__device__ __forceinline__ void phase_attn_b(Frame& F0, const Args& A, int l, int rep) {
    Frame F = F0; asm volatile("" : "+v"(F.tid)); F.lane = F.tid & 63;
    WQ_LOOP(F.ctl + CW_WQ + 64 * (l * 4 + 3) + 8 * rep, NB * 6 * 16, nsa_sw_unit(F, A, u));
    __syncthreads();
}
struct GnIn { v4u w0, w1; };
__device__ __forceinline__ void gn_load(GnIn& I, const Args& A, int tok, int lane) { const bf16* orow = F_o + (size_t)tok * D; I.w0 = __builtin_nontemporal_load((const v4u*)(orow + lane * 8)); I.w1 = __builtin_nontemporal_load((const v4u*)(orow + 512 + lane * 8)); }
__device__ __forceinline__ void gn_compute(const GnIn& I, const Args& A, int tok, int lane, const float* gg) {
    const v4u w0 = I.w0, w1 = I.w1;
    float v0[8] = {bflo(w0.x), bfhi(w0.x), bflo(w0.y), bfhi(w0.y), bflo(w0.z), bfhi(w0.z), bflo(w0.w), bfhi(w0.w)};
    float v1[8] = {bflo(w1.x), bfhi(w1.x), bflo(w1.y), bfhi(w1.y), bflo(w1.z), bfhi(w1.z), bflo(w1.w), bfhi(w1.w)};
    float s0 = 0.f, s1 = 0.f;
#pragma unroll
    for (int j = 0; j < 8; ++j) { s0 += v0[j] * v0[j]; s1 += v1[j] * v1[j]; }
    const float ssA = wave_sum(lane < 32 ? s0 : 0.f), ssB = wave_sum((lane >= 32 ? s0 : 0.f) + (lane < 16 ? s1 : 0.f)), ssC = wave_sum(lane >= 16 ? s1 : 0.f);
    const float rA = __builtin_amdgcn_rsqf(ssA * (1.f / 256.f) + RMS_EPS), rB = __builtin_amdgcn_rsqf(ssB * (1.f / 384.f) + RMS_EPS), rC = __builtin_amdgcn_rsqf(ssC * (1.f / 384.f) + RMS_EPS);
    const float r0 = lane < 32 ? rA : rB, r1 = lane < 16 ? rB : rC;
    const f32x4 g00 = *(const f32x4*)(gg + lane * 8), g01 = *(const f32x4*)(gg + lane * 8 + 4), g10 = *(const f32x4*)(gg + 512 + lane * 8), g11 = *(const f32x4*)(gg + 512 + lane * 8 + 4);
    v4u o0, o1;
    o0.x = pk2(v0[0] * r0 * g00.x, v0[1] * r0 * g00.y); o0.y = pk2(v0[2] * r0 * g00.z, v0[3] * r0 * g00.w); o0.z = pk2(v0[4] * r0 * g01.x, v0[5] * r0 * g01.y); o0.w = pk2(v0[6] * r0 * g01.z, v0[7] * r0 * g01.w);
    o1.x = pk2(v1[0] * r1 * g10.x, v1[1] * r1 * g10.y); o1.y = pk2(v1[2] * r1 * g10.z, v1[3] * r1 * g10.w); o1.z = pk2(v1[4] * r1 * g11.x, v1[5] * r1 * g11.y); o1.w = pk2(v1[6] * r1 * g11.z, v1[7] * r1 * g11.w);
    bf16* arow = F_act + (size_t)tok * D; *(v4u*)(arow + lane * 8) = o0; *(v4u*)(arow + 512 + lane * 8) = o1;
}
__device__ __forceinline__ void phase_gnorm(Frame& F, const Args& A, int l) {
    const int gw = F.vcu * NWAVES + F.wave, NGW = F.G * NWAVES, lane = F.lane; const float* gg = F_mix_g + (size_t)l * D;
    GnIn Ia, Ib; int tok = gw;
    if (tok < NTOK) gn_load(Ia, A, tok, lane);
    for (; tok < NTOK; tok += 2 * NGW) {
        if (tok + NGW < NTOK) gn_load(Ib, A, tok + NGW, lane);
        gn_compute(Ia, A, tok, lane, gg);
        if (tok + 2 * NGW < NTOK) gn_load(Ia, A, tok + 2 * NGW, lane);
        if (tok + NGW < NTOK) gn_compute(Ib, A, tok + NGW, lane, gg);
    }
}
struct PmIn { f32x4 x[4]; v2u xb[4]; v2u y[4]; };
__device__ __forceinline__ void pm_load(PmIn& I, const Args& A, int tok, int lane, int l) {
    const f32x4* xr = (const f32x4*)(F_x + (size_t)tok * D) + lane; const bf16* xm = F_xmid + (size_t)tok * D; const bf16* yr = F_y + (size_t)tok * D;
#pragma unroll
    for (int j = 0; j < 4; ++j) { if (l == 0) I.x[j] = __builtin_nontemporal_load(xr + 64 * j); else I.xb[j] = __builtin_nontemporal_load((const v2u*)(xm + 4 * lane + 256 * j)); I.y[j] = __builtin_nontemporal_load((const v2u*)(yr + 4 * lane + 256 * j)); } }
__device__ __forceinline__ void pm_compute(const PmIn& I, const Args& A, int tok, int lane, int l, const LAS float* cA1, const LAS float* cA2, const LAS float* cS0, LAS float* rs2out) {
    f32x4 xv[4], yv[4]; float ss = 0.f;
#pragma unroll
    for (int j = 0; j < 4; ++j) { if (l == 0) xv[j] = I.x[j]; else { const v2u xw = I.xb[j]; xv[j] = (f32x4){bflo(xw.x), bfhi(xw.x), bflo(xw.y), bfhi(xw.y)}; } const v2u w = I.y[j]; yv[j] = (f32x4){bflo(w.x), bfhi(w.x), bflo(w.y), bfhi(w.y)};
        ss += (yv[j].x * yv[j].x + yv[j].y * yv[j].y) + (yv[j].z * yv[j].z + yv[j].w * yv[j].w); }
    const float rs = __builtin_amdgcn_rsqf(wave_sum(ss) * (1.f / D) + RMS_EPS);
    bf16* x1r = F_x1b + (size_t)tok * D;
#pragma unroll
    for (int j = 0; j < 4; ++j) { const int c = 4 * lane + 256 * j; const f32x4 a1 = *(const LAS f32x4*)(cA1 + c);
        xv[j] = xv[j] + a1 * (yv[j] * rs); v2u xw; xw.x = pk2(xv[j].x, xv[j].y); xw.y = pk2(xv[j].z, xv[j].w); *(v2u*)(x1r + c) = xw; }
    float s2 = 0.f;
#pragma unroll
    for (int j = 0; j < 4; ++j) s2 += (xv[j].x * xv[j].x + xv[j].y * xv[j].y) + (xv[j].z * xv[j].z + xv[j].w * xv[j].w);
    const float rs2 = __builtin_amdgcn_rsqf(wave_sum(s2) * (1.f / D) + RMS_EPS);
    if (lane == 0) *rs2out = rs2;
    unsigned char* arow8 = F_act8 + (size_t)tok * D;
#pragma unroll
    for (int j = 0; j < 4; ++j) { const int c = 4 * lane + 256 * j; const f32x4 a2 = *(const LAS f32x4*)(cA2 + c), s0 = *(const LAS f32x4*)(cS0 + c);
        const f32x4 r = xv[j] * rs2 * a2 + s0; *(unsigned*)(arow8 + c) = pg8::pk4_fp8(r.x, r.y, r.z, r.w); }
}
__device__ __forceinline__ void phase_postmix(Frame& F, const Args& A, int l, int bank) {
    const int lane = F.lane, wave = F.wave;
    LAS float* lgt = (LAS float*)(F.lds + wave * 4096);
    LAS float* rsv = lgt + 512;
    LAS int* tE = (LAS int*)(F.lds + 32768); LAS int* tR = tE + 512; LAS unsigned* lcnt = (LAS unsigned*)(tR + 512); LAS unsigned* lbase = lcnt + 32; LAS float* tG = (LAS float*)(lbase + 32);
    const float* g1n = F_norm_g + ((size_t)l * 4 + 1) * D; const float* g2n = F_norm_g + ((size_t)l * 4 + 2) * D;
    for (int chunk = blockIdx.x; chunk < NTOK / 128; chunk += F.G) {
        __syncthreads();
        if (F.tid < 32) lcnt[F.tid] = 0u;
        __syncthreads();
        const int tok0 = chunk * 128 + wave * 16, b = tok0 >> 12; const float* md = F_mod + ((size_t)l * NB + b) * 6 * D;
        PmIn Ia, Ib; pm_load(Ia, A, tok0, lane, l);
        LAS float* cA1 = (LAS float*)(F.lds + 65536); LAS float* cA2 = cA1 + D; LAS float* cS0 = cA2 + D;
        for (int i = F.tid; i < D; i += NWAVES * 64) { cA1[i] = md[2 * D + i] * g1n[i]; cA2[i] = g2n[i] * (md[4 * D + i] + 1.f); cS0[i] = md[3 * D + i]; }
        __syncthreads();
        for (int i = 0; i < 16; i += 2) {
            pm_load(Ib, A, tok0 + i + 1, lane, l);
            pm_compute(Ia, A, tok0 + i, lane, l, cA1, cA2, cS0, rsv + i);
            if (i + 2 < 16) pm_load(Ia, A, tok0 + i + 2, lane, l);
            pm_compute(Ib, A, tok0 + i + 1, lane, l, cA1, cA2, cS0, rsv + i + 1);
        }
        VM_WAIT();
        {
            const int m16 = lane & 15, kg = lane >> 4; constexpr int BPB = 272;
            const bf16* ap = F_x1b + (size_t)(tok0 + m16) * D + 8 * kg;
            const unsigned short* bsrc = F_rw3 + ((size_t)l * NB + b) * NE * 3 * D + (size_t)(F.tid >> 4) * 3 * D + (F.tid & 15) * 8;
            LAS unsigned char* bl = F.lds + 77824; LAS unsigned char* bw = bl + (F.tid >> 4) * BPB + (F.tid & 15) * 16;
            f32x4 c0 = (f32x4){0.f, 0.f, 0.f, 0.f}, c1 = c0;
            v4u g[3]; c16x8 ac[4], an[4];
#pragma unroll
            for (int p = 0; p < 3; ++p) g[p] = *(const v4u*)(bsrc + p * D);
#pragma unroll
            for (int q4 = 0; q4 < 4; ++q4) ac[q4] = *(const c16x8*)(ap + 32 * q4);
#pragma unroll
            for (int p = 0; p < 3; ++p) *(LAS v4u*)(bw + p * 32 * BPB) = g[p];
            __syncthreads();
#pragma unroll
            for (int kc = 0; kc < 8; ++kc) { const LAS unsigned char* br = bl + (kc & 1) * 3 * 32 * BPB + m16 * BPB + 16 * kg;
                if (kc + 1 < 8) {
#pragma unroll
                    for (int p = 0; p < 3; ++p) g[p] = *(const v4u*)(bsrc + p * D + 128 * (kc + 1));
#pragma unroll
                    for (int q4 = 0; q4 < 4; ++q4) an[q4] = *(const c16x8*)(ap + 128 * (kc + 1) + 32 * q4); }
#pragma unroll
                for (int q4 = 0; q4 < 4; ++q4)
#pragma unroll
                    for (int p = 0; p < 3; ++p) { const c16x8 b0 = *(const LAS c16x8*)(br + p * 32 * BPB + 64 * q4), b1 = *(const LAS c16x8*)(br + p * 32 * BPB + 16 * BPB + 64 * q4);
                        c0 = __builtin_amdgcn_mfma_f32_16x16x32_bf16(ac[q4], b0, c0, 0, 0, 0); c1 = __builtin_amdgcn_mfma_f32_16x16x32_bf16(ac[q4], b1, c1, 0, 0, 0); }
                if (kc + 1 < 8) { LAS unsigned char* bn = bw + ((kc + 1) & 1) * 3 * 32 * BPB;
#pragma unroll
                    for (int p = 0; p < 3; ++p) *(LAS v4u*)(bn + p * 32 * BPB) = g[p];
#pragma unroll
                    for (int q4 = 0; q4 < 4; ++q4) ac[q4] = an[q4]; }
                __syncthreads(); }
#pragma unroll
            for (int r = 0; r < 4; ++r) { lgt[(4 * kg + r) * 32 + m16] = c0[r]; lgt[(4 * kg + r) * 32 + 16 + m16] = c1[r]; } }
        LDS_WAIT(); asm volatile("" ::: "memory");
        if (lane < 16) { const int tl = wave * 16 + lane, tok = tok0 + lane; const float rs2 = rsv[lane]; const float* rc = F_rconst + ((size_t)l * NB + b) * NE;
            float v0 = -3e38f, v1 = -3e38f, v2 = -3e38f, v3 = -3e38f; int i0 = 0, i1 = 0, i2 = 0, i3 = 0;
#pragma unroll 8
            for (int e = 0; e < NE; ++e) { const float g = lgt[lane * 32 + e] * rs2 + rc[e];
                if (g > v3) { if (g > v1) { v3 = v2; i3 = i2; v2 = v1; i2 = i1; if (g > v0) { v1 = v0; i1 = i0; v0 = g; i0 = e; } else { v1 = g; i1 = e; } }
                              else { if (g > v2) { v3 = v2; i3 = i2; v2 = g; i2 = e; } else { v3 = g; i3 = e; } } } }
            const float e1 = __expf(v1 - v0), e2 = __expf(v2 - v0), e3 = __expf(v3 - v0); const float inv = 1.f / (1.f + e1 + e2 + e3);
            const int ei[4] = {i0, i1, i2, i3}; const float gt[4] = {inv, e1 * inv, e2 * inv, e3 * inv};
#pragma unroll
            for (int s = 0; s < 4; ++s) { const unsigned rk = __hip_atomic_fetch_add(&lcnt[ei[s]], 1u, __ATOMIC_RELAXED, __HIP_MEMORY_SCOPE_WORKGROUP); tE[tl * 4 + s] = ei[s]; tR[tl * 4 + s] = (int)rk; tG[tl * 4 + s] = gt[s]; } }
        LDS_WAIT(); asm volatile("" ::: "memory");
        __syncthreads();
        if (F.tid < 32) lbase[F.tid] = atomicAdd((unsigned*)(F.ctl + CW_CNT + 64 * bank + F.tid), lcnt[F.tid]);
        __syncthreads();
        { const int tok = chunk * 128 + (F.tid >> 2), s = F.tid & 3, e = tE[F.tid]; const int pos = (int)lbase[e] + tR[F.tid]; F_list[(size_t)e * NTOK + pos] = tok * 4 + s; F_lgate[(size_t)e * NTOK + pos] = tG[F.tid]; }
    }
    __syncthreads();
}
__device__ __forceinline__ int moe_tables(Frame& F, const Args& A, int l) {
    LAS int* rowbase = (LAS int*)(F.lds + TAB_OFF); LAS unsigned char* texp = (LAS unsigned char*)(F.lds + TAB_OFF + 256); LAS int* ecnt = (LAS int*)(F.lds + TAB_OFF + 896);
    __syncthreads();
    if (F.tid < 64) { const int ln = F.tid;
        const int c = ln < NE ? (int)__hip_atomic_load(F.ctl + CW_CNT + 64 * l + ln, RLX_AGENT) : 0; const int nt = (c + 255) >> 8;
        int incl = nt;
#pragma unroll
        for (int o = 1; o < 64; o <<= 1) { const int t = __shfl_up(incl, o); if (ln >= o) incl += t; }
        const int excl = incl - nt;
        if (ln < NE) { rowbase[ln] = excl << 8; ecnt[ln] = c; for (int k = 0; k < nt; ++k) texp[excl + k] = (unsigned char)ln; }
        if (ln == NE - 1) rowbase[NE] = incl << 8; }
    __syncthreads();
    return rowbase[NE] >> 8;
}
struct CbIn { unsigned yb[4][4]; v2u x1[4]; };
__device__ __forceinline__ void cb_load(CbIn& I, const Args& A, int tok, int lane) { const unsigned char* yr = F_yt8 + (size_t)tok * 4 * D; const bf16* x1r = F_x1b + (size_t)tok * D;
#pragma unroll
    for (int s = 0; s < 4; ++s)
#pragma unroll
        for (int j = 0; j < 4; ++j) I.yb[s][j] = __builtin_nontemporal_load((const unsigned*)(yr + (size_t)s * D + 4 * lane + 256 * j));
#pragma unroll
    for (int j = 0; j < 4; ++j) I.x1[j] = __builtin_nontemporal_load((const v2u*)(x1r + 4 * lane + 256 * j)); }
__device__ __forceinline__ void cb_compute(const CbIn& I, const Args& A, int tok, int lane, int l, const LAS float* cA3, const LAS float* cA4, const LAS float* cS4) {
    f32x4 xv[4], yv[4];
#pragma unroll
    for (int j = 0; j < 4; ++j) { const v2u xw = I.x1[j]; xv[j] = (f32x4){bflo(xw.x), bfhi(xw.x), bflo(xw.y), bfhi(xw.y)}; yv[j] = (f32x4){0.f, 0.f, 0.f, 0.f};
#pragma unroll
        for (int s = 0; s < 4; ++s) { typedef float f32x2_ __attribute__((ext_vector_type(2))); const f32x2_ lo = __builtin_amdgcn_cvt_pk_f32_fp8((int)I.yb[s][j], false), hi2 = __builtin_amdgcn_cvt_pk_f32_fp8((int)I.yb[s][j], true); yv[j] = yv[j] + (f32x4){lo.x, lo.y, hi2.x, hi2.y}; } }
    float ss = 0.f;
#pragma unroll
    for (int j = 0; j < 4; ++j) ss += (yv[j].x * yv[j].x + yv[j].y * yv[j].y) + (yv[j].z * yv[j].z + yv[j].w * yv[j].w);
    const float rs = __builtin_amdgcn_rsqf(wave_sum(ss) * (1.f / D) + RMS_EPS * (pg8::YT8_SCALE * pg8::YT8_SCALE));
    f32x4* outr = (f32x4*)(F_out + (size_t)tok * D) + lane; bf16* xmr = F_xmid + (size_t)tok * D;
#pragma unroll
    for (int j = 0; j < 4; ++j) { const int c = 4 * lane + 256 * j; const f32x4 a3 = *(const LAS f32x4*)(cA3 + c);
        xv[j] = xv[j] + a3 * (yv[j] * rs);
        if (l + 1 < NL) { v2u xw; xw.x = pk2(xv[j].x, xv[j].y); xw.y = pk2(xv[j].z, xv[j].w); *(v2u*)(xmr + c) = xw; } else outr[64 * j] = xv[j]; }
    if (l + 1 < NL) mod_norm_row_l(xv, cA4, cS4, F_act + (size_t)tok * D, lane);
}
__device__ __forceinline__ void phase_combine(Frame& F, const Args& A, int l) {
    const int lane = F.lane; const float* g3n = F_norm_g + ((size_t)l * 4 + 3) * D;
    LAS float* cA3 = (LAS float*)(F.lds + 65536); LAS float* cA4 = cA3 + D; LAS float* cS4 = cA4 + D;
    for (int chunk = blockIdx.x; chunk < NTOK / 128; chunk += F.G) {
        const int tok0 = chunk * 128 + F.wave * 16, b = tok0 >> 12; const float* md = F_mod + ((size_t)l * NB + b) * 6 * D;
        CbIn Ia, Ib; cb_load(Ia, A, tok0, lane);
        __syncthreads();
        for (int i = F.tid; i < D; i += NWAVES * 64) { cA3[i] = md[5 * D + i] * g3n[i];
            if (l + 1 < NL) { const float* md2 = F_mod + ((size_t)(l + 1) * NB + b) * 6 * D; cA4[i] = F_norm_g[(size_t)(l + 1) * 4 * D + i] * (md2[D + i] + 1.f); cS4[i] = md2[i]; } }
        __syncthreads();
        for (int i = 0; i < 16; i += 2) {
            cb_load(Ib, A, tok0 + i + 1, lane);
            cb_compute(Ia, A, tok0 + i, lane, l, cA3, cA4, cS4);
            if (i + 2 < 16) cb_load(Ia, A, tok0 + i + 2, lane);
            cb_compute(Ib, A, tok0 + i + 1, lane, l, cA3, cA4, cS4);
        }
    }
}
#ifndef MK_SINGLE
#define MK_SINGLE 1
#endif
#ifndef DUPMASK
#define DUPMASK 0
#endif
#define REPS(g) ((PROBE_PHASE == (g)) ? 2 : 1)
#define IN(k) (lo <= (k) && (k) < hi)
#define SEAM(k) do { if (IN((k) + 1)) xcd_barrier(bar); } while (0)
template <int l> __device__ __forceinline__ void layer_phases(Frame& F, const Args& A, const int lo, const int hi, const XcdBarrier& bar) {
        enum { P_HM = 0, P_PROJ, P_CMPR, P_ATTA, P_ATTB, P_OUT, P_POST, P_GU, P_DN, P_COMB, NPL };
        const int pb = 1 + NPL * l;
        if (IN(pb + P_HM) && l == 0) { _Pragma("nounroll") for (int rep = 0; rep < REPS(1); ++rep) phase_hm0(F, A); SEAM(pb + P_HM); }
        if (IN(pb + P_PROJ)) {
            pg8::Gemm g{F_act, F_WinT + (size_t)l * PW * D, NTOK, PW, D}; pg8::StaticOrder So; So.init(NTOK, PW, F.G, (int)blockIdx.x);
            pg8::EpiProj E{F_proj, PW, F_ropec, F_ropes, F_kmean + (size_t)l * NB * 4 * 16 * 64};
            pg8::gemm_phase<pg8::EpiProj, pg8::StaticOrder, true, true>(F.lds, g, So, E);
            if (l == 0) { const int rem = ((NTOK / 256) * (PW / 256)) % F.G, c = (int)blockIdx.x;
                if (rem == 0) router_tables(F, A, c, F.G); else if (c >= rem) router_tables(F, A, c - rem, F.G - rem); }
            SEAM(pb + P_PROJ); }
        if (IN(pb + P_CMPR)) { _Pragma("nounroll") for (int rep = 0; rep < REPS(3); ++rep) phase_compress(F, A, l); SEAM(pb + P_CMPR); }
        if (IN(pb + P_ATTA)) { _Pragma("nounroll") for (int rep = 0; rep < REPS(4); ++rep) phase_attn_a(F, A, l, rep); SEAM(pb + P_ATTA); }
        if (IN(pb + P_ATTB)) { _Pragma("nounroll") for (int rep = 0; rep < REPS(5); ++rep) phase_attn_b(F, A, l, rep); SEAM(pb + P_ATTB); }
        if (IN(pb + P_OUT)) {
            pg8::Gemm g{F_o, F_WoutT + (size_t)l * D * D, NTOK, D, D}; pg8::StaticOrder So; So.init(NTOK, D, F.G, (int)blockIdx.x);
            LAS float* rt = (LAS float*)(F.lds + TAB_OFF + 2048);
            { const int ui = F.tid >> 8, r = F.tid & 255; pg8::Unit uu; if (So.next(ui, uu)) { const f32x4* sp = (const f32x4*)(F_oss + ((size_t)uu.pm * 256 + r) * 16);
                  const f32x4 a = sp[0], b1 = sp[1], c1 = sp[2], d1 = sp[3];
                  const float ssA = (a.x + a.y) + (a.z + a.w), ssB = ((b1.x + b1.y) + (b1.z + b1.w)) + (c1.x + c1.y), ssC = (c1.z + c1.w) + ((d1.x + d1.y) + (d1.z + d1.w));
                  const float rA = __builtin_amdgcn_rsqf(ssA * (1.f / 256.f) + RMS_EPS), rB = __builtin_amdgcn_rsqf(ssB * (1.f / 384.f) + RMS_EPS), rC = __builtin_amdgcn_rsqf(ssC * (1.f / 384.f) + RMS_EPS);
                  *(LAS f32x4*)(rt + (ui * 256 + r) * 4) = (f32x4){rA * __builtin_amdgcn_rcpf(rB), rB * __builtin_amdgcn_rcpf(rC), rC, 0.f}; } }
            __syncthreads();
            pg8::EpiBf16 E{F_y, D, nullptr, 0, 0};
            pg8::gemm_phase_gn<pg8::EpiBf16, pg8::StaticOrder, true, true>(F.lds, g, So, E, (const LAS float*)rt);
            SEAM(pb + P_OUT); }
        if (IN(pb + P_POST)) { _Pragma("nounroll") for (int rep = 0; rep < REPS(8); ++rep) phase_postmix(F, A, l, l + 2 * rep); SEAM(pb + P_POST); }
        if (IN(pb + P_GU)) {
            const int nt = moe_tables(F, A, l);
            pg8::Gemm g{(const pg8::bf16_t*)F_act8, (const pg8::bf16_t*)(F_Wgu8 + (size_t)l * NE * 2048 * D), MAXROWS, NE * 2048, D};
            pg8::MoeOrder So{8, nt, F.G, F.vcu, (const LAS unsigned char*)(F.lds + TAB_OFF + 256), (const LAS int*)(F.lds + TAB_OFF), (const LAS int*)(F.lds + TAB_OFF + 896), F_list, NTOK};
            pg8::EpiSwiglu8 E{F_sact8, F_b_gu + (size_t)l * NE * 2048, (LAS float*)(F.lds + TAB_OFF + 2048)};
            _Pragma("nounroll") for (int rep = 0; rep < REPS(9); ++rep) pg8::gemm_phase_g8<pg8::EpiSwiglu8, pg8::MoeOrder, true, true>(F.lds, g, So, E);
            SEAM(pb + P_GU); }
        if (IN(pb + P_DN)) {
            const int nt = moe_tables(F, A, l);
            pg8::Gemm g{(const pg8::bf16_t*)F_sact8, (const pg8::bf16_t*)(F_Wdn8 + (size_t)l * NE * D * D), MAXROWS, NE * D, D};
            pg8::MoeOrder So{4, nt, F.G, F.vcu, (const LAS unsigned char*)(F.lds + TAB_OFF + 256), (const LAS int*)(F.lds + TAB_OFF), (const LAS int*)(F.lds + TAB_OFF + 896), F_list, NTOK};
            pg8::EpiDn E{F_yt8, F_b_dn + (size_t)l * NE * D, (const LAS int*)(F.lds + TAB_OFF), (const LAS int*)(F.lds + TAB_OFF + 896), F_list, NTOK, F_lgate, (LAS float*)(F.lds + TAB_OFF + 2048)};
            _Pragma("nounroll") for (int rep = 0; rep < REPS(10); ++rep) pg8::gemm_phase8<pg8::EpiDn, pg8::MoeOrder, true, true>(F.lds, g, So, E);
            SEAM(pb + P_DN); }
        if (IN(pb + P_COMB)) { _Pragma("nounroll") for (int rep = 0; rep < REPS(11); ++rep) phase_combine(F, A, l); SEAM(pb + P_COMB); }
    }
#undef IN
#undef SEAM
__global__ void __launch_bounds__(NWAVES * 64, 2) mk_fwd(Args A) {
    extern __shared__ __attribute__((aligned(16))) unsigned char lds[];
    Frame F;
    F.lds = (LAS unsigned char*)lds; F.MISC = (volatile LAS unsigned*)(F.lds + MISC_OFF);
    F.tid = threadIdx.x; F.lane = F.tid & 63; F.wave = __builtin_amdgcn_readfirstlane(F.tid >> 6);
    F.G = gridDim.x; { const int bx = blockIdx.x; F.vcu = (F.G % 8 == 0) ? (bx % 8) * (F.G / 8) + bx / 8 : bx; }
    F.ctl = (gu32*)(A.ws + WS_CTL);
    for (int u = F.tid; u < (LDS_BYTES - LDSCTL_OFF) / 4; u += NWAVES * 64) ((LAS unsigned*)(F.lds + LDSCTL_OFF))[u] = 0u;
    __syncthreads();
    const int lo = A.ph_lo, hi = A.ph_hi;
    XcdBarrier bar; bar.bar = (unsigned*)(F.ctl + CW_BAR) + A.li * XCD_BAR_WORDS; bar.x = 0; bar.st = nullptr;
    if (hi - lo > 1) bar = xcd_barrier_post((unsigned*)(F.ctl + CW_BAR) + A.li * XCD_BAR_WORDS, F.MISC + 8);
#define IN(k) (lo <= (k) && (k) < hi)
#define SEAM(k) do { if (IN((k) + 1)) xcd_barrier(bar); } while (0)
    if (IN(0)) { _Pragma("nounroll") for (int rep = 0; rep < REPS(0); ++rep) p0_prologue(F, A); SEAM(0); }
    layer_phases<0>(F, A, lo, hi, bar);
    layer_phases<1>(F, A, lo, hi, bar);
#undef IN
#undef SEAM
}

extern "C" void kernel_launch(void* const* d_in, const int* in_sizes, int n_in, void* d_out, int out_size, void* d_ws, size_t ws_size, hipStream_t stream) {
    static int grid = 0;
    if (grid == 0) {
        if (n_in != 17 || in_sizes[0] != NTOK * D || out_size != NTOK * D || ws_size < WS_END) { fprintf(stderr, "kernel_launch: unexpected shapes (n_in %d, in0 %d, out %d, ws %zu); nothing launched\n", n_in, n_in > 0 ? in_sizes[0] : -1, out_size, ws_size); grid = -1; return; }
        int dev = 0, cus = 0, per_cu = 0;
        if (hipGetDevice(&dev) != hipSuccess || hipDeviceGetAttribute(&cus, hipDeviceAttributeMultiprocessorCount, dev) != hipSuccess) { grid = -1; return; }
        if (hipFuncSetAttribute((const void*)mk_fwd, hipFuncAttributeMaxDynamicSharedMemorySize, LDS_BYTES) != hipSuccess) { fprintf(stderr, "kernel_launch: hipFuncSetAttribute failed\n"); grid = -1; return; }
        if (hipOccupancyMaxActiveBlocksPerMultiprocessor(&per_cu, (const void*)mk_fwd, NWAVES * 64, LDS_BYTES) != hipSuccess || per_cu < 1) { fprintf(stderr, "kernel_launch: occupancy query says %d blocks per CU\n", per_cu); }
        (void)hipGetLastError();
        grid = cus;
    }
    if (grid < 0) return;
    if (hipMemsetAsync((char*)d_ws + WS_CTL, 0, CTL_ZERO_BYTES, stream) != hipSuccess) return;
    Args a{};
    for (int i = 0; i < 17; ++i) a.in[i] = (const float*)d_in[i];
        a.out = (float*)d_out; a.ws = (unsigned char*)d_ws; a.pad = 0;
#if MK_SINGLE
    a.ph_lo = 0; a.ph_hi = NPHASE; a.li = 0;
    hipLaunchKernelGGL(mk_fwd, dim3(grid), dim3(NWAVES * 64), LDS_BYTES, stream, a);
#else
    int li = 0;
    for (int p = 0; p < NPHASE; ++p) { if (p == 11) continue;
        a.ph_lo = p; a.ph_hi = p + 1; a.li = li++;
        hipLaunchKernelGGL(mk_fwd, dim3(grid), dim3(NWAVES * 64), LDS_BYTES, stream, a); }
#endif
    const hipError_t le = hipPeekAtLastError();
    if (le != hipSuccess) fprintf(stderr, "kernel_launch: launch failed: %s\n", hipGetErrorName(le));
}
```

```cpp
#include <hip/hip_runtime.h>
#include <cstdio>
#include <cstdint>
namespace pg8 {
#define PG8_LAS __attribute__((address_space(3)))
typedef unsigned short bf16_t;
typedef short bf16x8 __attribute__((ext_vector_type(8)));
typedef float f32x4 __attribute__((ext_vector_type(4)));
typedef unsigned u32x4 __attribute__((ext_vector_type(4)));
constexpr int BM = 256, BK = 64, HALF = 128, HTB = HALF * BK * 2  , STAGE_BYTES = 8 * HTB, NXCD = 8, WGM = 8;

__host__ __device__ __forceinline__ int lds_byte(int r, int c) { const int st = (r >> 4) * 2 + (c >> 5), rr = r & 15, cc = c & 31, ob = rr * 64 + cc * 2; return st * 1024 + (ob ^ (((ob >> 9) & 1) << 5)); }
__host__ __device__ __forceinline__ void stage_rc(int b, int& R, int& C) { const int st = b / 1024, sb = b % 1024, swz = sb ^ (((sb >> 9) & 1) << 5); R = (st >> 1) * 16 + swz / 64; C = (st & 1) * 32 + (swz % 64) / 2; }
__host__ __device__ __forceinline__ int perm32(int rho) { const int n = rho >> 4, i = rho & 15; return 8 * (i >> 2) + 4 * n + (i & 3); }

struct Unit { int pm, pn; };
struct Gemm { const bf16_t* A; const bf16_t* Bt; int M, N, K; };

struct StaticOrder {
    int nM, nN, nwg, G, c;
    __host__ __device__ void init(int M, int N, int G_, int c_) { nM = M / BM; nN = N / BM; nwg = nM * nN; G = G_; c = c_; }
    __host__ __device__ bool next(int i, Unit& u) const {
        const long L = (long)i * G + c; if (L >= nwg) return false;
        int wgid = (int)L; { const int q = nwg / NXCD, r = nwg % NXCD, xcd = wgid % NXCD, off = wgid / NXCD; wgid = (xcd < r ? xcd * (q + 1) : r * (q + 1) + (xcd - r) * q) + off; }
        const int nig = WGM * nN, gid = wgid / nig, fm = gid * WGM, gsz = (nM - fm) < WGM ? (nM - fm) : WGM;
        u.pm = fm + ((wgid % nig) % gsz); u.pn = (wgid % nig) / gsz; return true;
    }
    __device__ __forceinline__ void a_ready(const Unit&) const {}
    __device__ __forceinline__ void done(const Unit&) const {}
};

__device__ __forceinline__ unsigned cvt_pk_bf16(float lo, float hi) { unsigned r; asm volatile("v_cvt_pk_bf16_f32 %0, %1, %2" : "=v"(r) : "v"(lo), "v"(hi)); return r; }
struct EpiBf16 {
    static constexpr bool PERM = true, AFTER_DRAIN = false;
    bf16_t* O; int ldc; const float* bias; int split_cols; size_t split_stride;
    __device__ __forceinline__ void operator()(const f32x4 (&acc)[2][2][4][2], const Unit& u, int wr, int wc, int fr, int fq) const {
        const int row0 = u.pm * BM + wr * 64 + fr; int colt = u.pn * BM; bf16_t* base = O;
        if (split_cols) { const int t = colt / split_cols; base += (size_t)t * split_stride; colt -= t * split_cols; }
        const int col0 = colt + wc * 32 + 8 * fq, bcol0 = u.pn * BM + wc * 32 + 8 * fq;
        f32x4 bv[2][2];
#pragma unroll
        for (int bj = 0; bj < 2; ++bj)
#pragma unroll
            for (int n = 0; n < 2; ++n) bv[bj][n] = bias ? *(const f32x4*)(bias + bcol0 + bj * HALF + 4 * n) : (f32x4){0.f, 0.f, 0.f, 0.f};
#pragma unroll
        for (int ai = 0; ai < 2; ++ai)
#pragma unroll
            for (int m = 0; m < 4; ++m) { bf16_t* rowp = base + (size_t)(row0 + ai * HALF + m * 16) * ldc + col0;
#pragma unroll
                for (int bj = 0; bj < 2; ++bj) { f32x4 v0 = acc[ai][bj][m][0] + bv[bj][0], v1 = acc[ai][bj][m][1] + bv[bj][1];
                    u32x4 w; w.x = cvt_pk_bf16(v0[0], v0[1]); w.y = cvt_pk_bf16(v0[2], v0[3]); w.z = cvt_pk_bf16(v1[0], v1[1]); w.w = cvt_pk_bf16(v1[2], v1[3]);
                    *(u32x4*)(rowp + bj * HALF) = w; } }
    }
};
struct EpiProj {
    static constexpr bool PERM = true, AFTER_DRAIN = false;
    bf16_t* O; int ldc; const float* ropec; const float* ropes; float* kmean;
    __device__ __forceinline__ void operator()(const f32x4 (&acc)[2][2][4][2], const Unit& u, int wr, int wc, int fr, int fq) const {
        const int row0 = u.pm * BM + wr * 64 + fr; const int colt = u.pn * BM;
        const int col0 = colt + wc * 32 + 8 * fq;
        constexpr unsigned ROPEM = 0xFFu | (0x3Fu << 12) | (1u << 18) | (1u << 20) | (1u << 22);
        float ks[2][8];
#pragma unroll
        for (int bj = 0; bj < 2; ++bj)
#pragma unroll
            for (int q = 0; q < 8; ++q) ks[bj][q] = 0.f;
#pragma unroll
        for (int ai = 0; ai < 2; ++ai)
#pragma unroll
            for (int m = 0; m < 4; ++m) { const int row = row0 + ai * HALF + m * 16; bf16_t* rowp = O + (size_t)row * ldc + col0;
#pragma unroll
                for (int bj = 0; bj < 2; ++bj) { f32x4 v0 = acc[ai][bj][m][0], v1 = acc[ai][bj][m][1];
                    const int head = (colt + bj * HALF + wc * 32) >> 6;
                    if (((wc & 1) == 0) && head < 32 && ((ROPEM >> head) & 1u)) {
                        float x[8] = {v0[0], v0[1], v0[2], v0[3], v1[0], v1[1], v1[2], v1[3]}, y[8];
#pragma unroll
                        for (int q = 0; q < 8; ++q) y[q] = __shfl_xor(x[q], 16);
                        if (fq < 2) { const int t = row & 4095; const f32x4 c0 = *(const f32x4*)(ropec + t * 8), c1 = *(const f32x4*)(ropec + t * 8 + 4), s0 = *(const f32x4*)(ropes + t * 8), s1 = *(const f32x4*)(ropes + t * 8 + 4);
                            const float cs[8] = {c0[0], c0[1], c0[2], c0[3], c1[0], c1[1], c1[2], c1[3]}, sn[8] = {s0[0], s0[1], s0[2], s0[3], s1[0], s1[1], s1[2], s1[3]};
#pragma unroll
                            for (int q = 0; q < 8; ++q) x[q] = (fq == 0) ? x[q] * cs[q] - y[q] * sn[q] : x[q] * cs[q] + y[q] * sn[q];
                            v0 = (f32x4){x[0], x[1], x[2], x[3]}; v1 = (f32x4){x[4], x[5], x[6], x[7]}; } }
                    if (u.pn == 1) {
#pragma unroll
                        for (int q = 0; q < 4; ++q) { ks[bj][q] += v0[q]; ks[bj][4 + q] += v1[q]; } }
                    u32x4 w; w.x = cvt_pk_bf16(v0[0], v0[1]); w.y = cvt_pk_bf16(v0[2], v0[3]); w.z = cvt_pk_bf16(v1[0], v1[1]); w.w = cvt_pk_bf16(v1[2], v1[3]);
                    *(u32x4*)(rowp + bj * HALF) = w; } }
        if (u.pn == 1) {
#pragma unroll
            for (int bj = 0; bj < 2; ++bj)
#pragma unroll
                for (int q = 0; q < 8; ++q) { float s = ks[bj][q]; s += __shfl_xor(s, 1); s += __shfl_xor(s, 2); s += __shfl_xor(s, 4); s += __shfl_xor(s, 8); ks[bj][q] = s; }
            if (fr == 0) { const int b = u.pm >> 4, blk = u.pm & 15;
#pragma unroll
                for (int bj = 0; bj < 2; ++bj) { const int c = bj * HALF + wc * 32 + 8 * fq, h = c >> 6, d = c & 63;
#pragma unroll
                    for (int q = 0; q < 8; ++q) atomicAdd(kmean + ((size_t)(b * 4 + h) * 16 + blk) * 64 + d + q, ks[bj][q] * (1.f / 256.f)); } }
        }
    }
};
struct EpiSwiglu {
    static constexpr bool PERM = true, AFTER_DRAIN = false;
    bf16_t* O; const float* bias;
    __device__ __forceinline__ void operator()(const f32x4 (&acc)[2][2][4][2], const Unit& u, int wr, int wc, int fr, int fq) const {
        const int row0 = u.pm * BM + wr * 64 + fr; const int e = u.pn >> 3, j = u.pn & 7;
        const int cc = wc * 32 + 8 * fq;
        const float* bg = bias + (size_t)e * 2048 + j * 128 + cc; const float* bl = bg + 1024;
        f32x4 bgv[2], blv[2];
#pragma unroll
        for (int n = 0; n < 2; ++n) { bgv[n] = *(const f32x4*)(bg + 4 * n); blv[n] = *(const f32x4*)(bl + 4 * n); }
#pragma unroll
        for (int ai = 0; ai < 2; ++ai)
#pragma unroll
            for (int m = 0; m < 4; ++m) { bf16_t* rowp = O + (size_t)(row0 + ai * HALF + m * 16) * 1024 + j * 128 + cc;
                float r[8];
#pragma unroll
                for (int n = 0; n < 2; ++n) { const f32x4 g4 = acc[ai][0][m][n] + bgv[n], l4 = acc[ai][1][m][n] + blv[n];
#pragma unroll
                    for (int q = 0; q < 4; ++q) { float g = fminf(g4[q], 7.0f); float l = fminf(fmaxf(l4[q], -7.0f), 7.0f);
                        const float sg = 1.0f / (1.0f + __expf(-1.702f * g)); r[4 * n + q] = g * sg * (l + 1.0f); } }
                u32x4 w; w.x = cvt_pk_bf16(r[0], r[1]); w.y = cvt_pk_bf16(r[2], r[3]); w.z = cvt_pk_bf16(r[4], r[5]); w.w = cvt_pk_bf16(r[6], r[7]);
                *(u32x4*)rowp = w; }
    }
};
__device__ __forceinline__ unsigned pk4_fp8(float a, float b, float c, float d) { const int r = __builtin_amdgcn_cvt_pk_fp8_f32(a, b, 0, false); return (unsigned)__builtin_amdgcn_cvt_pk_fp8_f32(c, d, r, true); }
constexpr float W8_SCALE = 64.f, W8_INV = 1.f / 64.f, ACT8_SCALE = 4.f, DN8_INV = 1.f / 256.f, YT8_SCALE = 16.f;
struct EpiSwiglu8 {
    static constexpr bool PERM = true, AFTER_DRAIN = false;
    unsigned char* O; const float* bias; PG8_LAS float* tab;
    __device__ __forceinline__ void prefetch(const Unit& u, int par, int wid, int lane) const {
        if (wid < 4) { const int e = u.pn >> 3, j = u.pn & 7, idx = wid * 64 + lane;
            __builtin_amdgcn_global_load_lds((const unsigned*)(bias + (size_t)e * 2048 + (idx >> 7) * 1024 + j * 128 + (idx & 127)), (PG8_LAS unsigned*)(tab + par * 256 + wid * 64), 4, 0, 0); }
    }
    __device__ __forceinline__ void operator()(const f32x4 (&acc)[2][2][4][2], const Unit& u, int wr, int wc, int fr, int fq, int par) const {
        const int row0 = u.pm * BM + wr * 64 + fr; const int j = u.pn & 7;
        const int cc = wc * 32 + 8 * fq;
        const PG8_LAS float* bg = tab + par * 256 + cc; const PG8_LAS float* bl = bg + 128;
        typedef _Float16 h2_ __attribute__((ext_vector_type(2))); typedef short s2_ __attribute__((ext_vector_type(2)));
#define PG8_PKH(a, b) __builtin_bit_cast(h2_, __builtin_amdgcn_cvt_pkrtz((a), (b)))
        h2_ bg2[2][2], bl2[2][2];
#pragma unroll
        for (int n = 0; n < 2; ++n) { const f32x4 a = *(const PG8_LAS f32x4*)(bg + 4 * n), b = *(const PG8_LAS f32x4*)(bl + 4 * n);
            bg2[n][0] = PG8_PKH(a.x, a.y); bg2[n][1] = PG8_PKH(a.z, a.w); bl2[n][0] = PG8_PKH(b.x, b.y); bl2[n][1] = PG8_PKH(b.z, b.w); }
        const h2_ hinv = {(_Float16)W8_INV, (_Float16)W8_INV}, h7 = {(_Float16)7.0f, (_Float16)7.0f}, hm7 = {(_Float16)-7.0f, (_Float16)-7.0f}, hk = {(_Float16)-2.4554669595930156f, (_Float16)-2.4554669595930156f},
                  h1 = {(_Float16)1.0f, (_Float16)1.0f}, h4 = {(_Float16)ACT8_SCALE, (_Float16)ACT8_SCALE};
#pragma unroll
        for (int ai = 0; ai < 2; ++ai)
#pragma unroll
            for (int m = 0; m < 4; ++m) { unsigned char* rowp = O + (size_t)(row0 + ai * HALF + m * 16) * 1024 + j * 128 + cc;
                s2_ wv[2];
#pragma unroll
                for (int n = 0; n < 2; ++n) { wv[n] = (s2_){0, 0};
#pragma unroll
                    for (int hq = 0; hq < 2; ++hq) {
                        const h2_ G = PG8_PKH(acc[ai][0][m][n][2 * hq], acc[ai][0][m][n][2 * hq + 1]) * hinv + bg2[n][hq];
                        const h2_ L = PG8_PKH(acc[ai][1][m][n][2 * hq], acc[ai][1][m][n][2 * hq + 1]) * hinv + bl2[n][hq];
                        const h2_ g = __builtin_elementwise_min(G, h7), l = __builtin_elementwise_max(__builtin_elementwise_min(L, h7), hm7);
                        const h2_ t = g * hk; h2_ e; e.x = __builtin_exp2f16(t.x); e.y = __builtin_exp2f16(t.y);
                        const h2_ d = e + h1; h2_ rr; rr.x = __builtin_amdgcn_rcph(d.x); rr.y = __builtin_amdgcn_rcph(d.y);
                        const h2_ o = (g * rr) * (l * h4 + h4);
                        wv[n] = hq == 0 ? __builtin_amdgcn_cvt_scalef32_pk_fp8_f16(wv[n], o, 1.0f, false) : __builtin_amdgcn_cvt_scalef32_pk_fp8_f16(wv[n], o, 1.0f, true); } }
                typedef unsigned u32x2_ __attribute__((ext_vector_type(2)));
                u32x2_ w; w.x = __builtin_bit_cast(unsigned, wv[0]); w.y = __builtin_bit_cast(unsigned, wv[1]);
                *(u32x2_*)rowp = w; }
#undef PG8_PKH
    }
};
struct EpiDn {
    static constexpr bool PERM = true, AFTER_DRAIN = false;
    unsigned char* O; const float* bias; const PG8_LAS int* rowbase; const PG8_LAS int* ecnt; const int* list; int cap; const float* lgate; PG8_LAS float* tab;
    __device__ __forceinline__ void prefetch(const Unit& u, int par, int wid, int lane) const {
        const int e = u.pn >> 2, j = u.pn & 3; const int pb = u.pm * BM - rowbase[e]; PG8_LAS float* t = tab + par * 768;
        if (wid < 4) { const int r = wid * 64 + lane;
            __builtin_amdgcn_global_load_lds((const unsigned*)(list + (size_t)e * cap + pb + r), (PG8_LAS unsigned*)(t + wid * 64), 4, 0, 0);
            __builtin_amdgcn_global_load_lds((const unsigned*)(bias + (size_t)e * 1024 + j * BM + r), (PG8_LAS unsigned*)(t + 512 + wid * 64), 4, 0, 0); }
        else { const int r = (wid - 4) * 64 + lane;
            __builtin_amdgcn_global_load_lds((const unsigned*)(lgate + (size_t)e * cap + pb + r), (PG8_LAS unsigned*)(t + 256 + (wid - 4) * 64), 4, 0, 0); }
    }
    __device__ __forceinline__ void operator()(const f32x4 (&acc)[2][2][4][2], const Unit& u, int wr, int wc, int fr, int fq, int par) const {
        const int e = u.pn >> 2, j = u.pn & 3; const int pl0 = wr * 64 + fr; const int p0 = u.pm * BM - rowbase[e] + pl0, cnt = ecnt[e];
        const int col0 = j * BM + wc * 64 + 16 * fq; const PG8_LAS float* t = tab + par * 768; const PG8_LAS float* bp = t + 512 + wc * 64 + 16 * fq;
        f32x4 bv[2][2];
#pragma unroll
        for (int bj = 0; bj < 2; ++bj)
#pragma unroll
            for (int n = 0; n < 2; ++n) bv[bj][n] = *(const PG8_LAS f32x4*)(bp + 8 * bj + 4 * n);
        int id[2][4]; float gt[2][4];
#pragma unroll
        for (int ai = 0; ai < 2; ++ai)
#pragma unroll
            for (int m = 0; m < 4; ++m) { const int q = ai * HALF + m * 16; id[ai][m] = (p0 + q < cnt) ? ((const PG8_LAS int*)t)[pl0 + q] : -1; gt[ai][m] = t[256 + pl0 + q]; }
#pragma unroll
        for (int ai = 0; ai < 2; ++ai)
#pragma unroll
            for (int m = 0; m < 4; ++m) { if (id[ai][m] < 0) continue; unsigned char* rowp = O + (size_t)id[ai][m] * 1024 + col0; const float g = gt[ai][m] * YT8_SCALE;
                unsigned wq[4];
#pragma unroll
                for (int bj = 0; bj < 2; ++bj) { const f32x4 v0 = (acc[ai][bj][m][0] * DN8_INV + bv[bj][0]) * g, v1 = (acc[ai][bj][m][1] * DN8_INV + bv[bj][1]) * g;
                    wq[2 * bj] = pk4_fp8(v0[0], v0[1], v0[2], v0[3]); wq[2 * bj + 1] = pk4_fp8(v1[0], v1[1], v1[2], v1[3]); }
                *(u32x4*)rowp = (u32x4){wq[0], wq[1], wq[2], wq[3]}; }
    }
};
struct MoeOrder {
    int NJ, ntiles, G, vcu; const PG8_LAS unsigned char* texp; const PG8_LAS int* rowbase; const PG8_LAS int* ecnt; const int* list; int cap;
    __device__ __forceinline__ int rowtok(const Unit& u, int r) const { const int e = u.pn / NJ; const int p = u.pm * 256 - rowbase[e] + r; return p < ecnt[e] ? (list[(size_t)e * cap + p] >> 2) : 0; }
    __device__ __forceinline__ bool next(int i, Unit& u) const {
        const int L = i * G + vcu; const int pm = L / NJ; if (pm >= ntiles) return false;
        const int j = L - pm * NJ; const int e = texp[pm]; u.pm = pm; u.pn = e * NJ + j; return true; }
    __device__ __forceinline__ void a_ready(const Unit&) const {}
    __device__ __forceinline__ void done(const Unit&) const {}
};
template <class Epi, class Sched, bool ALIGN_EPI = false, bool SP2 = false>
__device__ __forceinline__ void gemm_phase(PG8_LAS unsigned char* lds, const Gemm g, const Sched& S, const Epi& E) {
    int tid_ = threadIdx.x; asm volatile("" : "+v"(tid_));
    const int tid = tid_, wid = __builtin_amdgcn_readfirstlane(tid >> 6), lane = tid & 63, wr = wid >> 2, wc = wid & 3, fr = lane & 15, fq = lane >> 4;
    const int K = g.K, nt = K / BK;
    unsigned voffA[2], voffB[2];
#pragma unroll
    for (int i = 0; i < 2; ++i) { int R, C; stage_rc(tid * 16 + i * 8192, R, C); const int Rb = Epi::PERM ? ((R & ~31) + perm32(R & 31)) : R;
        voffA[i] = (unsigned)(R * K + C) * 2u; voffB[i] = (unsigned)(Rb * K + C) * 2u; }
    const size_t kstep = (size_t)(BK * 2);
    const size_t hstep = (size_t)HALF * K * 2;
    const size_t tstep = 2 * hstep;
    const unsigned ldsw = (unsigned)wid * 1024u;
    const int aoff = lds_byte(wr * 64 + fr, fq * 8), boff = lds_byte(wc * 32 + fr, fq * 8);
#define PG8_SA(b, h) (((b) * 2 + (h)) * HTB)
#define PG8_SB(b, h) ((4 + (b) * 2 + (h)) * HTB)
#define PG8_STAGE(bufoff, gbase, voff) do { _Pragma("unroll") for (int _i = 0; _i < 2; ++_i) \
        __builtin_amdgcn_global_load_lds((const unsigned*)((const char*)(gbase) + (voff)[_i]), (PG8_LAS unsigned*)(lds + (bufoff) + ldsw + _i * 8192), 16, 0, 0); } while (0)
#define PG8_LDA(dst, b, h) do { _Pragma("unroll") for (int m = 0; m < 4; ++m) _Pragma("unroll") for (int k = 0; k < 2; ++k) dst[m][k] = *(const PG8_LAS bf16x8*)(lds + PG8_SA(b, h) + aoff + m * 2048 + k * 1024); } while (0)
#define PG8_LDB(dst, b, h) do { _Pragma("unroll") for (int n = 0; n < 2; ++n) _Pragma("unroll") for (int k = 0; k < 2; ++k) dst[n][k] = *(const PG8_LAS bf16x8*)(lds + PG8_SB(b, h) + boff + n * 2048 + k * 1024); } while (0)
#define PG8_MMA(ai, bj, At, Bt) do { __builtin_amdgcn_s_setprio(1); _Pragma("unroll") for (int m = 0; m < 4; ++m) _Pragma("unroll") for (int n = 0; n < 2; ++n) _Pragma("unroll") for (int k = 0; k < 2; ++k) \
        acc[ai][bj][m][n] = __builtin_amdgcn_mfma_f32_16x16x32_bf16(Bt[n][k], At[m][k], acc[ai][bj][m][n], 0, 0, 0); __builtin_amdgcn_s_setprio(0); } while (0)
#define PG8_WAIT_V(n) asm volatile("s_waitcnt vmcnt(" #n ")" ::: "memory")
#define PG8_WAIT_L(n) asm volatile("s_waitcnt lgkmcnt(" #n ")" ::: "memory")
#define PG8_BAR __builtin_amdgcn_s_barrier()
#define PG8_SCHED __builtin_amdgcn_sched_barrier(0)
    Unit cur, nxt; int ui = 0;
    if (!S.next(0, cur)) return;
    f32x4 acc[2][2][4][2];
#pragma unroll
    for (int a = 0; a < 2; ++a)
#pragma unroll
        for (int b = 0; b < 2; ++b)
#pragma unroll
            for (int m = 0; m < 4; ++m)
#pragma unroll
                for (int n = 0; n < 2; ++n) acc[a][b][m][n] = (f32x4){0.f, 0.f, 0.f, 0.f};
    bf16x8 At[4][2], B0[2][2], B1[2][2];
    const char* cA = (const char*)g.A + (size_t)cur.pm * tstep; const char* cB = (const char*)g.Bt + (size_t)cur.pn * tstep;
    S.a_ready(cur);
    if constexpr (SP2) {
        PG8_STAGE(PG8_SB(0, 0), cB, voffB); PG8_STAGE(PG8_SB(0, 1), cB + hstep, voffB); PG8_STAGE(PG8_SA(0, 0), cA, voffA); PG8_STAGE(PG8_SA(0, 1), cA + hstep, voffA);
        if (wr == 1) PG8_BAR;
        PG8_WAIT_V(2); PG8_BAR;
        PG8_STAGE(PG8_SB(1, 0), cB + kstep, voffB); PG8_STAGE(PG8_SA(1, 0), cA + kstep, voffA); PG8_STAGE(PG8_SB(1, 1), cB + hstep + kstep, voffB);
        PG8_WAIT_V(6); PG8_BAR;
    } else {
        PG8_STAGE(PG8_SB(0, 0), cB, voffB); PG8_STAGE(PG8_SA(0, 0), cA, voffA); PG8_STAGE(PG8_SB(0, 1), cB + hstep, voffB); PG8_STAGE(PG8_SA(0, 1), cA + hstep, voffA);
        if (wr == 1) PG8_BAR;
        PG8_WAIT_V(4); PG8_BAR;
        PG8_STAGE(PG8_SB(1, 0), cB + kstep, voffB); PG8_STAGE(PG8_SA(1, 0), cA + kstep, voffA); PG8_STAGE(PG8_SB(1, 1), cB + hstep + kstep, voffB);
        PG8_WAIT_V(6); PG8_BAR;
    }
    for (;;) {
        const bool has_next = S.next(ui + 1, nxt);
        const char* nA = has_next ? (const char*)g.A + (size_t)nxt.pm * tstep : cA; const char* nB = has_next ? (const char*)g.Bt + (size_t)nxt.pn * tstep : cB;
        for (int t = 0; t < nt; t += 2) {
            const bool last = (t == nt - 2);
            const char* a1 = cA + (size_t)(t + 1) * kstep;
            const char* a2 = last ? nA : cA + (size_t)(t + 2) * kstep; const char* b2 = last ? nB : cB + (size_t)(t + 2) * kstep;
            const char* a3 = a2 + kstep; const char* b3 = b2 + kstep;
            if (last && has_next) S.a_ready(nxt);
            if constexpr (SP2) {
            PG8_LDB(B0, 0, 0); PG8_LDB(B1, 0, 1); PG8_SCHED; PG8_LDA(At, 0, 0); PG8_STAGE(PG8_SA(1, 1), a1 + hstep, voffA);
            PG8_WAIT_V(8); PG8_WAIT_L(0); PG8_BAR; PG8_MMA(0, 0, At, B0); PG8_MMA(0, 1, At, B1); PG8_BAR; PG8_SCHED;
            PG8_LDA(At, 0, 1); PG8_STAGE(PG8_SB(0, 0), b2, voffB); PG8_STAGE(PG8_SB(0, 1), b2 + hstep, voffB); PG8_STAGE(PG8_SA(0, 0), a2, voffA);
            PG8_WAIT_V(8); PG8_WAIT_L(0); PG8_BAR; PG8_MMA(1, 0, At, B0); PG8_MMA(1, 1, At, B1); PG8_BAR; PG8_SCHED;
            PG8_LDB(B0, 1, 0); PG8_LDB(B1, 1, 1); PG8_SCHED; PG8_LDA(At, 1, 0); PG8_STAGE(PG8_SA(0, 1), a2 + hstep, voffA);
            PG8_WAIT_V(8); PG8_WAIT_L(0); PG8_BAR; PG8_MMA(0, 0, At, B0); PG8_MMA(0, 1, At, B1); PG8_BAR; PG8_SCHED;
            PG8_LDA(At, 1, 1); PG8_STAGE(PG8_SB(1, 0), b3, voffB); PG8_STAGE(PG8_SB(1, 1), b3 + hstep, voffB); PG8_STAGE(PG8_SA(1, 0), a3, voffA);
            PG8_WAIT_V(8); PG8_WAIT_L(0); PG8_BAR; PG8_MMA(1, 0, At, B0); PG8_MMA(1, 1, At, B1); PG8_BAR; PG8_SCHED;
            } else {
            PG8_LDB(B0, 0, 0); PG8_SCHED; PG8_LDA(At, 0, 0); PG8_STAGE(PG8_SA(1, 1), a1 + hstep, voffA);
            PG8_WAIT_L(8); PG8_BAR; PG8_WAIT_L(0); PG8_MMA(0, 0, At, B0); PG8_BAR; PG8_SCHED;
            PG8_LDB(B1, 0, 1); PG8_STAGE(PG8_SB(0, 0), b2, voffB);
            PG8_BAR; PG8_WAIT_L(0); PG8_MMA(0, 1, At, B1); PG8_BAR;
            PG8_LDA(At, 0, 1); PG8_STAGE(PG8_SA(0, 0), a2, voffA);
            PG8_BAR; PG8_WAIT_L(0); PG8_MMA(1, 0, At, B0); PG8_BAR; PG8_SCHED;
            PG8_STAGE(PG8_SB(0, 1), b2 + hstep, voffB);
            PG8_WAIT_V(6); PG8_BAR; PG8_MMA(1, 1, At, B1); PG8_BAR;
            PG8_LDB(B0, 1, 0); PG8_SCHED; PG8_LDA(At, 1, 0); PG8_STAGE(PG8_SA(0, 1), a2 + hstep, voffA);
            PG8_WAIT_L(8); PG8_BAR; PG8_WAIT_L(0); PG8_MMA(0, 0, At, B0); PG8_BAR; PG8_SCHED;
            PG8_LDB(B1, 1, 1); PG8_STAGE(PG8_SB(1, 0), b3, voffB);
            PG8_BAR; PG8_WAIT_L(0); PG8_MMA(0, 1, At, B1); PG8_BAR;
            PG8_LDA(At, 1, 1); PG8_STAGE(PG8_SA(1, 0), a3, voffA);
            PG8_BAR; PG8_WAIT_L(0); PG8_MMA(1, 0, At, B0); PG8_BAR; PG8_SCHED;
            PG8_STAGE(PG8_SB(1, 1), b3 + hstep, voffB);
            PG8_WAIT_V(6); PG8_BAR; PG8_MMA(1, 1, At, B1); PG8_BAR;
            }
        }
        if constexpr (ALIGN_EPI) { if (wr == 0) PG8_BAR; }
        if constexpr (!Epi::AFTER_DRAIN) { E(acc, cur, wr, wc, fr, fq); S.done(cur); }
        if (!has_next) break;
#pragma unroll
        for (int a = 0; a < 2; ++a)
#pragma unroll
            for (int b = 0; b < 2; ++b)
#pragma unroll
                for (int m = 0; m < 4; ++m)
#pragma unroll
                    for (int n = 0; n < 2; ++n) acc[a][b][m][n] = (f32x4){0.f, 0.f, 0.f, 0.f};
        cur = nxt; cA = nA; cB = nB; ++ui;
        if constexpr (ALIGN_EPI) { if (wr == 1) PG8_BAR; }
    }
    PG8_WAIT_V(0);
    if constexpr (!ALIGN_EPI) { if (wr == 0) PG8_BAR; }
    PG8_BAR;
    if constexpr (Epi::AFTER_DRAIN) { E.fused(acc, cur, wr, wc, fr, fq, lds, wid, lane); S.done(cur); }
#undef PG8_SA
#undef PG8_SB
#undef PG8_STAGE
#undef PG8_LDA
#undef PG8_LDB
#undef PG8_MMA
#ifdef PG8_MMAI
#undef PG8_MMAI
#endif
#undef PG8_WAIT_V
#undef PG8_WAIT_L
#undef PG8_BAR
#undef PG8_SCHED
}
template <class Epi, class Sched, bool ALIGN_EPI = false, bool SP2 = false>
__device__ __forceinline__ void gemm_phase_gn(PG8_LAS unsigned char* lds, const Gemm g, const Sched& S, const Epi& E, const PG8_LAS float* rt) {
    int tid_ = threadIdx.x; asm volatile("" : "+v"(tid_));
    const int tid = tid_, wid = __builtin_amdgcn_readfirstlane(tid >> 6), lane = tid & 63, wr = wid >> 2, wc = wid & 3, fr = lane & 15, fq = lane >> 4;
    const int K = g.K, nt = K / BK;
    unsigned voffA[2], voffB[2];
#pragma unroll
    for (int i = 0; i < 2; ++i) { int R, C; stage_rc(tid * 16 + i * 8192, R, C); const int Rb = Epi::PERM ? ((R & ~31) + perm32(R & 31)) : R;
        voffA[i] = (unsigned)(R * K + C) * 2u; voffB[i] = (unsigned)(Rb * K + C) * 2u; }
    const size_t kstep = (size_t)(BK * 2);
    const size_t hstep = (size_t)HALF * K * 2;
    const size_t tstep = 2 * hstep;
    const unsigned ldsw = (unsigned)wid * 1024u;
    const int aoff = lds_byte(wr * 64 + fr, fq * 8), boff = lds_byte(wc * 32 + fr, fq * 8);
#define PG8_SA(b, h) (((b) * 2 + (h)) * HTB)
#define PG8_SB(b, h) ((4 + (b) * 2 + (h)) * HTB)
#define PG8_STAGE(bufoff, gbase, voff) do { _Pragma("unroll") for (int _i = 0; _i < 2; ++_i) \
        __builtin_amdgcn_global_load_lds((const unsigned*)((const char*)(gbase) + (voff)[_i]), (PG8_LAS unsigned*)(lds + (bufoff) + ldsw + _i * 8192), 16, 0, 0); } while (0)
#define PG8_LDA(dst, b, h) do { _Pragma("unroll") for (int m = 0; m < 4; ++m) _Pragma("unroll") for (int k = 0; k < 2; ++k) dst[m][k] = *(const PG8_LAS bf16x8*)(lds + PG8_SA(b, h) + aoff + m * 2048 + k * 1024); } while (0)
#define PG8_LDB(dst, b, h) do { _Pragma("unroll") for (int n = 0; n < 2; ++n) _Pragma("unroll") for (int k = 0; k < 2; ++k) dst[n][k] = *(const PG8_LAS bf16x8*)(lds + PG8_SB(b, h) + boff + n * 2048 + k * 1024); } while (0)
#define PG8_MMA(ai, bj, At, Bt) do { __builtin_amdgcn_s_setprio(1); _Pragma("unroll") for (int m = 0; m < 4; ++m) _Pragma("unroll") for (int n = 0; n < 2; ++n) _Pragma("unroll") for (int k = 0; k < 2; ++k) \
        acc[ai][bj][m][n] = __builtin_amdgcn_mfma_f32_16x16x32_bf16(Bt[n][k], At[m][k], acc[ai][bj][m][n], 0, 0, 0); __builtin_amdgcn_s_setprio(0); } while (0)
#define PG8_WAIT_V(n) asm volatile("s_waitcnt vmcnt(" #n ")" ::: "memory")
#define PG8_WAIT_L(n) asm volatile("s_waitcnt lgkmcnt(" #n ")" ::: "memory")
#define PG8_BAR __builtin_amdgcn_s_barrier()
#define PG8_SCHED __builtin_amdgcn_sched_barrier(0)
    Unit cur, nxt; int ui = 0;
    if (!S.next(0, cur)) return;
    f32x4 acc[2][2][4][2];
#pragma unroll
    for (int a = 0; a < 2; ++a)
#pragma unroll
        for (int b = 0; b < 2; ++b)
#pragma unroll
            for (int m = 0; m < 4; ++m)
#pragma unroll
                for (int n = 0; n < 2; ++n) acc[a][b][m][n] = (f32x4){0.f, 0.f, 0.f, 0.f};
    bf16x8 At[4][2], B0[2][2], B1[2][2];
    const char* cA = (const char*)g.A + (size_t)cur.pm * tstep; const char* cB = (const char*)g.Bt + (size_t)cur.pn * tstep;
    S.a_ready(cur);
    if constexpr (SP2) {
        PG8_STAGE(PG8_SB(0, 0), cB, voffB); PG8_STAGE(PG8_SB(0, 1), cB + hstep, voffB); PG8_STAGE(PG8_SA(0, 0), cA, voffA); PG8_STAGE(PG8_SA(0, 1), cA + hstep, voffA);
        if (wr == 1) PG8_BAR;
        PG8_WAIT_V(2); PG8_BAR;
        PG8_STAGE(PG8_SB(1, 0), cB + kstep, voffB); PG8_STAGE(PG8_SA(1, 0), cA + kstep, voffA); PG8_STAGE(PG8_SB(1, 1), cB + hstep + kstep, voffB);
        PG8_WAIT_V(6); PG8_BAR;
    } else {
        PG8_STAGE(PG8_SB(0, 0), cB, voffB); PG8_STAGE(PG8_SA(0, 0), cA, voffA); PG8_STAGE(PG8_SB(0, 1), cB + hstep, voffB); PG8_STAGE(PG8_SA(0, 1), cA + hstep, voffA);
        if (wr == 1) PG8_BAR;
        PG8_WAIT_V(4); PG8_BAR;
        PG8_STAGE(PG8_SB(1, 0), cB + kstep, voffB); PG8_STAGE(PG8_SA(1, 0), cA + kstep, voffA); PG8_STAGE(PG8_SB(1, 1), cB + hstep + kstep, voffB);
        PG8_WAIT_V(6); PG8_BAR;
    }
    for (;;) {
        const bool has_next = S.next(ui + 1, nxt);
        const char* nA = has_next ? (const char*)g.A + (size_t)nxt.pm * tstep : cA; const char* nB = has_next ? (const char*)g.Bt + (size_t)nxt.pn * tstep : cB;
        for (int t = 0; t < nt; t += 2) {
            if (t == 4 || t == 10) { const int w_ = (t == 4) ? 0 : 1;
#pragma unroll
                for (int a = 0; a < 2; ++a)
#pragma unroll
                    for (int m = 0; m < 4; ++m) { const float f_ = rt[((ui & 1) * 256 + a * HALF + wr * 64 + m * 16 + fr) * 4 + w_];
#pragma unroll
                        for (int b = 0; b < 2; ++b)
#pragma unroll
                            for (int n = 0; n < 2; ++n) acc[a][b][m][n] = acc[a][b][m][n] * f_; } }
            const bool last = (t == nt - 2);
            const char* a1 = cA + (size_t)(t + 1) * kstep;
            const char* a2 = last ? nA : cA + (size_t)(t + 2) * kstep; const char* b2 = last ? nB : cB + (size_t)(t + 2) * kstep;
            const char* a3 = a2 + kstep; const char* b3 = b2 + kstep;
            if (last && has_next) S.a_ready(nxt);
            if constexpr (SP2) {
            PG8_LDB(B0, 0, 0); PG8_LDB(B1, 0, 1); PG8_SCHED; PG8_LDA(At, 0, 0); PG8_STAGE(PG8_SA(1, 1), a1 + hstep, voffA);
            PG8_WAIT_V(8); PG8_WAIT_L(0); PG8_BAR; PG8_MMA(0, 0, At, B0); PG8_MMA(0, 1, At, B1); PG8_BAR; PG8_SCHED;
            PG8_LDA(At, 0, 1); PG8_STAGE(PG8_SB(0, 0), b2, voffB); PG8_STAGE(PG8_SB(0, 1), b2 + hstep, voffB); PG8_STAGE(PG8_SA(0, 0), a2, voffA);
            PG8_WAIT_V(8); PG8_WAIT_L(0); PG8_BAR; PG8_MMA(1, 0, At, B0); PG8_MMA(1, 1, At, B1); PG8_BAR; PG8_SCHED;
            PG8_LDB(B0, 1, 0); PG8_LDB(B1, 1, 1); PG8_SCHED; PG8_LDA(At, 1, 0); PG8_STAGE(PG8_SA(0, 1), a2 + hstep, voffA);
            PG8_WAIT_V(8); PG8_WAIT_L(0); PG8_BAR; PG8_MMA(0, 0, At, B0); PG8_MMA(0, 1, At, B1); PG8_BAR; PG8_SCHED;
            PG8_LDA(At, 1, 1); PG8_STAGE(PG8_SB(1, 0), b3, voffB); PG8_STAGE(PG8_SB(1, 1), b3 + hstep, voffB); PG8_STAGE(PG8_SA(1, 0), a3, voffA);
            PG8_WAIT_V(8); PG8_WAIT_L(0); PG8_BAR; PG8_MMA(1, 0, At, B0); PG8_MMA(1, 1, At, B1); PG8_BAR; PG8_SCHED;
            } else {
            PG8_LDB(B0, 0, 0); PG8_SCHED; PG8_LDA(At, 0, 0); PG8_STAGE(PG8_SA(1, 1), a1 + hstep, voffA);
            PG8_WAIT_L(8); PG8_BAR; PG8_WAIT_L(0); PG8_MMA(0, 0, At, B0); PG8_BAR; PG8_SCHED;
            PG8_LDB(B1, 0, 1); PG8_STAGE(PG8_SB(0, 0), b2, voffB);
            PG8_BAR; PG8_WAIT_L(0); PG8_MMA(0, 1, At, B1); PG8_BAR;
            PG8_LDA(At, 0, 1); PG8_STAGE(PG8_SA(0, 0), a2, voffA);
            PG8_BAR; PG8_WAIT_L(0); PG8_MMA(1, 0, At, B0); PG8_BAR; PG8_SCHED;
            PG8_STAGE(PG8_SB(0, 1), b2 + hstep, voffB);
            PG8_WAIT_V(6); PG8_BAR; PG8_MMA(1, 1, At, B1); PG8_BAR;
            PG8_LDB(B0, 1, 0); PG8_SCHED; PG8_LDA(At, 1, 0); PG8_STAGE(PG8_SA(0, 1), a2 + hstep, voffA);
            PG8_WAIT_L(8); PG8_BAR; PG8_WAIT_L(0); PG8_MMA(0, 0, At, B0); PG8_BAR; PG8_SCHED;
            PG8_LDB(B1, 1, 1); PG8_STAGE(PG8_SB(1, 0), b3, voffB);
            PG8_BAR; PG8_WAIT_L(0); PG8_MMA(0, 1, At, B1); PG8_BAR;
            PG8_LDA(At, 1, 1); PG8_STAGE(PG8_SA(1, 0), a3, voffA);
            PG8_BAR; PG8_WAIT_L(0); PG8_MMA(1, 0, At, B0); PG8_BAR; PG8_SCHED;
            PG8_STAGE(PG8_SB(1, 1), b3 + hstep, voffB);
            PG8_WAIT_V(6); PG8_BAR; PG8_MMA(1, 1, At, B1); PG8_BAR;
            }
        }
        if constexpr (ALIGN_EPI) { if (wr == 0) PG8_BAR; }
        {
#pragma unroll
            for (int a = 0; a < 2; ++a)
#pragma unroll
                for (int m = 0; m < 4; ++m) { const float f_ = rt[((ui & 1) * 256 + a * HALF + wr * 64 + m * 16 + fr) * 4 + 2];
#pragma unroll
                    for (int b = 0; b < 2; ++b)
#pragma unroll
                        for (int n = 0; n < 2; ++n) acc[a][b][m][n] = acc[a][b][m][n] * f_; } }
        if constexpr (!Epi::AFTER_DRAIN) { E(acc, cur, wr, wc, fr, fq); S.done(cur); }
        if (!has_next) break;
#pragma unroll
        for (int a = 0; a < 2; ++a)
#pragma unroll
            for (int b = 0; b < 2; ++b)
#pragma unroll
                for (int m = 0; m < 4; ++m)
#pragma unroll
                    for (int n = 0; n < 2; ++n) acc[a][b][m][n] = (f32x4){0.f, 0.f, 0.f, 0.f};
        cur = nxt; cA = nA; cB = nB; ++ui;
        if constexpr (ALIGN_EPI) { if (wr == 1) PG8_BAR; }
    }
    PG8_WAIT_V(0);
    if constexpr (!ALIGN_EPI) { if (wr == 0) PG8_BAR; }
    PG8_BAR;
    if constexpr (Epi::AFTER_DRAIN) { E.fused(acc, cur, wr, wc, fr, fq, lds, wid, lane); S.done(cur); }
#undef PG8_SA
#undef PG8_SB
#undef PG8_STAGE
#undef PG8_LDA
#undef PG8_LDB
#undef PG8_MMA
#ifdef PG8_MMAI
#undef PG8_MMAI
#endif
#undef PG8_WAIT_V
#undef PG8_WAIT_L
#undef PG8_BAR
#undef PG8_SCHED
}
template <class Epi, class Sched, bool ALIGN_EPI = false, bool SP2 = false>
__device__ __forceinline__ void gemm_phase_g(PG8_LAS unsigned char* lds, const Gemm g, const Sched& S, const Epi& E) {
    int tid_ = threadIdx.x; asm volatile("" : "+v"(tid_));
    const int tid = tid_, wid = __builtin_amdgcn_readfirstlane(tid >> 6), lane = tid & 63, wr = wid >> 2, wc = wid & 3, fr = lane & 15, fq = lane >> 4;
    const int K = g.K, nt = K / BK;
    unsigned voffA[2], voffB[2];
#pragma unroll
    for (int i = 0; i < 2; ++i) { int R, C; stage_rc(tid * 16 + i * 8192, R, C); const int Rb = Epi::PERM ? ((R & ~31) + perm32(R & 31)) : R;
        voffA[i] = (unsigned)(R * K + C) * 2u; voffB[i] = (unsigned)(Rb * K + C) * 2u; }
    const size_t kstep = (size_t)(BK * 2);
    const size_t hstep = (size_t)HALF * K * 2;
    const size_t tstep = 2 * hstep;
    const unsigned ldsw = (unsigned)wid * 1024u;
    const int aoff = lds_byte(wr * 64 + fr, fq * 8), boff = lds_byte(wc * 32 + fr, fq * 8);
#define PG8_SA(b, h) (((b) * 2 + (h)) * HTB)
#define PG8_SB(b, h) ((4 + (b) * 2 + (h)) * HTB)
#define PG8_STAGE(bufoff, gbase, voff) do { _Pragma("unroll") for (int _i = 0; _i < 2; ++_i) \
        __builtin_amdgcn_global_load_lds((const unsigned*)((const char*)(gbase) + (voff)[_i]), (PG8_LAS unsigned*)(lds + (bufoff) + ldsw + _i * 8192), 16, 0, 0); } while (0)
#define PG8_STAGE_A(bufoff, OFF, h, kb) do { _Pragma("unroll") for (int _i = 0; _i < 2; ++_i) \
        __builtin_amdgcn_global_load_lds((const unsigned*)((const char*)g.A + (OFF)[h][_i] + (kb)), (PG8_LAS unsigned*)(lds + (bufoff) + ldsw + _i * 8192), 16, 0, 0); } while (0)
#define PG8_LDA(dst, b, h) do { _Pragma("unroll") for (int m = 0; m < 4; ++m) _Pragma("unroll") for (int k = 0; k < 2; ++k) dst[m][k] = *(const PG8_LAS bf16x8*)(lds + PG8_SA(b, h) + aoff + m * 2048 + k * 1024); } while (0)
#define PG8_LDB(dst, b, h) do { _Pragma("unroll") for (int n = 0; n < 2; ++n) _Pragma("unroll") for (int k = 0; k < 2; ++k) dst[n][k] = *(const PG8_LAS bf16x8*)(lds + PG8_SB(b, h) + boff + n * 2048 + k * 1024); } while (0)
#define PG8_MMA(ai, bj, At, Bt) do { __builtin_amdgcn_s_setprio(1); _Pragma("unroll") for (int m = 0; m < 4; ++m) _Pragma("unroll") for (int n = 0; n < 2; ++n) _Pragma("unroll") for (int k = 0; k < 2; ++k) \
        acc[ai][bj][m][n] = __builtin_amdgcn_mfma_f32_16x16x32_bf16(Bt[n][k], At[m][k], acc[ai][bj][m][n], 0, 0, 0); __builtin_amdgcn_s_setprio(0); } while (0)
#define PG8_WAIT_V(n) asm volatile("s_waitcnt vmcnt(" #n ")" ::: "memory")
#define PG8_WAIT_L(n) asm volatile("s_waitcnt lgkmcnt(" #n ")" ::: "memory")
#define PG8_BAR __builtin_amdgcn_s_barrier()
#define PG8_SCHED __builtin_amdgcn_sched_barrier(0)
    Unit cur, nxt; int ui = 0;
    if (!S.next(0, cur)) return;
    f32x4 acc[2][2][4][2];
#pragma unroll
    for (int a = 0; a < 2; ++a)
#pragma unroll
        for (int b = 0; b < 2; ++b)
#pragma unroll
            for (int m = 0; m < 4; ++m)
#pragma unroll
                for (int n = 0; n < 2; ++n) acc[a][b][m][n] = (f32x4){0.f, 0.f, 0.f, 0.f};
    bf16x8 At[4][2], B0[2][2], B1[2][2];
    const char* cB = (const char*)g.Bt + (size_t)cur.pn * tstep;
    unsigned go[2][2], ngo[2][2]; int Rr[2], Cc[2];
#pragma unroll
    for (int i = 0; i < 2; ++i) stage_rc(tid * 16 + i * 8192, Rr[i], Cc[i]);
#pragma unroll
    for (int h = 0; h < 2; ++h)
#pragma unroll
        for (int i = 0; i < 2; ++i) go[h][i] = (unsigned)S.rowtok(cur, h * HALF + Rr[i]) * (unsigned)(K * 2) + (unsigned)Cc[i] * 2u;
    S.a_ready(cur);
    if constexpr (SP2) {
        PG8_STAGE(PG8_SB(0, 0), cB, voffB); PG8_STAGE(PG8_SB(0, 1), cB + hstep, voffB); PG8_STAGE_A(PG8_SA(0, 0), go, 0, 0); PG8_STAGE_A(PG8_SA(0, 1), go, 1, 0);
        if (wr == 1) PG8_BAR;
        PG8_WAIT_V(2); PG8_BAR;
        PG8_STAGE(PG8_SB(1, 0), cB + kstep, voffB); PG8_STAGE_A(PG8_SA(1, 0), go, 0, kstep); PG8_STAGE(PG8_SB(1, 1), cB + hstep + kstep, voffB);
        PG8_WAIT_V(6); PG8_BAR;
    } else {
        PG8_STAGE(PG8_SB(0, 0), cB, voffB); PG8_STAGE_A(PG8_SA(0, 0), go, 0, 0); PG8_STAGE(PG8_SB(0, 1), cB + hstep, voffB); PG8_STAGE_A(PG8_SA(0, 1), go, 1, 0);
        if (wr == 1) PG8_BAR;
        PG8_WAIT_V(4); PG8_BAR;
        PG8_STAGE(PG8_SB(1, 0), cB + kstep, voffB); PG8_STAGE_A(PG8_SA(1, 0), go, 0, kstep); PG8_STAGE(PG8_SB(1, 1), cB + hstep + kstep, voffB);
        PG8_WAIT_V(6); PG8_BAR;
    }
    for (;;) {
        const bool has_next = S.next(ui + 1, nxt);
        const char* nB = has_next ? (const char*)g.Bt + (size_t)nxt.pn * tstep : cB;
#pragma unroll
        for (int h = 0; h < 2; ++h)
#pragma unroll
            for (int i = 0; i < 2; ++i) ngo[h][i] = has_next ? (unsigned)S.rowtok(nxt, h * HALF + Rr[i]) * (unsigned)(K * 2) + (unsigned)Cc[i] * 2u : go[h][i];
        for (int t = 0; t < nt; t += 2) {
            const bool last = (t == nt - 2);
            const size_t ka1 = (size_t)(t + 1) * kstep;
            const size_t k2 = last ? 0 : (size_t)(t + 2) * kstep; const char* b2 = last ? nB : cB + (size_t)(t + 2) * kstep;
            unsigned o2[2][2];
#pragma unroll
            for (int h = 0; h < 2; ++h)
#pragma unroll
                for (int i = 0; i < 2; ++i) o2[h][i] = last ? ngo[h][i] : go[h][i];
            const char* b3 = b2 + kstep;
            if (last && has_next) S.a_ready(nxt);
            if constexpr (SP2) {
            PG8_LDB(B0, 0, 0); PG8_LDB(B1, 0, 1); PG8_SCHED; PG8_LDA(At, 0, 0); PG8_STAGE_A(PG8_SA(1, 1), go, 1, ka1);
            PG8_WAIT_V(8); PG8_WAIT_L(0); PG8_BAR; PG8_MMA(0, 0, At, B0); PG8_MMA(0, 1, At, B1); PG8_BAR; PG8_SCHED;
            PG8_LDA(At, 0, 1); PG8_STAGE(PG8_SB(0, 0), b2, voffB); PG8_STAGE(PG8_SB(0, 1), b2 + hstep, voffB); PG8_STAGE_A(PG8_SA(0, 0), o2, 0, k2);
            PG8_WAIT_V(8); PG8_WAIT_L(0); PG8_BAR; PG8_MMA(1, 0, At, B0); PG8_MMA(1, 1, At, B1); PG8_BAR; PG8_SCHED;
            PG8_LDB(B0, 1, 0); PG8_LDB(B1, 1, 1); PG8_SCHED; PG8_LDA(At, 1, 0); PG8_STAGE_A(PG8_SA(0, 1), o2, 1, k2);
            PG8_WAIT_V(8); PG8_WAIT_L(0); PG8_BAR; PG8_MMA(0, 0, At, B0); PG8_MMA(0, 1, At, B1); PG8_BAR; PG8_SCHED;
            PG8_LDA(At, 1, 1); PG8_STAGE(PG8_SB(1, 0), b3, voffB); PG8_STAGE(PG8_SB(1, 1), b3 + hstep, voffB); PG8_STAGE_A(PG8_SA(1, 0), o2, 0, k2 + kstep);
            PG8_WAIT_V(8); PG8_WAIT_L(0); PG8_BAR; PG8_MMA(1, 0, At, B0); PG8_MMA(1, 1, At, B1); PG8_BAR; PG8_SCHED;
            } else {
            PG8_LDB(B0, 0, 0); PG8_SCHED; PG8_LDA(At, 0, 0); PG8_STAGE_A(PG8_SA(1, 1), go, 1, ka1);
            PG8_WAIT_L(8); PG8_BAR; PG8_WAIT_L(0); PG8_MMA(0, 0, At, B0); PG8_BAR; PG8_SCHED;
            PG8_LDB(B1, 0, 1); PG8_STAGE(PG8_SB(0, 0), b2, voffB);
            PG8_BAR; PG8_WAIT_L(0); PG8_MMA(0, 1, At, B1); PG8_BAR;
            PG8_LDA(At, 0, 1); PG8_STAGE_A(PG8_SA(0, 0), o2, 0, k2);
            PG8_BAR; PG8_WAIT_L(0); PG8_MMA(1, 0, At, B0); PG8_BAR; PG8_SCHED;
            PG8_STAGE(PG8_SB(0, 1), b2 + hstep, voffB);
            PG8_WAIT_V(6); PG8_BAR; PG8_MMA(1, 1, At, B1); PG8_BAR;
            PG8_LDB(B0, 1, 0); PG8_SCHED; PG8_LDA(At, 1, 0); PG8_STAGE_A(PG8_SA(0, 1), o2, 1, k2);
            PG8_WAIT_L(8); PG8_BAR; PG8_WAIT_L(0); PG8_MMA(0, 0, At, B0); PG8_BAR; PG8_SCHED;
            PG8_LDB(B1, 1, 1); PG8_STAGE(PG8_SB(1, 0), b3, voffB);
            PG8_BAR; PG8_WAIT_L(0); PG8_MMA(0, 1, At, B1); PG8_BAR;
            PG8_LDA(At, 1, 1); PG8_STAGE_A(PG8_SA(1, 0), o2, 0, k2 + kstep);
            PG8_BAR; PG8_WAIT_L(0); PG8_MMA(1, 0, At, B0); PG8_BAR; PG8_SCHED;
            PG8_STAGE(PG8_SB(1, 1), b3 + hstep, voffB);
            PG8_WAIT_V(6); PG8_BAR; PG8_MMA(1, 1, At, B1); PG8_BAR;
            }
        }
        if constexpr (ALIGN_EPI) { if (wr == 0) PG8_BAR; }
        if constexpr (!Epi::AFTER_DRAIN) { E(acc, cur, wr, wc, fr, fq); S.done(cur); }
        if (!has_next) break;
#pragma unroll
        for (int a = 0; a < 2; ++a)
#pragma unroll
            for (int b = 0; b < 2; ++b)
#pragma unroll
                for (int m = 0; m < 4; ++m)
#pragma unroll
                    for (int n = 0; n < 2; ++n) acc[a][b][m][n] = (f32x4){0.f, 0.f, 0.f, 0.f};
        cur = nxt; cB = nB; ++ui;
#pragma unroll
        for (int h = 0; h < 2; ++h)
#pragma unroll
            for (int i = 0; i < 2; ++i) go[h][i] = ngo[h][i];
        if constexpr (ALIGN_EPI) { if (wr == 1) PG8_BAR; }
    }
    PG8_WAIT_V(0);
    if constexpr (!ALIGN_EPI) { if (wr == 0) PG8_BAR; }
    PG8_BAR;
    if constexpr (Epi::AFTER_DRAIN) { E.fused(acc, cur, wr, wc, fr, fq, lds, wid, lane); S.done(cur); }
#undef PG8_SA
#undef PG8_SB
#undef PG8_STAGE
#undef PG8_STAGE_A
#undef PG8_LDA
#undef PG8_LDB
#undef PG8_MMA
#ifdef PG8_MMAI
#undef PG8_MMAI
#endif
#undef PG8_WAIT_V
#undef PG8_WAIT_L
#undef PG8_BAR
#undef PG8_SCHED
}

typedef int i32x8 __attribute__((ext_vector_type(8)));
__device__ __forceinline__ void mfma8(f32x4& c, const i32x8& a, const i32x8& b, int sc) { asm volatile("v_mfma_scale_f32_16x16x128_f8f6f4 %0, %1, %2, %0, %3, %3 op_sel_hi:[0,0,0]" : "+v"(c) : "v"(a), "v"(b), "v"(sc)); }
template <class Epi, class Sched, bool ALIGN_EPI = false, bool SP2 = false>
__device__ __forceinline__ void gemm_phase8(PG8_LAS unsigned char* lds, const Gemm g, const Sched& S, const Epi& E) {
    int tid_ = threadIdx.x; asm volatile("" : "+v"(tid_));
    const int tid = tid_, wid = __builtin_amdgcn_readfirstlane(tid >> 6), lane = tid & 63, wr = wid >> 2, wc = wid & 3, fr = lane & 15, fq = lane >> 4;
    int sc8 = 0x7F7F7F7F; asm volatile("" : "+v"(sc8));
    const int K = g.K, nt = K / 128;
    unsigned voffA[2], voffB[2];
#pragma unroll
    for (int i = 0; i < 2; ++i) { int R, C; stage_rc(tid * 16 + i * 8192, R, C); const int Rb = Epi::PERM ? ((R & ~31) + perm32(R & 31)) : R;
        voffA[i] = (unsigned)(R * K + C * 2); voffB[i] = (unsigned)(Rb * K + C * 2); }
    const size_t kstep = (size_t)(BK * 2);
    const size_t hstep = (size_t)HALF * K;
    const size_t tstep = 2 * hstep;
    const unsigned ldsw = (unsigned)wid * 1024u;
    const int aoff = lds_byte(wr * 64 + fr, fq * 8), boff = lds_byte(wc * 32 + fr, fq * 8);
#define PG8_SA(b, h) (((b) * 2 + (h)) * HTB)
#define PG8_SB(b, h) ((4 + (b) * 2 + (h)) * HTB)
#define PG8_STAGE(bufoff, gbase, voff) do { _Pragma("unroll") for (int _i = 0; _i < 2; ++_i) \
        __builtin_amdgcn_global_load_lds((const unsigned*)((const char*)(gbase) + (voff)[_i]), (PG8_LAS unsigned*)(lds + (bufoff) + ldsw + _i * 8192), 16, 0, 0); } while (0)
#define PG8_LDA(dst, b, h) do { _Pragma("unroll") for (int m = 0; m < 4; ++m) { const u32x4 lo_ = *(const PG8_LAS u32x4*)(lds + PG8_SA(b, h) + aoff + m * 2048), hi_ = *(const PG8_LAS u32x4*)(lds + PG8_SA(b, h) + aoff + m * 2048 + 1024); \
        dst[m] = (i32x8){(int)lo_.x, (int)lo_.y, (int)lo_.z, (int)lo_.w, (int)hi_.x, (int)hi_.y, (int)hi_.z, (int)hi_.w}; } } while (0)
#define PG8_LDB(dst, b, h) do { _Pragma("unroll") for (int n = 0; n < 2; ++n) { const u32x4 lo_ = *(const PG8_LAS u32x4*)(lds + PG8_SB(b, h) + boff + n * 2048), hi_ = *(const PG8_LAS u32x4*)(lds + PG8_SB(b, h) + boff + n * 2048 + 1024); \
        dst[n] = (i32x8){(int)lo_.x, (int)lo_.y, (int)lo_.z, (int)lo_.w, (int)hi_.x, (int)hi_.y, (int)hi_.z, (int)hi_.w}; } } while (0)
#define PG8_MMA(ai, bj, At, Bt) do { __builtin_amdgcn_s_setprio(1); _Pragma("unroll") for (int m = 0; m < 4; ++m) _Pragma("unroll") for (int n = 0; n < 2; ++n) \
        mfma8(acc[ai][bj][m][n], Bt[n], At[m], sc8); __builtin_amdgcn_s_setprio(0); } while (0)
#define PG8_MMAI(ai, At, ST1, ST2, ST3) do { __builtin_amdgcn_s_setprio(1); \
        mfma8(acc[ai][0][0][0], B0[0], At[0], sc8); mfma8(acc[ai][0][0][1], B0[1], At[0], sc8); __builtin_amdgcn_sched_barrier(0); ST1; __builtin_amdgcn_sched_barrier(0); \
        mfma8(acc[ai][0][1][0], B0[0], At[1], sc8); mfma8(acc[ai][0][1][1], B0[1], At[1], sc8); mfma8(acc[ai][0][2][0], B0[0], At[2], sc8); mfma8(acc[ai][0][2][1], B0[1], At[2], sc8); __builtin_amdgcn_sched_barrier(0); ST2; __builtin_amdgcn_sched_barrier(0); \
        mfma8(acc[ai][0][3][0], B0[0], At[3], sc8); mfma8(acc[ai][0][3][1], B0[1], At[3], sc8); mfma8(acc[ai][1][0][0], B1[0], At[0], sc8); mfma8(acc[ai][1][0][1], B1[1], At[0], sc8); __builtin_amdgcn_sched_barrier(0); ST3; __builtin_amdgcn_sched_barrier(0); \
        mfma8(acc[ai][1][1][0], B1[0], At[1], sc8); mfma8(acc[ai][1][1][1], B1[1], At[1], sc8); mfma8(acc[ai][1][2][0], B1[0], At[2], sc8); mfma8(acc[ai][1][2][1], B1[1], At[2], sc8); \
        mfma8(acc[ai][1][3][0], B1[0], At[3], sc8); mfma8(acc[ai][1][3][1], B1[1], At[3], sc8); __builtin_amdgcn_s_setprio(0); } while (0)
#define PG8_WAIT_V(n) asm volatile("s_waitcnt vmcnt(" #n ")" ::: "memory")
#define PG8_WAIT_L(n) asm volatile("s_waitcnt lgkmcnt(" #n ")" ::: "memory")
#define PG8_BAR __builtin_amdgcn_s_barrier()
#define PG8_SCHED __builtin_amdgcn_sched_barrier(0)
    Unit cur, nxt; int ui = 0;
    if (!S.next(0, cur)) return;
    f32x4 acc[2][2][4][2];
#pragma unroll
    for (int a = 0; a < 2; ++a)
#pragma unroll
        for (int b = 0; b < 2; ++b)
#pragma unroll
            for (int m = 0; m < 4; ++m)
#pragma unroll
                for (int n = 0; n < 2; ++n) acc[a][b][m][n] = (f32x4){0.f, 0.f, 0.f, 0.f};
    i32x8 At[4], B0[2], B1[2];
    const char* cA = (const char*)g.A + (size_t)cur.pm * tstep; const char* cB = (const char*)g.Bt + (size_t)cur.pn * tstep;
    S.a_ready(cur);
    if constexpr (SP2) {
        PG8_STAGE(PG8_SB(0, 0), cB, voffB); PG8_STAGE(PG8_SB(0, 1), cB + hstep, voffB); PG8_STAGE(PG8_SA(0, 0), cA, voffA); PG8_STAGE(PG8_SA(0, 1), cA + hstep, voffA);
        if (wr == 1) PG8_BAR;
        PG8_WAIT_V(2); PG8_BAR;
        PG8_STAGE(PG8_SB(1, 0), cB + kstep, voffB); PG8_STAGE(PG8_SA(1, 0), cA + kstep, voffA); PG8_STAGE(PG8_SB(1, 1), cB + hstep + kstep, voffB);
        PG8_WAIT_V(6); PG8_BAR;
    } else {
        PG8_STAGE(PG8_SB(0, 0), cB, voffB); PG8_STAGE(PG8_SA(0, 0), cA, voffA); PG8_STAGE(PG8_SB(0, 1), cB + hstep, voffB); PG8_STAGE(PG8_SA(0, 1), cA + hstep, voffA);
        if (wr == 1) PG8_BAR;
        PG8_WAIT_V(4); PG8_BAR;
        PG8_STAGE(PG8_SB(1, 0), cB + kstep, voffB); PG8_STAGE(PG8_SA(1, 0), cA + kstep, voffA); PG8_STAGE(PG8_SB(1, 1), cB + hstep + kstep, voffB);
        PG8_WAIT_V(6); PG8_BAR;
    }
    for (;;) {
        const bool has_next = S.next(ui + 1, nxt);
        E.prefetch(cur, ui & 1, wid, lane);
        const char* nA = has_next ? (const char*)g.A + (size_t)nxt.pm * tstep : cA; const char* nB = has_next ? (const char*)g.Bt + (size_t)nxt.pn * tstep : cB;
        _Pragma("nounroll") for (int t = 0; t < nt; t += 2) {
            const bool last = (t == nt - 2);
            const char* a1 = cA + (size_t)(t + 1) * kstep;
            const char* a2 = last ? nA : cA + (size_t)(t + 2) * kstep; const char* b2 = last ? nB : cB + (size_t)(t + 2) * kstep;
            const char* a3 = a2 + kstep; const char* b3 = b2 + kstep;
            if (last && has_next) S.a_ready(nxt);
            if constexpr (SP2) {
            PG8_LDB(B0, 0, 0); PG8_LDB(B1, 0, 1); PG8_SCHED; PG8_LDA(At, 0, 0);
            PG8_WAIT_V(6); PG8_WAIT_L(0); PG8_BAR; PG8_MMAI(0, At, PG8_STAGE(PG8_SA(1, 1), a1 + hstep, voffA), (void)0, (void)0); PG8_BAR; PG8_SCHED;
            PG8_LDA(At, 0, 1);
            PG8_WAIT_V(2); PG8_WAIT_L(0); PG8_BAR; PG8_MMAI(1, At, PG8_STAGE(PG8_SB(0, 0), b2, voffB), PG8_STAGE(PG8_SB(0, 1), b2 + hstep, voffB), PG8_STAGE(PG8_SA(0, 0), a2, voffA)); PG8_BAR; PG8_SCHED;
            PG8_LDB(B0, 1, 0); PG8_LDB(B1, 1, 1); PG8_SCHED; PG8_LDA(At, 1, 0);
            PG8_WAIT_V(6); PG8_WAIT_L(0); PG8_BAR; PG8_MMAI(0, At, PG8_STAGE(PG8_SA(0, 1), a2 + hstep, voffA), (void)0, (void)0); PG8_BAR; PG8_SCHED;
            PG8_LDA(At, 1, 1);
            PG8_WAIT_V(2); PG8_WAIT_L(0); PG8_BAR; PG8_MMAI(1, At, PG8_STAGE(PG8_SB(1, 0), b3, voffB), PG8_STAGE(PG8_SB(1, 1), b3 + hstep, voffB), PG8_STAGE(PG8_SA(1, 0), a3, voffA)); PG8_BAR; PG8_SCHED;
            } else {
            PG8_LDB(B0, 0, 0); PG8_SCHED; PG8_LDA(At, 0, 0); PG8_STAGE(PG8_SA(1, 1), a1 + hstep, voffA);
            PG8_WAIT_L(8); PG8_BAR; PG8_WAIT_L(0); PG8_MMA(0, 0, At, B0); PG8_BAR; PG8_SCHED;
            PG8_LDB(B1, 0, 1); PG8_STAGE(PG8_SB(0, 0), b2, voffB);
            PG8_BAR; PG8_WAIT_L(0); PG8_MMA(0, 1, At, B1); PG8_BAR;
            PG8_LDA(At, 0, 1); PG8_STAGE(PG8_SA(0, 0), a2, voffA);
            PG8_BAR; PG8_WAIT_L(0); PG8_MMA(1, 0, At, B0); PG8_BAR; PG8_SCHED;
            PG8_STAGE(PG8_SB(0, 1), b2 + hstep, voffB);
            PG8_WAIT_V(6); PG8_BAR; PG8_MMA(1, 1, At, B1); PG8_BAR;
            PG8_LDB(B0, 1, 0); PG8_SCHED; PG8_LDA(At, 1, 0); PG8_STAGE(PG8_SA(0, 1), a2 + hstep, voffA);
            PG8_WAIT_L(8); PG8_BAR; PG8_WAIT_L(0); PG8_MMA(0, 0, At, B0); PG8_BAR; PG8_SCHED;
            PG8_LDB(B1, 1, 1); PG8_STAGE(PG8_SB(1, 0), b3, voffB);
            PG8_BAR; PG8_WAIT_L(0); PG8_MMA(0, 1, At, B1); PG8_BAR;
            PG8_LDA(At, 1, 1); PG8_STAGE(PG8_SA(1, 0), a3, voffA);
            PG8_BAR; PG8_WAIT_L(0); PG8_MMA(1, 0, At, B0); PG8_BAR; PG8_SCHED;
            PG8_STAGE(PG8_SB(1, 1), b3 + hstep, voffB);
            PG8_WAIT_V(6); PG8_BAR; PG8_MMA(1, 1, At, B1); PG8_BAR;
            }
        }
        if constexpr (ALIGN_EPI) { if (wr == 0) PG8_BAR; }
        asm volatile("s_nop 15\n\ts_nop 15" ::: "memory");
        if constexpr (!Epi::AFTER_DRAIN) { E(acc, cur, wr, wc, fr, fq, ui & 1); S.done(cur); }
        if (!has_next) break;
#pragma unroll
        for (int a = 0; a < 2; ++a)
#pragma unroll
            for (int b = 0; b < 2; ++b)
#pragma unroll
                for (int m = 0; m < 4; ++m)
#pragma unroll
                    for (int n = 0; n < 2; ++n) acc[a][b][m][n] = (f32x4){0.f, 0.f, 0.f, 0.f};
        cur = nxt; cA = nA; cB = nB; ++ui;
        if constexpr (ALIGN_EPI) { if (wr == 1) PG8_BAR; }
    }
    PG8_WAIT_V(0);
    if constexpr (!ALIGN_EPI) { if (wr == 0) PG8_BAR; }
    PG8_BAR;
    if constexpr (Epi::AFTER_DRAIN) { E.fused(acc, cur, wr, wc, fr, fq, lds, wid, lane); S.done(cur); }
#undef PG8_SA
#undef PG8_SB
#undef PG8_STAGE
#undef PG8_LDA
#undef PG8_LDB
#undef PG8_MMA
#ifdef PG8_MMAI
#undef PG8_MMAI
#endif
#undef PG8_MMAI
#undef PG8_WAIT_V
#undef PG8_WAIT_L
#undef PG8_BAR
#undef PG8_SCHED
}

template <class Epi, class Sched, bool ALIGN_EPI = false, bool SP2 = false>
__device__ __forceinline__ void gemm_phase_g8(PG8_LAS unsigned char* lds, const Gemm g, const Sched& S, const Epi& E) {
    int tid_ = threadIdx.x; asm volatile("" : "+v"(tid_));
    const int tid = tid_, wid = __builtin_amdgcn_readfirstlane(tid >> 6), lane = tid & 63, wr = wid >> 2, wc = wid & 3, fr = lane & 15, fq = lane >> 4;
    int sc8 = 0x7F7F7F7F; asm volatile("" : "+v"(sc8));
    const int K = g.K, nt = K / 128;
    unsigned voffA[2], voffB[2];
#pragma unroll
    for (int i = 0; i < 2; ++i) { int R, C; stage_rc(tid * 16 + i * 8192, R, C); const int Rb = Epi::PERM ? ((R & ~31) + perm32(R & 31)) : R;
        voffA[i] = (unsigned)(R * K + C * 2); voffB[i] = (unsigned)(Rb * K + C * 2); }
    const size_t kstep = (size_t)(BK * 2);
    const size_t hstep = (size_t)HALF * K;
    const size_t tstep = 2 * hstep;
    const unsigned ldsw = (unsigned)wid * 1024u;
    const int aoff = lds_byte(wr * 64 + fr, fq * 8), boff = lds_byte(wc * 32 + fr, fq * 8);
#define PG8_SA(b, h) (((b) * 2 + (h)) * HTB)
#define PG8_SB(b, h) ((4 + (b) * 2 + (h)) * HTB)
#define PG8_STAGE(bufoff, gbase, voff) do { _Pragma("unroll") for (int _i = 0; _i < 2; ++_i) \
        __builtin_amdgcn_global_load_lds((const unsigned*)((const char*)(gbase) + (voff)[_i]), (PG8_LAS unsigned*)(lds + (bufoff) + ldsw + _i * 8192), 16, 0, 0); } while (0)
#define PG8_STAGE_A(bufoff, OFF, h, kb) do { _Pragma("unroll") for (int _i = 0; _i < 2; ++_i) \
        __builtin_amdgcn_global_load_lds((const unsigned*)((const char*)g.A + (OFF)[h][_i] + (kb)), (PG8_LAS unsigned*)(lds + (bufoff) + ldsw + _i * 8192), 16, 0, 0); } while (0)
#define PG8_LDA(dst, b, h) do { _Pragma("unroll") for (int m = 0; m < 4; ++m) { const u32x4 lo_ = *(const PG8_LAS u32x4*)(lds + PG8_SA(b, h) + aoff + m * 2048), hi_ = *(const PG8_LAS u32x4*)(lds + PG8_SA(b, h) + aoff + m * 2048 + 1024); \
        dst[m] = (i32x8){(int)lo_.x, (int)lo_.y, (int)lo_.z, (int)lo_.w, (int)hi_.x, (int)hi_.y, (int)hi_.z, (int)hi_.w}; } } while (0)
#define PG8_LDB(dst, b, h) do { _Pragma("unroll") for (int n = 0; n < 2; ++n) { const u32x4 lo_ = *(const PG8_LAS u32x4*)(lds + PG8_SB(b, h) + boff + n * 2048), hi_ = *(const PG8_LAS u32x4*)(lds + PG8_SB(b, h) + boff + n * 2048 + 1024); \
        dst[n] = (i32x8){(int)lo_.x, (int)lo_.y, (int)lo_.z, (int)lo_.w, (int)hi_.x, (int)hi_.y, (int)hi_.z, (int)hi_.w}; } } while (0)
#define PG8_MMA(ai, bj, At, Bt) do { __builtin_amdgcn_s_setprio(1); _Pragma("unroll") for (int m = 0; m < 4; ++m) _Pragma("unroll") for (int n = 0; n < 2; ++n) \
        mfma8(acc[ai][bj][m][n], Bt[n], At[m], sc8); __builtin_amdgcn_s_setprio(0); } while (0)
#define PG8_MMAI(ai, At, ST1, ST2, ST3) do { __builtin_amdgcn_s_setprio(1); \
        mfma8(acc[ai][0][0][0], B0[0], At[0], sc8); mfma8(acc[ai][0][0][1], B0[1], At[0], sc8); __builtin_amdgcn_sched_barrier(0); ST1; __builtin_amdgcn_sched_barrier(0); \
        mfma8(acc[ai][0][1][0], B0[0], At[1], sc8); mfma8(acc[ai][0][1][1], B0[1], At[1], sc8); mfma8(acc[ai][0][2][0], B0[0], At[2], sc8); mfma8(acc[ai][0][2][1], B0[1], At[2], sc8); __builtin_amdgcn_sched_barrier(0); ST2; __builtin_amdgcn_sched_barrier(0); \
        mfma8(acc[ai][0][3][0], B0[0], At[3], sc8); mfma8(acc[ai][0][3][1], B0[1], At[3], sc8); mfma8(acc[ai][1][0][0], B1[0], At[0], sc8); mfma8(acc[ai][1][0][1], B1[1], At[0], sc8); __builtin_amdgcn_sched_barrier(0); ST3; __builtin_amdgcn_sched_barrier(0); \
        mfma8(acc[ai][1][1][0], B1[0], At[1], sc8); mfma8(acc[ai][1][1][1], B1[1], At[1], sc8); mfma8(acc[ai][1][2][0], B1[0], At[2], sc8); mfma8(acc[ai][1][2][1], B1[1], At[2], sc8); \
        mfma8(acc[ai][1][3][0], B1[0], At[3], sc8); mfma8(acc[ai][1][3][1], B1[1], At[3], sc8); __builtin_amdgcn_s_setprio(0); } while (0)
#define PG8_WAIT_V(n) asm volatile("s_waitcnt vmcnt(" #n ")" ::: "memory")
#define PG8_WAIT_L(n) asm volatile("s_waitcnt lgkmcnt(" #n ")" ::: "memory")
#define PG8_BAR __builtin_amdgcn_s_barrier()
#define PG8_SCHED __builtin_amdgcn_sched_barrier(0)
    Unit cur, nxt; int ui = 0;
    if (!S.next(0, cur)) return;
    f32x4 acc[2][2][4][2];
#pragma unroll
    for (int a = 0; a < 2; ++a)
#pragma unroll
        for (int b = 0; b < 2; ++b)
#pragma unroll
            for (int m = 0; m < 4; ++m)
#pragma unroll
                for (int n = 0; n < 2; ++n) acc[a][b][m][n] = (f32x4){0.f, 0.f, 0.f, 0.f};
    i32x8 At[4], B0[2], B1[2];
    const char* cB = (const char*)g.Bt + (size_t)cur.pn * tstep;
    unsigned go[2][2], ngo[2][2]; int Rr[2], Cc[2];
#pragma unroll
    for (int i = 0; i < 2; ++i) stage_rc(tid * 16 + i * 8192, Rr[i], Cc[i]);
#pragma unroll
    for (int h = 0; h < 2; ++h)
#pragma unroll
        for (int i = 0; i < 2; ++i) go[h][i] = (unsigned)S.rowtok(cur, h * HALF + Rr[i]) * (unsigned)K + (unsigned)Cc[i] * 2u;
    S.a_ready(cur);
    if constexpr (SP2) {
        PG8_STAGE(PG8_SB(0, 0), cB, voffB); PG8_STAGE(PG8_SB(0, 1), cB + hstep, voffB); PG8_STAGE_A(PG8_SA(0, 0), go, 0, 0); PG8_STAGE_A(PG8_SA(0, 1), go, 1, 0);
        if (wr == 1) PG8_BAR;
        PG8_WAIT_V(2); PG8_BAR;
        PG8_STAGE(PG8_SB(1, 0), cB + kstep, voffB); PG8_STAGE_A(PG8_SA(1, 0), go, 0, kstep); PG8_STAGE(PG8_SB(1, 1), cB + hstep + kstep, voffB);
        PG8_WAIT_V(6); PG8_BAR;
    } else {
        PG8_STAGE(PG8_SB(0, 0), cB, voffB); PG8_STAGE_A(PG8_SA(0, 0), go, 0, 0); PG8_STAGE(PG8_SB(0, 1), cB + hstep, voffB); PG8_STAGE_A(PG8_SA(0, 1), go, 1, 0);
        if (wr == 1) PG8_BAR;
        PG8_WAIT_V(4); PG8_BAR;
        PG8_STAGE(PG8_SB(1, 0), cB + kstep, voffB); PG8_STAGE_A(PG8_SA(1, 0), go, 0, kstep); PG8_STAGE(PG8_SB(1, 1), cB + hstep + kstep, voffB);
        PG8_WAIT_V(6); PG8_BAR;
    }
    for (;;) {
        const bool has_next = S.next(ui + 1, nxt);
        E.prefetch(cur, ui & 1, wid, lane);
        const char* nB = has_next ? (const char*)g.Bt + (size_t)nxt.pn * tstep : cB;
#pragma unroll
        for (int h = 0; h < 2; ++h)
#pragma unroll
            for (int i = 0; i < 2; ++i) ngo[h][i] = has_next ? (unsigned)S.rowtok(nxt, h * HALF + Rr[i]) * (unsigned)K + (unsigned)Cc[i] * 2u : go[h][i];
        _Pragma("nounroll") for (int t = 0; t < nt; t += 2) {
            const bool last = (t == nt - 2);
            const size_t ka1 = (size_t)(t + 1) * kstep;
            const size_t k2 = last ? 0 : (size_t)(t + 2) * kstep; const char* b2 = last ? nB : cB + (size_t)(t + 2) * kstep;
            unsigned o2[2][2];
#pragma unroll
            for (int h = 0; h < 2; ++h)
#pragma unroll
                for (int i = 0; i < 2; ++i) o2[h][i] = last ? ngo[h][i] : go[h][i];
            const char* b3 = b2 + kstep;
            if (last && has_next) S.a_ready(nxt);
            if constexpr (SP2) {
            PG8_LDB(B0, 0, 0); PG8_LDB(B1, 0, 1); PG8_SCHED; PG8_LDA(At, 0, 0);
            PG8_WAIT_V(6); PG8_WAIT_L(0); PG8_BAR; PG8_MMAI(0, At, PG8_STAGE_A(PG8_SA(1, 1), go, 1, ka1), (void)0, (void)0); PG8_BAR; PG8_SCHED;
            PG8_LDA(At, 0, 1);
            PG8_WAIT_V(2); PG8_WAIT_L(0); PG8_BAR; PG8_MMAI(1, At, PG8_STAGE(PG8_SB(0, 0), b2, voffB), PG8_STAGE(PG8_SB(0, 1), b2 + hstep, voffB), PG8_STAGE_A(PG8_SA(0, 0), o2, 0, k2)); PG8_BAR; PG8_SCHED;
            PG8_LDB(B0, 1, 0); PG8_LDB(B1, 1, 1); PG8_SCHED; PG8_LDA(At, 1, 0);
            PG8_WAIT_V(6); PG8_WAIT_L(0); PG8_BAR; PG8_MMAI(0, At, PG8_STAGE_A(PG8_SA(0, 1), o2, 1, k2), (void)0, (void)0); PG8_BAR; PG8_SCHED;
            PG8_LDA(At, 1, 1);
            PG8_WAIT_V(2); PG8_WAIT_L(0); PG8_BAR; PG8_MMAI(1, At, PG8_STAGE(PG8_SB(1, 0), b3, voffB), PG8_STAGE(PG8_SB(1, 1), b3 + hstep, voffB), PG8_STAGE_A(PG8_SA(1, 0), o2, 0, k2 + kstep)); PG8_BAR; PG8_SCHED;
            } else {
            PG8_LDB(B0, 0, 0); PG8_SCHED; PG8_LDA(At, 0, 0); PG8_STAGE_A(PG8_SA(1, 1), go, 1, ka1);
            PG8_WAIT_L(8); PG8_BAR; PG8_WAIT_L(0); PG8_MMA(0, 0, At, B0); PG8_BAR; PG8_SCHED;
            PG8_LDB(B1, 0, 1); PG8_STAGE(PG8_SB(0, 0), b2, voffB);
            PG8_BAR; PG8_WAIT_L(0); PG8_MMA(0, 1, At, B1); PG8_BAR;
            PG8_LDA(At, 0, 1); PG8_STAGE_A(PG8_SA(0, 0), o2, 0, k2);
            PG8_BAR; PG8_WAIT_L(0); PG8_MMA(1, 0, At, B0); PG8_BAR; PG8_SCHED;
            PG8_STAGE(PG8_SB(0, 1), b2 + hstep, voffB);
            PG8_WAIT_V(6); PG8_BAR; PG8_MMA(1, 1, At, B1); PG8_BAR;
            PG8_LDB(B0, 1, 0); PG8_SCHED; PG8_LDA(At, 1, 0); PG8_STAGE_A(PG8_SA(0, 1), o2, 1, k2);
            PG8_WAIT_L(8); PG8_BAR; PG8_WAIT_L(0); PG8_MMA(0, 0, At, B0); PG8_BAR; PG8_SCHED;
            PG8_LDB(B1, 1, 1); PG8_STAGE(PG8_SB(1, 0), b3, voffB);
            PG8_BAR; PG8_WAIT_L(0); PG8_MMA(0, 1, At, B1); PG8_BAR;
            PG8_LDA(At, 1, 1); PG8_STAGE_A(PG8_SA(1, 0), o2, 0, k2 + kstep);
            PG8_BAR; PG8_WAIT_L(0); PG8_MMA(1, 0, At, B0); PG8_BAR; PG8_SCHED;
            PG8_STAGE(PG8_SB(1, 1), b3 + hstep, voffB);
            PG8_WAIT_V(6); PG8_BAR; PG8_MMA(1, 1, At, B1); PG8_BAR;
            }
        }
        if constexpr (ALIGN_EPI) { if (wr == 0) PG8_BAR; }
        asm volatile("s_nop 15\n\ts_nop 15" ::: "memory");
        if constexpr (!Epi::AFTER_DRAIN) { E(acc, cur, wr, wc, fr, fq, ui & 1); S.done(cur); }
        if (!has_next) break;
#pragma unroll
        for (int a = 0; a < 2; ++a)
#pragma unroll
            for (int b = 0; b < 2; ++b)
#pragma unroll
                for (int m = 0; m < 4; ++m)
#pragma unroll
                    for (int n = 0; n < 2; ++n) acc[a][b][m][n] = (f32x4){0.f, 0.f, 0.f, 0.f};
        cur = nxt; cB = nB; ++ui;
#pragma unroll
        for (int h = 0; h < 2; ++h)
#pragma unroll
            for (int i = 0; i < 2; ++i) go[h][i] = ngo[h][i];
        if constexpr (ALIGN_EPI) { if (wr == 1) PG8_BAR; }
    }
    PG8_WAIT_V(0);
    if constexpr (!ALIGN_EPI) { if (wr == 0) PG8_BAR; }
    PG8_BAR;
    if constexpr (Epi::AFTER_DRAIN) { E.fused(acc, cur, wr, wc, fr, fq, lds, wid, lane); S.done(cur); }
#undef PG8_SA
#undef PG8_SB
#undef PG8_STAGE
#undef PG8_STAGE_A
#undef PG8_LDA
#undef PG8_LDB
#undef PG8_MMA
#ifdef PG8_MMAI
#undef PG8_MMAI
#endif
#undef PG8_MMAI
#undef PG8_WAIT_V
#undef PG8_WAIT_L
#undef PG8_BAR
#undef PG8_SCHED
}


}
constexpr int NB = 8, S = 4096, D = 1024, NTOK = NB * S, NL = 2, NE = 32, PW = 2816, INW = 2706;
constexpr int MAXROWS = NTOK * 4 + NE * 256, MAXTILES = MAXROWS / 256;
constexpr float RMS_EPS = 1e-6f;
constexpr int C_QA = 0, C_KA = 256, C_VA = 512, C_QB = 768, C_KVB = 1152, C_QC = 1536, C_KC = 1920, C_VC = 2304, C_GB = 2688;
constexpr int NWAVES = 8;
constexpr size_t MiB = 1u << 20;
constexpr size_t WS_CTL = 0, CTL_ZERO_BYTES = 1 * MiB;
constexpr size_t WS_ROPE = 1 * MiB;
constexpr size_t WS_MOD = 1 * MiB + 512 * 1024;
constexpr size_t WS_KMEAN = 2 * MiB;
constexpr size_t WS_KC = 2 * MiB + 256 * 1024, WS_VC = 2 * MiB + 768 * 1024;
constexpr size_t WS_ASG_E = 4 * MiB, WS_ASG_POS = 4 * MiB + 512 * 1024, WS_ASG_GATE = 5 * MiB, WS_ASG_ROW = 5 * MiB + 512 * 1024;
constexpr size_t WS_SELM = 6 * MiB, WS_KCB = 6 * MiB + 512 * 1024, WS_VCB = 7 * MiB;
constexpr size_t WS_WIN = 8 * MiB;
constexpr size_t WS_WOUT = 20 * MiB;
constexpr size_t WS_CW1T = 28 * MiB, WS_CW2T = 29 * MiB, WS_CCONST = 29 * MiB + 64 * 1024;
constexpr size_t WS_RWT = 29 * MiB + 128 * 1024, WS_RCONST = 31 * MiB + 512 * 1024;
constexpr size_t WS_LIST = 24 * MiB;
constexpr size_t WS_WGU = 32 * MiB;
constexpr size_t WS_WDN = 288 * MiB;
constexpr size_t WS_ACT = 416 * MiB;
constexpr size_t WS_PROJ = 480 * MiB;
constexpr size_t WS_O = 656 * MiB;
constexpr size_t WS_Y = 720 * MiB;
constexpr size_t WS_X1 = 784 * MiB;
constexpr size_t WS_SA = 912 * MiB;
constexpr size_t WS_SACT = 1184 * MiB;
constexpr size_t WS_OCP = 1456 * MiB;
constexpr size_t WS_ACT8 = 1484 * MiB;
constexpr size_t WS_OSS = 1516 * MiB;
constexpr size_t WS_LGATE = 1518 * MiB;
constexpr size_t WS_RW3 = 1522 * MiB;
constexpr size_t WS_END = 1526 * MiB;
static_assert(WS_SA + (size_t)MAXROWS * D * 2 <= WS_SACT && WS_SACT + (size_t)MAXROWS * D * 2 <= WS_END, "ws map");
constexpr int CW_TMO = 0, CW_CODE = 1, CW_CNT = 1024, CW_WQ = 2048, CW_BAR = 4096;
constexpr int NPHASE = 21, MAX_LAUNCHES = 21;
constexpr int RING_BYTES = 131072, LDSCTL_OFF = RING_BYTES, MISC_OFF = LDSCTL_OFF + 320, TAB_OFF = LDSCTL_OFF + 512;
constexpr int LDS_BYTES = 147456;
#define GAS __attribute__((address_space(1)))
#define LAS __attribute__((address_space(3)))
typedef unsigned short bf16;
typedef unsigned v4u __attribute__((ext_vector_type(4)));
typedef unsigned v2u __attribute__((ext_vector_type(2)));
typedef float f32x4 __attribute__((ext_vector_type(4)));
typedef GAS unsigned gu32;
#define RLX_AGENT __ATOMIC_RELAXED, __HIP_MEMORY_SCOPE_AGENT
#define LDS_WAIT() asm volatile("s_waitcnt lgkmcnt(0)" ::: "memory")
#define VM_WAIT() asm volatile("s_waitcnt vmcnt(0)" ::: "memory")
__device__ __forceinline__ unsigned f2bf(float f) { unsigned u = __builtin_bit_cast(unsigned, f); return (u + 0x7fffu + ((u >> 16) & 1u)) >> 16; }
__device__ __forceinline__ unsigned pk2(float lo, float hi) { return pg8::cvt_pk_bf16(lo, hi); }
__device__ __forceinline__ float bflo(unsigned v) { return __builtin_bit_cast(float, v << 16); }
__device__ __forceinline__ float bfhi(unsigned v) { return __builtin_bit_cast(float, v & 0xffff0000u); }
__device__ __forceinline__ float bf1(bf16 v) { return __builtin_bit_cast(float, (unsigned)v << 16); }
#define XB_TMO      128
#define XB_XCNT(j)  (256  + 64 * (j))
#define XB_XSUB(j)  (1280 + 64 * (j))
#define XB_XGEN(j)  (2304 + 64 * (j))
#define XB_TOP      3328
#define XB_TOPGEN   3392
#define XCD_BAR_WORDS 3456
#define XB_SPIN_CAP (1u << 18)

__device__ __forceinline__ unsigned xb_ld(unsigned* p)              { return __hip_atomic_load(p, __ATOMIC_RELAXED, __HIP_MEMORY_SCOPE_AGENT); }
__device__ __forceinline__ unsigned xb_add(unsigned* p, unsigned v) { return __hip_atomic_fetch_add(p, v, __ATOMIC_RELAXED, __HIP_MEMORY_SCOPE_AGENT); }
__device__ __forceinline__ unsigned xb_xcc_id() { return (unsigned)__builtin_amdgcn_s_getreg((3 << 11) | 20) & 0xFu; }
#define XB_SPIN(cond, bar) do { unsigned _sp = 0; while (cond) { __builtin_amdgcn_s_sleep(1); \
    if ((++_sp & 255u) == 0u) { if (xb_ld(&(bar)[XB_TMO])) break; if (_sp > XB_SPIN_CAP) { atomicAdd(&(bar)[XB_TMO], 1u); break; } } } } while (0)

struct XcdBarrier {
    unsigned* bar; unsigned x;
    volatile LAS unsigned* st;
};

__device__ __forceinline__ XcdBarrier xcd_barrier_post(unsigned* bar, volatile LAS unsigned* st) {
    XcdBarrier b; b.bar = bar; b.x = xb_xcc_id(); b.st = st;
    if (threadIdx.x == 0) (void)xb_add(&bar[XB_XCNT(b.x)], 1u);
    return b;
}
__device__ __forceinline__ void xcd_barrier_complete(unsigned* bar, unsigned x, unsigned& nloc, unsigned& nx) {
    const unsigned G = gridDim.x * gridDim.y * gridDim.z;
    unsigned sum, cnt, mine, sp = 0u;
    for (;;) {
        sum = 0u; cnt = 0u; mine = 0u;
#pragma unroll
        for (unsigned j = 0; j < 16; ++j) { const unsigned c = xb_ld(&bar[XB_XCNT(j)]); sum += c; cnt += (c > 0u) ? 1u : 0u; mine = (j == x) ? c : mine; }
        if (sum == G) break;
        __builtin_amdgcn_s_sleep(1);
        if ((++sp & 255u) == 0u) { if (xb_ld(&bar[XB_TMO])) break; if (sp > XB_SPIN_CAP) { atomicAdd(&bar[XB_TMO], 1u); break; } }
    }
    nloc = mine > 0u ? mine : 1u; nx = cnt > 0u ? cnt : 1u;
}

__device__ __forceinline__ void xcd_barrier(const XcdBarrier& b) {
    asm volatile("s_waitcnt vmcnt(0)" ::: "memory");
    __syncthreads();
    if (threadIdx.x == 0) {
        unsigned* bar = b.bar;
        __builtin_amdgcn_s_waitcnt(0);
        unsigned nloc = b.st[0], nx = b.st[1];
        if (nloc == 0u) { xcd_barrier_complete(bar, b.x, nloc, nx); b.st[0] = nloc; b.st[1] = nx; }
        const unsigned old = xb_add(&bar[XB_XSUB(b.x)], 1u);
        const unsigned gen = old / nloc;
        if (old + 1u == (gen + 1u) * nloc) {
            __builtin_amdgcn_fence(__ATOMIC_RELEASE, "agent");
            asm volatile("s_waitcnt vmcnt(0)" ::: "memory");
            const unsigned og = xb_add(&bar[XB_TOP], 1u);
            const unsigned tg = og / nx;
            if (og + 1u == (tg + 1u) * nx) xb_add(&bar[XB_TOPGEN], 1u);
            else XB_SPIN(xb_ld(&bar[XB_TOPGEN]) == tg, bar);
            __builtin_amdgcn_fence(__ATOMIC_ACQUIRE, "agent");
            xb_add(&bar[XB_XGEN(b.x)], 1u);
            asm volatile("s_waitcnt vmcnt(0)" ::: "memory");
        } else {
            XB_SPIN(xb_ld(&bar[XB_XGEN(b.x)]) == gen, bar);
            __builtin_amdgcn_fence(__ATOMIC_ACQUIRE, "agent");
            asm volatile("s_waitcnt vmcnt(0)" ::: "memory");
        }
    }
    __syncthreads();
}
struct Args { const float* in[17]; float* out; unsigned char* ws; int ph_lo, ph_hi, li, pad; };
struct Frame {
    LAS unsigned char* lds;
    volatile LAS unsigned* MISC;
    gu32* ctl;
    int tid, lane, wave, vcu, G;
    gu32* qctr; unsigned tk;
};
#define F_x (A.in[0])
#define F_c (A.in[1])
#define F_ada_w (A.in[2])
#define F_ada_b (A.in[3])
#define F_norm_g (A.in[4])
#define F_w_in (A.in[5])
#define F_cmp_pe (A.in[6])
#define F_cmp_w1 (A.in[7])
#define F_cmp_w2 (A.in[8])
#define F_mix_g (A.in[9])
#define F_w_out (A.in[10])
#define F_router_w (A.in[11])
#define F_router_b (A.in[12])
#define F_w_gu (A.in[13])
#define F_b_gu (A.in[14])
#define F_w_dn (A.in[15])
#define F_b_dn (A.in[16])
#define F_out (A.out)
#define F_oss ((float*)(A.ws + WS_OSS))
#define F_x1b ((bf16*)(A.ws + WS_X1))
#define F_xmid ((bf16*)(A.ws + WS_X1 + (size_t)64 * MiB))
#define F_yt8 ((unsigned char*)(A.ws + WS_SA))
#define F_Wgu8 ((unsigned char*)(A.ws + WS_WGU))
#define F_Wdn8 ((unsigned char*)(A.ws + WS_WDN))
#define F_act8 ((unsigned char*)(A.ws + WS_ACT8))
#define F_sact8 ((unsigned char*)(A.ws + WS_SACT))
#define F_rwT ((float*)(A.ws + WS_RWT))
#define F_rw3 ((unsigned short*)(A.ws + WS_RW3))
#define F_rconst ((float*)(A.ws + WS_RCONST))
#define F_ocp ((bf16*)(A.ws + WS_OCP))
#define F_cw1T ((bf16*)(A.ws + WS_CW1T))
#define F_cw2T ((bf16*)(A.ws + WS_CW2T))
#define F_cconst ((float*)(A.ws + WS_CCONST))
#define F_list ((int*)(A.ws + WS_LIST))
#define F_lgate ((float*)(A.ws + WS_LGATE))
#define F_selm ((unsigned*)(A.ws + WS_SELM))
#define F_kcb ((bf16*)(A.ws + WS_KCB))
#define F_vcb ((bf16*)(A.ws + WS_VCB))
#define F_ropec ((float*)(A.ws + WS_ROPE))
#define F_ropes ((float*)(A.ws + WS_ROPE + (size_t)S * 8 * 4))
#define F_mod ((float*)(A.ws + WS_MOD))
#define F_kmean ((float*)(A.ws + WS_KMEAN))
#define F_kc ((float*)(A.ws + WS_KC))
#define F_vc ((float*)(A.ws + WS_VC))
#define F_x1 ((float*)(A.ws + WS_X1))
#define F_asg_gate ((float*)(A.ws + WS_ASG_GATE))
#define F_asg_e ((int*)(A.ws + WS_ASG_E))
#define F_asg_pos ((int*)(A.ws + WS_ASG_POS))
#define F_asg_row ((int*)(A.ws + WS_ASG_ROW))
#define F_WinT ((bf16*)(A.ws + WS_WIN))
#define F_WoutT ((bf16*)(A.ws + WS_WOUT))
#define F_WguT ((bf16*)(A.ws + WS_WGU))
#define F_WdnT ((bf16*)(A.ws + WS_WDN))
#define F_act ((bf16*)(A.ws + WS_ACT))
#define F_proj ((bf16*)(A.ws + WS_PROJ))
#define F_o ((bf16*)(A.ws + WS_O))
#define F_y ((bf16*)(A.ws + WS_Y))
#define F_sa ((bf16*)(A.ws + WS_SA))
#define F_sact ((bf16*)(A.ws + WS_SACT))

template <int CTRL> __device__ __forceinline__ float dpp_mov(float v) { return __builtin_bit_cast(float, __builtin_amdgcn_update_dpp(0, __builtin_bit_cast(int, v), CTRL, 0xF, 0xF, true)); }
__device__ __forceinline__ float rdl(float v, int l) { return __builtin_bit_cast(float, __builtin_amdgcn_readlane(__builtin_bit_cast(int, v), l)); }
__device__ __forceinline__ float wave_sum(float v) {
    v += dpp_mov<0xB1>(v); v += dpp_mov<0x4E>(v); v += dpp_mov<0x124>(v); v += dpp_mov<0x128>(v);
    return (rdl(v, 0) + rdl(v, 16)) + (rdl(v, 32) + rdl(v, 48));
}
__device__ __forceinline__ float wave_max(float v) {
#pragma unroll
    for (int o = 1; o < 64; o <<= 1) v = fmaxf(v, __shfl_xor(v, o));
    return v;
}
__device__ __forceinline__ void wave_argmax(float& v, int& i) {
#pragma unroll
    for (int o = 32; o >= 1; o >>= 1) { const float ov = __shfl_xor(v, o); const int oi = __shfl_xor(i, o); if (ov > v || (ov == v && oi < i)) { v = ov; i = oi; } }
}
__device__ __forceinline__ void loadq(float (&q)[64], const bf16* qp) {
    const v4u* p = (const v4u*)qp;
#pragma unroll
    for (int c = 0; c < 8; ++c) { const v4u v = p[c]; q[8*c+0] = bflo(v.x); q[8*c+1] = bfhi(v.x); q[8*c+2] = bflo(v.y); q[8*c+3] = bfhi(v.y); q[8*c+4] = bflo(v.z); q[8*c+5] = bfhi(v.z); q[8*c+6] = bflo(v.w); q[8*c+7] = bfhi(v.w); }
}
__device__ __forceinline__ float dot64(const float (&q)[64], const bf16* kp) {
    const v4u* p = (const v4u*)kp; float s = 0.f;
#pragma unroll
    for (int c = 0; c < 8; ++c) { const v4u v = p[c];
        s += q[8*c+0] * bflo(v.x); s += q[8*c+1] * bfhi(v.x); s += q[8*c+2] * bflo(v.y); s += q[8*c+3] * bfhi(v.y);
        s += q[8*c+4] * bflo(v.z); s += q[8*c+5] * bfhi(v.z); s += q[8*c+6] * bflo(v.w); s += q[8*c+7] * bfhi(v.w); }
    return s;
}
__device__ __forceinline__ float dot64l(const float (&q)[64], const LAS float* kp) {
    const LAS f32x4* p = (const LAS f32x4*)kp; float s = 0.f;
#pragma unroll
    for (int c = 0; c < 16; ++c) { const f32x4 v = p[c]; s += q[4*c+0] * v.x; s += q[4*c+1] * v.y; s += q[4*c+2] * v.z; s += q[4*c+3] * v.w; }
    return s;
}
__device__ __forceinline__ float dot64f(const float (&q)[64], const float* kp) {
    const f32x4* p = (const f32x4*)kp; float s = 0.f;
#pragma unroll
    for (int c = 0; c < 16; ++c) { const f32x4 v = p[c]; s += q[4*c+0] * v.x; s += q[4*c+1] * v.y; s += q[4*c+2] * v.z; s += q[4*c+3] * v.w; }
    return s;
}
__device__ __forceinline__ void acc8(float (&a)[8], float p, const v4u v) {
    a[0] += p * bflo(v.x); a[1] += p * bfhi(v.x); a[2] += p * bflo(v.y); a[3] += p * bfhi(v.y); a[4] += p * bflo(v.z); a[5] += p * bfhi(v.z); a[6] += p * bflo(v.w); a[7] += p * bfhi(v.w);
}
__device__ __forceinline__ void red8(float (&a)[8]) {
#pragma unroll
    for (int j = 0; j < 8; ++j) { a[j] += __shfl_xor(a[j], 8); a[j] += __shfl_xor(a[j], 16); a[j] += __shfl_xor(a[j], 32); }
}
__device__ __forceinline__ void list_attn(const float (&q)[64], int n, LAS float* P, const LAS int* KR, const bf16* Kb, const bf16* Vb, int lane, float (&o)[8]) {
    float mx = -3e38f;
    for (int i = lane; i < n; i += 64) { const float s = dot64(q, Kb + (size_t)KR[i] * PW) * 0.125f; P[i] = s; mx = fmaxf(mx, s); }
    mx = wave_max(mx);
    float sum = 0.f;
    for (int i = lane; i < n; i += 64) { const float e = __expf(P[i] - mx); P[i] = e; sum += e; }
    sum = wave_sum(sum);
    const float inv = (n > 0) ? 1.f / sum : 0.f;
    LDS_WAIT();
    const int kg = lane >> 3, dg = lane & 7;
    float a[8];
#pragma unroll
    for (int j = 0; j < 8; ++j) a[j] = 0.f;
    for (int i = kg; i < n; i += 8) { const float p = P[i]; const v4u v = *(const v4u*)(Vb + (size_t)KR[i] * PW + dg * 8); acc8(a, p, v); }
    red8(a);
#pragma unroll
    for (int j = 0; j < 8; ++j) o[j] = a[j] * inv;
    LDS_WAIT();
}
__device__ __forceinline__ float sigmoidf_(float v) { return 1.f / (1.f + __expf(-v)); }
template <class RM> __device__ __forceinline__ void tr_item(const float* W, int K, int N, bf16* WT, LAS float* scr, int kb, int nb, int lane, RM rm) {
    const int k0 = 64 * kb, n0 = 32 * nb; const int n = n0 + (lane & 31);
#pragma unroll 8
    for (int i = 0; i < 32; ++i) { const int kk = 2 * i + (lane >> 5); scr[kk * 33 + (lane & 31)] = (n < N) ? W[(size_t)(k0 + kk) * N + n] : 0.f; }
    LDS_WAIT(); asm volatile("" ::: "memory");
    const int c = lane & 7;
#pragma unroll
    for (int j = 0; j < 4; ++j) { const int nn = (lane >> 3) + 8 * j; const LAS float* s = scr + (8 * c) * 33 + nn;
        v4u o; o.x = pk2(s[0 * 33], s[1 * 33]); o.y = pk2(s[2 * 33], s[3 * 33]); o.z = pk2(s[4 * 33], s[5 * 33]); o.w = pk2(s[6 * 33], s[7 * 33]);
        if (n0 + nn < N) *(v4u*)(WT + (size_t)rm(n0 + nn) * K + k0 + 8 * c) = o; }
    LDS_WAIT(); asm volatile("" ::: "memory");
}
template <class RM> __device__ __forceinline__ void tr_item64(const float* W, int K, int N, bf16* WT, LAS float* scr, int kb, int nb, int lane, RM rm, const float* kgain = nullptr) {
    const int k0 = 64 * kb, n0 = 64 * nb; const float* src = W + (size_t)(k0 + (lane >> 4)) * N + n0 + (lane & 15) * 4;
    f32x4 v[16];
#pragma unroll
    for (int i = 0; i < 16; ++i) v[i] = *(const f32x4*)(src + (size_t)(4 * i) * N);
#pragma unroll
    for (int i = 0; i < 16; ++i) *(LAS f32x4*)(scr + ((lane >> 4) + 4 * i) * 64 + (lane & 15) * 4) = v[i];
    LDS_WAIT(); asm volatile("" ::: "memory");
#pragma unroll
    for (int j = 0; j < 2; ++j)
#pragma unroll
        for (int c = 0; c < 4; ++c) { const int n = (lane & 31) + 32 * j, kc = (lane >> 5) + 2 * c; const LAS float* s = scr + (8 * kc) * 64 + n;
            f32x4 g0 = {1.f, 1.f, 1.f, 1.f}, g1 = g0; if (kgain) { g0 = *(const f32x4*)(kgain + k0 + 8 * kc); g1 = *(const f32x4*)(kgain + k0 + 8 * kc + 4); }
            v4u o; o.x = pk2(s[0 * 64] * g0.x, s[1 * 64] * g0.y); o.y = pk2(s[2 * 64] * g0.z, s[3 * 64] * g0.w); o.z = pk2(s[4 * 64] * g1.x, s[5 * 64] * g1.y); o.w = pk2(s[6 * 64] * g1.z, s[7 * 64] * g1.w);
            *(v4u*)(WT + (size_t)rm(n0 + n) * K + k0 + 8 * kc) = o; }
    LDS_WAIT(); asm volatile("" ::: "memory");
}
template <class RM> __device__ __forceinline__ void tr_item64_f8(const float* W, int K, int N, unsigned char* WT, LAS float* scr, int kb, int nb, int lane, RM rm) {
    const int k0 = 64 * kb, n0 = 64 * nb; const float* src = W + (size_t)(k0 + (lane >> 4)) * N + n0 + (lane & 15) * 4;
    f32x4 v[16];
#pragma unroll
    for (int i = 0; i < 16; ++i) v[i] = __builtin_nontemporal_load((const f32x4*)(src + (size_t)(4 * i) * N));
#pragma unroll
    for (int i = 0; i < 16; ++i) *(LAS f32x4*)(scr + ((lane >> 4) + 4 * i) * 64 + (lane & 15) * 4) = v[i];
    LDS_WAIT(); asm volatile("" ::: "memory");
    v2u o[2][4];
#pragma unroll
    for (int j = 0; j < 2; ++j)
#pragma unroll
        for (int c = 0; c < 4; ++c) { const int n = (lane & 31) + 32 * j, kc = (lane >> 5) + 2 * c; const LAS float* s = scr + (8 * kc) * 64 + n;
            o[j][c].x = pg8::pk4_fp8(s[0 * 64] * pg8::W8_SCALE, s[1 * 64] * pg8::W8_SCALE, s[2 * 64] * pg8::W8_SCALE, s[3 * 64] * pg8::W8_SCALE);
            o[j][c].y = pg8::pk4_fp8(s[4 * 64] * pg8::W8_SCALE, s[5 * 64] * pg8::W8_SCALE, s[6 * 64] * pg8::W8_SCALE, s[7 * 64] * pg8::W8_SCALE); }
    LDS_WAIT(); asm volatile("" ::: "memory");
    LAS unsigned char* ob = (LAS unsigned char*)scr;
#pragma unroll
    for (int j = 0; j < 2; ++j)
#pragma unroll
        for (int c = 0; c < 4; ++c) { const int n = (lane & 31) + 32 * j, kc = (lane >> 5) + 2 * c; *(LAS v2u*)(ob + n * 80 + kc * 8) = o[j][c]; }
    LDS_WAIT(); asm volatile("" ::: "memory");
#pragma unroll
    for (int r = 0; r < 4; ++r) { const int row = (lane >> 2) + 16 * r, ch = lane & 3; const v4u w = *(const LAS v4u*)(ob + row * 80 + ch * 16);
        *(v4u*)(WT + (size_t)rm(n0 + row) * K + k0 + ch * 16) = w; }
    LDS_WAIT(); asm volatile("" ::: "memory");
}
template <class RM> __device__ __forceinline__ void tr_item128_f8(const float* W, int K, int N, unsigned char* WT, LAS float* scr, int kb, int nb, int lane, RM rm) {
    const int k0 = 128 * kb, n0 = 32 * nb; const float* src = W + (size_t)(k0 + (lane >> 3)) * N + n0 + (lane & 7) * 4;
    f32x4 v[16];
#pragma unroll
    for (int i = 0; i < 16; ++i) v[i] = __builtin_nontemporal_load((const f32x4*)(src + (size_t)(8 * i) * N));
#pragma unroll
    for (int i = 0; i < 16; ++i) *(LAS f32x4*)(scr + ((lane >> 3) + 8 * i) * 32 + (lane & 7) * 4) = v[i];
    LDS_WAIT(); asm volatile("" ::: "memory");
    v2u o[8];
#pragma unroll
    for (int c = 0; c < 8; ++c) { const int n = lane & 31, kc = (lane >> 5) + 2 * c; const LAS float* s = scr + (8 * kc) * 32 + n;
        o[c].x = pg8::pk4_fp8(s[0 * 32] * pg8::W8_SCALE, s[1 * 32] * pg8::W8_SCALE, s[2 * 32] * pg8::W8_SCALE, s[3 * 32] * pg8::W8_SCALE);
        o[c].y = pg8::pk4_fp8(s[4 * 32] * pg8::W8_SCALE, s[5 * 32] * pg8::W8_SCALE, s[6 * 32] * pg8::W8_SCALE, s[7 * 32] * pg8::W8_SCALE); }
    LDS_WAIT(); asm volatile("" ::: "memory");
    LAS unsigned char* ob = (LAS unsigned char*)scr;
#pragma unroll
    for (int c = 0; c < 8; ++c) { const int n = lane & 31, kc = (lane >> 5) + 2 * c; *(LAS v2u*)(ob + n * 144 + kc * 8) = o[c]; }
    LDS_WAIT(); asm volatile("" ::: "memory");
#pragma unroll
    for (int r = 0; r < 4; ++r) { const int row = (lane >> 3) + 8 * r, ch = lane & 7; const v4u w = *(const LAS v4u*)(ob + row * 144 + ch * 16);
        *(v4u*)(WT + (size_t)rm(n0 + row) * K + k0 + ch * 16) = w; }
    LDS_WAIT(); asm volatile("" ::: "memory");
}
struct RmId { __device__ __forceinline__ int operator()(int n) const { return n; } };
struct RmDn { __device__ __forceinline__ int operator()(int n) const { const int c = n & 255; return (n & ~255) + ((c >> 3) & 1) * 128 + (c >> 6) * 32 + ((c >> 4) & 3) * 8 + (c & 7); } };
struct RmWin { __device__ __forceinline__ int operator()(int n) const { return n < 1536 ? n : (n < 1554 ? C_GB + (n - 1536) : n - 18); } };
struct RmGu { __device__ __forceinline__ int operator()(int n) const { const int h = n >> 10, r = n & 1023; return (r >> 7) * 256 + h * 128 + (r & 127); } };

__device__ __forceinline__ void p0_prologue(Frame& F, const Args& A) {
    LAS float* scr = (LAS float*)(F.lds + F.wave * 16384);
    const int gw = F.vcu * NWAVES + F.wave, NGW = F.G * NWAVES, lane = F.lane;
    constexpr int I_GU = NL * NE * 16 * 32, I_DN = NL * NE * 16 * 16, I_IN = NL * 16 * 85, I_OUT = NL * 16 * 16, I_MOD = NL * 96, I_C1 = NL * 2 * 32 * 2, I_C2 = NL * 2 * 2, I_CC = NL * 2 * 16;
    constexpr int NITEMS = I_GU + I_DN + I_IN + I_OUT + I_C1 + I_C2;
    for (int wi = F.vcu; wi < I_MOD + I_CC; wi += F.G) {
        LAS float* red = (LAS float*)F.lds;
        if (wi < I_MOD) {
            const int l = wi / 96, cb = (wi % 96) * 64, col = cb + lane; const float* w = F_ada_w + (size_t)l * D * 6 * D + col;
            float a[NB];
#pragma unroll
            for (int b = 0; b < NB; ++b) a[b] = 0.f;
#pragma unroll 1
            for (int k0 = 128 * F.wave; k0 < 128 * F.wave + 128; k0 += 64) {
                float wv[64]; float sv[8];
#pragma unroll
                for (int kk = 0; kk < 64; ++kk) wv[kk] = w[(size_t)(k0 + kk) * 6 * D];
#pragma unroll
                for (int g = 0; g < 8; ++g) { const float cv = F_c[(lane >> 3) * D + k0 + 8 * g + (lane & 7)]; sv[g] = cv / (1.f + __expf(-cv)); }
#pragma unroll
                for (int g = 0; g < 8; ++g)
#pragma unroll
                    for (int kk = 0; kk < 8; ++kk)
#pragma unroll
                        for (int b = 0; b < NB; ++b) a[b] += __builtin_bit_cast(float, __builtin_amdgcn_readlane(__builtin_bit_cast(int, sv[g]), b * 8 + kk)) * wv[8 * g + kk]; }
#pragma unroll
            for (int b = 0; b < NB; ++b) red[(F.wave * NB + b) * 64 + lane] = a[b];
            __syncthreads();
            { const int b = F.tid >> 6; float t = 0.f;
#pragma unroll
              for (int w8 = 0; w8 < 8; ++w8) t += red[(w8 * NB + b) * 64 + lane];
              F_mod[((size_t)l * NB + b) * 6 * D + col] = t + F_ada_b[l * 6 * D + col]; }
            __syncthreads();
        } else {
            const int r = wi - I_MOD, lw = r >> 4, part = r & 15; const float* pe = F_cmp_pe + (size_t)lw * 2048 + part * 128 + 16 * F.wave; const float* w1 = F_cmp_w1 + ((size_t)lw * 2048 + part * 128 + 16 * F.wave) * 64 + lane; float a = 0.f;
#pragma unroll
            for (int k = 0; k < 16; ++k) a += pe[k] * w1[(size_t)k * 64];
            red[F.wave * 64 + lane] = a;
            __syncthreads();
            if (F.tid < 64) { float t = 0.f;
#pragma unroll
              for (int w8 = 0; w8 < 8; ++w8) t += red[w8 * 64 + lane];
              F_cconst[(size_t)r * 64 + lane] = t; }
            __syncthreads();
        }
    }
    for (int it = gw; it < NITEMS; it += NGW) {
        int r = it;
        if (r < I_GU) { const int le = r >> 9, q = r & 511; tr_item128_f8(F_w_gu + (size_t)le * D * 2048, D, 2048, F_Wgu8 + (size_t)le * 2048 * D, scr, q >> 6, q & 63, lane, RmGu()); continue; } r -= I_GU;
        if (r < I_DN) { const int le = r >> 8, q = r & 255; tr_item128_f8(F_w_dn + (size_t)le * D * D, D, D, F_Wdn8 + (size_t)le * D * D, scr, q >> 5, q & 31, lane, RmDn()); continue; } r -= I_DN;
        if (r < I_IN) { const int l = r / (16 * 85), q = r % (16 * 85); tr_item(F_w_in + (size_t)l * D * INW, D, INW, F_WinT + (size_t)l * PW * D, scr, q / 85, q % 85, lane, RmWin()); continue; } r -= I_IN;
        if (r < I_OUT) { const int l = r >> 8, q = r & 255; tr_item64(F_w_out + (size_t)l * D * D, D, D, F_WoutT + (size_t)l * D * D, scr, q >> 4, q & 15, lane, RmId(), F_mix_g + (size_t)l * D); continue; } r -= I_OUT;
        if (r < I_C1) { const int lw = r >> 6, q = r & 63; tr_item(F_cmp_w1 + (size_t)lw * 2048 * 64, 2048, 64, F_cw1T + (size_t)lw * 64 * 2048, scr, q >> 1, q & 1, lane, RmId()); continue; } r -= I_C1;
        if (r < I_C2) { const int lw = r >> 1, q = r & 1; tr_item(F_cmp_w2 + (size_t)lw * 64 * 64, 64, 64, F_cw2T + (size_t)lw * 64 * 64, scr, 0, q, lane, RmId()); continue; } r -= I_C2;
    }
    const int gt = F.vcu * (NWAVES * 64) + F.tid, NGT = F.G * NWAVES * 64;
    for (int i = gt; i < NL * (PW - INW) * (D / 8); i += NGT) { const int l = i / ((PW - INW) * (D / 8)), q = i % ((PW - INW) * (D / 8));
        *(v4u*)(F_WinT + ((size_t)l * PW + INW + q / (D / 8)) * D + (q % (D / 8)) * 8) = (v4u){0u, 0u, 0u, 0u}; }
    for (int i = gt; i < NL * NB * 4 * 16 * 64; i += NGT) F_kmean[i] = 0.f;
    for (int i = gt; i < S * 8; i += NGT) { const int t = i >> 3, f = i & 7; const double inv = pow(500000.0, -(double)f / 8.0); const double ang = (double)t * inv;
        F_ropec[i] = (float)cos(ang); F_ropes[i] = (float)sin(ang); }
}
__device__ __forceinline__ void mod_norm_row(const f32x4 (&v)[4], const float* g, const float* sc, const float* sh, bf16* orow, int lane) {
    float ss = 0.f;
#pragma unroll
    for (int j = 0; j < 4; ++j) ss += (v[j].x * v[j].x + v[j].y * v[j].y) + (v[j].z * v[j].z + v[j].w * v[j].w);
    const float rs = __builtin_amdgcn_rsqf(wave_sum(ss) * (1.f / D) + RMS_EPS);
#pragma unroll
    for (int j = 0; j < 4; ++j) { const int c = 4 * lane + 256 * j; const f32x4 gg = *(const f32x4*)(g + c), s1 = *(const f32x4*)(sc + c), s0 = *(const f32x4*)(sh + c);
        const f32x4 r = v[j] * rs * gg * (s1 + 1.f) + s0; v2u w; w.x = pk2(r.x, r.y); w.y = pk2(r.z, r.w); *(v2u*)(orow + c) = w; }
}
__device__ __forceinline__ void mod_norm_row_l(const f32x4 (&v)[4], const LAS float* cA, const LAS float* cS, bf16* orow, int lane) {
    float ss = 0.f;
#pragma unroll
    for (int j = 0; j < 4; ++j) ss += (v[j].x * v[j].x + v[j].y * v[j].y) + (v[j].z * v[j].z + v[j].w * v[j].w);
    const float rs = __builtin_amdgcn_rsqf(wave_sum(ss) * (1.f / D) + RMS_EPS);
#pragma unroll
    for (int j = 0; j < 4; ++j) { const int c = 4 * lane + 256 * j; const f32x4 a = *(const LAS f32x4*)(cA + c), s0 = *(const LAS f32x4*)(cS + c);
        const f32x4 r = v[j] * rs * a + s0; v2u w; w.x = pk2(r.x, r.y); w.y = pk2(r.z, r.w); *(v2u*)(orow + c) = w; }
}
__device__ __forceinline__ void router_tables(Frame& F, const Args& A, int q, int nq) {
    for (int it = q * NWAVES + F.wave; it < NL * NB * NE; it += nq * NWAVES) { const int e = it & 31, b = (it >> 5) & 7, l = it >> 8; const float* md = F_mod + ((size_t)l * NB + b) * 6 * D; const float* g2 = F_norm_g + ((size_t)l * 4 + 2) * D;
        const float* rw = F_router_w + (size_t)l * D * NE + e; float cs = 0.f;
#pragma unroll
        for (int j = 0; j < 16; ++j) { const int k = F.lane + 64 * j; const float w = rw[(size_t)k * NE]; const float v = g2[k] * (1.f + md[4 * D + k]) * w; cs += md[3 * D + k] * w;
            const unsigned h0 = f2bf(v); const float r1 = v - bflo(h0); const unsigned h1 = f2bf(r1); const unsigned h2 = f2bf(r1 - bflo(h1));
            unsigned short* pl = F_rw3 + (size_t)it * 3 * D + k; pl[0] = (unsigned short)h0; pl[D] = (unsigned short)h1; pl[2 * D] = (unsigned short)h2; }
        cs = wave_sum(cs); if (F.lane == 0) F_rconst[it] = cs + F_router_b[l * NE + e]; }
}
__device__ __forceinline__ void phase_hm0(Frame& F, const Args& A) {
    const int gw = F.vcu * NWAVES + F.wave, NGW = F.G * NWAVES;
    for (int chunk = blockIdx.x; chunk < NTOK / 128; chunk += F.G) {
        f32x4 va[4], vb[4]; const int tok0 = chunk * 128 + F.wave * 16; const float* md_ = F_mod + (size_t)(tok0 >> 12) * 6 * D;
        LAS float* cA = (LAS float*)(F.lds + 65536); LAS float* cS = cA + D;
#define HM_LOAD(V, T) { const f32x4* xr_ = (const f32x4*)(F_x + (size_t)(T) * D) + F.lane; _Pragma("unroll") for (int j = 0; j < 4; ++j) V[j] = __builtin_nontemporal_load(xr_ + 64 * j); }
#define HM_DO(V, T) mod_norm_row_l(V, cA, cS, F_act + (size_t)(T) * D, F.lane)
        HM_LOAD(va, tok0);
        __syncthreads();
        for (int i = F.tid; i < D; i += NWAVES * 64) { cA[i] = F_norm_g[i] * (md_[D + i] + 1.f); cS[i] = md_[i]; }
        __syncthreads();
        for (int i = 0; i < 16; i += 2) {
            HM_LOAD(vb, tok0 + i + 1);
            HM_DO(va, tok0 + i);
            if (i + 2 < 16) HM_LOAD(va, tok0 + i + 2);
            HM_DO(vb, tok0 + i + 1);
        }
#undef HM_LOAD
#undef HM_DO
    }
}
typedef short c16x8 __attribute__((ext_vector_type(8)));
__device__ __forceinline__ void phase_compress(Frame& F, const Args& A, int l) {
    const int lane = F.lane, fr = lane & 15, fq = lane >> 4;
    LAS unsigned short* h1s = (LAS unsigned short*)F.lds;
    LAS f32x4* red = (LAS f32x4*)(F.lds + 16384);
    for (int it = blockIdx.x; it < NB * 2 * 16; it += F.G) { const int nt = it & 15, which = (it >> 4) & 1, b = it >> 5;
        const bf16* w1t = F_cw1T + ((size_t)l * 2 + which) * 64 * 2048; const bf16* w2t = F_cw2T + ((size_t)l * 2 + which) * 64 * 64; const float* cc = F_cconst + ((size_t)l * 2 + which) * 16 * 64;
        const int n = 16 * nt + fr;
        f32x4 acc[4];
#pragma unroll
        for (int jt = 0; jt < 4; ++jt) acc[jt] = (f32x4){0.f, 0.f, 0.f, 0.f};
#pragma unroll
        for (int k8 = 0; k8 < 8; ++k8) { const int ks = 8 * F.wave + k8; int tokn = 16 * n + (ks >> 1); if (tokn > S - 1) tokn = S - 1;
            const c16x8 a = *(const c16x8*)(F_proj + ((size_t)b * S + tokn) * PW + C_KVB + which * 64 + 32 * (ks & 1) + 8 * fq);
#pragma unroll
            for (int jt = 0; jt < 4; ++jt) { const c16x8 bb = *(const c16x8*)(w1t + (size_t)(jt * 16 + fr) * 2048 + 32 * ks + 8 * fq); acc[jt] = __builtin_amdgcn_mfma_f32_16x16x32_bf16(a, bb, acc[jt], 0, 0, 0); } }
        __syncthreads();
#pragma unroll
        for (int jt = 0; jt < 4; ++jt) red[(F.wave * 4 + jt) * 64 + lane] = acc[jt];
        __syncthreads();
        if (F.wave == 0) {
#pragma unroll
        for (int jt = 0; jt < 4; ++jt) { f32x4 t = red[jt * 64 + lane];
#pragma unroll
            for (int w8 = 1; w8 < 8; ++w8) t = t + red[(w8 * 4 + jt) * 64 + lane];
            acc[jt] = t; }
#pragma unroll
        for (int jt = 0; jt < 4; ++jt) { float cj = 0.f;
#pragma unroll
            for (int part = 0; part < 16; ++part) cj += cc[part * 64 + jt * 16 + fr];
#pragma unroll
            for (int r = 0; r < 4; ++r) { const float v = acc[jt][r] + cj; h1s[(4 * fq + r) * 72 + jt * 16 + fr] = (unsigned short)f2bf(v / (1.f + __expf(-v))); } }
        LDS_WAIT(); asm volatile("" ::: "memory");
        f32x4 o2[4];
#pragma unroll
        for (int jt = 0; jt < 4; ++jt) o2[jt] = (f32x4){0.f, 0.f, 0.f, 0.f};
#pragma unroll
        for (int ks = 0; ks < 2; ++ks) { const c16x8 a = *(const LAS c16x8*)(h1s + fr * 72 + 32 * ks + 8 * fq);
#pragma unroll
            for (int jt = 0; jt < 4; ++jt) { const c16x8 bb = *(const c16x8*)(w2t + (size_t)(jt * 16 + fr) * 64 + 32 * ks + 8 * fq); o2[jt] = __builtin_amdgcn_mfma_f32_16x16x32_bf16(a, bb, o2[jt], 0, 0, 0); } }
        bf16* dst = (which ? F_vcb : F_kcb) + (size_t)b * 256 * 64;
#pragma unroll
        for (int jt = 0; jt < 4; ++jt)
#pragma unroll
            for (int r = 0; r < 4; ++r) { const int nn = 16 * nt + 4 * fq + r; dst[(size_t)nn * 64 + jt * 16 + fr] = (bf16)f2bf(nn < 255 ? o2[jt][r] : 0.f); }
        LDS_WAIT(); asm volatile("" ::: "memory");
        }
    }
    __syncthreads();
}
typedef float f32x16 __attribute__((ext_vector_type(16)));
typedef short s16x8 __attribute__((ext_vector_type(8)));
typedef short s16x4 __attribute__((ext_vector_type(4)));
constexpr int KP = 144, VP = 192, KT_BYTES = 64 * KP, VT_BYTES = 64 * VP, TB_BYTES = KT_BYTES + VT_BYTES;
constexpr float QSCALE_LOG2 = 0.125f * 1.4426950408889634f;
#define NEGINF (-__builtin_inff())
struct TileRegs { v4u k, v; };
__device__ __forceinline__ void tile_load(TileRegs& R, const bf16* Kg, const bf16* Vg, size_t pitch, int tid) {
    const int r = tid >> 3, c = tid & 7; R.k = *(const v4u*)(Kg + (size_t)r * pitch + c * 8); R.v = *(const v4u*)(Vg + (size_t)r * pitch + c * 8); }
__device__ __forceinline__ void tile_store(const TileRegs& R, LAS unsigned char* buf, int tid) {
    const int r = tid >> 3, c = tid & 7; *(LAS v4u*)(buf + r * KP + c * 16) = R.k; *(LAS v4u*)(buf + KT_BYTES + r * VP + c * 16) = R.v; }
__device__ __forceinline__ s16x8 pack8(float a0, float a1, float a2, float a3, float a4, float a5, float a6, float a7) {
    v4u w; w.x = pg8::cvt_pk_bf16(a0, a1); w.y = pg8::cvt_pk_bf16(a2, a3); w.z = pg8::cvt_pk_bf16(a4, a5); w.w = pg8::cvt_pk_bf16(a6, a7); return __builtin_bit_cast(s16x8, w); }
__device__ __forceinline__ void load_qfrags(s16x8 (&qf)[4], const bf16* qrow, float sc, int lane) {
#pragma unroll
    for (int ks = 0; ks < 4; ++ks) { const v4u v = *(const v4u*)(qrow + 16 * ks + 8 * (lane >> 5));
        qf[ks] = pack8(bflo(v.x) * sc, bfhi(v.x) * sc, bflo(v.y) * sc, bfhi(v.y) * sc, bflo(v.z) * sc, bfhi(v.z) * sc, bflo(v.w) * sc, bfhi(v.w) * sc); }
}
__device__ __forceinline__ void qk_tile(f32x16 (&p)[2], const LAS unsigned char* kb, const s16x8 (&qf)[4], int lane, float init = 0.f) {
    const LAS unsigned char* a = kb + (lane & 31) * KP + (lane >> 5) * 16;
    s16x8 kf[2][4];
#pragma unroll
    for (int T = 0; T < 2; ++T)
#pragma unroll
        for (int ks = 0; ks < 4; ++ks) kf[T][ks] = *(const LAS s16x8*)(a + T * 32 * KP + ks * 32);
#pragma unroll
    for (int T = 0; T < 2; ++T) {
#pragma unroll
        for (int j = 0; j < 16; ++j) p[T][j] = init;
#pragma unroll
        for (int ks = 0; ks < 4; ++ks) p[T] = __builtin_amdgcn_mfma_f32_32x32x16_bf16(kf[T][ks], qf[ks], p[T], 0, 0, 0); }
}
__device__ __forceinline__ void pv_tile(f32x16 (&o)[2], const LAS unsigned char* vb, const s16x8 (&pf)[4], int lane) {
    const LAS unsigned char* base = vb + (4 * (lane >> 5) + ((lane & 15) >> 2)) * VP + (16 * ((lane >> 4) & 1) + 4 * (lane & 3)) * 2;
    v2u lo[2][4], hi[2][4];
#pragma unroll
    for (int dt = 0; dt < 2; ++dt)
#pragma unroll
        for (int c = 0; c < 4; ++c) {
            lo[dt][c] = __builtin_bit_cast(v2u, __builtin_amdgcn_ds_read_tr16_b64_v4i16((LAS s16x4*)(base + c * 16 * VP + dt * 64)));
            hi[dt][c] = __builtin_bit_cast(v2u, __builtin_amdgcn_ds_read_tr16_b64_v4i16((LAS s16x4*)(base + c * 16 * VP + 8 * VP + dt * 64))); }
#pragma unroll
    for (int dt = 0; dt < 2; ++dt)
#pragma unroll
        for (int c = 0; c < 4; ++c) { const s16x8 vf = __builtin_bit_cast(s16x8, (v4u){lo[dt][c].x, lo[dt][c].y, hi[dt][c].x, hi[dt][c].y});
            o[dt] = __builtin_amdgcn_mfma_f32_32x32x16_bf16(vf, pf[c], o[dt], 0, 0, 0); }
}
__device__ __forceinline__ float half_max(float v) { const unsigned u = __builtin_bit_cast(unsigned, v); auto rr = __builtin_amdgcn_permlane32_swap(u, u, false, false);
    return fmaxf(__builtin_bit_cast(float, rr[0]), __builtin_bit_cast(float, rr[1])); }
__device__ __forceinline__ void softmax_step(f32x16 (&p)[2], f32x16 (&o)[2], float& m, float& l, s16x8 (&pf)[4], bool keep) {
    float tm = fmaxf(p[0][0], p[1][0]);
#pragma unroll
    for (int j = 1; j < 16; ++j) tm = fmaxf(tm, fmaxf(p[0][j], p[1][j]));
    tm = keep ? half_max(tm) : NEGINF;
    const bool grow = (m == NEGINF) ? (tm > NEGINF) : (tm > 8.f);
    if (__builtin_amdgcn_ballot_w64(grow) != 0ull) {
        const float mu = (m == NEGINF) ? 0.f : m, tabs = tm + mu;
        const float mn = fmaxf(m, tabs), mu0 = (mn == NEGINF) ? 0.f : mn; const float alpha = __builtin_amdgcn_exp2f(m - mu0), shift = mu0 - mu;
        m = mn; l *= alpha;
#pragma unroll
        for (int dt = 0; dt < 2; ++dt)
#pragma unroll
            for (int j = 0; j < 16; ++j) o[dt][j] *= alpha;
#pragma unroll
        for (int T = 0; T < 2; ++T)
#pragma unroll
            for (int j = 0; j < 16; ++j) p[T][j] -= shift; }
    float s = 0.f;
#pragma unroll
    for (int T = 0; T < 2; ++T)
#pragma unroll
        for (int j = 0; j < 16; ++j) { p[T][j] = __builtin_amdgcn_exp2f(p[T][j]); s += p[T][j]; }
    l += s;
#pragma unroll
    for (int c = 0; c < 4; ++c) { const int T = c >> 1, b8 = (c & 1) * 8;
        pf[c] = pack8(p[T][b8 + 0], p[T][b8 + 1], p[T][b8 + 2], p[T][b8 + 3], p[T][b8 + 4], p[T][b8 + 5], p[T][b8 + 6], p[T][b8 + 7]); }
}
#define EOFF(T, j) (32 * (T) + 8 * ((j) >> 2) + ((j) & 3))
__device__ __forceinline__ void mask_le(f32x16 (&p)[2], int lim) {
#pragma unroll
    for (int T = 0; T < 2; ++T)
#pragma unroll
        for (int j = 0; j < 16; ++j) p[T][j] = (EOFF(T, j) <= lim) ? p[T][j] : NEGINF;
}
__device__ __forceinline__ void mask_ge(f32x16 (&p)[2], int lim) {
#pragma unroll
    for (int T = 0; T < 2; ++T)
#pragma unroll
        for (int j = 0; j < 16; ++j) p[T][j] = (EOFF(T, j) >= lim) ? p[T][j] : NEGINF;
}
__device__ __forceinline__ void mask_all(f32x16 (&p)[2], bool keep) {
#pragma unroll
    for (int T = 0; T < 2; ++T)
#pragma unroll
        for (int j = 0; j < 16; ++j) p[T][j] = keep ? p[T][j] : NEGINF;
}
__device__ __forceinline__ void store_o(const f32x16 (&o)[2], float sc, bf16* orow, int lane, float* stat = nullptr) {
    float ss = 0.f;
#pragma unroll
    for (int dt = 0; dt < 2; ++dt)
#pragma unroll
        for (int g = 0; g < 4; ++g) { const float a0 = o[dt][4 * g] * sc, a1 = o[dt][4 * g + 1] * sc, a2 = o[dt][4 * g + 2] * sc, a3 = o[dt][4 * g + 3] * sc; ss += (a0 * a0 + a1 * a1) + (a2 * a2 + a3 * a3);
            v2u w; w.x = pg8::cvt_pk_bf16(a0, a1); w.y = pg8::cvt_pk_bf16(a2, a3);
            *(v2u*)(orow + 32 * dt + 8 * g + 4 * (lane >> 5)) = w; }
    if (stat) { ss += __shfl_xor(ss, 32); if (lane < 32) *stat = ss; }
}
__device__ __forceinline__ int wq_next(Frame& F, gu32* ctr) {
    __syncthreads(); if (F.tid == 0) F.MISC[0] = __hip_atomic_fetch_add(ctr, 1u, RLX_AGENT); __syncthreads(); return (int)F.MISC[0]; }
__device__ __forceinline__ void wq_prefetch(Frame& F) { if (F.tid == 0) F.tk = __hip_atomic_fetch_add(F.qctr, 1u, RLX_AGENT); }

__device__ __forceinline__ void sb_unit(Frame& F, const Args& A, int u) {
    const int qt = 15 - (u & 15), bh = u >> 4, h = bh % 6, b = bh / 6, lane = F.lane, w = F.wave, hi = lane >> 5;
    const int t0 = 256 * qt + 32 * w, tq = t0 + (lane & 31); const size_t tok = (size_t)b * S + tq;
    s16x8 qf[4]; load_qfrags(qf, F_proj + tok * PW + C_QC + h * 64, QSCALE_LOG2, lane);
    f32x16 o[2];
#pragma unroll
    for (int dt = 0; dt < 2; ++dt)
#pragma unroll
        for (int j = 0; j < 16; ++j) o[dt][j] = 0.f;
    float carry = 0.f; bool wdone = false;
    const bf16* Kb = F_proj + (size_t)b * S * PW + C_KC + h * 64; const bf16* Vb = F_proj + (size_t)b * S * PW + C_VC + h * 64;
    volatile LAS unsigned* flag = F.MISC + 16;
    TileRegs R;
    int kt = 4 * qt + 3;
    __syncthreads();
    tile_load(R, Kb + (size_t)kt * 64 * PW, Vb + (size_t)kt * 64 * PW, PW, F.tid); tile_store(R, F.lds, F.tid);
    __syncthreads();
    for (int i = 0;; ++i, --kt) {
        const bool more = kt > 0;
        if (more) tile_load(R, Kb + (size_t)(kt - 1) * 64 * PW, Vb + (size_t)(kt - 1) * 64 * PW, PW, F.tid);
        const LAS unsigned char* buf = F.lds + (i & 1) * TB_BYTES;
        if (!wdone && 64 * kt <= t0 + 30) {
            f32x16 z[2]; qk_tile(z, buf, qf, lane);
            const int lim = tq - 64 * kt - 4 * hi - 1;
            f32x16 lk[2];
#pragma unroll
            for (int T = 0; T < 2; ++T)
#pragma unroll
                for (int j = 0; j < 16; ++j) { const float zz = z[T][j]; const float L = fmaxf(zz, 0.f) + __builtin_amdgcn_logf(1.f + __builtin_amdgcn_exp2f(-fabsf(zz)));
                    const bool valid = EOFF(T, j) <= lim; lk[T][j] = valid ? -L : 0.f; z[T][j] = valid ? zz - L : NEGINF; }
            float gs[2][4]; f32x16 inl[2];
#pragma unroll
            for (int T = 0; T < 2; ++T)
#pragma unroll
                for (int g = 0; g < 4; ++g) { const float s3 = lk[T][4 * g + 3], s2 = s3 + lk[T][4 * g + 2], s1 = s2 + lk[T][4 * g + 1]; gs[T][g] = s1 + lk[T][4 * g];
                    inl[T][4 * g + 3] = 0.f; inl[T][4 * g + 2] = s3; inl[T][4 * g + 1] = s2; inl[T][4 * g] = s1; }
            float run = carry;
#pragma unroll
            for (int T = 1; T >= 0; --T)
#pragma unroll
                for (int g = 3; g >= 0; --g) { const float gp = __shfl_xor(gs[T][g], 32); const float base = run + (hi == 0 ? gp : 0.f);
#pragma unroll
                    for (int r = 0; r < 4; ++r) z[T][4 * g + r] = __builtin_amdgcn_exp2f(z[T][4 * g + r] + base + inl[T][4 * g + r]);
                    run += gs[T][g] + gp; }
            carry = run;
            s16x8 pf[4];
#pragma unroll
            for (int c = 0; c < 4; ++c) { const int T = c >> 1, b8 = (c & 1) * 8;
                pf[c] = pack8(z[T][b8 + 0], z[T][b8 + 1], z[T][b8 + 2], z[T][b8 + 3], z[T][b8 + 4], z[T][b8 + 5], z[T][b8 + 6], z[T][b8 + 7]); }
            pv_tile(o, buf + KT_BYTES, pf, lane);
            wdone = __builtin_amdgcn_ballot_w64(carry >= -58.f) == 0ull;
        }
        if (lane == 0) flag[(i & 1) * 8 + w] = (wdone || !more) ? 1u : 0u;
        if (more) tile_store(R, F.lds + ((i + 1) & 1) * TB_BYTES, F.tid);
        __syncthreads();
        if (!more) break;
        unsigned alld = 1u;
#pragma unroll
        for (int k = 0; k < 8; ++k) alld &= flag[(i & 1) * 8 + k];
        if (alld) break;
    }
    wq_prefetch(F);
    store_o(o, 1.f, F_o + tok * D + 640 + h * 64, lane, F_oss + tok * 16 + 10 + h);
}
template <class Pol> __device__ __forceinline__ void flash_pass(Frame& F, const Pol& P, int ntile, const bf16* Kb, const bf16* Vb, const s16x8 (&qf)[4], f32x16 (&o)[2], float& m, float& l) {
    TileRegs R0, R1, R2; const int lane = F.lane;
    int tid = F.tid; asm volatile("" : "+v"(tid));
    __syncthreads();
    tile_load(R0, Kb + (size_t)P.row0(0) * PW, Vb + (size_t)P.row0(0) * PW, PW, tid);
    if (ntile > 1) tile_load(R1, Kb + (size_t)P.row0(1) * PW, Vb + (size_t)P.row0(1) * PW, PW, tid);
    if (ntile > 2) tile_load(R2, Kb + (size_t)P.row0(2) * PW, Vb + (size_t)P.row0(2) * PW, PW, tid);
    tile_store(R0, F.lds, tid);
    __syncthreads();
#define FSTEP(I, RL, RS) { const int i_ = (I); if (i_ < ntile) { \
        if (i_ + 3 < ntile) tile_load(RL, Kb + (size_t)P.row0(i_ + 3) * PW, Vb + (size_t)P.row0(i_ + 3) * PW, PW, tid); \
        const LAS unsigned char* buf = F.lds + (i_ & 1) * TB_BYTES; \
        if (P.active(i_)) { const bool keep = P.keep(i_); f32x16 p[2]; qk_tile(p, buf, qf, lane, keep ? ((m == NEGINF) ? 0.f : -m) : NEGINF); P.maskp(i_, p); s16x8 pf[4]; softmax_step(p, o, m, l, pf, keep); pv_tile(o, buf + KT_BYTES, pf, lane); } \
        if (i_ + 1 < ntile) tile_store(RS, F.lds + ((i_ + 1) & 1) * TB_BYTES, tid); \
        __syncthreads(); } }
    for (int i = 0; i < ntile; i += 3) { FSTEP(i, R0, R1); FSTEP(i + 1, R1, R2); FSTEP(i + 2, R2, R0); }
#undef FSTEP
}
struct PolMoba { unsigned selm; int own, w, qrel  ;
    __device__ __forceinline__ int row0(int i) const { return 64 * i; }
    __device__ __forceinline__ bool active(int i) const { const int blk = i >> 2; return blk < own ? (__builtin_amdgcn_ballot_w64((selm >> blk) & 1u) != 0ull) : ((64 * (i & 3)) <= 32 * w + 31); }
    __device__ __forceinline__ bool keep(int i) const { const int blk = i >> 2; return blk < own ? ((selm >> blk) & 1u) != 0u : true; }
    __device__ __forceinline__ void maskp(int i, f32x16 (&p)[2]) const { if ((i >> 2) >= own) mask_le(p, qrel - 64 * (i & 3)); } };
struct PolSlc { unsigned sl, sh; int ownw, lim_own  ;
    __device__ __forceinline__ int row0(int i) const { return 64 * i; }
    __device__ __forceinline__ bool bit(int i) const { return ((i < 32 ? sl >> i : sh >> (i - 32)) & 1u) != 0u; }
    __device__ __forceinline__ bool active(int i) const { return i <= ownw && __builtin_amdgcn_ballot_w64(bit(i)) != 0ull; }
    __device__ __forceinline__ bool keep(int i) const { return i == ownw ? true : bit(i); }
    __device__ __forceinline__ void maskp(int i, f32x16 (&p)[2]) const { if (i == ownw) mask_le(p, lim_own); } };
struct PolWin { int klo, t0, trel  ;
    __device__ __forceinline__ int row0(int i) const { return 64 * (klo + i); }
    __device__ __forceinline__ bool active(int i) const { const int k0 = 64 * (klo + i); return k0 + 63 >= t0 - 511 && k0 <= t0 + 31; }
    __device__ __forceinline__ bool keep(int) const { return true; }
    __device__ __forceinline__ void maskp(int i, f32x16 (&p)[2]) const { const int k0 = 64 * (klo + i);
        if (k0 + 63 > t0) mask_le(p, trel - k0);
        if (k0 < t0 + 31 - 511) mask_ge(p, trel - 511 - k0); } };
__device__ __forceinline__ void nsa_sw_unit(Frame& F, const Args& A, int u) {
    const int qt = 15 - (u / 48), bh = u % 48, h = bh % 6, b = bh / 6, lane = F.lane, w = F.wave, hi = lane >> 5;
    const int t0 = 256 * qt + 32 * w, tq = t0 + (lane & 31); const size_t tok = (size_t)b * S + tq;
    const bf16* prow = F_proj + tok * PW;
    s16x8 qf[4]; load_qfrags(qf, prow + C_QB + h * 64, QSCALE_LOG2, lane);
    const bf16* Pb = F_proj + (size_t)b * S * PW;
    f32x16 os[2], ow[2];
#pragma unroll
    for (int dt = 0; dt < 2; ++dt)
#pragma unroll
        for (int j = 0; j < 16; ++j) { os[dt][j] = 0.f; ow[dt][j] = 0.f; }
    float ms = NEGINF, ls = 0.f, mw = NEGINF, lw = 0.f;
    { const v2u sm = *(const v2u*)(F_selm + tok * 2); PolSlc P{sm.x, sm.y, t0 >> 6, tq - 64 * (t0 >> 6) - 4 * hi};
      flash_pass(F, P, 4 * qt + 4, Pb + C_KVB + 128, Pb + C_KVB + 192, qf, os, ms, ls); }
    { int klo = (256 * qt - 511) >> 6; if (klo < 0) klo = 0; PolWin P{klo, t0, tq - 4 * hi};
      flash_pass(F, P, 4 * qt + 4 - klo, Pb + C_KVB + 256, Pb + C_KVB + 320, qf, ow, mw, lw); }
    wq_prefetch(F);
    const float lst = ls + __shfl_xor(ls, 32), lwt = lw + __shfl_xor(lw, 32);
    const float gs = sigmoidf_(bf1(prow[C_GB + h * 3 + 1])) * (lst > 0.f ? 1.f / lst : 0.f), gw = sigmoidf_(bf1(prow[C_GB + h * 3 + 2])) * (lwt > 0.f ? 1.f / lwt : 0.f);
    bf16* orow = F_o + tok * D + 256 + h * 64; float ssq = 0.f;
#pragma unroll
    for (int dt = 0; dt < 2; ++dt)
#pragma unroll
        for (int g = 0; g < 4; ++g) { bf16* op = orow + 32 * dt + 8 * g + 4 * hi; const v2u c = *(const v2u*)(F_ocp + tok * 384 + h * 64 + 32 * dt + 8 * g + 4 * hi);
            const float r0 = bflo(c.x) + gs * os[dt][4 * g] + gw * ow[dt][4 * g], r1 = bfhi(c.x) + gs * os[dt][4 * g + 1] + gw * ow[dt][4 * g + 1];
            const float r2 = bflo(c.y) + gs * os[dt][4 * g + 2] + gw * ow[dt][4 * g + 2], r3 = bfhi(c.y) + gs * os[dt][4 * g + 3] + gw * ow[dt][4 * g + 3];
            ssq += (r0 * r0 + r1 * r1) + (r2 * r2 + r3 * r3); v2u wv; wv.x = pg8::cvt_pk_bf16(r0, r1); wv.y = pg8::cvt_pk_bf16(r2, r3); *(v2u*)op = wv; }
    ssq += __shfl_xor(ssq, 32); if (lane < 32) F_oss[tok * 16 + 4 + h] = ssq;
}
__device__ __forceinline__ void nsa_cmp_unit(Frame& F, const Args& A, int u) {
    const int qt = u & 15, b = u >> 4, lane = F.lane, w = F.wave, hi = lane >> 5;
    const int t0 = 256 * qt + 32 * w, tq = t0 + (lane & 31); const size_t tok = (size_t)b * S + tq;
    const bf16* prow = F_proj + tok * PW;
    __syncthreads();
    { const bf16* kc = F_kcb + (size_t)b * 256 * 64; const bf16* vc = F_vcb + (size_t)b * 256 * 64;
#pragma unroll
      for (int q = 0; q < 4; ++q) { const int idx = F.tid + 512 * q, r = idx >> 3, c = idx & 7;
          *(LAS v4u*)(F.lds + (r >> 6) * KT_BYTES + (r & 63) * KP + c * 16) = *(const v4u*)(kc + (size_t)r * 64 + c * 8);
          *(LAS v4u*)(F.lds + 4 * KT_BYTES + (r >> 6) * VT_BYTES + (r & 63) * VP + c * 16) = *(const v4u*)(vc + (size_t)r * 64 + c * 8); } }
    __syncthreads();
    const int nmax = tq >= 31 ? (tq - 31) >> 4 : -1;
    const int nmax_w = (t0 + 31) >= 31 ? (t0 + 31 - 31) >> 4 : -1;
    float IM[4][2][4];
#pragma unroll
    for (int a = 0; a < 4; ++a)
#pragma unroll
        for (int T = 0; T < 2; ++T)
#pragma unroll
            for (int g = 0; g < 4; ++g) IM[a][T][g] = 0.f;
    for (int h = 0; h < 6; ++h) {
        s16x8 qf[4]; load_qfrags(qf, prow + C_QB + h * 64, QSCALE_LOG2, lane);
        float m = NEGINF, l = 0.f;
#pragma unroll
        for (int kt = 0; kt < 4; ++kt) { if (64 * kt > nmax_w) continue;
            f32x16 p[2]; qk_tile(p, F.lds + kt * KT_BYTES, qf, lane); mask_le(p, nmax - 64 * kt - 4 * hi);
            float tm = p[0][0];
#pragma unroll
            for (int j = 1; j < 16; ++j) tm = fmaxf(tm, p[0][j]);
#pragma unroll
            for (int j = 0; j < 16; ++j) tm = fmaxf(tm, p[1][j]);
            const float mn = fmaxf(m, tm), mu = (mn == NEGINF) ? 0.f : mn; l *= __builtin_amdgcn_exp2f(m - mu); m = mn;
#pragma unroll
            for (int T = 0; T < 2; ++T)
#pragma unroll
                for (int j = 0; j < 16; ++j) l += __builtin_amdgcn_exp2f(p[T][j] - mu); }
        { const float mo = __shfl_xor(m, 32), lo = __shfl_xor(l, 32); const float M = fmaxf(m, mo), Mu = (M == NEGINF) ? 0.f : M;
          l = l * __builtin_amdgcn_exp2f(m - Mu) + lo * __builtin_amdgcn_exp2f(mo - Mu); m = Mu; }
        const float inv = l > 0.f ? 1.f / l : 0.f;
        f32x16 o[2];
#pragma unroll
        for (int dt = 0; dt < 2; ++dt)
#pragma unroll
            for (int j = 0; j < 16; ++j) o[dt][j] = 0.f;
        float carry = 0.f;
#pragma unroll
        for (int kt = 0; kt < 4; ++kt) { if (64 * kt > nmax_w) continue;
            f32x16 p[2]; qk_tile(p, F.lds + kt * KT_BYTES, qf, lane); mask_le(p, nmax - 64 * kt - 4 * hi);
#pragma unroll
            for (int T = 0; T < 2; ++T)
#pragma unroll
                for (int j = 0; j < 16; ++j) p[T][j] = __builtin_amdgcn_exp2f(p[T][j] - m) * inv;
            float x[2][4];
#pragma unroll
            for (int T = 0; T < 2; ++T)
#pragma unroll
                for (int g = 0; g < 4; ++g) x[T][g] = __shfl_xor(p[T][4 * g + 3], 32);
#pragma unroll
            for (int T = 0; T < 2; ++T)
#pragma unroll
                for (int g = 0; g < 4; ++g) { const float prev = g > 0 ? x[T][g - 1] : (T > 0 ? x[0][3] : carry);
                    IM[kt][T][g] += ((p[T][4 * g] + p[T][4 * g + 1]) + (p[T][4 * g + 2] + p[T][4 * g + 3])) + (hi ? x[T][g] : prev); }
            carry = x[1][3];
            s16x8 pf[4];
#pragma unroll
            for (int c = 0; c < 4; ++c) { const int T = c >> 1, b8 = (c & 1) * 8;
                pf[c] = pack8(p[T][b8 + 0], p[T][b8 + 1], p[T][b8 + 2], p[T][b8 + 3], p[T][b8 + 4], p[T][b8 + 5], p[T][b8 + 6], p[T][b8 + 7]); }
            pv_tile(o, F.lds + 4 * KT_BYTES + kt * VT_BYTES, pf, lane); }
        store_o(o, sigmoidf_(bf1(prow[C_GB + h * 3 + 0])), F_ocp + tok * 384 + h * 64, lane);
    }
    wq_prefetch(F);
    const int ownb = tq >> 6;
#pragma unroll
    for (int a = 0; a < 4; ++a)
#pragma unroll
        for (int T = 0; T < 2; ++T)
#pragma unroll
            for (int g = 0; g < 4; ++g) { const int mm = 16 * a + 8 * T + 2 * g + hi; float v = IM[a][T][g];
                if (mm == 0 || mm == ownb || mm == ownb - 1) v = 1e4f; if (64 * mm > tq) v = -1e30f; IM[a][T][g] = v; }
    unsigned sl = 0u, sh = 0u;
    for (int r = 0; r < 16; ++r) { float bv = -3.4e38f; int bm = 0;
#pragma unroll
        for (int a = 0; a < 4; ++a)
#pragma unroll
            for (int T = 0; T < 2; ++T)
#pragma unroll
                for (int g = 0; g < 4; ++g) { const int mm = 16 * a + 8 * T + 2 * g + hi; if (IM[a][T][g] > bv) { bv = IM[a][T][g]; bm = mm; } }
        const float ov = __shfl_xor(bv, 32); const int om = __shfl_xor(bm, 32);
        if (ov > bv || (ov == bv && om < bm)) { bv = ov; bm = om; }
        if (bv > -5e29f) { if (bm < 32) sl |= 1u << bm; else sh |= 1u << (bm - 32); }
#pragma unroll
        for (int a = 0; a < 4; ++a)
#pragma unroll
            for (int T = 0; T < 2; ++T)
#pragma unroll
                for (int g = 0; g < 4; ++g) { const int mm = 16 * a + 8 * T + 2 * g + hi; IM[a][T][g] = (mm == bm) ? -3.4e38f : IM[a][T][g]; }
    }
    if (hi == 0) { v2u sm; sm.x = sl; sm.y = sh; *(v2u*)(F_selm + tok * 2) = sm; }
}
__device__ __forceinline__ void moba_unit(Frame& F, const Args& A, int u, int layer) {
    const int own = 15 - (u >> 5), bh = u & 31, b = bh >> 2, h = bh & 3, lane = F.lane, w = F.wave, hi = lane >> 5;
    const int tq = own * 256 + 32 * w + (lane & 31); const size_t tok = (size_t)b * S + tq;
    const bf16* qrow = F_proj + tok * PW + C_QA + h * 64;
    unsigned selm = 0u;
    {   float q[64]; loadq(q, qrow);
        const float* km = F_kmean + (size_t)layer * NB * 4 * 16 * 64 + (size_t)(b * 4 + h) * 16 * 64;
        LAS float* kmL = (LAS float*)(F.lds + 98304);
        if (F.tid < 256) *(LAS f32x4*)(kmL + 4 * F.tid) = *(const f32x4*)(km + 4 * F.tid);
        __syncthreads();
        float v1 = -3e38f, v2 = -3e38f, v3 = -3e38f; int i1 = -1, i2 = -1, i3 = -1;
        for (int n = 0; n < own; ++n) { const float g = dot64l(q, kmL + n * 64);
            if (g > v1) { v3 = v2; i3 = i2; v2 = v1; i2 = i1; v1 = g; i1 = n; } else if (g > v2) { v3 = v2; i3 = i2; v2 = g; i2 = n; } else if (g > v3) { v3 = g; i3 = n; } }
        if (i1 >= 0) selm |= 1u << i1; if (i2 >= 0) selm |= 1u << i2; if (i3 >= 0) selm |= 1u << i3;
    }
    s16x8 qf[4]; load_qfrags(qf, qrow, QSCALE_LOG2, lane);
    f32x16 o[2];
#pragma unroll
    for (int dt = 0; dt < 2; ++dt)
#pragma unroll
        for (int j = 0; j < 16; ++j) o[dt][j] = 0.f;
    float m = NEGINF, l = 0.f;
    const bf16* Kb = F_proj + (size_t)b * S * PW + C_KA + h * 64; const bf16* Vb = F_proj + (size_t)b * S * PW + C_VA + h * 64;
    { PolMoba P{selm, own, w, 32 * w + (lane & 31) - 4 * hi}; flash_pass(F, P, 4 * own + 4, Kb, Vb, qf, o, m, l); }
    wq_prefetch(F);
    const float lt = l + __shfl_xor(l, 32);
    store_o(o, lt > 0.f ? 1.f / lt : 0.f, F_o + tok * D + h * 64, lane, F_oss + tok * 16 + h);
}
#ifndef PROBE_PHASE
#define PROBE_PHASE -1
#endif
#define QREPS(g) ((PROBE_PHASE == (g)) ? 2 : 1)
#define WQ_LOOP(CTR, NUNITS, CALL) do { { int z_ = 0; asm volatile("" : "+v"(z_)); F.qctr = (CTR) + z_; } F.tk = 0u; \
    int u = __builtin_amdgcn_readfirstlane(wq_next(F, F.qctr)); \
    while (u < (NUNITS)) { CALL; __syncthreads(); if (F.tid == 0) F.MISC[0] = F.tk; __syncthreads(); u = __builtin_amdgcn_readfirstlane((int)F.MISC[0]); } } while (0)
__device__ __forceinline__ void phase_attn_a(Frame& F0, const Args& A, int l, int rep) {
    Frame F = F0; asm volatile("" : "+v"(F.tid)); F.lane = F.tid & 63;
    WQ_LOOP(F.ctl + CW_WQ + 64 * (l * 4 + 2) + 8 * rep, NB * 16, nsa_cmp_unit(F, A, u));
    WQ_LOOP(F.ctl + CW_WQ + 64 * (l * 4 + 0) + 8 * rep, NB * 4 * 16, moba_unit(F, A, u, l));
    WQ_LOOP(F.ctl + CW_WQ + 64 * (l * 4 + 1) + 8 * rep, NB * 6 * 16, sb_unit(F, A, u));
    __syncthreads();
}
__device__ __forceinline__ void phase_attn_b(Frame& F0, const Args& A, int l, int rep) {
    Frame F = F0; asm volatile("" : "+v"(F.tid)); F.lane = F.tid & 63;
    WQ_LOOP(F.ctl + CW_WQ + 64 * (l * 4 + 3) + 8 * rep, NB * 6 * 16, nsa_sw_unit(F, A, u));
    __syncthreads();
}
struct GnIn { v4u w0, w1; };
__device__ __forceinline__ void gn_load(GnIn& I, const Args& A, int tok, int lane) { const bf16* orow = F_o + (size_t)tok * D; I.w0 = __builtin_nontemporal_load((const v4u*)(orow + lane * 8)); I.w1 = __builtin_nontemporal_load((const v4u*)(orow + 512 + lane * 8)); }
__device__ __forceinline__ void gn_compute(const GnIn& I, const Args& A, int tok, int lane, const float* gg) {
    const v4u w0 = I.w0, w1 = I.w1;
    float v0[8] = {bflo(w0.x), bfhi(w0.x), bflo(w0.y), bfhi(w0.y), bflo(w0.z), bfhi(w0.z), bflo(w0.w), bfhi(w0.w)};
    float v1[8] = {bflo(w1.x), bfhi(w1.x), bflo(w1.y), bfhi(w1.y), bflo(w1.z), bfhi(w1.z), bflo(w1.w), bfhi(w1.w)};
    float s0 = 0.f, s1 = 0.f;
#pragma unroll
    for (int j = 0; j < 8; ++j) { s0 += v0[j] * v0[j]; s1 += v1[j] * v1[j]; }
    const float ssA = wave_sum(lane < 32 ? s0 : 0.f), ssB = wave_sum((lane >= 32 ? s0 : 0.f) + (lane < 16 ? s1 : 0.f)), ssC = wave_sum(lane >= 16 ? s1 : 0.f);
    const float rA = __builtin_amdgcn_rsqf(ssA * (1.f / 256.f) + RMS_EPS), rB = __builtin_amdgcn_rsqf(ssB * (1.f / 384.f) + RMS_EPS), rC = __builtin_amdgcn_rsqf(ssC * (1.f / 384.f) + RMS_EPS);
    const float r0 = lane < 32 ? rA : rB, r1 = lane < 16 ? rB : rC;
    const f32x4 g00 = *(const f32x4*)(gg + lane * 8), g01 = *(const f32x4*)(gg + lane * 8 + 4), g10 = *(const f32x4*)(gg + 512 + lane * 8), g11 = *(const f32x4*)(gg + 512 + lane * 8 + 4);
    v4u o0, o1;
    o0.x = pk2(v0[0] * r0 * g00.x, v0[1] * r0 * g00.y); o0.y = pk2(v0[2] * r0 * g00.z, v0[3] * r0 * g00.w); o0.z = pk2(v0[4] * r0 * g01.x, v0[5] * r0 * g01.y); o0.w = pk2(v0[6] * r0 * g01.z, v0[7] * r0 * g01.w);
    o1.x = pk2(v1[0] * r1 * g10.x, v1[1] * r1 * g10.y); o1.y = pk2(v1[2] * r1 * g10.z, v1[3] * r1 * g10.w); o1.z = pk2(v1[4] * r1 * g11.x, v1[5] * r1 * g11.y); o1.w = pk2(v1[6] * r1 * g11.z, v1[7] * r1 * g11.w);
    bf16* arow = F_act + (size_t)tok * D; *(v4u*)(arow + lane * 8) = o0; *(v4u*)(arow + 512 + lane * 8) = o1;
}
__device__ __forceinline__ void phase_gnorm(Frame& F, const Args& A, int l) {
    const int gw = F.vcu * NWAVES + F.wave, NGW = F.G * NWAVES, lane = F.lane; const float* gg = F_mix_g + (size_t)l * D;
    GnIn Ia, Ib; int tok = gw;
    if (tok < NTOK) gn_load(Ia, A, tok, lane);
    for (; tok < NTOK; tok += 2 * NGW) {
        if (tok + NGW < NTOK) gn_load(Ib, A, tok + NGW, lane);
        gn_compute(Ia, A, tok, lane, gg);
        if (tok + 2 * NGW < NTOK) gn_load(Ia, A, tok + 2 * NGW, lane);
        if (tok + NGW < NTOK) gn_compute(Ib, A, tok + NGW, lane, gg);
    }
}
struct PmIn { f32x4 x[4]; v2u xb[4]; v2u y[4]; };
__device__ __forceinline__ void pm_load(PmIn& I, const Args& A, int tok, int lane, int l) {
    const f32x4* xr = (const f32x4*)(F_x + (size_t)tok * D) + lane; const bf16* xm = F_xmid + (size_t)tok * D; const bf16* yr = F_y + (size_t)tok * D;
#pragma unroll
    for (int j = 0; j < 4; ++j) { if (l == 0) I.x[j] = __builtin_nontemporal_load(xr + 64 * j); else I.xb[j] = __builtin_nontemporal_load((const v2u*)(xm + 4 * lane + 256 * j)); I.y[j] = __builtin_nontemporal_load((const v2u*)(yr + 4 * lane + 256 * j)); } }
__device__ __forceinline__ void pm_compute(const PmIn& I, const Args& A, int tok, int lane, int l, const LAS float* cA1, const LAS float* cA2, const LAS float* cS0, LAS float* rs2out) {
    f32x4 xv[4], yv[4]; float ss = 0.f;
#pragma unroll
    for (int j = 0; j < 4; ++j) { if (l == 0) xv[j] = I.x[j]; else { const v2u xw = I.xb[j]; xv[j] = (f32x4){bflo(xw.x), bfhi(xw.x), bflo(xw.y), bfhi(xw.y)}; } const v2u w = I.y[j]; yv[j] = (f32x4){bflo(w.x), bfhi(w.x), bflo(w.y), bfhi(w.y)};
        ss += (yv[j].x * yv[j].x + yv[j].y * yv[j].y) + (yv[j].z * yv[j].z + yv[j].w * yv[j].w); }
    const float rs = __builtin_amdgcn_rsqf(wave_sum(ss) * (1.f / D) + RMS_EPS);
    bf16* x1r = F_x1b + (size_t)tok * D;
#pragma unroll
    for (int j = 0; j < 4; ++j) { const int c = 4 * lane + 256 * j; const f32x4 a1 = *(const LAS f32x4*)(cA1 + c);
        xv[j] = xv[j] + a1 * (yv[j] * rs); v2u xw; xw.x = pk2(xv[j].x, xv[j].y); xw.y = pk2(xv[j].z, xv[j].w); *(v2u*)(x1r + c) = xw; }
    float s2 = 0.f;
#pragma unroll
    for (int j = 0; j < 4; ++j) s2 += (xv[j].x * xv[j].x + xv[j].y * xv[j].y) + (xv[j].z * xv[j].z + xv[j].w * xv[j].w);
    const float rs2 = __builtin_amdgcn_rsqf(wave_sum(s2) * (1.f / D) + RMS_EPS);
    if (lane == 0) *rs2out = rs2;
    unsigned char* arow8 = F_act8 + (size_t)tok * D;
#pragma unroll
    for (int j = 0; j < 4; ++j) { const int c = 4 * lane + 256 * j; const f32x4 a2 = *(const LAS f32x4*)(cA2 + c), s0 = *(const LAS f32x4*)(cS0 + c);
        const f32x4 r = xv[j] * rs2 * a2 + s0; *(unsigned*)(arow8 + c) = pg8::pk4_fp8(r.x, r.y, r.z, r.w); }
}
__device__ __forceinline__ void phase_postmix(Frame& F, const Args& A, int l, int bank) {
    const int lane = F.lane, wave = F.wave;
    LAS float* lgt = (LAS float*)(F.lds + wave * 4096);
    LAS float* rsv = lgt + 512;
    LAS int* tE = (LAS int*)(F.lds + 32768); LAS int* tR = tE + 512; LAS unsigned* lcnt = (LAS unsigned*)(tR + 512); LAS unsigned* lbase = lcnt + 32; LAS float* tG = (LAS float*)(lbase + 32);
    const float* g1n = F_norm_g + ((size_t)l * 4 + 1) * D; const float* g2n = F_norm_g + ((size_t)l * 4 + 2) * D;
    for (int chunk = blockIdx.x; chunk < NTOK / 128; chunk += F.G) {
        __syncthreads();
        if (F.tid < 32) lcnt[F.tid] = 0u;
        __syncthreads();
        const int tok0 = chunk * 128 + wave * 16, b = tok0 >> 12; const float* md = F_mod + ((size_t)l * NB + b) * 6 * D;
        PmIn Ia, Ib; pm_load(Ia, A, tok0, lane, l);
        LAS float* cA1 = (LAS float*)(F.lds + 65536); LAS float* cA2 = cA1 + D; LAS float* cS0 = cA2 + D;
        for (int i = F.tid; i < D; i += NWAVES * 64) { cA1[i] = md[2 * D + i] * g1n[i]; cA2[i] = g2n[i] * (md[4 * D + i] + 1.f); cS0[i] = md[3 * D + i]; }
        __syncthreads();
        for (int i = 0; i < 16; i += 2) {
            pm_load(Ib, A, tok0 + i + 1, lane, l);
            pm_compute(Ia, A, tok0 + i, lane, l, cA1, cA2, cS0, rsv + i);
            if (i + 2 < 16) pm_load(Ia, A, tok0 + i + 2, lane, l);
            pm_compute(Ib, A, tok0 + i + 1, lane, l, cA1, cA2, cS0, rsv + i + 1);
        }
        VM_WAIT();
        {
            const int m16 = lane & 15, kg = lane >> 4; constexpr int BPB = 272;
            const bf16* ap = F_x1b + (size_t)(tok0 + m16) * D + 8 * kg;
            const unsigned short* bsrc = F_rw3 + ((size_t)l * NB + b) * NE * 3 * D + (size_t)(F.tid >> 4) * 3 * D + (F.tid & 15) * 8;
            LAS unsigned char* bl = F.lds + 77824; LAS unsigned char* bw = bl + (F.tid >> 4) * BPB + (F.tid & 15) * 16;
            f32x4 c0 = (f32x4){0.f, 0.f, 0.f, 0.f}, c1 = c0;
            v4u g[3]; c16x8 ac[4], an[4];
#pragma unroll
            for (int p = 0; p < 3; ++p) g[p] = *(const v4u*)(bsrc + p * D);
#pragma unroll
            for (int q4 = 0; q4 < 4; ++q4) ac[q4] = *(const c16x8*)(ap + 32 * q4);
#pragma unroll
            for (int p = 0; p < 3; ++p) *(LAS v4u*)(bw + p * 32 * BPB) = g[p];
            __syncthreads();
#pragma unroll
            for (int kc = 0; kc < 8; ++kc) { const LAS unsigned char* br = bl + (kc & 1) * 3 * 32 * BPB + m16 * BPB + 16 * kg;
                if (kc + 1 < 8) {
#pragma unroll
                    for (int p = 0; p < 3; ++p) g[p] = *(const v4u*)(bsrc + p * D + 128 * (kc + 1));
#pragma unroll
                    for (int q4 = 0; q4 < 4; ++q4) an[q4] = *(const c16x8*)(ap + 128 * (kc + 1) + 32 * q4); }
#pragma unroll
                for (int q4 = 0; q4 < 4; ++q4)
#pragma unroll
                    for (int p = 0; p < 3; ++p) { const c16x8 b0 = *(const LAS c16x8*)(br + p * 32 * BPB + 64 * q4), b1 = *(const LAS c16x8*)(br + p * 32 * BPB + 16 * BPB + 64 * q4);
                        c0 = __builtin_amdgcn_mfma_f32_16x16x32_bf16(ac[q4], b0, c0, 0, 0, 0); c1 = __builtin_amdgcn_mfma_f32_16x16x32_bf16(ac[q4], b1, c1, 0, 0, 0); }
                if (kc + 1 < 8) { LAS unsigned char* bn = bw + ((kc + 1) & 1) * 3 * 32 * BPB;
#pragma unroll
                    for (int p = 0; p < 3; ++p) *(LAS v4u*)(bn + p * 32 * BPB) = g[p];
#pragma unroll
                    for (int q4 = 0; q4 < 4; ++q4) ac[q4] = an[q4]; }
                __syncthreads(); }
#pragma unroll
            for (int r = 0; r < 4; ++r) { lgt[(4 * kg + r) * 32 + m16] = c0[r]; lgt[(4 * kg + r) * 32 + 16 + m16] = c1[r]; } }
        LDS_WAIT(); asm volatile("" ::: "memory");
        if (lane < 16) { const int tl = wave * 16 + lane, tok = tok0 + lane; const float rs2 = rsv[lane]; const float* rc = F_rconst + ((size_t)l * NB + b) * NE;
            float v0 = -3e38f, v1 = -3e38f, v2 = -3e38f, v3 = -3e38f; int i0 = 0, i1 = 0, i2 = 0, i3 = 0;
#pragma unroll 8
            for (int e = 0; e < NE; ++e) { const float g = lgt[lane * 32 + e] * rs2 + rc[e];
                if (g > v3) { if (g > v1) { v3 = v2; i3 = i2; v2 = v1; i2 = i1; if (g > v0) { v1 = v0; i1 = i0; v0 = g; i0 = e; } else { v1 = g; i1 = e; } }
                              else { if (g > v2) { v3 = v2; i3 = i2; v2 = g; i2 = e; } else { v3 = g; i3 = e; } } } }
            const float e1 = __expf(v1 - v0), e2 = __expf(v2 - v0), e3 = __expf(v3 - v0); const float inv = 1.f / (1.f + e1 + e2 + e3);
            const int ei[4] = {i0, i1, i2, i3}; const float gt[4] = {inv, e1 * inv, e2 * inv, e3 * inv};
#pragma unroll
            for (int s = 0; s < 4; ++s) { const unsigned rk = __hip_atomic_fetch_add(&lcnt[ei[s]], 1u, __ATOMIC_RELAXED, __HIP_MEMORY_SCOPE_WORKGROUP); tE[tl * 4 + s] = ei[s]; tR[tl * 4 + s] = (int)rk; tG[tl * 4 + s] = gt[s]; } }
        LDS_WAIT(); asm volatile("" ::: "memory");
        __syncthreads();
        if (F.tid < 32) lbase[F.tid] = atomicAdd((unsigned*)(F.ctl + CW_CNT + 64 * bank + F.tid), lcnt[F.tid]);
        __syncthreads();
        { const int tok = chunk * 128 + (F.tid >> 2), s = F.tid & 3, e = tE[F.tid]; const int pos = (int)lbase[e] + tR[F.tid]; F_list[(size_t)e * NTOK + pos] = tok * 4 + s; F_lgate[(size_t)e * NTOK + pos] = tG[F.tid]; }
    }
    __syncthreads();
}
__device__ __forceinline__ int moe_tables(Frame& F, const Args& A, int l) {
    LAS int* rowbase = (LAS int*)(F.lds + TAB_OFF); LAS unsigned char* texp = (LAS unsigned char*)(F.lds + TAB_OFF + 256); LAS int* ecnt = (LAS int*)(F.lds + TAB_OFF + 896);
    __syncthreads();
    if (F.tid < 64) { const int ln = F.tid;
        const int c = ln < NE ? (int)__hip_atomic_load(F.ctl + CW_CNT + 64 * l + ln, RLX_AGENT) : 0; const int nt = (c + 255) >> 8;
        int incl = nt;
#pragma unroll
        for (int o = 1; o < 64; o <<= 1) { const int t = __shfl_up(incl, o); if (ln >= o) incl += t; }
        const int excl = incl - nt;
        if (ln < NE) { rowbase[ln] = excl << 8; ecnt[ln] = c; for (int k = 0; k < nt; ++k) texp[excl + k] = (unsigned char)ln; }
        if (ln == NE - 1) rowbase[NE] = incl << 8; }
    __syncthreads();
    return rowbase[NE] >> 8;
}
struct CbIn { unsigned yb[4][4]; v2u x1[4]; };
__device__ __forceinline__ void cb_load(CbIn& I, const Args& A, int tok, int lane) { const unsigned char* yr = F_yt8 + (size_t)tok * 4 * D; const bf16* x1r = F_x1b + (size_t)tok * D;
#pragma unroll
    for (int s = 0; s < 4; ++s)
#pragma unroll
        for (int j = 0; j < 4; ++j) I.yb[s][j] = __builtin_nontemporal_load((const unsigned*)(yr + (size_t)s * D + 4 * lane + 256 * j));
#pragma unroll
    for (int j = 0; j < 4; ++j) I.x1[j] = __builtin_nontemporal_load((const v2u*)(x1r + 4 * lane + 256 * j)); }
__device__ __forceinline__ void cb_compute(const CbIn& I, const Args& A, int tok, int lane, int l, const LAS float* cA3, const LAS float* cA4, const LAS float* cS4) {
    f32x4 xv[4], yv[4];
#pragma unroll
    for (int j = 0; j < 4; ++j) { const v2u xw = I.x1[j]; xv[j] = (f32x4){bflo(xw.x), bfhi(xw.x), bflo(xw.y), bfhi(xw.y)}; yv[j] = (f32x4){0.f, 0.f, 0.f, 0.f};
#pragma unroll
        for (int s = 0; s < 4; ++s) { typedef float f32x2_ __attribute__((ext_vector_type(2))); const f32x2_ lo = __builtin_amdgcn_cvt_pk_f32_fp8((int)I.yb[s][j], false), hi2 = __builtin_amdgcn_cvt_pk_f32_fp8((int)I.yb[s][j], true); yv[j] = yv[j] + (f32x4){lo.x, lo.y, hi2.x, hi2.y}; } }
    float ss = 0.f;
#pragma unroll
    for (int j = 0; j < 4; ++j) ss += (yv[j].x * yv[j].x + yv[j].y * yv[j].y) + (yv[j].z * yv[j].z + yv[j].w * yv[j].w);
    const float rs = __builtin_amdgcn_rsqf(wave_sum(ss) * (1.f / D) + RMS_EPS * (pg8::YT8_SCALE * pg8::YT8_SCALE));
    f32x4* outr = (f32x4*)(F_out + (size_t)tok * D) + lane; bf16* xmr = F_xmid + (size_t)tok * D;
#pragma unroll
    for (int j = 0; j < 4; ++j) { const int c = 4 * lane + 256 * j; const f32x4 a3 = *(const LAS f32x4*)(cA3 + c);
        xv[j] = xv[j] + a3 * (yv[j] * rs);
        if (l + 1 < NL) { v2u xw; xw.x = pk2(xv[j].x, xv[j].y); xw.y = pk2(xv[j].z, xv[j].w); *(v2u*)(xmr + c) = xw; } else outr[64 * j] = xv[j]; }
    if (l + 1 < NL) mod_norm_row_l(xv, cA4, cS4, F_act + (size_t)tok * D, lane);
}
__device__ __forceinline__ void phase_combine(Frame& F, const Args& A, int l) {
    const int lane = F.lane; const float* g3n = F_norm_g + ((size_t)l * 4 + 3) * D;
    LAS float* cA3 = (LAS float*)(F.lds + 65536); LAS float* cA4 = cA3 + D; LAS float* cS4 = cA4 + D;
    for (int chunk = blockIdx.x; chunk < NTOK / 128; chunk += F.G) {
        const int tok0 = chunk * 128 + F.wave * 16, b = tok0 >> 12; const float* md = F_mod + ((size_t)l * NB + b) * 6 * D;
        CbIn Ia, Ib; cb_load(Ia, A, tok0, lane);
        __syncthreads();
        for (int i = F.tid; i < D; i += NWAVES * 64) { cA3[i] = md[5 * D + i] * g3n[i];
            if (l + 1 < NL) { const float* md2 = F_mod + ((size_t)(l + 1) * NB + b) * 6 * D; cA4[i] = F_norm_g[(size_t)(l + 1) * 4 * D + i] * (md2[D + i] + 1.f); cS4[i] = md2[i]; } }
        __syncthreads();
        for (int i = 0; i < 16; i += 2) {
            cb_load(Ib, A, tok0 + i + 1, lane);
            cb_compute(Ia, A, tok0 + i, lane, l, cA3, cA4, cS4);
            if (i + 2 < 16) cb_load(Ia, A, tok0 + i + 2, lane);
            cb_compute(Ib, A, tok0 + i + 1, lane, l, cA3, cA4, cS4);
        }
    }
}
#ifndef MK_SINGLE
#define MK_SINGLE 1
#endif
#ifndef DUPMASK
#define DUPMASK 0
#endif
#define REPS(g) ((PROBE_PHASE == (g)) ? 2 : 1)
#define IN(k) (lo <= (k) && (k) < hi)
#define SEAM(k) do { if (IN((k) + 1)) xcd_barrier(bar); } while (0)
template <int l> __device__ __forceinline__ void layer_phases(Frame& F, const Args& A, const int lo, const int hi, const XcdBarrier& bar) {
        enum { P_HM = 0, P_PROJ, P_CMPR, P_ATTA, P_ATTB, P_OUT, P_POST, P_GU, P_DN, P_COMB, NPL };
        const int pb = 1 + NPL * l;
        if (IN(pb + P_HM) && l == 0) { _Pragma("nounroll") for (int rep = 0; rep < REPS(1); ++rep) phase_hm0(F, A); SEAM(pb + P_HM); }
        if (IN(pb + P_PROJ)) {
            pg8::Gemm g{F_act, F_WinT + (size_t)l * PW * D, NTOK, PW, D}; pg8::StaticOrder So; So.init(NTOK, PW, F.G, (int)blockIdx.x);
            pg8::EpiProj E{F_proj, PW, F_ropec, F_ropes, F_kmean + (size_t)l * NB * 4 * 16 * 64};
            pg8::gemm_phase<pg8::EpiProj, pg8::StaticOrder, true, true>(F.lds, g, So, E);
            if (l == 0) { const int rem = ((NTOK / 256) * (PW / 256)) % F.G, c = (int)blockIdx.x;
                if (rem == 0) router_tables(F, A, c, F.G); else if (c >= rem) router_tables(F, A, c - rem, F.G - rem); }
            SEAM(pb + P_PROJ); }
        if (IN(pb + P_CMPR)) { _Pragma("nounroll") for (int rep = 0; rep < REPS(3); ++rep) phase_compress(F, A, l); SEAM(pb + P_CMPR); }
        if (IN(pb + P_ATTA)) { _Pragma("nounroll") for (int rep = 0; rep < REPS(4); ++rep) phase_attn_a(F, A, l, rep); SEAM(pb + P_ATTA); }
        if (IN(pb + P_ATTB)) { _Pragma("nounroll") for (int rep = 0; rep < REPS(5); ++rep) phase_attn_b(F, A, l, rep); SEAM(pb + P_ATTB); }
        if (IN(pb + P_OUT)) {
            pg8::Gemm g{F_o, F_WoutT + (size_t)l * D * D, NTOK, D, D}; pg8::StaticOrder So; So.init(NTOK, D, F.G, (int)blockIdx.x);
            LAS float* rt = (LAS float*)(F.lds + TAB_OFF + 2048);
            { const int ui = F.tid >> 8, r = F.tid & 255; pg8::Unit uu; if (So.next(ui, uu)) { const f32x4* sp = (const f32x4*)(F_oss + ((size_t)uu.pm * 256 + r) * 16);
                  const f32x4 a = sp[0], b1 = sp[1], c1 = sp[2], d1 = sp[3];
                  const float ssA = (a.x + a.y) + (a.z + a.w), ssB = ((b1.x + b1.y) + (b1.z + b1.w)) + (c1.x + c1.y), ssC = (c1.z + c1.w) + ((d1.x + d1.y) + (d1.z + d1.w));
                  const float rA = __builtin_amdgcn_rsqf(ssA * (1.f / 256.f) + RMS_EPS), rB = __builtin_amdgcn_rsqf(ssB * (1.f / 384.f) + RMS_EPS), rC = __builtin_amdgcn_rsqf(ssC * (1.f / 384.f) + RMS_EPS);
                  *(LAS f32x4*)(rt + (ui * 256 + r) * 4) = (f32x4){rA * __builtin_amdgcn_rcpf(rB), rB * __builtin_amdgcn_rcpf(rC), rC, 0.f}; } }
            __syncthreads();
            pg8::EpiBf16 E{F_y, D, nullptr, 0, 0};
            pg8::gemm_phase_gn<pg8::EpiBf16, pg8::StaticOrder, true, true>(F.lds, g, So, E, (const LAS float*)rt);
            SEAM(pb + P_OUT); }
        if (IN(pb + P_POST)) { _Pragma("nounroll") for (int rep = 0; rep < REPS(8); ++rep) phase_postmix(F, A, l, l + 2 * rep); SEAM(pb + P_POST); }
        if (IN(pb + P_GU)) {
            const int nt = moe_tables(F, A, l);
            pg8::Gemm g{(const pg8::bf16_t*)F_act8, (const pg8::bf16_t*)(F_Wgu8 + (size_t)l * NE * 2048 * D), MAXROWS, NE * 2048, D};
            pg8::MoeOrder So{8, nt, F.G, F.vcu, (const LAS unsigned char*)(F.lds + TAB_OFF + 256), (const LAS int*)(F.lds + TAB_OFF), (const LAS int*)(F.lds + TAB_OFF + 896), F_list, NTOK};
            pg8::EpiSwiglu8 E{F_sact8, F_b_gu + (size_t)l * NE * 2048, (LAS float*)(F.lds + TAB_OFF + 2048)};
            _Pragma("nounroll") for (int rep = 0; rep < REPS(9); ++rep) pg8::gemm_phase_g8<pg8::EpiSwiglu8, pg8::MoeOrder, true, true>(F.lds, g, So, E);
            SEAM(pb + P_GU); }
        if (IN(pb + P_DN)) {
            const int nt = moe_tables(F, A, l);
            pg8::Gemm g{(const pg8::bf16_t*)F_sact8, (const pg8::bf16_t*)(F_Wdn8 + (size_t)l * NE * D * D), MAXROWS, NE * D, D};
            pg8::MoeOrder So{4, nt, F.G, F.vcu, (const LAS unsigned char*)(F.lds + TAB_OFF + 256), (const LAS int*)(F.lds + TAB_OFF), (const LAS int*)(F.lds + TAB_OFF + 896), F_list, NTOK};
            pg8::EpiDn E{F_yt8, F_b_dn + (size_t)l * NE * D, (const LAS int*)(F.lds + TAB_OFF), (const LAS int*)(F.lds + TAB_OFF + 896), F_list, NTOK, F_lgate, (LAS float*)(F.lds + TAB_OFF + 2048)};
            _Pragma("nounroll") for (int rep = 0; rep < REPS(10); ++rep) pg8::gemm_phase8<pg8::EpiDn, pg8::MoeOrder, true, true>(F.lds, g, So, E);
            SEAM(pb + P_DN); }
        if (IN(pb + P_COMB)) { _Pragma("nounroll") for (int rep = 0; rep < REPS(11); ++rep) phase_combine(F, A, l); SEAM(pb + P_COMB); }
    }
#undef IN
#undef SEAM
__global__ void __launch_bounds__(NWAVES * 64, 2) mk_fwd(Args A) {
    extern __shared__ __attribute__((aligned(16))) unsigned char lds[];
    Frame F;
    F.lds = (LAS unsigned char*)lds; F.MISC = (volatile LAS unsigned*)(F.lds + MISC_OFF);
    F.tid = threadIdx.x; F.lane = F.tid & 63; F.wave = __builtin_amdgcn_readfirstlane(F.tid >> 6);
    F.G = gridDim.x; { const int bx = blockIdx.x; F.vcu = (F.G % 8 == 0) ? (bx % 8) * (F.G / 8) + bx / 8 : bx; }
    F.ctl = (gu32*)(A.ws + WS_CTL);
    for (int u = F.tid; u < (LDS_BYTES - LDSCTL_OFF) / 4; u += NWAVES * 64) ((LAS unsigned*)(F.lds + LDSCTL_OFF))[u] = 0u;
    __syncthreads();
    const int lo = A.ph_lo, hi = A.ph_hi;
    XcdBarrier bar; bar.bar = (unsigned*)(F.ctl + CW_BAR) + A.li * XCD_BAR_WORDS; bar.x = 0; bar.st = nullptr;
    if (hi - lo > 1) bar = xcd_barrier_post((unsigned*)(F.ctl + CW_BAR) + A.li * XCD_BAR_WORDS, F.MISC + 8);
#define IN(k) (lo <= (k) && (k) < hi)
#define SEAM(k) do { if (IN((k) + 1)) xcd_barrier(bar); } while (0)
    if (IN(0)) { _Pragma("nounroll") for (int rep = 0; rep < REPS(0); ++rep) p0_prologue(F, A); SEAM(0); }
    layer_phases<0>(F, A, lo, hi, bar);
    layer_phases<1>(F, A, lo, hi, bar);
#undef IN
#undef SEAM
}

extern "C" void kernel_launch(void* const* d_in, const int* in_sizes, int n_in, void* d_out, int out_size, void* d_ws, size_t ws_size, hipStream_t stream) {
    static int grid = 0;
    if (grid == 0) {
        if (n_in != 17 || in_sizes[0] != NTOK * D || out_size != NTOK * D || ws_size < WS_END) { fprintf(stderr, "kernel_launch: unexpected shapes (n_in %d, in0 %d, out %d, ws %zu); nothing launched\n", n_in, n_in > 0 ? in_sizes[0] : -1, out_size, ws_size); grid = -1; return; }
        int dev = 0, cus = 0, per_cu = 0;
        if (hipGetDevice(&dev) != hipSuccess || hipDeviceGetAttribute(&cus, hipDeviceAttributeMultiprocessorCount, dev) != hipSuccess) { grid = -1; return; }
        if (hipFuncSetAttribute((const void*)mk_fwd, hipFuncAttributeMaxDynamicSharedMemorySize, LDS_BYTES) != hipSuccess) { fprintf(stderr, "kernel_launch: hipFuncSetAttribute failed\n"); grid = -1; return; }
        if (hipOccupancyMaxActiveBlocksPerMultiprocessor(&per_cu, (const void*)mk_fwd, NWAVES * 64, LDS_BYTES) != hipSuccess || per_cu < 1) { fprintf(stderr, "kernel_launch: occupancy query says %d blocks per CU\n", per_cu); }
        (void)hipGetLastError();
        grid = cus;
    }
    if (grid < 0) return;
    if (hipMemsetAsync((char*)d_ws + WS_CTL, 0, CTL_ZERO_BYTES, stream) != hipSuccess) return;
    Args a{};
    for (int i = 0; i < 17; ++i) a.in[i] = (const float*)d_in[i];
        a.out = (float*)d_out; a.ws = (unsigned char*)d_ws; a.pad = 0;
#if MK_SINGLE
    a.ph_lo = 0; a.ph_hi = NPHASE; a.li = 0;
    hipLaunchKernelGGL(mk_fwd, dim3(grid), dim3(NWAVES * 64), LDS_BYTES, stream, a);
#else
    int li = 0;
    for (int p = 0; p < NPHASE; ++p) { if (p == 11) continue;
        a.ph_lo = p; a.ph_hi = p + 1; a.li = li++;
        hipLaunchKernelGGL(mk_fwd, dim3(grid), dim3(NWAVES * 64), LDS_BYTES, stream, a); }
#endif
    const hipError_t le = hipPeekAtLastError();
    if (le != hipSuccess) fprintf(stderr, "kernel_launch: launch failed: %s\n", hipGetErrorName(le));
}
```

```cpp
#include <hip/hip_runtime.h>
#include <cstdio>
#include <cstdint>
namespace pg8 {
#define PG8_LAS __attribute__((address_space(3)))
typedef unsigned short bf16_t;
typedef short bf16x8 __attribute__((ext_vector_type(8)));
typedef float f32x4 __attribute__((ext_vector_type(4)));
typedef unsigned u32x4 __attribute__((ext_vector_type(4)));
constexpr int BM = 256, BK = 64, HALF = 128, HTB = HALF * BK * 2  , STAGE_BYTES = 8 * HTB, NXCD = 8, WGM = 8;

__host__ __device__ __forceinline__ int lds_byte(int r, int c) { const int st = (r >> 4) * 2 + (c >> 5), rr = r & 15, cc = c & 31, ob = rr * 64 + cc * 2; return st * 1024 + (ob ^ (((ob >> 9) & 1) << 5)); }
__host__ __device__ __forceinline__ void stage_rc(int b, int& R, int& C) { const int st = b / 1024, sb = b % 1024, swz = sb ^ (((sb >> 9) & 1) << 5); R = (st >> 1) * 16 + swz / 64; C = (st & 1) * 32 + (swz % 64) / 2; }
__host__ __device__ __forceinline__ int perm32(int rho) { const int n = rho >> 4, i = rho & 15; return 8 * (i >> 2) + 4 * n + (i & 3); }

struct Unit { int pm, pn; };
struct Gemm { const bf16_t* A; const bf16_t* Bt; int M, N, K; };

struct StaticOrder {
    int nM, nN, nwg, G, c;
    __host__ __device__ void init(int M, int N, int G_, int c_) { nM = M / BM; nN = N / BM; nwg = nM * nN; G = G_; c = c_; }
    __host__ __device__ bool next(int i, Unit& u) const {
        const long L = (long)i * G + c; if (L >= nwg) return false;
        int wgid = (int)L; { const int q = nwg / NXCD, r = nwg % NXCD, xcd = wgid % NXCD, off = wgid / NXCD; wgid = (xcd < r ? xcd * (q + 1) : r * (q + 1) + (xcd - r) * q) + off; }
        const int nig = WGM * nN, gid = wgid / nig, fm = gid * WGM, gsz = (nM - fm) < WGM ? (nM - fm) : WGM;
        u.pm = fm + ((wgid % nig) % gsz); u.pn = (wgid % nig) / gsz; return true;
    }
    __device__ __forceinline__ void a_ready(const Unit&) const {}
    __device__ __forceinline__ void done(const Unit&) const {}
};

__device__ __forceinline__ unsigned cvt_pk_bf16(float lo, float hi) { unsigned r; asm volatile("v_cvt_pk_bf16_f32 %0, %1, %2" : "=v"(r) : "v"(lo), "v"(hi)); return r; }
struct EpiBf16 {
    static constexpr bool PERM = true, AFTER_DRAIN = false;
    bf16_t* O; int ldc; const float* bias; int split_cols; size_t split_stride;
    __device__ __forceinline__ void operator()(const f32x4 (&acc)[2][2][4][2], const Unit& u, int wr, int wc, int fr, int fq) const {
        const int row0 = u.pm * BM + wr * 64 + fr; int colt = u.pn * BM; bf16_t* base = O;
        if (split_cols) { const int t = colt / split_cols; base += (size_t)t * split_stride; colt -= t * split_cols; }
        const int col0 = colt + wc * 32 + 8 * fq, bcol0 = u.pn * BM + wc * 32 + 8 * fq;
        f32x4 bv[2][2];
#pragma unroll
        for (int bj = 0; bj < 2; ++bj)
#pragma unroll
            for (int n = 0; n < 2; ++n) bv[bj][n] = bias ? *(const f32x4*)(bias + bcol0 + bj * HALF + 4 * n) : (f32x4){0.f, 0.f, 0.f, 0.f};
#pragma unroll
        for (int ai = 0; ai < 2; ++ai)
#pragma unroll
            for (int m = 0; m < 4; ++m) { bf16_t* rowp = base + (size_t)(row0 + ai * HALF + m * 16) * ldc + col0;
#pragma unroll
                for (int bj = 0; bj < 2; ++bj) { f32x4 v0 = acc[ai][bj][m][0] + bv[bj][0], v1 = acc[ai][bj][m][1] + bv[bj][1];
                    u32x4 w; w.x = cvt_pk_bf16(v0[0], v0[1]); w.y = cvt_pk_bf16(v0[2], v0[3]); w.z = cvt_pk_bf16(v1[0], v1[1]); w.w = cvt_pk_bf16(v1[2], v1[3]);
                    *(u32x4*)(rowp + bj * HALF) = w; } }
    }
};
struct EpiProj {
    static constexpr bool PERM = true, AFTER_DRAIN = false;
    bf16_t* O; int ldc; const float* ropec; const float* ropes; float* kmean;
    __device__ __forceinline__ void operator()(const f32x4 (&acc)[2][2][4][2], const Unit& u, int wr, int wc, int fr, int fq) const {
        const int row0 = u.pm * BM + wr * 64 + fr; const int colt = u.pn * BM;
        const int col0 = colt + wc * 32 + 8 * fq;
        constexpr unsigned ROPEM = 0xFFu | (0x3Fu << 12) | (1u << 18) | (1u << 20) | (1u << 22);
        float ks[2][8];
#pragma unroll
        for (int bj = 0; bj < 2; ++bj)
#pragma unroll
            for (int q = 0; q < 8; ++q) ks[bj][q] = 0.f;
#pragma unroll
        for (int ai = 0; ai < 2; ++ai)
#pragma unroll
            for (int m = 0; m < 4; ++m) { const int row = row0 + ai * HALF + m * 16; bf16_t* rowp = O + (size_t)row * ldc + col0;
#pragma unroll
                for (int bj = 0; bj < 2; ++bj) { f32x4 v0 = acc[ai][bj][m][0], v1 = acc[ai][bj][m][1];
                    const int head = (colt + bj * HALF + wc * 32) >> 6;
                    if (((wc & 1) == 0) && head < 32 && ((ROPEM >> head) & 1u)) {
                        float x[8] = {v0[0], v0[1], v0[2], v0[3], v1[0], v1[1], v1[2], v1[3]}, y[8];
#pragma unroll
                        for (int q = 0; q < 8; ++q) y[q] = __shfl_xor(x[q], 16);
                        if (fq < 2) { const int t = row & 4095; const f32x4 c0 = *(const f32x4*)(ropec + t * 8), c1 = *(const f32x4*)(ropec + t * 8 + 4), s0 = *(const f32x4*)(ropes + t * 8), s1 = *(const f32x4*)(ropes + t * 8 + 4);
                            const float cs[8] = {c0[0], c0[1], c0[2], c0[3], c1[0], c1[1], c1[2], c1[3]}, sn[8] = {s0[0], s0[1], s0[2], s0[3], s1[0], s1[1], s1[2], s1[3]};
#pragma unroll
                            for (int q = 0; q < 8; ++q) x[q] = (fq == 0) ? x[q] * cs[q] - y[q] * sn[q] : x[q] * cs[q] + y[q] * sn[q];
                            v0 = (f32x4){x[0], x[1], x[2], x[3]}; v1 = (f32x4){x[4], x[5], x[6], x[7]}; } }
                    if (u.pn == 1) {
#pragma unroll
                        for (int q = 0; q < 4; ++q) { ks[bj][q] += v0[q]; ks[bj][4 + q] += v1[q]; } }
                    u32x4 w; w.x = cvt_pk_bf16(v0[0], v0[1]); w.y = cvt_pk_bf16(v0[2], v0[3]); w.z = cvt_pk_bf16(v1[0], v1[1]); w.w = cvt_pk_bf16(v1[2], v1[3]);
                    *(u32x4*)(rowp + bj * HALF) = w; } }
        if (u.pn == 1) {
#pragma unroll
            for (int bj = 0; bj < 2; ++bj)
#pragma unroll
                for (int q = 0; q < 8; ++q) { float s = ks[bj][q]; s += __shfl_xor(s, 1); s += __shfl_xor(s, 2); s += __shfl_xor(s, 4); s += __shfl_xor(s, 8); ks[bj][q] = s; }
            if (fr == 0) { const int b = u.pm >> 4, blk = u.pm & 15;
#pragma unroll
                for (int bj = 0; bj < 2; ++bj) { const int c = bj * HALF + wc * 32 + 8 * fq, h = c >> 6, d = c & 63;
#pragma unroll
                    for (int q = 0; q < 8; ++q) atomicAdd(kmean + ((size_t)(b * 4 + h) * 16 + blk) * 64 + d + q, ks[bj][q] * (1.f / 256.f)); } }
        }
    }
};
struct EpiSwiglu {
    static constexpr bool PERM = true, AFTER_DRAIN = false;
    bf16_t* O; const float* bias;
    __device__ __forceinline__ void operator()(const f32x4 (&acc)[2][2][4][2], const Unit& u, int wr, int wc, int fr, int fq) const {
        const int row0 = u.pm * BM + wr * 64 + fr; const int e = u.pn >> 3, j = u.pn & 7;
        const int cc = wc * 32 + 8 * fq;
        const float* bg = bias + (size_t)e * 2048 + j * 128 + cc; const float* bl = bg + 1024;
        f32x4 bgv[2], blv[2];
#pragma unroll
        for (int n = 0; n < 2; ++n) { bgv[n] = *(const f32x4*)(bg + 4 * n); blv[n] = *(const f32x4*)(bl + 4 * n); }
#pragma unroll
        for (int ai = 0; ai < 2; ++ai)
#pragma unroll
            for (int m = 0; m < 4; ++m) { bf16_t* rowp = O + (size_t)(row0 + ai * HALF + m * 16) * 1024 + j * 128 + cc;
                float r[8];
#pragma unroll
                for (int n = 0; n < 2; ++n) { const f32x4 g4 = acc[ai][0][m][n] + bgv[n], l4 = acc[ai][1][m][n] + blv[n];
#pragma unroll
                    for (int q = 0; q < 4; ++q) { float g = fminf(g4[q], 7.0f); float l = fminf(fmaxf(l4[q], -7.0f), 7.0f);
                        const float sg = 1.0f / (1.0f + __expf(-1.702f * g)); r[4 * n + q] = g * sg * (l + 1.0f); } }
                u32x4 w; w.x = cvt_pk_bf16(r[0], r[1]); w.y = cvt_pk_bf16(r[2], r[3]); w.z = cvt_pk_bf16(r[4], r[5]); w.w = cvt_pk_bf16(r[6], r[7]);
                *(u32x4*)rowp = w; }
    }
};
__device__ __forceinline__ unsigned pk4_fp8(float a, float b, float c, float d) { const int r = __builtin_amdgcn_cvt_pk_fp8_f32(a, b, 0, false); return (unsigned)__builtin_amdgcn_cvt_pk_fp8_f32(c, d, r, true); }
constexpr float W8_SCALE = 64.f, W8_INV = 1.f / 64.f, ACT8_SCALE = 4.f, DN8_INV = 1.f / 256.f, YT8_SCALE = 16.f;
struct EpiSwiglu8 {
    static constexpr bool PERM = true, AFTER_DRAIN = false;
    unsigned char* O; const float* bias; PG8_LAS float* tab;
    __device__ __forceinline__ void prefetch(const Unit& u, int par, int wid, int lane) const {
        if (wid < 4) { const int e = u.pn >> 3, j = u.pn & 7, idx = wid * 64 + lane;
            __builtin_amdgcn_global_load_lds((const unsigned*)(bias + (size_t)e * 2048 + (idx >> 7) * 1024 + j * 128 + (idx & 127)), (PG8_LAS unsigned*)(tab + par * 256 + wid * 64), 4, 0, 0); }
    }
    __device__ __forceinline__ void operator()(const f32x4 (&acc)[2][2][4][2], const Unit& u, int wr, int wc, int fr, int fq, int par) const {
        const int row0 = u.pm * BM + wr * 64 + fr; const int j = u.pn & 7;
        const int cc = wc * 32 + 8 * fq;
        const PG8_LAS float* bg = tab + par * 256 + cc; const PG8_LAS float* bl = bg + 128;
        typedef _Float16 h2_ __attribute__((ext_vector_type(2))); typedef short s2_ __attribute__((ext_vector_type(2)));
#define PG8_PKH(a, b) __builtin_bit_cast(h2_, __builtin_amdgcn_cvt_pkrtz((a), (b)))
        h2_ bg2[2][2], bl2[2][2];
#pragma unroll
        for (int n = 0; n < 2; ++n) { const f32x4 a = *(const PG8_LAS f32x4*)(bg + 4 * n), b = *(const PG8_LAS f32x4*)(bl + 4 * n);
            bg2[n][0] = PG8_PKH(a.x, a.y); bg2[n][1] = PG8_PKH(a.z, a.w); bl2[n][0] = PG8_PKH(b.x, b.y); bl2[n][1] = PG8_PKH(b.z, b.w); }
        const h2_ hinv = {(_Float16)W8_INV, (_Float16)W8_INV}, h7 = {(_Float16)7.0f, (_Float16)7.0f}, hm7 = {(_Float16)-7.0f, (_Float16)-7.0f}, hk = {(_Float16)-2.4554669595930156f, (_Float16)-2.4554669595930156f},
                  h1 = {(_Float16)1.0f, (_Float16)1.0f}, h4 = {(_Float16)ACT8_SCALE, (_Float16)ACT8_SCALE};
#pragma unroll
        for (int ai = 0; ai < 2; ++ai)
#pragma unroll
            for (int m = 0; m < 4; ++m) { unsigned char* rowp = O + (size_t)(row0 + ai * HALF + m * 16) * 1024 + j * 128 + cc;
                s2_ wv[2];
#pragma unroll
                for (int n = 0; n < 2; ++n) { wv[n] = (s2_){0, 0};
#pragma unroll
                    for (int hq = 0; hq < 2; ++hq) {
                        const h2_ G = PG8_PKH(acc[ai][0][m][n][2 * hq], acc[ai][0][m][n][2 * hq + 1]) * hinv + bg2[n][hq];
                        const h2_ L = PG8_PKH(acc[ai][1][m][n][2 * hq], acc[ai][1][m][n][2 * hq + 1]) * hinv + bl2[n][hq];
                        const h2_ g = __builtin_elementwise_min(G, h7), l = __builtin_elementwise_max(__builtin_elementwise_min(L, h7), hm7);
                        const h2_ t = g * hk; h2_ e; e.x = __builtin_exp2f16(t.x); e.y = __builtin_exp2f16(t.y);
                        const h2_ d = e + h1; h2_ rr; rr.x = __builtin_amdgcn_rcph(d.x); rr.y = __builtin_amdgcn_rcph(d.y);
                        const h2_ o = (g * rr) * (l * h4 + h4);
                        wv[n] = hq == 0 ? __builtin_amdgcn_cvt_scalef32_pk_fp8_f16(wv[n], o, 1.0f, false) : __builtin_amdgcn_cvt_scalef32_pk_fp8_f16(wv[n], o, 1.0f, true); } }
                typedef unsigned u32x2_ __attribute__((ext_vector_type(2)));
                u32x2_ w; w.x = __builtin_bit_cast(unsigned, wv[0]); w.y = __builtin_bit_cast(unsigned, wv[1]);
                *(u32x2_*)rowp = w; }
#undef PG8_PKH
    }
};
struct EpiDn {
    static constexpr bool PERM = true, AFTER_DRAIN = false;
    unsigned char* O; const float* bias; const PG8_LAS int* rowbase; const PG8_LAS int* ecnt; const int* list; int cap; const float* lgate; PG8_LAS float* tab;
    __device__ __forceinline__ void prefetch(const Unit& u, int par, int wid, int lane) const {
        const int e = u.pn >> 2, j = u.pn & 3; const int pb = u.pm * BM - rowbase[e]; PG8_LAS float* t = tab + par * 768;
        if (wid < 4) { const int r = wid * 64 + lane;
            __builtin_amdgcn_global_load_lds((const unsigned*)(list + (size_t)e * cap + pb + r), (PG8_LAS unsigned*)(t + wid * 64), 4, 0, 0);
            __builtin_amdgcn_global_load_lds((const unsigned*)(bias + (size_t)e * 1024 + j * BM + r), (PG8_LAS unsigned*)(t + 512 + wid * 64), 4, 0, 0); }
        else { const int r = (wid - 4) * 64 + lane;
            __builtin_amdgcn_global_load_lds((const unsigned*)(lgate + (size_t)e * cap + pb + r), (PG8_LAS unsigned*)(t + 256 + (wid - 4) * 64), 4, 0, 0); }
    }
    __device__ __forceinline__ void operator()(const f32x4 (&acc)[2][2][4][2], const Unit& u, int wr, int wc, int fr, int fq, int par) const {
        const int e = u.pn >> 2, j = u.pn & 3; const int pl0 = wr * 64 + fr; const int p0 = u.pm * BM - rowbase[e] + pl0, cnt = ecnt[e];
        const int col0 = j * BM + wc * 64 + 16 * fq; const PG8_LAS float* t = tab + par * 768; const PG8_LAS float* bp = t + 512 + wc * 64 + 16 * fq;
        f32x4 bv[2][2];
#pragma unroll
        for (int bj = 0; bj < 2; ++bj)
#pragma unroll
            for (int n = 0; n < 2; ++n) bv[bj][n] = *(const PG8_LAS f32x4*)(bp + 8 * bj + 4 * n);
        int id[2][4]; float gt[2][4];
#pragma unroll
        for (int ai = 0; ai < 2; ++ai)
#pragma unroll
            for (int m = 0; m < 4; ++m) { const int q = ai * HALF + m * 16; id[ai][m] = (p0 + q < cnt) ? ((const PG8_LAS int*)t)[pl0 + q] : -1; gt[ai][m] = t[256 + pl0 + q]; }
#pragma unroll
        for (int ai = 0; ai < 2; ++ai)
#pragma unroll
            for (int m = 0; m < 4; ++m) { if (id[ai][m] < 0) continue; unsigned char* rowp = O + (size_t)id[ai][m] * 1024 + col0; const float g = gt[ai][m] * YT8_SCALE;
                unsigned wq[4];
#pragma unroll
                for (int bj = 0; bj < 2; ++bj) { const f32x4 v0 = (acc[ai][bj][m][0] * DN8_INV + bv[bj][0]) * g, v1 = (acc[ai][bj][m][1] * DN8_INV + bv[bj][1]) * g;
                    wq[2 * bj] = pk4_fp8(v0[0], v0[1], v0[2], v0[3]); wq[2 * bj + 1] = pk4_fp8(v1[0], v1[1], v1[2], v1[3]); }
                *(u32x4*)rowp = (u32x4){wq[0], wq[1], wq[2], wq[3]}; }
    }
};
struct MoeOrder {
    int NJ, ntiles, G, vcu; const PG8_LAS unsigned char* texp; const PG8_LAS int* rowbase; const PG8_LAS int* ecnt; const int* list; int cap;
    __device__ __forceinline__ int rowtok(const Unit& u, int r) const { const int e = u.pn / NJ; const int p = u.pm * 256 - rowbase[e] + r; return p < ecnt[e] ? (list[(size_t)e * cap + p] >> 2) : 0; }
    __device__ __forceinline__ bool next(int i, Unit& u) const {
        const int L = i * G + vcu; const int pm = L / NJ; if (pm >= ntiles) return false;
        const int j = L - pm * NJ; const int e = texp[pm]; u.pm = pm; u.pn = e * NJ + j; return true; }
    __device__ __forceinline__ void a_ready(const Unit&) const {}
    __device__ __forceinline__ void done(const Unit&) const {}
};
template <class Epi, class Sched, bool ALIGN_EPI = false, bool SP2 = false>
__device__ __forceinline__ void gemm_phase(PG8_LAS unsigned char* lds, const Gemm g, const Sched& S, const Epi& E) {
    int tid_ = threadIdx.x; asm volatile("" : "+v"(tid_));
    const int tid = tid_, wid = __builtin_amdgcn_readfirstlane(tid >> 6), lane = tid & 63, wr = wid >> 2, wc = wid & 3, fr = lane & 15, fq = lane >> 4;
    const int K = g.K, nt = K / BK;
    unsigned voffA[2], voffB[2];
#pragma unroll
    for (int i = 0; i < 2; ++i) { int R, C; stage_rc(tid * 16 + i * 8192, R, C); const int Rb = Epi::PERM ? ((R & ~31) + perm32(R & 31)) : R;
        voffA[i] = (unsigned)(R * K + C) * 2u; voffB[i] = (unsigned)(Rb * K + C) * 2u; }
    const size_t kstep = (size_t)(BK * 2);
    const size_t hstep = (size_t)HALF * K * 2;
    const size_t tstep = 2 * hstep;
    const unsigned ldsw = (unsigned)wid * 1024u;
    const int aoff = lds_byte(wr * 64 + fr, fq * 8), boff = lds_byte(wc * 32 + fr, fq * 8);
#define PG8_SA(b, h) (((b) * 2 + (h)) * HTB)
#define PG8_SB(b, h) ((4 + (b) * 2 + (h)) * HTB)
#define PG8_STAGE(bufoff, gbase, voff) do { _Pragma("unroll") for (int _i = 0; _i < 2; ++_i) \
        __builtin_amdgcn_global_load_lds((const unsigned*)((const char*)(gbase) + (voff)[_i]), (PG8_LAS unsigned*)(lds + (bufoff) + ldsw + _i * 8192), 16, 0, 0); } while (0)
#define PG8_LDA(dst, b, h) do { _Pragma("unroll") for (int m = 0; m < 4; ++m) _Pragma("unroll") for (int k = 0; k < 2; ++k) dst[m][k] = *(const PG8_LAS bf16x8*)(lds + PG8_SA(b, h) + aoff + m * 2048 + k * 1024); } while (0)
#define PG8_LDB(dst, b, h) do { _Pragma("unroll") for (int n = 0; n < 2; ++n) _Pragma("unroll") for (int k = 0; k < 2; ++k) dst[n][k] = *(const PG8_LAS bf16x8*)(lds + PG8_SB(b, h) + boff + n * 2048 + k * 1024); } while (0)
#define PG8_MMA(ai, bj, At, Bt) do { __builtin_amdgcn_s_setprio(1); _Pragma("unroll") for (int m = 0; m < 4; ++m) _Pragma("unroll") for (int n = 0; n < 2; ++n) _Pragma("unroll") for (int k = 0; k < 2; ++k) \
        acc[ai][bj][m][n] = __builtin_amdgcn_mfma_f32_16x16x32_bf16(Bt[n][k], At[m][k], acc[ai][bj][m][n], 0, 0, 0); __builtin_amdgcn_s_setprio(0); } while (0)
#define PG8_WAIT_V(n) asm volatile("s_waitcnt vmcnt(" #n ")" ::: "memory")
#define PG8_WAIT_L(n) asm volatile("s_waitcnt lgkmcnt(" #n ")" ::: "memory")
#define PG8_BAR __builtin_amdgcn_s_barrier()
#define PG8_SCHED __builtin_amdgcn_sched_barrier(0)
    Unit cur, nxt; int ui = 0;
    if (!S.next(0, cur)) return;
    f32x4 acc[2][2][4][2];
#pragma unroll
    for (int a = 0; a < 2; ++a)
#pragma unroll
        for (int b = 0; b < 2; ++b)
#pragma unroll
            for (int m = 0; m < 4; ++m)
#pragma unroll
                for (int n = 0; n < 2; ++n) acc[a][b][m][n] = (f32x4){0.f, 0.f, 0.f, 0.f};
    bf16x8 At[4][2], B0[2][2], B1[2][2];
    const char* cA = (const char*)g.A + (size_t)cur.pm * tstep; const char* cB = (const char*)g.Bt + (size_t)cur.pn * tstep;
    S.a_ready(cur);
    if constexpr (SP2) {
        PG8_STAGE(PG8_SB(0, 0), cB, voffB); PG8_STAGE(PG8_SB(0, 1), cB + hstep, voffB); PG8_STAGE(PG8_SA(0, 0), cA, voffA); PG8_STAGE(PG8_SA(0, 1), cA + hstep, voffA);
        if (wr == 1) PG8_BAR;
        PG8_WAIT_V(2); PG8_BAR;
        PG8_STAGE(PG8_SB(1, 0), cB + kstep, voffB); PG8_STAGE(PG8_SA(1, 0), cA + kstep, voffA); PG8_STAGE(PG8_SB(1, 1), cB + hstep + kstep, voffB);
        PG8_WAIT_V(6); PG8_BAR;
    } else {
        PG8_STAGE(PG8_SB(0, 0), cB, voffB); PG8_STAGE(PG8_SA(0, 0), cA, voffA); PG8_STAGE(PG8_SB(0, 1), cB + hstep, voffB); PG8_STAGE(PG8_SA(0, 1), cA + hstep, voffA);
        if (wr == 1) PG8_BAR;
        PG8_WAIT_V(4); PG8_BAR;
        PG8_STAGE(PG8_SB(1, 0), cB + kstep, voffB); PG8_STAGE(PG8_SA(1, 0), cA + kstep, voffA); PG8_STAGE(PG8_SB(1, 1), cB + hstep + kstep, voffB);
        PG8_WAIT_V(6); PG8_BAR;
    }
    for (;;) {
        const bool has_next = S.next(ui + 1, nxt);
        const char* nA = has_next ? (const char*)g.A + (size_t)nxt.pm * tstep : cA; const char* nB = has_next ? (const char*)g.Bt + (size_t)nxt.pn * tstep : cB;
        for (int t = 0; t < nt; t += 2) {
            const bool last = (t == nt - 2);
            const char* a1 = cA + (size_t)(t + 1) * kstep;
            const char* a2 = last ? nA : cA + (size_t)(t + 2) * kstep; const char* b2 = last ? nB : cB + (size_t)(t + 2) * kstep;
            const char* a3 = a2 + kstep; const char* b3 = b2 + kstep;
            if (last && has_next) S.a_ready(nxt);
            if constexpr (SP2) {
            PG8_LDB(B0, 0, 0); PG8_LDB(B1, 0, 1); PG8_SCHED; PG8_LDA(At, 0, 0); PG8_STAGE(PG8_SA(1, 1), a1 + hstep, voffA);
            PG8_WAIT_V(8); PG8_WAIT_L(0); PG8_BAR; PG8_MMA(0, 0, At, B0); PG8_MMA(0, 1, At, B1); PG8_BAR; PG8_SCHED;
            PG8_LDA(At, 0, 1); PG8_STAGE(PG8_SB(0, 0), b2, voffB); PG8_STAGE(PG8_SB(0, 1), b2 + hstep, voffB); PG8_STAGE(PG8_SA(0, 0), a2, voffA);
            PG8_WAIT_V(8); PG8_WAIT_L(0); PG8_BAR; PG8_MMA(1, 0, At, B0); PG8_MMA(1, 1, At, B1); PG8_BAR; PG8_SCHED;
            PG8_LDB(B0, 1, 0); PG8_LDB(B1, 1, 1); PG8_SCHED; PG8_LDA(At, 1, 0); PG8_STAGE(PG8_SA(0, 1), a2 + hstep, voffA);
            PG8_WAIT_V(8); PG8_WAIT_L(0); PG8_BAR; PG8_MMA(0, 0, At, B0); PG8_MMA(0, 1, At, B1); PG8_BAR; PG8_SCHED;
            PG8_LDA(At, 1, 1); PG8_STAGE(PG8_SB(1, 0), b3, voffB); PG8_STAGE(PG8_SB(1, 1), b3 + hstep, voffB); PG8_STAGE(PG8_SA(1, 0), a3, voffA);
            PG8_WAIT_V(8); PG8_WAIT_L(0); PG8_BAR; PG8_MMA(1, 0, At, B0); PG8_MMA(1, 1, At, B1); PG8_BAR; PG8_SCHED;
            } else {
            PG8_LDB(B0, 0, 0); PG8_SCHED; PG8_LDA(At, 0, 0); PG8_STAGE(PG8_SA(1, 1), a1 + hstep, voffA);
            PG8_WAIT_L(8); PG8_BAR; PG8_WAIT_L(0); PG8_MMA(0, 0, At, B0); PG8_BAR; PG8_SCHED;
            PG8_LDB(B1, 0, 1); PG8_STAGE(PG8_SB(0, 0), b2, voffB);
            PG8_BAR; PG8_WAIT_L(0); PG8_MMA(0, 1, At, B1); PG8_BAR;
            PG8_LDA(At, 0, 1); PG8_STAGE(PG8_SA(0, 0), a2, voffA);
            PG8_BAR; PG8_WAIT_L(0); PG8_MMA(1, 0, At, B0); PG8_BAR; PG8_SCHED;
            PG8_STAGE(PG8_SB(0, 1), b2 + hstep, voffB);
            PG8_WAIT_V(6); PG8_BAR; PG8_MMA(1, 1, At, B1); PG8_BAR;
            PG8_LDB(B0, 1, 0); PG8_SCHED; PG8_LDA(At, 1, 0); PG8_STAGE(PG8_SA(0, 1), a2 + hstep, voffA);
            PG8_WAIT_L(8); PG8_BAR; PG8_WAIT_L(0); PG8_MMA(0, 0, At, B0); PG8_BAR; PG8_SCHED;
            PG8_LDB(B1, 1, 1); PG8_STAGE(PG8_SB(1, 0), b3, voffB);
            PG8_BAR; PG8_WAIT_L(0); PG8_MMA(0, 1, At, B1); PG8_BAR;
            PG8_LDA(At, 1, 1); PG8_STAGE(PG8_SA(1, 0), a3, voffA);
            PG8_BAR; PG8_WAIT_L(0); PG8_MMA(1, 0, At, B0); PG8_BAR; PG8_SCHED;
            PG8_STAGE(PG8_SB(1, 1), b3 + hstep, voffB);
            PG8_WAIT_V(6); PG8_BAR; PG8_MMA(1, 1, At, B1); PG8_BAR;
            }
        }
        if constexpr (ALIGN_EPI) { if (wr == 0) PG8_BAR; }
        if constexpr (!Epi::AFTER_DRAIN) { E(acc, cur, wr, wc, fr, fq); S.done(cur); }
        if (!has_next) break;
#pragma unroll
        for (int a = 0; a < 2; ++a)
#pragma unroll
            for (int b = 0; b < 2; ++b)
#pragma unroll
                for (int m = 0; m < 4; ++m)
#pragma unroll
                    for (int n = 0; n < 2; ++n) acc[a][b][m][n] = (f32x4){0.f, 0.f, 0.f, 0.f};
        cur = nxt; cA = nA; cB = nB; ++ui;
        if constexpr (ALIGN_EPI) { if (wr == 1) PG8_BAR; }
    }
    PG8_WAIT_V(0);
    if constexpr (!ALIGN_EPI) { if (wr == 0) PG8_BAR; }
    PG8_BAR;
    if constexpr (Epi::AFTER_DRAIN) { E.fused(acc, cur, wr, wc, fr, fq, lds, wid, lane); S.done(cur); }
#undef PG8_SA
#undef PG8_SB
#undef PG8_STAGE
#undef PG8_LDA
#undef PG8_LDB
#undef PG8_MMA
#ifdef PG8_MMAI
#undef PG8_MMAI
#endif
#undef PG8_WAIT_V
#undef PG8_WAIT_L
#undef PG8_BAR
#undef PG8_SCHED
}
template <class Epi, class Sched, bool ALIGN_EPI = false, bool SP2 = false>
__device__ __forceinline__ void gemm_phase_gn(PG8_LAS unsigned char* lds, const Gemm g, const Sched& S, const Epi& E, const PG8_LAS float* rt) {
    int tid_ = threadIdx.x; asm volatile("" : "+v"(tid_));
    const int tid = tid_, wid = __builtin_amdgcn_readfirstlane(tid >> 6), lane = tid & 63, wr = wid >> 2, wc = wid & 3, fr = lane & 15, fq = lane >> 4;
    const int K = g.K, nt = K / BK;
    unsigned voffA[2], voffB[2];
#pragma unroll
    for (int i = 0; i < 2; ++i) { int R, C; stage_rc(tid * 16 + i * 8192, R, C); const int Rb = Epi::PERM ? ((R & ~31) + perm32(R & 31)) : R;
        voffA[i] = (unsigned)(R * K + C) * 2u; voffB[i] = (unsigned)(Rb * K + C) * 2u; }
    const size_t kstep = (size_t)(BK * 2);
    const size_t hstep = (size_t)HALF * K * 2;
    const size_t tstep = 2 * hstep;
    const unsigned ldsw = (unsigned)wid * 1024u;
    const int aoff = lds_byte(wr * 64 + fr, fq * 8), boff = lds_byte(wc * 32 + fr, fq * 8);
#define PG8_SA(b, h) (((b) * 2 + (h)) * HTB)
#define PG8_SB(b, h) ((4 + (b) * 2 + (h)) * HTB)
#define PG8_STAGE(bufoff, gbase, voff) do { _Pragma("unroll") for (int _i = 0; _i < 2; ++_i) \
        __builtin_amdgcn_global_load_lds((const unsigned*)((const char*)(gbase) + (voff)[_i]), (PG8_LAS unsigned*)(lds + (bufoff) + ldsw + _i * 8192), 16, 0, 0); } while (0)
#define PG8_LDA(dst, b, h) do { _Pragma("unroll") for (int m = 0; m < 4; ++m) _Pragma("unroll") for (int k = 0; k < 2; ++k) dst[m][k] = *(const PG8_LAS bf16x8*)(lds + PG8_SA(b, h) + aoff + m * 2048 + k * 1024); } while (0)
#define PG8_LDB(dst, b, h) do { _Pragma("unroll") for (int n = 0; n < 2; ++n) _Pragma("unroll") for (int k = 0; k < 2; ++k) dst[n][k] = *(const PG8_LAS bf16x8*)(lds + PG8_SB(b, h) + boff + n * 2048 + k * 1024); } while (0)
#define PG8_MMA(ai, bj, At, Bt) do { __builtin_amdgcn_s_setprio(1); _Pragma("unroll") for (int m = 0; m < 4; ++m) _Pragma("unroll") for (int n = 0; n < 2; ++n) _Pragma("unroll") for (int k = 0; k < 2; ++k) \
        acc[ai][bj][m][n] = __builtin_amdgcn_mfma_f32_16x16x32_bf16(Bt[n][k], At[m][k], acc[ai][bj][m][n], 0, 0, 0); __builtin_amdgcn_s_setprio(0); } while (0)
#define PG8_WAIT_V(n) asm volatile("s_waitcnt vmcnt(" #n ")" ::: "memory")
#define PG8_WAIT_L(n) asm volatile("s_waitcnt lgkmcnt(" #n ")" ::: "memory")
#define PG8_BAR __builtin_amdgcn_s_barrier()
#define PG8_SCHED __builtin_amdgcn_sched_barrier(0)
    Unit cur, nxt; int ui = 0;
    if (!S.next(0, cur)) return;
    f32x4 acc[2][2][4][2];
#pragma unroll
    for (int a = 0; a < 2; ++a)
#pragma unroll
        for (int b = 0; b < 2; ++b)
#pragma unroll
            for (int m = 0; m < 4; ++m)
#pragma unroll
                for (int n = 0; n < 2; ++n) acc[a][b][m][n] = (f32x4){0.f, 0.f, 0.f, 0.f};
    bf16x8 At[4][2], B0[2][2], B1[2][2];
    const char* cA = (const char*)g.A + (size_t)cur.pm * tstep; const char* cB = (const char*)g.Bt + (size_t)cur.pn * tstep;
    S.a_ready(cur);
    if constexpr (SP2) {
        PG8_STAGE(PG8_SB(0, 0), cB, voffB); PG8_STAGE(PG8_SB(0, 1), cB + hstep, voffB); PG8_STAGE(PG8_SA(0, 0), cA, voffA); PG8_STAGE(PG8_SA(0, 1), cA + hstep, voffA);
        if (wr == 1) PG8_BAR;
        PG8_WAIT_V(2); PG8_BAR;
        PG8_STAGE(PG8_SB(1, 0), cB + kstep, voffB); PG8_STAGE(PG8_SA(1, 0), cA + kstep, voffA); PG8_STAGE(PG8_SB(1, 1), cB + hstep + kstep, voffB);
        PG8_WAIT_V(6); PG8_BAR;
    } else {
        PG8_STAGE(PG8_SB(0, 0), cB, voffB); PG8_STAGE(PG8_SA(0, 0), cA, voffA); PG8_STAGE(PG8_SB(0, 1), cB + hstep, voffB); PG8_STAGE(PG8_SA(0, 1), cA + hstep, voffA);
        if (wr == 1) PG8_BAR;
        PG8_WAIT_V(4); PG8_BAR;
        PG8_STAGE(PG8_SB(1, 0), cB + kstep, voffB); PG8_STAGE(PG8_SA(1, 0), cA + kstep, voffA); PG8_STAGE(PG8_SB(1, 1), cB + hstep + kstep, voffB);
        PG8_WAIT_V(6); PG8_BAR;
    }
    for (;;) {
        const bool has_next = S.next(ui + 1, nxt);
        const char* nA = has_next ? (const char*)g.A + (size_t)nxt.pm * tstep : cA; const char* nB = has_next ? (const char*)g.Bt + (size_t)nxt.pn * tstep : cB;
        for (int t = 0; t < nt; t += 2) {
            if (t == 4 || t == 10) { const int w_ = (t == 4) ? 0 : 1;
#pragma unroll
                for (int a = 0; a < 2; ++a)
#pragma unroll
                    for (int m = 0; m < 4; ++m) { const float f_ = rt[((ui & 1) * 256 + a * HALF + wr * 64 + m * 16 + fr) * 4 + w_];
#pragma unroll
                        for (int b = 0; b < 2; ++b)
#pragma unroll
                            for (int n = 0; n < 2; ++n) acc[a][b][m][n] = acc[a][b][m][n] * f_; } }
            const bool last = (t == nt - 2);
            const char* a1 = cA + (size_t)(t + 1) * kstep;
            const char* a2 = last ? nA : cA + (size_t)(t + 2) * kstep; const char* b2 = last ? nB : cB + (size_t)(t + 2) * kstep;
            const char* a3 = a2 + kstep; const char* b3 = b2 + kstep;
            if (last && has_next) S.a_ready(nxt);
            if constexpr (SP2) {
            PG8_LDB(B0, 0, 0); PG8_LDB(B1, 0, 1); PG8_SCHED; PG8_LDA(At, 0, 0); PG8_STAGE(PG8_SA(1, 1), a1 + hstep, voffA);
            PG8_WAIT_V(8); PG8_WAIT_L(0); PG8_BAR; PG8_MMA(0, 0, At, B0); PG8_MMA(0, 1, At, B1); PG8_BAR; PG8_SCHED;
            PG8_LDA(At, 0, 1); PG8_STAGE(PG8_SB(0, 0), b2, voffB); PG8_STAGE(PG8_SB(0, 1), b2 + hstep, voffB); PG8_STAGE(PG8_SA(0, 0), a2, voffA);
            PG8_WAIT_V(8); PG8_WAIT_L(0); PG8_BAR; PG8_MMA(1, 0, At, B0); PG8_MMA(1, 1, At, B1); PG8_BAR; PG8_SCHED;
            PG8_LDB(B0, 1, 0); PG8_LDB(B1, 1, 1); PG8_SCHED; PG8_LDA(At, 1, 0); PG8_STAGE(PG8_SA(0, 1), a2 + hstep, voffA);
            PG8_WAIT_V(8); PG8_WAIT_L(0); PG8_BAR; PG8_MMA(0, 0, At, B0); PG8_MMA(0, 1, At, B1); PG8_BAR; PG8_SCHED;
            PG8_LDA(At, 1, 1); PG8_STAGE(PG8_SB(1, 0), b3, voffB); PG8_STAGE(PG8_SB(1, 1), b3 + hstep, voffB); PG8_STAGE(PG8_SA(1, 0), a3, voffA);
            PG8_WAIT_V(8); PG8_WAIT_L(0); PG8_BAR; PG8_MMA(1, 0, At, B0); PG8_MMA(1, 1, At, B1); PG8_BAR; PG8_SCHED;
            } else {
            PG8_LDB(B0, 0, 0); PG8_SCHED; PG8_LDA(At, 0, 0); PG8_STAGE(PG8_SA(1, 1), a1 + hstep, voffA);
            PG8_WAIT_L(8); PG8_BAR; PG8_WAIT_L(0); PG8_MMA(0, 0, At, B0); PG8_BAR; PG8_SCHED;
            PG8_LDB(B1, 0, 1); PG8_STAGE(PG8_SB(0, 0), b2, voffB);
            PG8_BAR; PG8_WAIT_L(0); PG8_MMA(0, 1, At, B1); PG8_BAR;
            PG8_LDA(At, 0, 1); PG8_STAGE(PG8_SA(0, 0), a2, voffA);
            PG8_BAR; PG8_WAIT_L(0); PG8_MMA(1, 0, At, B0); PG8_BAR; PG8_SCHED;
            PG8_STAGE(PG8_SB(0, 1), b2 + hstep, voffB);
            PG8_WAIT_V(6); PG8_BAR; PG8_MMA(1, 1, At, B1); PG8_BAR;
            PG8_LDB(B0, 1, 0); PG8_SCHED; PG8_LDA(At, 1, 0); PG8_STAGE(PG8_SA(0, 1), a2 + hstep, voffA);
            PG8_WAIT_L(8); PG8_BAR; PG8_WAIT_L(0); PG8_MMA(0, 0, At, B0); PG8_BAR; PG8_SCHED;
            PG8_LDB(B1, 1, 1); PG8_STAGE(PG8_SB(1, 0), b3, voffB);
            PG8_BAR; PG8_WAIT_L(0); PG8_MMA(0, 1, At, B1); PG8_BAR;
            PG8_LDA(At, 1, 1); PG8_STAGE(PG8_SA(1, 0), a3, voffA);
            PG8_BAR; PG8_WAIT_L(0); PG8_MMA(1, 0, At, B0); PG8_BAR; PG8_SCHED;
            PG8_STAGE(PG8_SB(1, 1), b3 + hstep, voffB);
            PG8_WAIT_V(6); PG8_BAR; PG8_MMA(1, 1, At, B1); PG8_BAR;
            }
        }
        if constexpr (ALIGN_EPI) { if (wr == 0) PG8_BAR; }
        {
#pragma unroll
            for (int a = 0; a < 2; ++a)
#pragma unroll
                for (int m = 0; m < 4; ++m) { const float f_ = rt[((ui & 1) * 256 + a * HALF + wr * 64 + m * 16 + fr) * 4 + 2];
#pragma unroll
                    for (int b = 0; b < 2; ++b)
#pragma unroll
                        for (int n = 0; n < 2; ++n) acc[a][b][m][n] = acc[a][b][m][n] * f_; } }
        if constexpr (!Epi::AFTER_DRAIN) { E(acc, cur, wr, wc, fr, fq); S.done(cur); }
        if (!has_next) break;
#pragma unroll
        for (int a = 0; a < 2; ++a)
#pragma unroll
            for (int b = 0; b < 2; ++b)
#pragma unroll
                for (int m = 0; m < 4; ++m)
#pragma unroll
                    for (int n = 0; n < 2; ++n) acc[a][b][m][n] = (f32x4){0.f, 0.f, 0.f, 0.f};
        cur = nxt; cA = nA; cB = nB; ++ui;
        if constexpr (ALIGN_EPI) { if (wr == 1) PG8_BAR; }
    }
    PG8_WAIT_V(0);
    if constexpr (!ALIGN_EPI) { if (wr == 0) PG8_BAR; }
    PG8_BAR;
    if constexpr (Epi::AFTER_DRAIN) { E.fused(acc, cur, wr, wc, fr, fq, lds, wid, lane); S.done(cur); }
#undef PG8_SA
#undef PG8_SB
#undef PG8_STAGE
#undef PG8_LDA
#undef PG8_LDB
#undef PG8_MMA
#ifdef PG8_MMAI
#undef PG8_MMAI
#endif
#undef PG8_WAIT_V
#undef PG8_WAIT_L
#undef PG8_BAR
#undef PG8_SCHED
}
template <class Epi, class Sched, bool ALIGN_EPI = false, bool SP2 = false>
__device__ __forceinline__ void gemm_phase_g(PG8_LAS unsigned char* lds, const Gemm g, const Sched& S, const Epi& E) {
    int tid_ = threadIdx.x; asm volatile("" : "+v"(tid_));
    const int tid = tid_, wid = __builtin_amdgcn_readfirstlane(tid >> 6), lane = tid & 63, wr = wid >> 2, wc = wid & 3, fr = lane & 15, fq = lane >> 4;
    const int K = g.K, nt = K / BK;
    unsigned voffA[2], voffB[2];
#pragma unroll
    for (int i = 0; i < 2; ++i) { int R, C; stage_rc(tid * 16 + i * 8192, R, C); const int Rb = Epi::PERM ? ((R & ~31) + perm32(R & 31)) : R;
        voffA[i] = (unsigned)(R * K + C) * 2u; voffB[i] = (unsigned)(Rb * K + C) * 2u; }
    const size_t kstep = (size_t)(BK * 2);
    const size_t hstep = (size_t)HALF * K * 2;
    const size_t tstep = 2 * hstep;
    const unsigned ldsw = (unsigned)wid * 1024u;
    const int aoff = lds_byte(wr * 64 + fr, fq * 8), boff = lds_byte(wc * 32 + fr, fq * 8);
#define PG8_SA(b, h) (((b) * 2 + (h)) * HTB)
#define PG8_SB(b, h) ((4 + (b) * 2 + (h)) * HTB)
#define PG8_STAGE(bufoff, gbase, voff) do { _Pragma("unroll") for (int _i = 0; _i < 2; ++_i) \
        __builtin_amdgcn_global_load_lds((const unsigned*)((const char*)(gbase) + (voff)[_i]), (PG8_LAS unsigned*)(lds + (bufoff) + ldsw + _i * 8192), 16, 0, 0); } while (0)
#define PG8_STAGE_A(bufoff, OFF, h, kb) do { _Pragma("unroll") for (int _i = 0; _i < 2; ++_i) \
        __builtin_amdgcn_global_load_lds((const unsigned*)((const char*)g.A + (OFF)[h][_i] + (kb)), (PG8_LAS unsigned*)(lds + (bufoff) + ldsw + _i * 8192), 16, 0, 0); } while (0)
#define PG8_LDA(dst, b, h) do { _Pragma("unroll") for (int m = 0; m < 4; ++m) _Pragma("unroll") for (int k = 0; k < 2; ++k) dst[m][k] = *(const PG8_LAS bf16x8*)(lds + PG8_SA(b, h) + aoff + m * 2048 + k * 1024); } while (0)
#define PG8_LDB(dst, b, h) do { _Pragma("unroll") for (int n = 0; n < 2; ++n) _Pragma("unroll") for (int k = 0; k < 2; ++k) dst[n][k] = *(const PG8_LAS bf16x8*)(lds + PG8_SB(b, h) + boff + n * 2048 + k * 1024); } while (0)
#define PG8_MMA(ai, bj, At, Bt) do { __builtin_amdgcn_s_setprio(1); _Pragma("unroll") for (int m = 0; m < 4; ++m) _Pragma("unroll") for (int n = 0; n < 2; ++n) _Pragma("unroll") for (int k = 0; k < 2; ++k) \
        acc[ai][bj][m][n] = __builtin_amdgcn_mfma_f32_16x16x32_bf16(Bt[n][k], At[m][k], acc[ai][bj][m][n], 0, 0, 0); __builtin_amdgcn_s_setprio(0); } while (0)
#define PG8_WAIT_V(n) asm volatile("s_waitcnt vmcnt(" #n ")" ::: "memory")
#define PG8_WAIT_L(n) asm volatile("s_waitcnt lgkmcnt(" #n ")" ::: "memory")
#define PG8_BAR __builtin_amdgcn_s_barrier()
#define PG8_SCHED __builtin_amdgcn_sched_barrier(0)
    Unit cur, nxt; int ui = 0;
    if (!S.next(0, cur)) return;
    f32x4 acc[2][2][4][2];
#pragma unroll
    for (int a = 0; a < 2; ++a)
#pragma unroll
        for (int b = 0; b < 2; ++b)
#pragma unroll
            for (int m = 0; m < 4; ++m)
#pragma unroll
                for (int n = 0; n < 2; ++n) acc[a][b][m][n] = (f32x4){0.f, 0.f, 0.f, 0.f};
    bf16x8 At[4][2], B0[2][2], B1[2][2];
    const char* cB = (const char*)g.Bt + (size_t)cur.pn * tstep;
    unsigned go[2][2], ngo[2][2]; int Rr[2], Cc[2];
#pragma unroll
    for (int i = 0; i < 2; ++i) stage_rc(tid * 16 + i * 8192, Rr[i], Cc[i]);
#pragma unroll
    for (int h = 0; h < 2; ++h)
#pragma unroll
        for (int i = 0; i < 2; ++i) go[h][i] = (unsigned)S.rowtok(cur, h * HALF + Rr[i]) * (unsigned)(K * 2) + (unsigned)Cc[i] * 2u;
    S.a_ready(cur);
    if constexpr (SP2) {
        PG8_STAGE(PG8_SB(0, 0), cB, voffB); PG8_STAGE(PG8_SB(0, 1), cB + hstep, voffB); PG8_STAGE_A(PG8_SA(0, 0), go, 0, 0); PG8_STAGE_A(PG8_SA(0, 1), go, 1, 0);
        if (wr == 1) PG8_BAR;
        PG8_WAIT_V(2); PG8_BAR;
        PG8_STAGE(PG8_SB(1, 0), cB + kstep, voffB); PG8_STAGE_A(PG8_SA(1, 0), go, 0, kstep); PG8_STAGE(PG8_SB(1, 1), cB + hstep + kstep, voffB);
        PG8_WAIT_V(6); PG8_BAR;
    } else {
        PG8_STAGE(PG8_SB(0, 0), cB, voffB); PG8_STAGE_A(PG8_SA(0, 0), go, 0, 0); PG8_STAGE(PG8_SB(0, 1), cB + hstep, voffB); PG8_STAGE_A(PG8_SA(0, 1), go, 1, 0);
        if (wr == 1) PG8_BAR;
        PG8_WAIT_V(4); PG8_BAR;
        PG8_STAGE(PG8_SB(1, 0), cB + kstep, voffB); PG8_STAGE_A(PG8_SA(1, 0), go, 0, kstep); PG8_STAGE(PG8_SB(1, 1), cB + hstep + kstep, voffB);
        PG8_WAIT_V(6); PG8_BAR;
    }
    for (;;) {
        const bool has_next = S.next(ui + 1, nxt);
        const char* nB = has_next ? (const char*)g.Bt + (size_t)nxt.pn * tstep : cB;
#pragma unroll
        for (int h = 0; h < 2; ++h)
#pragma unroll
            for (int i = 0; i < 2; ++i) ngo[h][i] = has_next ? (unsigned)S.rowtok(nxt, h * HALF + Rr[i]) * (unsigned)(K * 2) + (unsigned)Cc[i] * 2u : go[h][i];
        for (int t = 0; t < nt; t += 2) {
            const bool last = (t == nt - 2);
            const size_t ka1 = (size_t)(t + 1) * kstep;
            const size_t k2 = last ? 0 : (size_t)(t + 2) * kstep; const char* b2 = last ? nB : cB + (size_t)(t + 2) * kstep;
            unsigned o2[2][2];
#pragma unroll
            for (int h = 0; h < 2; ++h)
#pragma unroll
                for (int i = 0; i < 2; ++i) o2[h][i] = last ? ngo[h][i] : go[h][i];
            const char* b3 = b2 + kstep;
            if (last && has_next) S.a_ready(nxt);
            if constexpr (SP2) {
            PG8_LDB(B0, 0, 0); PG8_LDB(B1, 0, 1); PG8_SCHED; PG8_LDA(At, 0, 0); PG8_STAGE_A(PG8_SA(1, 1), go, 1, ka1);
            PG8_WAIT_V(8); PG8_WAIT_L(0); PG8_BAR; PG8_MMA(0, 0, At, B0); PG8_MMA(0, 1, At, B1); PG8_BAR; PG8_SCHED;
            PG8_LDA(At, 0, 1); PG8_STAGE(PG8_SB(0, 0), b2, voffB); PG8_STAGE(PG8_SB(0, 1), b2 + hstep, voffB); PG8_STAGE_A(PG8_SA(0, 0), o2, 0, k2);
            PG8_WAIT_V(8); PG8_WAIT_L(0); PG8_BAR; PG8_MMA(1, 0, At, B0); PG8_MMA(1, 1, At, B1); PG8_BAR; PG8_SCHED;
            PG8_LDB(B0, 1, 0); PG8_LDB(B1, 1, 1); PG8_SCHED; PG8_LDA(At, 1, 0); PG8_STAGE_A(PG8_SA(0, 1), o2, 1, k2);
            PG8_WAIT_V(8); PG8_WAIT_L(0); PG8_BAR; PG8_MMA(0, 0, At, B0); PG8_MMA(0, 1, At, B1); PG8_BAR; PG8_SCHED;
            PG8_LDA(At, 1, 1); PG8_STAGE(PG8_SB(1, 0), b3, voffB); PG8_STAGE(PG8_SB(1, 1), b3 + hstep, voffB); PG8_STAGE_A(PG8_SA(1, 0), o2, 0, k2 + kstep);
            PG8_WAIT_V(8); PG8_WAIT_L(0); PG8_BAR; PG8_MMA(1, 0, At, B0); PG8_MMA(1, 1, At, B1); PG8_BAR; PG8_SCHED;
            } else {
            PG8_LDB(B0, 0, 0); PG8_SCHED; PG8_LDA(At, 0, 0); PG8_STAGE_A(PG8_SA(1, 1), go, 1, ka1);
            PG8_WAIT_L(8); PG8_BAR; PG8_WAIT_L(0); PG8_MMA(0, 0, At, B0); PG8_BAR; PG8_SCHED;
            PG8_LDB(B1, 0, 1); PG8_STAGE(PG8_SB(0, 0), b2, voffB);
            PG8_BAR; PG8_WAIT_L(0); PG8_MMA(0, 1, At, B1); PG8_BAR;
            PG8_LDA(At, 0, 1); PG8_STAGE_A(PG8_SA(0, 0), o2, 0, k2);
            PG8_BAR; PG8_WAIT_L(0); PG8_MMA(1, 0, At, B0); PG8_BAR; PG8_SCHED;
            PG8_STAGE(PG8_SB(0, 1), b2 + hstep, voffB);
            PG8_WAIT_V(6); PG8_BAR; PG8_MMA(1, 1, At, B1); PG8_BAR;
            PG8_LDB(B0, 1, 0); PG8_SCHED; PG8_LDA(At, 1, 0); PG8_STAGE_A(PG8_SA(0, 1), o2, 1, k2);
            PG8_WAIT_L(8); PG8_BAR; PG8_WAIT_L(0); PG8_MMA(0, 0, At, B0); PG8_BAR; PG8_SCHED;
            PG8_LDB(B1, 1, 1); PG8_STAGE(PG8_SB(1, 0), b3, voffB);
            PG8_BAR; PG8_WAIT_L(0); PG8_MMA(0, 1, At, B1); PG8_BAR;
            PG8_LDA(At, 1, 1); PG8_STAGE_A(PG8_SA(1, 0), o2, 0, k2 + kstep);
            PG8_BAR; PG8_WAIT_L(0); PG8_MMA(1, 0, At, B0); PG8_BAR; PG8_SCHED;
            PG8_STAGE(PG8_SB(1, 1), b3 + hstep, voffB);
            PG8_WAIT_V(6); PG8_BAR; PG8_MMA(1, 1, At, B1); PG8_BAR;
            }
        }
        if constexpr (ALIGN_EPI) { if (wr == 0) PG8_BAR; }
        if constexpr (!Epi::AFTER_DRAIN) { E(acc, cur, wr, wc, fr, fq); S.done(cur); }
        if (!has_next) break;
#pragma unroll
        for (int a = 0; a < 2; ++a)
#pragma unroll
            for (int b = 0; b < 2; ++b)
#pragma unroll
                for (int m = 0; m < 4; ++m)
#pragma unroll
                    for (int n = 0; n < 2; ++n) acc[a][b][m][n] = (f32x4){0.f, 0.f, 0.f, 0.f};
        cur = nxt; cB = nB; ++ui;
#pragma unroll
        for (int h = 0; h < 2; ++h)
#pragma unroll
            for (int i = 0; i < 2; ++i) go[h][i] = ngo[h][i];
        if constexpr (ALIGN_EPI) { if (wr == 1) PG8_BAR; }
    }
    PG8_WAIT_V(0);
    if constexpr (!ALIGN_EPI) { if (wr == 0) PG8_BAR; }
    PG8_BAR;
    if constexpr (Epi::AFTER_DRAIN) { E.fused(acc, cur, wr, wc, fr, fq, lds, wid, lane); S.done(cur); }
#undef PG8_SA
#undef PG8_SB
#undef PG8_STAGE
#undef PG8_STAGE_A
#undef PG8_LDA
#undef PG8_LDB
#undef PG8_MMA
#ifdef PG8_MMAI
#undef PG8_MMAI
#endif
#undef PG8_WAIT_V
#undef PG8_WAIT_L
#undef PG8_BAR
#undef PG8_SCHED
}

typedef int i32x8 __attribute__((ext_vector_type(8)));
__device__ __forceinline__ void mfma8(f32x4& c, const i32x8& a, const i32x8& b, int sc) { asm volatile("v_mfma_scale_f32_16x16x128_f8f6f4 %0, %1, %2, %0, %3, %3 op_sel_hi:[0,0,0]" : "+v"(c) : "v"(a), "v"(b), "v"(sc)); }
template <class Epi, class Sched, bool ALIGN_EPI = false, bool SP2 = false>
__device__ __forceinline__ void gemm_phase8(PG8_LAS unsigned char* lds, const Gemm g, const Sched& S, const Epi& E) {
    int tid_ = threadIdx.x; asm volatile("" : "+v"(tid_));
    const int tid = tid_, wid = __builtin_amdgcn_readfirstlane(tid >> 6), lane = tid & 63, wr = wid >> 2, wc = wid & 3, fr = lane & 15, fq = lane >> 4;
    int sc8 = 0x7F7F7F7F; asm volatile("" : "+v"(sc8));
    const int K = g.K, nt = K / 128;
    unsigned voffA[2], voffB[2];
#pragma unroll
    for (int i = 0; i < 2; ++i) { int R, C; stage_rc(tid * 16 + i * 8192, R, C); const int Rb = Epi::PERM ? ((R & ~31) + perm32(R & 31)) : R;
        voffA[i] = (unsigned)(R * K + C * 2); voffB[i] = (unsigned)(Rb * K + C * 2); }
    const size_t kstep = (size_t)(BK * 2);
    const size_t hstep = (size_t)HALF * K;
    const size_t tstep = 2 * hstep;
    const unsigned ldsw = (unsigned)wid * 1024u;
    const int aoff = lds_byte(wr * 64 + fr, fq * 8), boff = lds_byte(wc * 32 + fr, fq * 8);
#define PG8_SA(b, h) (((b) * 2 + (h)) * HTB)
#define PG8_SB(b, h) ((4 + (b) * 2 + (h)) * HTB)
#define PG8_STAGE(bufoff, gbase, voff) do { _Pragma("unroll") for (int _i = 0; _i < 2; ++_i) \
        __builtin_amdgcn_global_load_lds((const unsigned*)((const char*)(gbase) + (voff)[_i]), (PG8_LAS unsigned*)(lds + (bufoff) + ldsw + _i * 8192), 16, 0, 0); } while (0)
#define PG8_LDA(dst, b, h) do { _Pragma("unroll") for (int m = 0; m < 4; ++m) { const u32x4 lo_ = *(const PG8_LAS u32x4*)(lds + PG8_SA(b, h) + aoff + m * 2048), hi_ = *(const PG8_LAS u32x4*)(lds + PG8_SA(b, h) + aoff + m * 2048 + 1024); \
        dst[m] = (i32x8){(int)lo_.x, (int)lo_.y, (int)lo_.z, (int)lo_.w, (int)hi_.x, (int)hi_.y, (int)hi_.z, (int)hi_.w}; } } while (0)
#define PG8_LDB(dst, b, h) do { _Pragma("unroll") for (int n = 0; n < 2; ++n) { const u32x4 lo_ = *(const PG8_LAS u32x4*)(lds + PG8_SB(b, h) + boff + n * 2048), hi_ = *(const PG8_LAS u32x4*)(lds + PG8_SB(b, h) + boff + n * 2048 + 1024); \
        dst[n] = (i32x8){(int)lo_.x, (int)lo_.y, (int)lo_.z, (int)lo_.w, (int)hi_.x, (int)hi_.y, (int)hi_.z, (int)hi_.w}; } } while (0)
#define PG8_MMA(ai, bj, At, Bt) do { __builtin_amdgcn_s_setprio(1); _Pragma("unroll") for (int m = 0; m < 4; ++m) _Pragma("unroll") for (int n = 0; n < 2; ++n) \
        mfma8(acc[ai][bj][m][n], Bt[n], At[m], sc8); __builtin_amdgcn_s_setprio(0); } while (0)
#define PG8_MMAI(ai, At, ST1, ST2, ST3) do { __builtin_amdgcn_s_setprio(1); \
        mfma8(acc[ai][0][0][0], B0[0], At[0], sc8); mfma8(acc[ai][0][0][1], B0[1], At[0], sc8); __builtin_amdgcn_sched_barrier(0); ST1; __builtin_amdgcn_sched_barrier(0); \
        mfma8(acc[ai][0][1][0], B0[0], At[1], sc8); mfma8(acc[ai][0][1][1], B0[1], At[1], sc8); mfma8(acc[ai][0][2][0], B0[0], At[2], sc8); mfma8(acc[ai][0][2][1], B0[1], At[2], sc8); __builtin_amdgcn_sched_barrier(0); ST2; __builtin_amdgcn_sched_barrier(0); \
        mfma8(acc[ai][0][3][0], B0[0], At[3], sc8); mfma8(acc[ai][0][3][1], B0[1], At[3], sc8); mfma8(acc[ai][1][0][0], B1[0], At[0], sc8); mfma8(acc[ai][1][0][1], B1[1], At[0], sc8); __builtin_amdgcn_sched_barrier(0); ST3; __builtin_amdgcn_sched_barrier(0); \
        mfma8(acc[ai][1][1][0], B1[0], At[1], sc8); mfma8(acc[ai][1][1][1], B1[1], At[1], sc8); mfma8(acc[ai][1][2][0], B1[0], At[2], sc8); mfma8(acc[ai][1][2][1], B1[1], At[2], sc8); \
        mfma8(acc[ai][1][3][0], B1[0], At[3], sc8); mfma8(acc[ai][1][3][1], B1[1], At[3], sc8); __builtin_amdgcn_s_setprio(0); } while (0)
#define PG8_WAIT_V(n) asm volatile("s_waitcnt vmcnt(" #n ")" ::: "memory")
#define PG8_WAIT_L(n) asm volatile("s_waitcnt lgkmcnt(" #n ")" ::: "memory")
#define PG8_BAR __builtin_amdgcn_s_barrier()
#define PG8_SCHED __builtin_amdgcn_sched_barrier(0)
    Unit cur, nxt; int ui = 0;
    if (!S.next(0, cur)) return;
    f32x4 acc[2][2][4][2];
#pragma unroll
    for (int a = 0; a < 2; ++a)
#pragma unroll
        for (int b = 0; b < 2; ++b)
#pragma unroll
            for (int m = 0; m < 4; ++m)
#pragma unroll
                for (int n = 0; n < 2; ++n) acc[a][b][m][n] = (f32x4){0.f, 0.f, 0.f, 0.f};
    i32x8 At[4], B0[2], B1[2];
    const char* cA = (const char*)g.A + (size_t)cur.pm * tstep; const char* cB = (const char*)g.Bt + (size_t)cur.pn * tstep;
    S.a_ready(cur);
    if constexpr (SP2) {
        PG8_STAGE(PG8_SB(0, 0), cB, voffB); PG8_STAGE(PG8_SB(0, 1), cB + hstep, voffB); PG8_STAGE(PG8_SA(0, 0), cA, voffA); PG8_STAGE(PG8_SA(0, 1), cA + hstep, voffA);
        if (wr == 1) PG8_BAR;
        PG8_WAIT_V(2); PG8_BAR;
        PG8_STAGE(PG8_SB(1, 0), cB + kstep, voffB); PG8_STAGE(PG8_SA(1, 0), cA + kstep, voffA); PG8_STAGE(PG8_SB(1, 1), cB + hstep + kstep, voffB);
        PG8_WAIT_V(6); PG8_BAR;
    } else {
        PG8_STAGE(PG8_SB(0, 0), cB, voffB); PG8_STAGE(PG8_SA(0, 0), cA, voffA); PG8_STAGE(PG8_SB(0, 1), cB + hstep, voffB); PG8_STAGE(PG8_SA(0, 1), cA + hstep, voffA);
        if (wr == 1) PG8_BAR;
        PG8_WAIT_V(4); PG8_BAR;
        PG8_STAGE(PG8_SB(1, 0), cB + kstep, voffB); PG8_STAGE(PG8_SA(1, 0), cA + kstep, voffA); PG8_STAGE(PG8_SB(1, 1), cB + hstep + kstep, voffB);
        PG8_WAIT_V(6); PG8_BAR;
    }
    for (;;) {
        const bool has_next = S.next(ui + 1, nxt);
        E.prefetch(cur, ui & 1, wid, lane);
        const char* nA = has_next ? (const char*)g.A + (size_t)nxt.pm * tstep : cA; const char* nB = has_next ? (const char*)g.Bt + (size_t)nxt.pn * tstep : cB;
        _Pragma("nounroll") for (int t = 0; t < nt; t += 2) {
            const bool last = (t == nt - 2);
            const char* a1 = cA + (size_t)(t + 1) * kstep;
            const char* a2 = last ? nA : cA + (size_t)(t + 2) * kstep; const char* b2 = last ? nB : cB + (size_t)(t + 2) * kstep;
            const char* a3 = a2 + kstep; const char* b3 = b2 + kstep;
            if (last && has_next) S.a_ready(nxt);
            if constexpr (SP2) {
            PG8_LDB(B0, 0, 0); PG8_LDB(B1, 0, 1); PG8_SCHED; PG8_LDA(At, 0, 0);
            PG8_WAIT_V(6); PG8_WAIT_L(0); PG8_BAR; PG8_MMAI(0, At, PG8_STAGE(PG8_SA(1, 1), a1 + hstep, voffA), (void)0, (void)0); PG8_BAR; PG8_SCHED;
            PG8_LDA(At, 0, 1);
            PG8_WAIT_V(2); PG8_WAIT_L(0); PG8_BAR; PG8_MMAI(1, At, PG8_STAGE(PG8_SB(0, 0), b2, voffB), PG8_STAGE(PG8_SB(0, 1), b2 + hstep, voffB), PG8_STAGE(PG8_SA(0, 0), a2, voffA)); PG8_BAR; PG8_SCHED;
            PG8_LDB(B0, 1, 0); PG8_LDB(B1, 1, 1); PG8_SCHED; PG8_LDA(At, 1, 0);
            PG8_WAIT_V(6); PG8_WAIT_L(0); PG8_BAR; PG8_MMAI(0, At, PG8_STAGE(PG8_SA(0, 1), a2 + hstep, voffA), (void)0, (void)0); PG8_BAR; PG8_SCHED;
            PG8_LDA(At, 1, 1);
            PG8_WAIT_V(2); PG8_WAIT_L(0); PG8_BAR; PG8_MMAI(1, At, PG8_STAGE(PG8_SB(1, 0), b3, voffB), PG8_STAGE(PG8_SB(1, 1), b3 + hstep, voffB), PG8_STAGE(PG8_SA(1, 0), a3, voffA)); PG8_BAR; PG8_SCHED;
            } else {
            PG8_LDB(B0, 0, 0); PG8_SCHED; PG8_LDA(At, 0, 0); PG8_STAGE(PG8_SA(1, 1), a1 + hstep, voffA);
            PG8_WAIT_L(8); PG8_BAR; PG8_WAIT_L(0); PG8_MMA(0, 0, At, B0); PG8_BAR; PG8_SCHED;
            PG8_LDB(B1, 0, 1); PG8_STAGE(PG8_SB(0, 0), b2, voffB);
            PG8_BAR; PG8_WAIT_L(0); PG8_MMA(0, 1, At, B1); PG8_BAR;
            PG8_LDA(At, 0, 1); PG8_STAGE(PG8_SA(0, 0), a2, voffA);
            PG8_BAR; PG8_WAIT_L(0); PG8_MMA(1, 0, At, B0); PG8_BAR; PG8_SCHED;
            PG8_STAGE(PG8_SB(0, 1), b2 + hstep, voffB);
            PG8_WAIT_V(6); PG8_BAR; PG8_MMA(1, 1, At, B1); PG8_BAR;
            PG8_LDB(B0, 1, 0); PG8_SCHED; PG8_LDA(At, 1, 0); PG8_STAGE(PG8_SA(0, 1), a2 + hstep, voffA);
            PG8_WAIT_L(8); PG8_BAR; PG8_WAIT_L(0); PG8_MMA(0, 0, At, B0); PG8_BAR; PG8_SCHED;
            PG8_LDB(B1, 1, 1); PG8_STAGE(PG8_SB(1, 0), b3, voffB);
            PG8_BAR; PG8_WAIT_L(0); PG8_MMA(0, 1, At, B1); PG8_BAR;
            PG8_LDA(At, 1, 1); PG8_STAGE(PG8_SA(1, 0), a3, voffA);
            PG8_BAR; PG8_WAIT_L(0); PG8_MMA(1, 0, At, B0); PG8_BAR; PG8_SCHED;
            PG8_STAGE(PG8_SB(1, 1), b3 + hstep, voffB);
            PG8_WAIT_V(6); PG8_BAR; PG8_MMA(1, 1, At, B1); PG8_BAR;
            }
        }
        if constexpr (ALIGN_EPI) { if (wr == 0) PG8_BAR; }
        asm volatile("s_nop 15\n\ts_nop 15" ::: "memory");
        if constexpr (!Epi::AFTER_DRAIN) { E(acc, cur, wr, wc, fr, fq, ui & 1); S.done(cur); }
        if (!has_next) break;
#pragma unroll
        for (int a = 0; a < 2; ++a)
#pragma unroll
            for (int b = 0; b < 2; ++b)
#pragma unroll
                for (int m = 0; m < 4; ++m)
#pragma unroll
                    for (int n = 0; n < 2; ++n) acc[a][b][m][n] = (f32x4){0.f, 0.f, 0.f, 0.f};
        cur = nxt; cA = nA; cB = nB; ++ui;
        if constexpr (ALIGN_EPI) { if (wr == 1) PG8_BAR; }
    }
    PG8_WAIT_V(0);
    if constexpr (!ALIGN_EPI) { if (wr == 0) PG8_BAR; }
    PG8_BAR;
    if constexpr (Epi::AFTER_DRAIN) { E.fused(acc, cur, wr, wc, fr, fq, lds, wid, lane); S.done(cur); }
#undef PG8_SA
#undef PG8_SB
#undef PG8_STAGE
#undef PG8_LDA
#undef PG8_LDB
#undef PG8_MMA
#ifdef PG8_MMAI
#undef PG8_MMAI
#endif
#undef PG8_MMAI
#undef PG8_WAIT_V
#undef PG8_WAIT_L
#undef PG8_BAR
#undef PG8_SCHED
}

template <class Epi, class Sched, bool ALIGN_EPI = false, bool SP2 = false>
__device__ __forceinline__ void gemm_phase_g8(PG8_LAS unsigned char* lds, const Gemm g, const Sched& S, const Epi& E) {
    int tid_ = threadIdx.x; asm volatile("" : "+v"(tid_));
    const int tid = tid_, wid = __builtin_amdgcn_readfirstlane(tid >> 6), lane = tid & 63, wr = wid >> 2, wc = wid & 3, fr = lane & 15, fq = lane >> 4;
    int sc8 = 0x7F7F7F7F; asm volatile("" : "+v"(sc8));
    const int K = g.K, nt = K / 128;
    unsigned voffA[2], voffB[2];
#pragma unroll
    for (int i = 0; i < 2; ++i) { int R, C; stage_rc(tid * 16 + i * 8192, R, C); const int Rb = Epi::PERM ? ((R & ~31) + perm32(R & 31)) : R;
        voffA[i] = (unsigned)(R * K + C * 2); voffB[i] = (unsigned)(Rb * K + C * 2); }
    const size_t kstep = (size_t)(BK * 2);
    const size_t hstep = (size_t)HALF * K;
    const size_t tstep = 2 * hstep;
    const unsigned ldsw = (unsigned)wid * 1024u;
    const int aoff = lds_byte(wr * 64 + fr, fq * 8), boff = lds_byte(wc * 32 + fr, fq * 8);
#define PG8_SA(b, h) (((b) * 2 + (h)) * HTB)
#define PG8_SB(b, h) ((4 + (b) * 2 + (h)) * HTB)
#define PG8_STAGE(bufoff, gbase, voff) do { _Pragma("unroll") for (int _i = 0; _i < 2; ++_i) \
        __builtin_amdgcn_global_load_lds((const unsigned*)((const char*)(gbase) + (voff)[_i]), (PG8_LAS unsigned*)(lds + (bufoff) + ldsw + _i * 8192), 16, 0, 0); } while (0)
#define PG8_STAGE_A(bufoff, OFF, h, kb) do { _Pragma("unroll") for (int _i = 0; _i < 2; ++_i) \
        __builtin_amdgcn_global_load_lds((const unsigned*)((const char*)g.A + (OFF)[h][_i] + (kb)), (PG8_LAS unsigned*)(lds + (bufoff) + ldsw + _i * 8192), 16, 0, 0); } while (0)
#define PG8_LDA(dst, b, h) do { _Pragma("unroll") for (int m = 0; m < 4; ++m) { const u32x4 lo_ = *(const PG8_LAS u32x4*)(lds + PG8_SA(b, h) + aoff + m * 2048), hi_ = *(const PG8_LAS u32x4*)(lds + PG8_SA(b, h) + aoff + m * 2048 + 1024); \
        dst[m] = (i32x8){(int)lo_.x, (int)lo_.y, (int)lo_.z, (int)lo_.w, (int)hi_.x, (int)hi_.y, (int)hi_.z, (int)hi_.w}; } } while (0)
#define PG8_LDB(dst, b, h) do { _Pragma("unroll") for (int n = 0; n < 2; ++n) { const u32x4 lo_ = *(const PG8_LAS u32x4*)(lds + PG8_SB(b, h) + boff + n * 2048), hi_ = *(const PG8_LAS u32x4*)(lds + PG8_SB(b, h) + boff + n * 2048 + 1024); \
        dst[n] = (i32x8){(int)lo_.x, (int)lo_.y, (int)lo_.z, (int)lo_.w, (int)hi_.x, (int)hi_.y, (int)hi_.z, (int)hi_.w}; } } while (0)
#define PG8_MMA(ai, bj, At, Bt) do { __builtin_amdgcn_s_setprio(1); _Pragma("unroll") for (int m = 0; m < 4; ++m) _Pragma("unroll") for (int n = 0; n < 2; ++n) \
        mfma8(acc[ai][bj][m][n], Bt[n], At[m], sc8); __builtin_amdgcn_s_setprio(0); } while (0)
#define PG8_MMAI(ai, At, ST1, ST2, ST3) do { __builtin_amdgcn_s_setprio(1); \
        mfma8(acc[ai][0][0][0], B0[0], At[0], sc8); mfma8(acc[ai][0][0][1], B0[1], At[0], sc8); __builtin_amdgcn_sched_barrier(0); ST1; __builtin_amdgcn_sched_barrier(0); \
        mfma8(acc[ai][0][1][0], B0[0], At[1], sc8); mfma8(acc[ai][0][1][1], B0[1], At[1], sc8); mfma8(acc[ai][0][2][0], B0[0], At[2], sc8); mfma8(acc[ai][0][2][1], B0[1], At[2], sc8); __builtin_amdgcn_sched_barrier(0); ST2; __builtin_amdgcn_sched_barrier(0); \
        mfma8(acc[ai][0][3][0], B0[0], At[3], sc8); mfma8(acc[ai][0][3][1], B0[1], At[3], sc8); mfma8(acc[ai][1][0][0], B1[0], At[0], sc8); mfma8(acc[ai][1][0][1], B1[1], At[0], sc8); __builtin_amdgcn_sched_barrier(0); ST3; __builtin_amdgcn_sched_barrier(0); \
        mfma8(acc[ai][1][1][0], B1[0], At[1], sc8); mfma8(acc[ai][1][1][1], B1[1], At[1], sc8); mfma8(acc[ai][1][2][0], B1[0], At[2], sc8); mfma8(acc[ai][1][2][1], B1[1], At[2], sc8); \
        mfma8(acc[ai][1][3][0], B1[0], At[3], sc8); mfma8(acc[ai][1][3][1], B1[1], At[3], sc8); __builtin_amdgcn_s_setprio(0); } while (0)
#define PG8_WAIT_V(n) asm volatile("s_waitcnt vmcnt(" #n ")" ::: "memory")
#define PG8_WAIT_L(n) asm volatile("s_waitcnt lgkmcnt(" #n ")" ::: "memory")
#define PG8_BAR __builtin_amdgcn_s_barrier()
#define PG8_SCHED __builtin_amdgcn_sched_barrier(0)
    Unit cur, nxt; int ui = 0;
    if (!S.next(0, cur)) return;
    f32x4 acc[2][2][4][2];
#pragma unroll
    for (int a = 0; a < 2; ++a)
#pragma unroll
        for (int b = 0; b < 2; ++b)
#pragma unroll
            for (int m = 0; m < 4; ++m)
#pragma unroll
                for (int n = 0; n < 2; ++n) acc[a][b][m][n] = (f32x4){0.f, 0.f, 0.f, 0.f};
    i32x8 At[4], B0[2], B1[2];
    const char* cB = (const char*)g.Bt + (size_t)cur.pn * tstep;
    unsigned go[2][2], ngo[2][2]; int Rr[2], Cc[2];
#pragma unroll
    for (int i = 0; i < 2; ++i) stage_rc(tid * 16 + i * 8192, Rr[i], Cc[i]);
#pragma unroll
    for (int h = 0; h < 2; ++h)
#pragma unroll
        for (int i = 0; i < 2; ++i) go[h][i] = (unsigned)S.rowtok(cur, h * HALF + Rr[i]) * (unsigned)K + (unsigned)Cc[i] * 2u;
    S.a_ready(cur);
    if constexpr (SP2) {
        PG8_STAGE(PG8_SB(0, 0), cB, voffB); PG8_STAGE(PG8_SB(0, 1), cB + hstep, voffB); PG8_STAGE_A(PG8_SA(0, 0), go, 0, 0); PG8_STAGE_A(PG8_SA(0, 1), go, 1, 0);
        if (wr == 1) PG8_BAR;
        PG8_WAIT_V(2); PG8_BAR;
        PG8_STAGE(PG8_SB(1, 0), cB + kstep, voffB); PG8_STAGE_A(PG8_SA(1, 0), go, 0, kstep); PG8_STAGE(PG8_SB(1, 1), cB + hstep + kstep, voffB);
        PG8_WAIT_V(6); PG8_BAR;
    } else {
        PG8_STAGE(PG8_SB(0, 0), cB, voffB); PG8_STAGE_A(PG8_SA(0, 0), go, 0, 0); PG8_STAGE(PG8_SB(0, 1), cB + hstep, voffB); PG8_STAGE_A(PG8_SA(0, 1), go, 1, 0);
        if (wr == 1) PG8_BAR;
        PG8_WAIT_V(4); PG8_BAR;
        PG8_STAGE(PG8_SB(1, 0), cB + kstep, voffB); PG8_STAGE_A(PG8_SA(1, 0), go, 0, kstep); PG8_STAGE(PG8_SB(1, 1), cB + hstep + kstep, voffB);
        PG8_WAIT_V(6); PG8_BAR;
    }
    for (;;) {
        const bool has_next = S.next(ui + 1, nxt);
        E.prefetch(cur, ui & 1, wid, lane);
        const char* nB = has_next ? (const char*)g.Bt + (size_t)nxt.pn * tstep : cB;
#pragma unroll
        for (int h = 0; h < 2; ++h)
#pragma unroll
            for (int i = 0; i < 2; ++i) ngo[h][i] = has_next ? (unsigned)S.rowtok(nxt, h * HALF + Rr[i]) * (unsigned)K + (unsigned)Cc[i] * 2u : go[h][i];
        _Pragma("nounroll") for (int t = 0; t < nt; t += 2) {
            const bool last = (t == nt - 2);
            const size_t ka1 = (size_t)(t + 1) * kstep;
            const size_t k2 = last ? 0 : (size_t)(t + 2) * kstep; const char* b2 = last ? nB : cB + (size_t)(t + 2) * kstep;
            unsigned o2[2][2];
#pragma unroll
            for (int h = 0; h < 2; ++h)
#pragma unroll
                for (int i = 0; i < 2; ++i) o2[h][i] = last ? ngo[h][i] : go[h][i];
            const char* b3 = b2 + kstep;
            if (last && has_next) S.a_ready(nxt);
            if constexpr (SP2) {
            PG8_LDB(B0, 0, 0); PG8_LDB(B1, 0, 1); PG8_SCHED; PG8_LDA(At, 0, 0);
            PG8_WAIT_V(6); PG8_WAIT_L(0); PG8_BAR; PG8_MMAI(0, At, PG8_STAGE_A(PG8_SA(1, 1), go, 1, ka1), (void)0, (void)0); PG8_BAR; PG8_SCHED;
            PG8_LDA(At, 0, 1);
            PG8_WAIT_V(2); PG8_WAIT_L(0); PG8_BAR; PG8_MMAI(1, At, PG8_STAGE(PG8_SB(0, 0), b2, voffB), PG8_STAGE(PG8_SB(0, 1), b2 + hstep, voffB), PG8_STAGE_A(PG8_SA(0, 0), o2, 0, k2)); PG8_BAR; PG8_SCHED;
            PG8_LDB(B0, 1, 0); PG8_LDB(B1, 1, 1); PG8_SCHED; PG8_LDA(At, 1, 0);
            PG8_WAIT_V(6); PG8_WAIT_L(0); PG8_BAR; PG8_MMAI(0, At, PG8_STAGE_A(PG8_SA(0, 1), o2, 1, k2), (void)0, (void)0); PG8_BAR; PG8_SCHED;
            PG8_LDA(At, 1, 1);
            PG8_WAIT_V(2); PG8_WAIT_L(0); PG8_BAR; PG8_MMAI(1, At, PG8_STAGE(PG8_SB(1, 0), b3, voffB), PG8_STAGE(PG8_SB(1, 1), b3 + hstep, voffB), PG8_STAGE_A(PG8_SA(1, 0), o2, 0, k2 + kstep)); PG8_BAR; PG8_SCHED;
            } else {
            PG8_LDB(B0, 0, 0); PG8_SCHED; PG8_LDA(At, 0, 0); PG8_STAGE_A(PG8_SA(1, 1), go, 1, ka1);
            PG8_WAIT_L(8); PG8_BAR; PG8_WAIT_L(0); PG8_MMA(0, 0, At, B0); PG8_BAR; PG8_SCHED;
            PG8_LDB(B1, 0, 1); PG8_STAGE(PG8_SB(0, 0), b2, voffB);
            PG8_BAR; PG8_WAIT_L(0); PG8_MMA(0, 1, At, B1); PG8_BAR;
            PG8_LDA(At, 0, 1); PG8_STAGE_A(PG8_SA(0, 0), o2, 0, k2);
            PG8_BAR; PG8_WAIT_L(0); PG8_MMA(1, 0, At, B0); PG8_BAR; PG8_SCHED;
            PG8_STAGE(PG8_SB(0, 1), b2 + hstep, voffB);
            PG8_WAIT_V(6); PG8_BAR; PG8_MMA(1, 1, At, B1); PG8_BAR;
            PG8_LDB(B0, 1, 0); PG8_SCHED; PG8_LDA(At, 1, 0); PG8_STAGE_A(PG8_SA(0, 1), o2, 1, k2);
            PG8_WAIT_L(8); PG8_BAR; PG8_WAIT_L(0); PG8_MMA(0, 0, At, B0); PG8_BAR; PG8_SCHED;
            PG8_LDB(B1, 1, 1); PG8_STAGE(PG8_SB(1, 0), b3, voffB);
            PG8_BAR; PG8_WAIT_L(0); PG8_MMA(0, 1, At, B1); PG8_BAR;
            PG8_LDA(At, 1, 1); PG8_STAGE_A(PG8_SA(1, 0), o2, 0, k2 + kstep);
            PG8_BAR; PG8_WAIT_L(0); PG8_MMA(1, 0, At, B0); PG8_BAR; PG8_SCHED;
            PG8_STAGE(PG8_SB(1, 1), b3 + hstep, voffB);
            PG8_WAIT_V(6); PG8_BAR; PG8_MMA(1, 1, At, B1); PG8_BAR;
            }
        }
        if constexpr (ALIGN_EPI) { if (wr == 0) PG8_BAR; }
        asm volatile("s_nop 15\n\ts_nop 15" ::: "memory");
        if constexpr (!Epi::AFTER_DRAIN) { E(acc, cur, wr, wc, fr, fq, ui & 1); S.done(cur); }
        if (!has_next) break;
#pragma unroll
        for (int a = 0; a < 2; ++a)
#pragma unroll
            for (int b = 0; b < 2; ++b)
#pragma unroll
                for (int m = 0; m < 4; ++m)
#pragma unroll
                    for (int n = 0; n < 2; ++n) acc[a][b][m][n] = (f32x4){0.f, 0.f, 0.f, 0.f};
        cur = nxt; cB = nB; ++ui;
#pragma unroll
        for (int h = 0; h < 2; ++h)
#pragma unroll
            for (int i = 0; i < 2; ++i) go[h][i] = ngo[h][i];
        if constexpr (ALIGN_EPI) { if (wr == 1) PG8_BAR; }
    }
    PG8_WAIT_V(0);
    if constexpr (!ALIGN_EPI) { if (wr == 0) PG8_BAR; }
    PG8_BAR;
    if constexpr (Epi::AFTER_DRAIN) { E.fused(acc, cur, wr, wc, fr, fq, lds, wid, lane); S.done(cur); }
#undef PG8_SA
#undef PG8_SB
#undef PG8_STAGE
#undef PG8_STAGE_A
#undef PG8_LDA
#undef PG8_LDB
#undef PG8_MMA
#ifdef PG8_MMAI
#undef PG8_MMAI
#endif
#undef PG8_MMAI
#undef PG8_WAIT_V
#undef PG8_WAIT_L
#undef PG8_BAR
#undef PG8_SCHED
}


}
constexpr int NB = 8, S = 4096, D = 1024, NTOK = NB * S, NL = 2, NE = 32, PW = 2816, INW = 2706;
constexpr int MAXROWS = NTOK * 4 + NE * 256, MAXTILES = MAXROWS / 256;
constexpr float RMS_EPS = 1e-6f;
constexpr int C_QA = 0, C_KA = 256, C_VA = 512, C_QB = 768, C_KVB = 1152, C_QC = 1536, C_KC = 1920, C_VC = 2304, C_GB = 2688;
constexpr int NWAVES = 8;
constexpr size_t MiB = 1u << 20;
constexpr size_t WS_CTL = 0, CTL_ZERO_BYTES = 1 * MiB;
constexpr size_t WS_ROPE = 1 * MiB;
constexpr size_t WS_MOD = 1 * MiB + 512 * 1024;
constexpr size_t WS_KMEAN = 2 * MiB;
constexpr size_t WS_KC = 2 * MiB + 256 * 1024, WS_VC = 2 * MiB + 768 * 1024;
constexpr size_t WS_ASG_E = 4 * MiB, WS_ASG_POS = 4 * MiB + 512 * 1024, WS_ASG_GATE = 5 * MiB, WS_ASG_ROW = 5 * MiB + 512 * 1024;
constexpr size_t WS_SELM = 6 * MiB, WS_KCB = 6 * MiB + 512 * 1024, WS_VCB = 7 * MiB;
constexpr size_t WS_WIN = 8 * MiB;
constexpr size_t WS_WOUT = 20 * MiB;
constexpr size_t WS_CW1T = 28 * MiB, WS_CW2T = 29 * MiB, WS_CCONST = 29 * MiB + 64 * 1024;
constexpr size_t WS_RWT = 29 * MiB + 128 * 1024, WS_RCONST = 31 * MiB + 512 * 1024;
constexpr size_t WS_LIST = 24 * MiB;
constexpr size_t WS_WGU = 32 * MiB;
constexpr size_t WS_WDN = 288 * MiB;
constexpr size_t WS_ACT = 416 * MiB;
constexpr size_t WS_PROJ = 480 * MiB;
constexpr size_t WS_O = 656 * MiB;
constexpr size_t WS_Y = 720 * MiB;
constexpr size_t WS_X1 = 784 * MiB;
constexpr size_t WS_SA = 912 * MiB;
constexpr size_t WS_SACT = 1184 * MiB;
constexpr size_t WS_OCP = 1456 * MiB;
constexpr size_t WS_ACT8 = 1484 * MiB;
constexpr size_t WS_OSS = 1516 * MiB;
constexpr size_t WS_LGATE = 1518 * MiB;
constexpr size_t WS_RW3 = 1522 * MiB;
constexpr size_t WS_END = 1526 * MiB;
static_assert(WS_SA + (size_t)MAXROWS * D * 2 <= WS_SACT && WS_SACT + (size_t)MAXROWS * D * 2 <= WS_END, "ws map");
constexpr int CW_TMO = 0, CW_CODE = 1, CW_CNT = 1024, CW_WQ = 2048, CW_BAR = 4096;
constexpr int NPHASE = 21, MAX_LAUNCHES = 21;
constexpr int RING_BYTES = 131072, LDSCTL_OFF = RING_BYTES, MISC_OFF = LDSCTL_OFF + 320, TAB_OFF = LDSCTL_OFF + 512;
constexpr int LDS_BYTES = 147456;
#define GAS __attribute__((address_space(1)))
#define LAS __attribute__((address_space(3)))
typedef unsigned short bf16;
typedef unsigned v4u __attribute__((ext_vector_type(4)));
typedef unsigned v2u __attribute__((ext_vector_type(2)));
typedef float f32x4 __attribute__((ext_vector_type(4)));
typedef GAS unsigned gu32;
#define RLX_AGENT __ATOMIC_RELAXED, __HIP_MEMORY_SCOPE_AGENT
#define LDS_WAIT() asm volatile("s_waitcnt lgkmcnt(0)" ::: "memory")
#define VM_WAIT() asm volatile("s_waitcnt vmcnt(0)" ::: "memory")
__device__ __forceinline__ unsigned f2bf(float f) { unsigned u = __builtin_bit_cast(unsigned, f); return (u + 0x7fffu + ((u >> 16) & 1u)) >> 16; }
__device__ __forceinline__ unsigned pk2(float lo, float hi) { return pg8::cvt_pk_bf16(lo, hi); }
__device__ __forceinline__ float bflo(unsigned v) { return __builtin_bit_cast(float, v << 16); }
__device__ __forceinline__ float bfhi(unsigned v) { return __builtin_bit_cast(float, v & 0xffff0000u); }
__device__ __forceinline__ float bf1(bf16 v) { return __builtin_bit_cast(float, (unsigned)v << 16); }
#define XB_TMO      128
#define XB_XCNT(j)  (256  + 64 * (j))
#define XB_XSUB(j)  (1280 + 64 * (j))
#define XB_XGEN(j)  (2304 + 64 * (j))
#define XB_TOP      3328
#define XB_TOPGEN   3392
#define XCD_BAR_WORDS 3456
#define XB_SPIN_CAP (1u << 18)

__device__ __forceinline__ unsigned xb_ld(unsigned* p)              { return __hip_atomic_load(p, __ATOMIC_RELAXED, __HIP_MEMORY_SCOPE_AGENT); }
__device__ __forceinline__ unsigned xb_add(unsigned* p, unsigned v) { return __hip_atomic_fetch_add(p, v, __ATOMIC_RELAXED, __HIP_MEMORY_SCOPE_AGENT); }
__device__ __forceinline__ unsigned xb_xcc_id() { return (unsigned)__builtin_amdgcn_s_getreg((3 << 11) | 20) & 0xFu; }
#define XB_SPIN(cond, bar) do { unsigned _sp = 0; while (cond) { __builtin_amdgcn_s_sleep(1); \
    if ((++_sp & 255u) == 0u) { if (xb_ld(&(bar)[XB_TMO])) break; if (_sp > XB_SPIN_CAP) { atomicAdd(&(bar)[XB_TMO], 1u); break; } } } } while (0)

struct XcdBarrier {
    unsigned* bar; unsigned x;
    volatile LAS unsigned* st;
};

__device__ __forceinline__ XcdBarrier xcd_barrier_post(unsigned* bar, volatile LAS unsigned* st) {
    XcdBarrier b; b.bar = bar; b.x = xb_xcc_id(); b.st = st;
    if (threadIdx.x == 0) (void)xb_add(&bar[XB_XCNT(b.x)], 1u);
    return b;
}
__device__ __forceinline__ void xcd_barrier_complete(unsigned* bar, unsigned x, unsigned& nloc, unsigned& nx) {
    const unsigned G = gridDim.x * gridDim.y * gridDim.z;
    unsigned sum, cnt, mine, sp = 0u;
    for (;;) {
        sum = 0u; cnt = 0u; mine = 0u;
#pragma unroll
        for (unsigned j = 0; j < 16; ++j) { const unsigned c = xb_ld(&bar[XB_XCNT(j)]); sum += c; cnt += (c > 0u) ? 1u : 0u; mine = (j == x) ? c : mine; }
        if (sum == G) break;
        __builtin_amdgcn_s_sleep(1);
        if ((++sp & 255u) == 0u) { if (xb_ld(&bar[XB_TMO])) break; if (sp > XB_SPIN_CAP) { atomicAdd(&bar[XB_TMO], 1u); break; } }
    }
    nloc = mine > 0u ? mine : 1u; nx = cnt > 0u ? cnt : 1u;
}

__device__ __forceinline__ void xcd_barrier(const XcdBarrier& b) {
    asm volatile("s_waitcnt vmcnt(0)" ::: "memory");
    __syncthreads();
    if (threadIdx.x == 0) {
        unsigned* bar = b.bar;
        __builtin_amdgcn_s_waitcnt(0);
        unsigned nloc = b.st[0], nx = b.st[1];
        if (nloc == 0u) { xcd_barrier_complete(bar, b.x, nloc, nx); b.st[0] = nloc; b.st[1] = nx; }
        const unsigned old = xb_add(&bar[XB_XSUB(b.x)], 1u);
        const unsigned gen = old / nloc;
        if (old + 1u == (gen + 1u) * nloc) {
            __builtin_amdgcn_fence(__ATOMIC_RELEASE, "agent");
            asm volatile("s_waitcnt vmcnt(0)" ::: "memory");
            const unsigned og = xb_add(&bar[XB_TOP], 1u);
            const unsigned tg = og / nx;
            if (og + 1u == (tg + 1u) * nx) xb_add(&bar[XB_TOPGEN], 1u);
            else XB_SPIN(xb_ld(&bar[XB_TOPGEN]) == tg, bar);
            __builtin_amdgcn_fence(__ATOMIC_ACQUIRE, "agent");
            xb_add(&bar[XB_XGEN(b.x)], 1u);
            asm volatile("s_waitcnt vmcnt(0)" ::: "memory");
        } else {
            XB_SPIN(xb_ld(&bar[XB_XGEN(b.x)]) == gen, bar);
            __builtin_amdgcn_fence(__ATOMIC_ACQUIRE, "agent");
            asm volatile("s_waitcnt vmcnt(0)" ::: "memory");
        }
    }
    __syncthreads();
}
struct Args { const float* in[17]; float* out; unsigned char* ws; int ph_lo, ph_hi, li, pad; };
struct Frame {
    LAS unsigned char* lds;
    volatile LAS unsigned* MISC;
    gu32* ctl;
    int tid, lane, wave, vcu, G;
    gu32* qctr; unsigned tk;
};
#define F_x (A.in[0])
#define F_c (A.in[1])
#define F_ada_w (A.in[2])
#define F_ada_b (A.in[3])
#define F_norm_g (A.in[4])
#define F_w_in (A.in[5])
#define F_cmp_pe (A.in[6])
#define F_cmp_w1 (A.in[7])
#define F_cmp_w2 (A.in[8])
#define F_mix_g (A.in[9])
#define F_w_out (A.in[10])
#define F_router_w (A.in[11])
#define F_router_b (A.in[12])
#define F_w_gu (A.in[13])
#define F_b_gu (A.in[14])
#define F_w_dn (A.in[15])
#define F_b_dn (A.in[16])
#define F_out (A.out)
#define F_oss ((float*)(A.ws + WS_OSS))
#define F_x1b ((bf16*)(A.ws + WS_X1))
#define F_xmid ((bf16*)(A.ws + WS_X1 + (size_t)64 * MiB))
#define F_yt8 ((unsigned char*)(A.ws + WS_SA))
#define F_Wgu8 ((unsigned char*)(A.ws + WS_WGU))
#define F_Wdn8 ((unsigned char*)(A.ws + WS_WDN))
#define F_act8 ((unsigned char*)(A.ws + WS_ACT8))
#define F_sact8 ((unsigned char*)(A.ws + WS_SACT))
#define F_rwT ((float*)(A.ws + WS_RWT))
#define F_rw3 ((unsigned short*)(A.ws + WS_RW3))
#define F_rconst ((float*)(A.ws + WS_RCONST))
#define F_ocp ((bf16*)(A.ws + WS_OCP))
#define F_cw1T ((bf16*)(A.ws + WS_CW1T))
#define F_cw2T ((bf16*)(A.ws + WS_CW2T))
#define F_cconst ((float*)(A.ws + WS_CCONST))
#define F_list ((int*)(A.ws + WS_LIST))
#define F_lgate ((float*)(A.ws + WS_LGATE))
#define F_selm ((unsigned*)(A.ws + WS_SELM))
#define F_kcb ((bf16*)(A.ws + WS_KCB))
#define F_vcb ((bf16*)(A.ws + WS_VCB))
#define F_ropec ((float*)(A.ws + WS_ROPE))
#define F_ropes ((float*)(A.ws + WS_ROPE + (size_t)S * 8 * 4))
#define F_mod ((float*)(A.ws + WS_MOD))
#define F_kmean ((float*)(A.ws + WS_KMEAN))
#define F_kc ((float*)(A.ws + WS_KC))
#define F_vc ((float*)(A.ws + WS_VC))
#define F_x1 ((float*)(A.ws + WS_X1))
#define F_asg_gate ((float*)(A.ws + WS_ASG_GATE))
#define F_asg_e ((int*)(A.ws + WS_ASG_E))
#define F_asg_pos ((int*)(A.ws + WS_ASG_POS))
#define F_asg_row ((int*)(A.ws + WS_ASG_ROW))
#define F_WinT ((bf16*)(A.ws + WS_WIN))
#define F_WoutT ((bf16*)(A.ws + WS_WOUT))
#define F_WguT ((bf16*)(A.ws + WS_WGU))
#define F_WdnT ((bf16*)(A.ws + WS_WDN))
#define F_act ((bf16*)(A.ws + WS_ACT))
#define F_proj ((bf16*)(A.ws + WS_PROJ))
#define F_o ((bf16*)(A.ws + WS_O))
#define F_y ((bf16*)(A.ws + WS_Y))
#define F_sa ((bf16*)(A.ws + WS_SA))
#define F_sact ((bf16*)(A.ws + WS_SACT))

template <int CTRL> __device__ __forceinline__ float dpp_mov(float v) { return __builtin_bit_cast(float, __builtin_amdgcn_update_dpp(0, __builtin_bit_cast(int, v), CTRL, 0xF, 0xF, true)); }
__device__ __forceinline__ float rdl(float v, int l) { return __builtin_bit_cast(float, __builtin_amdgcn_readlane(__builtin_bit_cast(int, v), l)); }
__device__ __forceinline__ float wave_sum(float v) {
    v += dpp_mov<0xB1>(v); v += dpp_mov<0x4E>(v); v += dpp_mov<0x124>(v); v += dpp_mov<0x128>(v);
    return (rdl(v, 0) + rdl(v, 16)) + (rdl(v, 32) + rdl(v, 48));
}
__device__ __forceinline__ float wave_max(float v) {
#pragma unroll
    for (int o = 1; o < 64; o <<= 1) v = fmaxf(v, __shfl_xor(v, o));
    return v;
}
__device__ __forceinline__ void wave_argmax(float& v, int& i) {
#pragma unroll
    for (int o = 32; o >= 1; o >>= 1) { const float ov = __shfl_xor(v, o); const int oi = __shfl_xor(i, o); if (ov > v || (ov == v && oi < i)) { v = ov; i = oi; } }
}
__device__ __forceinline__ void loadq(float (&q)[64], const bf16* qp) {
    const v4u* p = (const v4u*)qp;
#pragma unroll
    for (int c = 0; c < 8; ++c) { const v4u v = p[c]; q[8*c+0] = bflo(v.x); q[8*c+1] = bfhi(v.x); q[8*c+2] = bflo(v.y); q[8*c+3] = bfhi(v.y); q[8*c+4] = bflo(v.z); q[8*c+5] = bfhi(v.z); q[8*c+6] = bflo(v.w); q[8*c+7] = bfhi(v.w); }
}
__device__ __forceinline__ float dot64(const float (&q)[64], const bf16* kp) {
    const v4u* p = (const v4u*)kp; float s = 0.f;
#pragma unroll
    for (int c = 0; c < 8; ++c) { const v4u v = p[c];
        s += q[8*c+0] * bflo(v.x); s += q[8*c+1] * bfhi(v.x); s += q[8*c+2] * bflo(v.y); s += q[8*c+3] * bfhi(v.y);
        s += q[8*c+4] * bflo(v.z); s += q[8*c+5] * bfhi(v.z); s += q[8*c+6] * bflo(v.w); s += q[8*c+7] * bfhi(v.w); }
    return s;
}
__device__ __forceinline__ float dot64l(const float (&q)[64], const LAS float* kp) {
    const LAS f32x4* p = (const LAS f32x4*)kp; float s = 0.f;
#pragma unroll
    for (int c = 0; c < 16; ++c) { const f32x4 v = p[c]; s += q[4*c+0] * v.x; s += q[4*c+1] * v.y; s += q[4*c+2] * v.z; s += q[4*c+3] * v.w; }
    return s;
}
__device__ __forceinline__ float dot64f(const float (&q)[64], const float* kp) {
    const f32x4* p = (const f32x4*)kp; float s = 0.f;
#pragma unroll
    for (int c = 0; c < 16; ++c) { const f32x4 v = p[c]; s += q[4*c+0] * v.x; s += q[4*c+1] * v.y; s += q[4*c+2] * v.z; s += q[4*c+3] * v.w; }
    return s;
}
__device__ __forceinline__ void acc8(float (&a)[8], float p, const v4u v) {
    a[0] += p * bflo(v.x); a[1] += p * bfhi(v.x); a[2] += p * bflo(v.y); a[3] += p * bfhi(v.y); a[4] += p * bflo(v.z); a[5] += p * bfhi(v.z); a[6] += p * bflo(v.w); a[7] += p * bfhi(v.w);
}
__device__ __forceinline__ void red8(float (&a)[8]) {
#pragma unroll
    for (int j = 0; j < 8; ++j) { a[j] += __shfl_xor(a[j], 8); a[j] += __shfl_xor(a[j], 16); a[j] += __shfl_xor(a[j], 32); }
}
__device__ __forceinline__ void list_attn(const float (&q)[64], int n, LAS float* P, const LAS int* KR, const bf16* Kb, const bf16* Vb, int lane, float (&o)[8]) {
    float mx = -3e38f;
    for (int i = lane; i < n; i += 64) { const float s = dot64(q, Kb + (size_t)KR[i] * PW) * 0.125f; P[i] = s; mx = fmaxf(mx, s); }
    mx = wave_max(mx);
    float sum = 0.f;
    for (int i = lane; i < n; i += 64) { const float e = __expf(P[i] - mx); P[i] = e; sum += e; }
    sum = wave_sum(sum);
    const float inv = (n > 0) ? 1.f / sum : 0.f;
    LDS_WAIT();
    const int kg = lane >> 3, dg = lane & 7;
    float a[8];
#pragma unroll
    for (int j = 0; j < 8; ++j) a[j] = 0.f;
    for (int i = kg; i < n; i += 8) { const float p = P[i]; const v4u v = *(const v4u*)(Vb + (size_t)KR[i] * PW + dg * 8); acc8(a, p, v); }
    red8(a);
#pragma unroll
    for (int j = 0; j < 8; ++j) o[j] = a[j] * inv;
    LDS_WAIT();
}
__device__ __forceinline__ float sigmoidf_(float v) { return 1.f / (1.f + __expf(-v)); }
template <class RM> __device__ __forceinline__ void tr_item(const float* W, int K, int N, bf16* WT, LAS float* scr, int kb, int nb, int lane, RM rm) {
    const int k0 = 64 * kb, n0 = 32 * nb; const int n = n0 + (lane & 31);
#pragma unroll 8
    for (int i = 0; i < 32; ++i) { const int kk = 2 * i + (lane >> 5); scr[kk * 33 + (lane & 31)] = (n < N) ? W[(size_t)(k0 + kk) * N + n] : 0.f; }
    LDS_WAIT(); asm volatile("" ::: "memory");
    const int c = lane & 7;
#pragma unroll
    for (int j = 0; j < 4; ++j) { const int nn = (lane >> 3) + 8 * j; const LAS float* s = scr + (8 * c) * 33 + nn;
        v4u o; o.x = pk2(s[0 * 33], s[1 * 33]); o.y = pk2(s[2 * 33], s[3 * 33]); o.z = pk2(s[4 * 33], s[5 * 33]); o.w = pk2(s[6 * 33], s[7 * 33]);
        if (n0 + nn < N) *(v4u*)(WT + (size_t)rm(n0 + nn) * K + k0 + 8 * c) = o; }
    LDS_WAIT(); asm volatile("" ::: "memory");
}
template <class RM> __device__ __forceinline__ void tr_item64(const float* W, int K, int N, bf16* WT, LAS float* scr, int kb, int nb, int lane, RM rm, const float* kgain = nullptr) {
    const int k0 = 64 * kb, n0 = 64 * nb; const float* src = W + (size_t)(k0 + (lane >> 4)) * N + n0 + (lane & 15) * 4;
    f32x4 v[16];
#pragma unroll
    for (int i = 0; i < 16; ++i) v[i] = *(const f32x4*)(src + (size_t)(4 * i) * N);
#pragma unroll
    for (int i = 0; i < 16; ++i) *(LAS f32x4*)(scr + ((lane >> 4) + 4 * i) * 64 + (lane & 15) * 4) = v[i];
    LDS_WAIT(); asm volatile("" ::: "memory");
#pragma unroll
    for (int j = 0; j < 2; ++j)
#pragma unroll
        for (int c = 0; c < 4; ++c) { const int n = (lane & 31) + 32 * j, kc = (lane >> 5) + 2 * c; const LAS float* s = scr + (8 * kc) * 64 + n;
            f32x4 g0 = {1.f, 1.f, 1.f, 1.f}, g1 = g0; if (kgain) { g0 = *(const f32x4*)(kgain + k0 + 8 * kc); g1 = *(const f32x4*)(kgain + k0 + 8 * kc + 4); }
            v4u o; o.x = pk2(s[0 * 64] * g0.x, s[1 * 64] * g0.y); o.y = pk2(s[2 * 64] * g0.z, s[3 * 64] * g0.w); o.z = pk2(s[4 * 64] * g1.x, s[5 * 64] * g1.y); o.w = pk2(s[6 * 64] * g1.z, s[7 * 64] * g1.w);
            *(v4u*)(WT + (size_t)rm(n0 + n) * K + k0 + 8 * kc) = o; }
    LDS_WAIT(); asm volatile("" ::: "memory");
}
template <class RM> __device__ __forceinline__ void tr_item64_f8(const float* W, int K, int N, unsigned char* WT, LAS float* scr, int kb, int nb, int lane, RM rm) {
    const int k0 = 64 * kb, n0 = 64 * nb; const float* src = W + (size_t)(k0 + (lane >> 4)) * N + n0 + (lane & 15) * 4;
    f32x4 v[16];
#pragma unroll
    for (int i = 0; i < 16; ++i) v[i] = __builtin_nontemporal_load((const f32x4*)(src + (size_t)(4 * i) * N));
#pragma unroll
    for (int i = 0; i < 16; ++i) *(LAS f32x4*)(scr + ((lane >> 4) + 4 * i) * 64 + (lane & 15) * 4) = v[i];
    LDS_WAIT(); asm volatile("" ::: "memory");
    v2u o[2][4];
#pragma unroll
    for (int j = 0; j < 2; ++j)
#pragma unroll
        for (int c = 0; c < 4; ++c) { const int n = (lane & 31) + 32 * j, kc = (lane >> 5) + 2 * c; const LAS float* s = scr + (8 * kc) * 64 + n;
            o[j][c].x = pg8::pk4_fp8(s[0 * 64] * pg8::W8_SCALE, s[1 * 64] * pg8::W8_SCALE, s[2 * 64] * pg8::W8_SCALE, s[3 * 64] * pg8::W8_SCALE);
            o[j][c].y = pg8::pk4_fp8(s[4 * 64] * pg8::W8_SCALE, s[5 * 64] * pg8::W8_SCALE, s[6 * 64] * pg8::W8_SCALE, s[7 * 64] * pg8::W8_SCALE); }
    LDS_WAIT(); asm volatile("" ::: "memory");
    LAS unsigned char* ob = (LAS unsigned char*)scr;
#pragma unroll
    for (int j = 0; j < 2; ++j)
#pragma unroll
        for (int c = 0; c < 4; ++c) { const int n = (lane & 31) + 32 * j, kc = (lane >> 5) + 2 * c; *(LAS v2u*)(ob + n * 80 + kc * 8) = o[j][c]; }
    LDS_WAIT(); asm volatile("" ::: "memory");
#pragma unroll
    for (int r = 0; r < 4; ++r) { const int row = (lane >> 2) + 16 * r, ch = lane & 3; const v4u w = *(const LAS v4u*)(ob + row * 80 + ch * 16);
        *(v4u*)(WT + (size_t)rm(n0 + row) * K + k0 + ch * 16) = w; }
    LDS_WAIT(); asm volatile("" ::: "memory");
}
template <class RM> __device__ __forceinline__ void tr_item128_f8(const float* W, int K, int N, unsigned char* WT, LAS float* scr, int kb, int nb, int lane, RM rm) {
    const int k0 = 128 * kb, n0 = 32 * nb; const float* src = W + (size_t)(k0 + (lane >> 3)) * N + n0 + (lane & 7) * 4;
    f32x4 v[16];
#pragma unroll
    for (int i = 0; i < 16; ++i) v[i] = __builtin_nontemporal_load((const f32x4*)(src + (size_t)(8 * i) * N));
#pragma unroll
    for (int i = 0; i < 16; ++i) *(LAS f32x4*)(scr + ((lane >> 3) + 8 * i) * 32 + (lane & 7) * 4) = v[i];
    LDS_WAIT(); asm volatile("" ::: "memory");
    v2u o[8];
#pragma unroll
    for (int c = 0; c < 8; ++c) { const int n = lane & 31, kc = (lane >> 5) + 2 * c; const LAS float* s = scr + (8 * kc) * 32 + n;
        o[c].x = pg8::pk4_fp8(s[0 * 32] * pg8::W8_SCALE, s[1 * 32] * pg8::W8_SCALE, s[2 * 32] * pg8::W8_SCALE, s[3 * 32] * pg8::W8_SCALE);
        o[c].y = pg8::pk4_fp8(s[4 * 32] * pg8::W8_SCALE, s[5 * 32] * pg8::W8_SCALE, s[6 * 32] * pg8::W8_SCALE, s[7 * 32] * pg8::W8_SCALE); }
    LDS_WAIT(); asm volatile("" ::: "memory");
    LAS unsigned char* ob = (LAS unsigned char*)scr;
#pragma unroll
    for (int c = 0; c < 8; ++c) { const int n = lane & 31, kc = (lane >> 5) + 2 * c; *(LAS v2u*)(ob + n * 144 + kc * 8) = o[c]; }
    LDS_WAIT(); asm volatile("" ::: "memory");
#pragma unroll
    for (int r = 0; r < 4; ++r) { const int row = (lane >> 3) + 8 * r, ch = lane & 7; const v4u w = *(const LAS v4u*)(ob + row * 144 + ch * 16);
        *(v4u*)(WT + (size_t)rm(n0 + row) * K + k0 + ch * 16) = w; }
    LDS_WAIT(); asm volatile("" ::: "memory");
}
struct RmId { __device__ __forceinline__ int operator()(int n) const { return n; } };
struct RmDn { __device__ __forceinline__ int operator()(int n) const { const int c = n & 255; return (n & ~255) + ((c >> 3) & 1) * 128 + (c >> 6) * 32 + ((c >> 4) & 3) * 8 + (c & 7); } };
struct RmWin { __device__ __forceinline__ int operator()(int n) const { return n < 1536 ? n : (n < 1554 ? C_GB + (n - 1536) : n - 18); } };
struct RmGu { __device__ __forceinline__ int operator()(int n) const { const int h = n >> 10, r = n & 1023; return (r >> 7) * 256 + h * 128 + (r & 127); } };

constexpr int NCONVX = 5, CB_A = 32, CB_B = 45, LYR_ITEMS = NE * 512 + NE * 256;
__device__ __forceinline__ bool conv_split(const Frame& F) { return (F.G & 31) == 0 && (F.G >> 5) * NCONVX * NWAVES * (CB_A + CB_B) >= LYR_ITEMS; }
__device__ __forceinline__ void conv_def(const Args& A, LAS float* scr, int d, int lane) {
    const int ly = d >= LYR_ITEMS ? 1 : 0, dd = d - ly * LYR_ITEMS;
    if (dd < NE * 512) { const int le = ly * NE + (dd >> 9), q = dd & 511; tr_item128_f8(F_w_gu + (size_t)le * D * 2048, D, 2048, F_Wgu8 + (size_t)le * 2048 * D, scr, q >> 6, q & 63, lane, RmGu()); }
    else { const int d2 = dd - NE * 512, le = ly * NE + (d2 >> 8), q = d2 & 255; tr_item128_f8(F_w_dn + (size_t)le * D * D, D, D, F_Wdn8 + (size_t)le * D * D, scr, q >> 5, q & 31, lane, RmDn()); }
}
struct CvIt { const float* W; unsigned char* WT; int N, kb, nb, isgu; };
__device__ __forceinline__ void cv_decode(const Args& A, int d, CvIt& I) {
    const int ly = d >= LYR_ITEMS ? 1 : 0, dd = d - ly * LYR_ITEMS;
    if (dd < NE * 512) { const int le = ly * NE + (dd >> 9), q = dd & 511; I.W = F_w_gu + (size_t)le * D * 2048; I.WT = F_Wgu8 + (size_t)le * 2048 * D; I.N = 2048; I.kb = q >> 6; I.nb = q & 63; I.isgu = 1; }
    else { const int d2 = dd - NE * 512, le = ly * NE + (d2 >> 8), q = d2 & 255; I.W = F_w_dn + (size_t)le * D * D; I.WT = F_Wdn8 + (size_t)le * D * D; I.N = D; I.kb = q >> 5; I.nb = q & 31; I.isgu = 0; }
}
__device__ __forceinline__ void cv_load(f32x4 (&v)[16], const CvIt& I, int lane) {
    const float* src = I.W + (size_t)(128 * I.kb + 16 * (lane >> 3)) * I.N + 32 * I.nb + (lane & 7) * 4;
#pragma unroll
    for (int i = 0; i < 16; ++i) v[i] = __builtin_nontemporal_load((const f32x4*)(src + (size_t)i * I.N));
}
__device__ __forceinline__ void cv_store(const f32x4 (&v)[16], const CvIt& I, LAS float*, int lane) {
    const int k0 = 128 * I.kb + 16 * (lane >> 3), n0 = 32 * I.nb + 4 * (lane & 7);
#pragma unroll
    for (int j = 0; j < 4; ++j) { v4u w;
        w.x = pg8::pk4_fp8(v[0][j] * pg8::W8_SCALE, v[1][j] * pg8::W8_SCALE, v[2][j] * pg8::W8_SCALE, v[3][j] * pg8::W8_SCALE);
        w.y = pg8::pk4_fp8(v[4][j] * pg8::W8_SCALE, v[5][j] * pg8::W8_SCALE, v[6][j] * pg8::W8_SCALE, v[7][j] * pg8::W8_SCALE);
        w.z = pg8::pk4_fp8(v[8][j] * pg8::W8_SCALE, v[9][j] * pg8::W8_SCALE, v[10][j] * pg8::W8_SCALE, v[11][j] * pg8::W8_SCALE);
        w.w = pg8::pk4_fp8(v[12][j] * pg8::W8_SCALE, v[13][j] * pg8::W8_SCALE, v[14][j] * pg8::W8_SCALE, v[15][j] * pg8::W8_SCALE);
        const int rw = I.isgu ? RmGu()(n0 + j) : RmDn()(n0 + j);
        *(v4u*)(I.WT + (size_t)rw * D + k0) = w; }
}
constexpr int SM_IN = 16 * 85, SM_OUT = 256, SM_C1 = 128, SM_C2 = 4, SM_ALL = SM_IN + SM_OUT + SM_C1 + SM_C2, SM_EARLY = SM_IN + SM_C1 + SM_C2;
__device__ __forceinline__ void small_item(const Args& A, LAS float* scr, int l, int r, int lane) {
    if (r < SM_IN) { tr_item(F_w_in + (size_t)l * D * INW, D, INW, F_WinT + (size_t)l * PW * D, scr, r / 85, r % 85, lane, RmWin()); return; } r -= SM_IN;
    if (r < SM_OUT) { tr_item64(F_w_out + (size_t)l * D * D, D, D, F_WoutT + (size_t)l * D * D, scr, r >> 4, r & 15, lane, RmId(), F_mix_g + (size_t)l * D); return; } r -= SM_OUT;
    if (r < SM_C1) { const int lw = l * 2 + (r >> 6), q = r & 63; tr_item(F_cmp_w1 + (size_t)lw * 2048 * 64, 2048, 64, F_cw1T + (size_t)lw * 64 * 2048, scr, q >> 1, q & 1, lane, RmId()); return; } r -= SM_C1;
    { const int lw = l * 2 + (r >> 1), q = r & 1; tr_item(F_cmp_w2 + (size_t)lw * 64 * 64, 64, 64, F_cw2T + (size_t)lw * 64 * 64, scr, 0, q, lane, RmId()); }
}
__device__ __forceinline__ void attn_convert(Frame& F, const Args& A, int slot) {
    if (!conv_split(F)) return;
    const int r32 = F.vcu & 31; if (r32 < 32 - NCONVX) return;
    const int nconv = (F.G >> 5) * NCONVX, q = (F.vcu >> 5) * NCONVX + (r32 - (32 - NCONVX));
    const int perA = nconv * NWAVES * CB_A, lbase = (slot >> 1) * LYR_ITEMS, lend = lbase + LYR_ITEMS;
    const int base = lbase + (slot & 1) * perA; int end = (slot & 1) ? lend : base + perA; if (end > lend) end = lend;
    LAS float* scr = (LAS float*)(F.lds + F.wave * 16384); const int lane = F.lane, st = nconv * NWAVES;
    int d = base + q * NWAVES + F.wave;
    if (d < end) {
        CvIt Ia, Ib, Ic; f32x4 va[16], vb[16], vc[16];
        cv_decode(A, d, Ia); cv_load(va, Ia, lane);
        bool hb = d + st < end; if (hb) { cv_decode(A, d + st, Ib); cv_load(vb, Ib, lane); }
        for (;;) {
            const bool hc = hb && d + 2 * st < end; if (hc) { cv_decode(A, d + 2 * st, Ic); cv_load(vc, Ic, lane); }
            cv_store(va, Ia, scr, lane);
            if (!hb) break;
            const bool ha = hc && d + 3 * st < end; if (ha) { cv_decode(A, d + 3 * st, Ia); cv_load(va, Ia, lane); }
            cv_store(vb, Ib, scr, lane);
            if (!hc) break;
            hb = ha && d + 4 * st < end; if (hb) { cv_decode(A, d + 4 * st, Ib); cv_load(vb, Ib, lane); }
            cv_store(vc, Ic, scr, lane);
            if (!ha) break;
            d += 3 * st;
        }
    }
    if (slot == 0) { for (int c = q * NWAVES + F.wave; c < SM_EARLY + SM_OUT; c += st) { if (c < SM_EARLY) small_item(A, scr, 1, c < SM_IN ? c : c + SM_OUT, lane); else small_item(A, scr, 0, SM_IN + (c - SM_EARLY), lane); } }
    else if (slot == 2) { for (int c = q * NWAVES + F.wave; c < SM_OUT; c += st) small_item(A, scr, 1, SM_IN + c, lane); }
}
__device__ __forceinline__ void p0_prologue(Frame& F, const Args& A) {
    LAS float* scr = (LAS float*)(F.lds + F.wave * 16384);
    const int gw = F.vcu * NWAVES + F.wave, NGW = F.G * NWAVES, lane = F.lane;
    constexpr int I_GU = NL * NE * 16 * 32, I_DN = NL * NE * 16 * 16, I_IN = NL * 16 * 85, I_OUT = NL * 16 * 16, I_MOD = NL * 96, I_C1 = NL * 2 * 32 * 2, I_C2 = NL * 2 * 2, I_CC = NL * 2 * 16;
    const bool split = conv_split(F);
    const int nex = split ? 0 : NL * LYR_ITEMS, NITEMS = split ? SM_EARLY : nex + NL * SM_ALL;
    for (int wi = F.vcu; wi < I_MOD + I_CC; wi += F.G) {
        LAS float* red = (LAS float*)F.lds;
        if (wi < I_MOD) {
            const int l = wi / 96, cb = (wi % 96) * 64, col = cb + lane; const float* w = F_ada_w + (size_t)l * D * 6 * D + col;
            float a[NB];
#pragma unroll
            for (int b = 0; b < NB; ++b) a[b] = 0.f;
#pragma unroll 1
            for (int k0 = 128 * F.wave; k0 < 128 * F.wave + 128; k0 += 64) {
                float wv[64]; float sv[8];
#pragma unroll
                for (int kk = 0; kk < 64; ++kk) wv[kk] = w[(size_t)(k0 + kk) * 6 * D];
#pragma unroll
                for (int g = 0; g < 8; ++g) { const float cv = F_c[(lane >> 3) * D + k0 + 8 * g + (lane & 7)]; sv[g] = cv / (1.f + __expf(-cv)); }
#pragma unroll
                for (int g = 0; g < 8; ++g)
#pragma unroll
                    for (int kk = 0; kk < 8; ++kk)
#pragma unroll
                        for (int b = 0; b < NB; ++b) a[b] += __builtin_bit_cast(float, __builtin_amdgcn_readlane(__builtin_bit_cast(int, sv[g]), b * 8 + kk)) * wv[8 * g + kk]; }
#pragma unroll
            for (int b = 0; b < NB; ++b) red[(F.wave * NB + b) * 64 + lane] = a[b];
            __syncthreads();
            { const int b = F.tid >> 6; float t = 0.f;
#pragma unroll
              for (int w8 = 0; w8 < 8; ++w8) t += red[(w8 * NB + b) * 64 + lane];
              F_mod[((size_t)l * NB + b) * 6 * D + col] = t + F_ada_b[l * 6 * D + col]; }
            __syncthreads();
        } else {
            const int r = wi - I_MOD, lw = r >> 4, part = r & 15; const float* pe = F_cmp_pe + (size_t)lw * 2048 + part * 128 + 16 * F.wave; const float* w1 = F_cmp_w1 + ((size_t)lw * 2048 + part * 128 + 16 * F.wave) * 64 + lane; float a = 0.f;
#pragma unroll
            for (int k = 0; k < 16; ++k) a += pe[k] * w1[(size_t)k * 64];
            red[F.wave * 64 + lane] = a;
            __syncthreads();
            if (F.tid < 64) { float t = 0.f;
#pragma unroll
              for (int w8 = 0; w8 < 8; ++w8) t += red[w8 * 64 + lane];
              F_cconst[(size_t)r * 64 + lane] = t; }
            __syncthreads();
        }
    }
    for (int it = gw; it < NITEMS; it += NGW) {
        if (split) { small_item(A, scr, 0, it < SM_IN ? it : it + SM_OUT, lane); continue; }
        if (it < nex) { conv_def(A, scr, it, lane); continue; }
        { const int rr = it - nex; small_item(A, scr, rr / SM_ALL, rr % SM_ALL, lane); }
    }
    const int gt = F.vcu * (NWAVES * 64) + F.tid, NGT = F.G * NWAVES * 64;
    for (int i = gt; i < NL * (PW - INW) * (D / 8); i += NGT) { const int l = i / ((PW - INW) * (D / 8)), q = i % ((PW - INW) * (D / 8));
        *(v4u*)(F_WinT + ((size_t)l * PW + INW + q / (D / 8)) * D + (q % (D / 8)) * 8) = (v4u){0u, 0u, 0u, 0u}; }
    for (int i = gt; i < NL * NB * 4 * 16 * 64; i += NGT) F_kmean[i] = 0.f;
    for (int i = gt; i < S * 8; i += NGT) { const int t = i >> 3, f = i & 7; const double inv = pow(500000.0, -(double)f / 8.0); const double ang = (double)t * inv;
        F_ropec[i] = (float)cos(ang); F_ropes[i] = (float)sin(ang); }
}
__device__ __forceinline__ void mod_norm_row(const f32x4 (&v)[4], const float* g, const float* sc, const float* sh, bf16* orow, int lane) {
    float ss = 0.f;
#pragma unroll
    for (int j = 0; j < 4; ++j) ss += (v[j].x * v[j].x + v[j].y * v[j].y) + (v[j].z * v[j].z + v[j].w * v[j].w);
    const float rs = __builtin_amdgcn_rsqf(wave_sum(ss) * (1.f / D) + RMS_EPS);
#pragma unroll
    for (int j = 0; j < 4; ++j) { const int c = 4 * lane + 256 * j; const f32x4 gg = *(const f32x4*)(g + c), s1 = *(const f32x4*)(sc + c), s0 = *(const f32x4*)(sh + c);
        const f32x4 r = v[j] * rs * gg * (s1 + 1.f) + s0; v2u w; w.x = pk2(r.x, r.y); w.y = pk2(r.z, r.w); *(v2u*)(orow + c) = w; }
}
__device__ __forceinline__ void mod_norm_row_l(const f32x4 (&v)[4], const LAS float* cA, const LAS float* cS, bf16* orow, int lane) {
    float ss = 0.f;
#pragma unroll
    for (int j = 0; j < 4; ++j) ss += (v[j].x * v[j].x + v[j].y * v[j].y) + (v[j].z * v[j].z + v[j].w * v[j].w);
    const float rs = __builtin_amdgcn_rsqf(wave_sum(ss) * (1.f / D) + RMS_EPS);
#pragma unroll
    for (int j = 0; j < 4; ++j) { const int c = 4 * lane + 256 * j; const f32x4 a = *(const LAS f32x4*)(cA + c), s0 = *(const LAS f32x4*)(cS + c);
        const f32x4 r = v[j] * rs * a + s0; v2u w; w.x = pk2(r.x, r.y); w.y = pk2(r.z, r.w); *(v2u*)(orow + c) = w; }
}
__device__ __forceinline__ void router_tables(Frame& F, const Args& A, int q, int nq) {
    for (int it = q * NWAVES + F.wave; it < NL * NB * NE; it += nq * NWAVES) { const int e = it & 31, b = (it >> 5) & 7, l = it >> 8; const float* md = F_mod + ((size_t)l * NB + b) * 6 * D; const float* g2 = F_norm_g + ((size_t)l * 4 + 2) * D;
        const float* rw = F_router_w + (size_t)l * D * NE + e; float cs = 0.f;
#pragma unroll
        for (int j = 0; j < 16; ++j) { const int k = F.lane + 64 * j; const float w = rw[(size_t)k * NE]; const float v = g2[k] * (1.f + md[4 * D + k]) * w; cs += md[3 * D + k] * w;
            const unsigned h0 = f2bf(v); const float r1 = v - bflo(h0); const unsigned h1 = f2bf(r1); const unsigned h2 = f2bf(r1 - bflo(h1));
            unsigned short* pl = F_rw3 + (size_t)it * 3 * D + k; pl[0] = (unsigned short)h0; pl[D] = (unsigned short)h1; pl[2 * D] = (unsigned short)h2; }
        cs = wave_sum(cs); if (F.lane == 0) F_rconst[it] = cs + F_router_b[l * NE + e]; }
}
__device__ __forceinline__ void phase_hm0(Frame& F, const Args& A) {
    const int gw = F.vcu * NWAVES + F.wave, NGW = F.G * NWAVES;
    for (int chunk = blockIdx.x; chunk < NTOK / 128; chunk += F.G) {
        f32x4 va[4], vb[4]; const int tok0 = chunk * 128 + F.wave * 16; const float* md_ = F_mod + (size_t)(tok0 >> 12) * 6 * D;
        LAS float* cA = (LAS float*)(F.lds + 65536); LAS float* cS = cA + D;
#define HM_LOAD(V, T) { const f32x4* xr_ = (const f32x4*)(F_x + (size_t)(T) * D) + F.lane; _Pragma("unroll") for (int j = 0; j < 4; ++j) V[j] = __builtin_nontemporal_load(xr_ + 64 * j); }
#define HM_DO(V, T) mod_norm_row_l(V, cA, cS, F_act + (size_t)(T) * D, F.lane)
        HM_LOAD(va, tok0);
        __syncthreads();
        for (int i = F.tid; i < D; i += NWAVES * 64) { cA[i] = F_norm_g[i] * (md_[D + i] + 1.f); cS[i] = md_[i]; }
        __syncthreads();
        for (int i = 0; i < 16; i += 2) {
            HM_LOAD(vb, tok0 + i + 1);
            HM_DO(va, tok0 + i);
            if (i + 2 < 16) HM_LOAD(va, tok0 + i + 2);
            HM_DO(vb, tok0 + i + 1);
        }
#undef HM_LOAD
#undef HM_DO
    }
}
typedef short c16x8 __attribute__((ext_vector_type(8)));
__device__ __forceinline__ void phase_compress(Frame& F, const Args& A, int l) {
    const int lane = F.lane, fr = lane & 15, fq = lane >> 4;
    LAS unsigned short* h1s = (LAS unsigned short*)F.lds;
    LAS f32x4* red = (LAS f32x4*)(F.lds + 16384);
    for (int it = blockIdx.x; it < NB * 2 * 16; it += F.G) { const int nt = it & 15, which = (it >> 4) & 1, b = it >> 5;
        const bf16* w1t = F_cw1T + ((size_t)l * 2 + which) * 64 * 2048; const bf16* w2t = F_cw2T + ((size_t)l * 2 + which) * 64 * 64; const float* cc = F_cconst + ((size_t)l * 2 + which) * 16 * 64;
        const int n = 16 * nt + fr;
        f32x4 acc[4];
#pragma unroll
        for (int jt = 0; jt < 4; ++jt) acc[jt] = (f32x4){0.f, 0.f, 0.f, 0.f};
#pragma unroll
        for (int k8 = 0; k8 < 8; ++k8) { const int ks = 8 * F.wave + k8; int tokn = 16 * n + (ks >> 1); if (tokn > S - 1) tokn = S - 1;
            const c16x8 a = *(const c16x8*)(F_proj + ((size_t)b * S + tokn) * PW + C_KVB + which * 64 + 32 * (ks & 1) + 8 * fq);
#pragma unroll
            for (int jt = 0; jt < 4; ++jt) { const c16x8 bb = *(const c16x8*)(w1t + (size_t)(jt * 16 + fr) * 2048 + 32 * ks + 8 * fq); acc[jt] = __builtin_amdgcn_mfma_f32_16x16x32_bf16(a, bb, acc[jt], 0, 0, 0); } }
        __syncthreads();
#pragma unroll
        for (int jt = 0; jt < 4; ++jt) red[(F.wave * 4 + jt) * 64 + lane] = acc[jt];
        __syncthreads();
        if (F.wave == 0) {
#pragma unroll
        for (int jt = 0; jt < 4; ++jt) { f32x4 t = red[jt * 64 + lane];
#pragma unroll
            for (int w8 = 1; w8 < 8; ++w8) t = t + red[(w8 * 4 + jt) * 64 + lane];
            acc[jt] = t; }
#pragma unroll
        for (int jt = 0; jt < 4; ++jt) { float cj = 0.f;
#pragma unroll
            for (int part = 0; part < 16; ++part) cj += cc[part * 64 + jt * 16 + fr];
#pragma unroll
            for (int r = 0; r < 4; ++r) { const float v = acc[jt][r] + cj; h1s[(4 * fq + r) * 72 + jt * 16 + fr] = (unsigned short)f2bf(v / (1.f + __expf(-v))); } }
        LDS_WAIT(); asm volatile("" ::: "memory");
        f32x4 o2[4];
#pragma unroll
        for (int jt = 0; jt < 4; ++jt) o2[jt] = (f32x4){0.f, 0.f, 0.f, 0.f};
#pragma unroll
        for (int ks = 0; ks < 2; ++ks) { const c16x8 a = *(const LAS c16x8*)(h1s + fr * 72 + 32 * ks + 8 * fq);
#pragma unroll
            for (int jt = 0; jt < 4; ++jt) { const c16x8 bb = *(const c16x8*)(w2t + (size_t)(jt * 16 + fr) * 64 + 32 * ks + 8 * fq); o2[jt] = __builtin_amdgcn_mfma_f32_16x16x32_bf16(a, bb, o2[jt], 0, 0, 0); } }
        bf16* dst = (which ? F_vcb : F_kcb) + (size_t)b * 256 * 64;
#pragma unroll
        for (int jt = 0; jt < 4; ++jt)
#pragma unroll
            for (int r = 0; r < 4; ++r) { const int nn = 16 * nt + 4 * fq + r; dst[(size_t)nn * 64 + jt * 16 + fr] = (bf16)f2bf(nn < 255 ? o2[jt][r] : 0.f); }
        LDS_WAIT(); asm volatile("" ::: "memory");
        }
    }
    __syncthreads();
}
typedef float f32x16 __attribute__((ext_vector_type(16)));
typedef short s16x8 __attribute__((ext_vector_type(8)));
typedef short s16x4 __attribute__((ext_vector_type(4)));
constexpr int KP = 144, VP = 192, KT_BYTES = 64 * KP, VT_BYTES = 64 * VP, TB_BYTES = KT_BYTES + VT_BYTES;
constexpr float QSCALE_LOG2 = 0.125f * 1.4426950408889634f;
#define NEGINF (-__builtin_inff())
struct TileRegs { v4u k, v; };
__device__ __forceinline__ void tile_load(TileRegs& R, const bf16* Kg, const bf16* Vg, size_t pitch, int tid) {
    const int r = tid >> 3, c = tid & 7; R.k = *(const v4u*)(Kg + (size_t)r * pitch + c * 8); R.v = *(const v4u*)(Vg + (size_t)r * pitch + c * 8); }
__device__ __forceinline__ void tile_store(const TileRegs& R, LAS unsigned char* buf, int tid) {
    const int r = tid >> 3, c = tid & 7; *(LAS v4u*)(buf + r * KP + c * 16) = R.k; *(LAS v4u*)(buf + KT_BYTES + r * VP + c * 16) = R.v; }
__device__ __forceinline__ s16x8 pack8(float a0, float a1, float a2, float a3, float a4, float a5, float a6, float a7) {
    v4u w; w.x = pg8::cvt_pk_bf16(a0, a1); w.y = pg8::cvt_pk_bf16(a2, a3); w.z = pg8::cvt_pk_bf16(a4, a5); w.w = pg8::cvt_pk_bf16(a6, a7); return __builtin_bit_cast(s16x8, w); }
__device__ __forceinline__ void load_qfrags(s16x8 (&qf)[4], const bf16* qrow, float sc, int lane) {
#pragma unroll
    for (int ks = 0; ks < 4; ++ks) { const v4u v = *(const v4u*)(qrow + 16 * ks + 8 * (lane >> 5));
        qf[ks] = pack8(bflo(v.x) * sc, bfhi(v.x) * sc, bflo(v.y) * sc, bfhi(v.y) * sc, bflo(v.z) * sc, bfhi(v.z) * sc, bflo(v.w) * sc, bfhi(v.w) * sc); }
}
__device__ __forceinline__ void qk_tile(f32x16 (&p)[2], const LAS unsigned char* kb, const s16x8 (&qf)[4], int lane, float init = 0.f) {
    const LAS unsigned char* a = kb + (lane & 31) * KP + (lane >> 5) * 16;
    s16x8 kf[2][4];
#pragma unroll
    for (int T = 0; T < 2; ++T)
#pragma unroll
        for (int ks = 0; ks < 4; ++ks) kf[T][ks] = *(const LAS s16x8*)(a + T * 32 * KP + ks * 32);
#pragma unroll
    for (int T = 0; T < 2; ++T) {
#pragma unroll
        for (int j = 0; j < 16; ++j) p[T][j] = init;
#pragma unroll
        for (int ks = 0; ks < 4; ++ks) p[T] = __builtin_amdgcn_mfma_f32_32x32x16_bf16(kf[T][ks], qf[ks], p[T], 0, 0, 0); }
}
__device__ __forceinline__ void pv_tile(f32x16 (&o)[2], const LAS unsigned char* vb, const s16x8 (&pf)[4], int lane) {
    const LAS unsigned char* base = vb + (4 * (lane >> 5) + ((lane & 15) >> 2)) * VP + (16 * ((lane >> 4) & 1) + 4 * (lane & 3)) * 2;
    v2u lo[2][4], hi[2][4];
#pragma unroll
    for (int dt = 0; dt < 2; ++dt)
#pragma unroll
        for (int c = 0; c < 4; ++c) {
            lo[dt][c] = __builtin_bit_cast(v2u, __builtin_amdgcn_ds_read_tr16_b64_v4i16((LAS s16x4*)(base + c * 16 * VP + dt * 64)));
            hi[dt][c] = __builtin_bit_cast(v2u, __builtin_amdgcn_ds_read_tr16_b64_v4i16((LAS s16x4*)(base + c * 16 * VP + 8 * VP + dt * 64))); }
#pragma unroll
    for (int dt = 0; dt < 2; ++dt)
#pragma unroll
        for (int c = 0; c < 4; ++c) { const s16x8 vf = __builtin_bit_cast(s16x8, (v4u){lo[dt][c].x, lo[dt][c].y, hi[dt][c].x, hi[dt][c].y});
            o[dt] = __builtin_amdgcn_mfma_f32_32x32x16_bf16(vf, pf[c], o[dt], 0, 0, 0); }
}
__device__ __forceinline__ float half_max(float v) { const unsigned u = __builtin_bit_cast(unsigned, v); auto rr = __builtin_amdgcn_permlane32_swap(u, u, false, false);
    return fmaxf(__builtin_bit_cast(float, rr[0]), __builtin_bit_cast(float, rr[1])); }
__device__ __forceinline__ void softmax_step(f32x16 (&p)[2], f32x16 (&o)[2], float& m, float& l, s16x8 (&pf)[4], bool keep) {
    float s = 0.f;
#pragma unroll
    for (int T = 0; T < 2; ++T)
#pragma unroll
        for (int j = 0; j < 16; ++j) { p[T][j] = __builtin_amdgcn_exp2f(p[T][j]); s += p[T][j]; }
    if (__builtin_amdgcn_ballot_w64(s > 65536.f) != 0ull) {
        float tm = fmaxf(p[0][0], p[1][0]);
#pragma unroll
        for (int j = 1; j < 16; ++j) tm = fmaxf(tm, fmaxf(p[0][j], p[1][j]));
        tm = half_max(tm);
        const float sh = tm > 256.f ? __builtin_ceilf(__builtin_amdgcn_logf(tm)) : 0.f; const float a = __builtin_amdgcn_exp2f(-sh);
        m += sh; l *= a; s *= a;
#pragma unroll
        for (int dt = 0; dt < 2; ++dt)
#pragma unroll
            for (int j = 0; j < 16; ++j) o[dt][j] *= a;
#pragma unroll
        for (int T = 0; T < 2; ++T)
#pragma unroll
            for (int j = 0; j < 16; ++j) p[T][j] *= a; }
    l += s;
#pragma unroll
    for (int c = 0; c < 4; ++c) { const int T = c >> 1, b8 = (c & 1) * 8;
        pf[c] = pack8(p[T][b8 + 0], p[T][b8 + 1], p[T][b8 + 2], p[T][b8 + 3], p[T][b8 + 4], p[T][b8 + 5], p[T][b8 + 6], p[T][b8 + 7]); }
}
#define EOFF(T, j) (32 * (T) + 8 * ((j) >> 2) + ((j) & 3))
__device__ __forceinline__ void mask_le(f32x16 (&p)[2], int lim) {
#pragma unroll
    for (int T = 0; T < 2; ++T)
#pragma unroll
        for (int j = 0; j < 16; ++j) p[T][j] = (EOFF(T, j) <= lim) ? p[T][j] : NEGINF;
}
__device__ __forceinline__ void mask_ge(f32x16 (&p)[2], int lim) {
#pragma unroll
    for (int T = 0; T < 2; ++T)
#pragma unroll
        for (int j = 0; j < 16; ++j) p[T][j] = (EOFF(T, j) >= lim) ? p[T][j] : NEGINF;
}
__device__ __forceinline__ void mask_all(f32x16 (&p)[2], bool keep) {
#pragma unroll
    for (int T = 0; T < 2; ++T)
#pragma unroll
        for (int j = 0; j < 16; ++j) p[T][j] = keep ? p[T][j] : NEGINF;
}
__device__ __forceinline__ void store_o(const f32x16 (&o)[2], float sc, bf16* orow, int lane, float* stat = nullptr) {
    float ss = 0.f;
#pragma unroll
    for (int dt = 0; dt < 2; ++dt)
#pragma unroll
        for (int g = 0; g < 4; ++g) { const float a0 = o[dt][4 * g] * sc, a1 = o[dt][4 * g + 1] * sc, a2 = o[dt][4 * g + 2] * sc, a3 = o[dt][4 * g + 3] * sc; ss += (a0 * a0 + a1 * a1) + (a2 * a2 + a3 * a3);
            v2u w; w.x = pg8::cvt_pk_bf16(a0, a1); w.y = pg8::cvt_pk_bf16(a2, a3);
            *(v2u*)(orow + 32 * dt + 8 * g + 4 * (lane >> 5)) = w; }
    if (stat) { ss += __shfl_xor(ss, 32); if (lane < 32) *stat = ss; }
}
__device__ __forceinline__ int wq_next(Frame& F, gu32* ctr) {
    __syncthreads(); if (F.tid == 0) F.MISC[0] = __hip_atomic_fetch_add(ctr, 1u, RLX_AGENT); __syncthreads(); return (int)F.MISC[0]; }
__device__ __forceinline__ void wq_prefetch(Frame& F) { if (F.tid == 0) F.tk = __hip_atomic_fetch_add(F.qctr, 1u, RLX_AGENT); }

__device__ __forceinline__ void sb_unit(Frame& F, const Args& A, int u) {
    const int qt = 15 - (u & 15), bh = u >> 4, h = bh % 6, b = bh / 6, lane = F.lane, w = F.wave, hi = lane >> 5;
    const int t0 = 256 * qt + 32 * w, tq = t0 + (lane & 31); const size_t tok = (size_t)b * S + tq;
    s16x8 qf[4]; load_qfrags(qf, F_proj + tok * PW + C_QC + h * 64, QSCALE_LOG2, lane);
    f32x16 o[2];
#pragma unroll
    for (int dt = 0; dt < 2; ++dt)
#pragma unroll
        for (int j = 0; j < 16; ++j) o[dt][j] = 0.f;
    float carry = 0.f; bool wdone = false;
    const bf16* Kb = F_proj + (size_t)b * S * PW + C_KC + h * 64; const bf16* Vb = F_proj + (size_t)b * S * PW + C_VC + h * 64;
    volatile LAS unsigned* flag = F.MISC + 16;
    TileRegs R;
    int kt = 4 * qt + 3;
    __syncthreads();
    tile_load(R, Kb + (size_t)kt * 64 * PW, Vb + (size_t)kt * 64 * PW, PW, F.tid); tile_store(R, F.lds, F.tid);
    __syncthreads();
    for (int i = 0;; ++i, --kt) {
        const bool more = kt > 0;
        if (more) tile_load(R, Kb + (size_t)(kt - 1) * 64 * PW, Vb + (size_t)(kt - 1) * 64 * PW, PW, F.tid);
        const LAS unsigned char* buf = F.lds + (i & 1) * TB_BYTES;
        if (!wdone && 64 * kt <= t0 + 30) {
            f32x16 z[2]; qk_tile(z, buf, qf, lane);
            const int lim = tq - 64 * kt - 4 * hi - 1;
            f32x16 lk[2];
#pragma unroll
            for (int T = 0; T < 2; ++T)
#pragma unroll
                for (int j = 0; j < 16; ++j) { const float zz = z[T][j]; const float L = fmaxf(zz, 0.f) + __builtin_amdgcn_logf(1.f + __builtin_amdgcn_exp2f(-fabsf(zz)));
                    const bool valid = EOFF(T, j) <= lim; lk[T][j] = valid ? -L : 0.f; z[T][j] = valid ? zz - L : NEGINF; }
            float gs[2][4]; f32x16 inl[2];
#pragma unroll
            for (int T = 0; T < 2; ++T)
#pragma unroll
                for (int g = 0; g < 4; ++g) { const float s3 = lk[T][4 * g + 3], s2 = s3 + lk[T][4 * g + 2], s1 = s2 + lk[T][4 * g + 1]; gs[T][g] = s1 + lk[T][4 * g];
                    inl[T][4 * g + 3] = 0.f; inl[T][4 * g + 2] = s3; inl[T][4 * g + 1] = s2; inl[T][4 * g] = s1; }
            float run = carry;
#pragma unroll
            for (int T = 1; T >= 0; --T)
#pragma unroll
                for (int g = 3; g >= 0; --g) { const float gp = __shfl_xor(gs[T][g], 32); const float base = run + (hi == 0 ? gp : 0.f);
#pragma unroll
                    for (int r = 0; r < 4; ++r) z[T][4 * g + r] = __builtin_amdgcn_exp2f(z[T][4 * g + r] + base + inl[T][4 * g + r]);
                    run += gs[T][g] + gp; }
            carry = run;
            s16x8 pf[4];
#pragma unroll
            for (int c = 0; c < 4; ++c) { const int T = c >> 1, b8 = (c & 1) * 8;
                pf[c] = pack8(z[T][b8 + 0], z[T][b8 + 1], z[T][b8 + 2], z[T][b8 + 3], z[T][b8 + 4], z[T][b8 + 5], z[T][b8 + 6], z[T][b8 + 7]); }
            pv_tile(o, buf + KT_BYTES, pf, lane);
            wdone = __builtin_amdgcn_ballot_w64(carry >= -58.f) == 0ull;
        }
        if (lane == 0) flag[(i & 1) * 8 + w] = (wdone || !more) ? 1u : 0u;
        if (more) tile_store(R, F.lds + ((i + 1) & 1) * TB_BYTES, F.tid);
        __syncthreads();
        if (!more) break;
        unsigned alld = 1u;
#pragma unroll
        for (int k = 0; k < 8; ++k) alld &= flag[(i & 1) * 8 + k];
        if (alld) break;
    }
    wq_prefetch(F);
    store_o(o, 1.f, F_o + tok * D + 640 + h * 64, lane, F_oss + tok * 16 + 10 + h);
}
template <class Pol> __device__ __forceinline__ void flash_pass(Frame& F, const Pol& P, int ntile, const bf16* Kb, const bf16* Vb, const s16x8 (&qf)[4], f32x16 (&o)[2], float& m, float& l) {
    TileRegs R0, R1, R2; const int lane = F.lane; m = 0.f;
    int tid = F.tid; asm volatile("" : "+v"(tid));
    __syncthreads();
    tile_load(R0, Kb + (size_t)P.row0(0) * PW, Vb + (size_t)P.row0(0) * PW, PW, tid);
    if (ntile > 1) tile_load(R1, Kb + (size_t)P.row0(1) * PW, Vb + (size_t)P.row0(1) * PW, PW, tid);
    if (ntile > 2) tile_load(R2, Kb + (size_t)P.row0(2) * PW, Vb + (size_t)P.row0(2) * PW, PW, tid);
    tile_store(R0, F.lds, tid);
    if (ntile > 3) tile_load(R0, Kb + (size_t)P.row0(3) * PW, Vb + (size_t)P.row0(3) * PW, PW, tid);
    if (ntile > 1) { tile_store(R1, F.lds + TB_BYTES, tid); if (ntile > 4) tile_load(R1, Kb + (size_t)P.row0(4) * PW, Vb + (size_t)P.row0(4) * PW, PW, tid); }
    if (ntile > 2) { tile_store(R2, F.lds + 2 * TB_BYTES, tid); if (ntile > 5) tile_load(R2, Kb + (size_t)P.row0(5) * PW, Vb + (size_t)P.row0(5) * PW, PW, tid); }
    __syncthreads();
    int sb = 0;
#define FSTEP(I, J, RS) { const int i_ = (I); if (i_ < ntile) { \
        if (i_ + 3 < ntile) { tile_store(RS, F.lds + ((sb ^ 3) + (J)) * TB_BYTES, tid); if (i_ + 6 < ntile) tile_load(RS, Kb + (size_t)P.row0(i_ + 6) * PW, Vb + (size_t)P.row0(i_ + 6) * PW, PW, tid); } \
        const LAS unsigned char* buf = F.lds + (sb + (J)) * TB_BYTES; \
        if (P.active(i_)) { const bool keep = P.keep(i_); f32x16 p[2]; qk_tile(p, buf, qf, lane, keep ? -m : NEGINF); P.maskp(i_, p); s16x8 pf[4]; softmax_step(p, o, m, l, pf, keep); pv_tile(o, buf + KT_BYTES, pf, lane); } } }
    for (int i = 0; i < ntile; i += 3) { FSTEP(i, 0, R0); FSTEP(i + 1, 1, R1); FSTEP(i + 2, 2, R2); __syncthreads(); sb ^= 3; }
#undef FSTEP
}
struct PolMoba { unsigned selm; int own, w, qrel  ;
    __device__ __forceinline__ int row0(int i) const { return 64 * i; }
    __device__ __forceinline__ bool active(int i) const { const int blk = i >> 2; return blk < own ? (__builtin_amdgcn_ballot_w64((selm >> blk) & 1u) != 0ull) : ((64 * (i & 3)) <= 32 * w + 31); }
    __device__ __forceinline__ bool keep(int i) const { const int blk = i >> 2; return blk < own ? ((selm >> blk) & 1u) != 0u : true; }
    __device__ __forceinline__ void maskp(int i, f32x16 (&p)[2]) const { if ((i >> 2) >= own) mask_le(p, qrel - 64 * (i & 3)); } };
struct PolSlc { unsigned sl, sh; int ownw, lim_own  ;
    __device__ __forceinline__ int row0(int i) const { return 64 * i; }
    __device__ __forceinline__ bool bit(int i) const { return ((i < 32 ? sl >> i : sh >> (i - 32)) & 1u) != 0u; }
    __device__ __forceinline__ bool active(int i) const { return i <= ownw && __builtin_amdgcn_ballot_w64(bit(i)) != 0ull; }
    __device__ __forceinline__ bool keep(int i) const { return i == ownw ? true : bit(i); }
    __device__ __forceinline__ void maskp(int i, f32x16 (&p)[2]) const { if (i == ownw) mask_le(p, lim_own); } };
struct PolWin { int klo, t0, trel  ;
    __device__ __forceinline__ int row0(int i) const { return 64 * (klo + i); }
    __device__ __forceinline__ bool active(int i) const { const int k0 = 64 * (klo + i); return k0 + 63 >= t0 - 511 && k0 <= t0 + 31; }
    __device__ __forceinline__ bool keep(int) const { return true; }
    __device__ __forceinline__ void maskp(int i, f32x16 (&p)[2]) const { const int k0 = 64 * (klo + i);
        if (k0 + 63 > t0) mask_le(p, trel - k0);
        if (k0 < t0 + 31 - 511) mask_ge(p, trel - 511 - k0); } };
__device__ __forceinline__ void nsa_sw_unit(Frame& F, const Args& A, int u) {
    const int qt = 15 - (u / 48), bh = u % 48, h = bh % 6, b = bh / 6, lane = F.lane, w = F.wave, hi = lane >> 5;
    const int t0 = 256 * qt + 32 * w, tq = t0 + (lane & 31); const size_t tok = (size_t)b * S + tq;
    const bf16* prow = F_proj + tok * PW;
    s16x8 qf[4]; load_qfrags(qf, prow + C_QB + h * 64, QSCALE_LOG2, lane);
    const bf16* Pb = F_proj + (size_t)b * S * PW;
    f32x16 os[2], ow[2];
#pragma unroll
    for (int dt = 0; dt < 2; ++dt)
#pragma unroll
        for (int j = 0; j < 16; ++j) { os[dt][j] = 0.f; ow[dt][j] = 0.f; }
    float ms = NEGINF, ls = 0.f, mw = NEGINF, lw = 0.f;
    { const v2u sm = *(const v2u*)(F_selm + tok * 2); PolSlc P{sm.x, sm.y, t0 >> 6, tq - 64 * (t0 >> 6) - 4 * hi};
      flash_pass(F, P, 4 * qt + 4, Pb + C_KVB + 128, Pb + C_KVB + 192, qf, os, ms, ls); }
    { int klo = (256 * qt - 511) >> 6; if (klo < 0) klo = 0; PolWin P{klo, t0, tq - 4 * hi};
      flash_pass(F, P, 4 * qt + 4 - klo, Pb + C_KVB + 256, Pb + C_KVB + 320, qf, ow, mw, lw); }
    wq_prefetch(F);
    const float lst = ls + __shfl_xor(ls, 32), lwt = lw + __shfl_xor(lw, 32);
    const float gs = sigmoidf_(bf1(prow[C_GB + h * 3 + 1])) * (lst > 0.f ? 1.f / lst : 0.f), gw = sigmoidf_(bf1(prow[C_GB + h * 3 + 2])) * (lwt > 0.f ? 1.f / lwt : 0.f);
    bf16* orow = F_o + tok * D + 256 + h * 64; float ssq = 0.f;
#pragma unroll
    for (int dt = 0; dt < 2; ++dt)
#pragma unroll
        for (int g = 0; g < 4; ++g) { bf16* op = orow + 32 * dt + 8 * g + 4 * hi; const v2u c = *(const v2u*)(F_ocp + tok * 384 + h * 64 + 32 * dt + 8 * g + 4 * hi);
            const float r0 = bflo(c.x) + gs * os[dt][4 * g] + gw * ow[dt][4 * g], r1 = bfhi(c.x) + gs * os[dt][4 * g + 1] + gw * ow[dt][4 * g + 1];
            const float r2 = bflo(c.y) + gs * os[dt][4 * g + 2] + gw * ow[dt][4 * g + 2], r3 = bfhi(c.y) + gs * os[dt][4 * g + 3] + gw * ow[dt][4 * g + 3];
            ssq += (r0 * r0 + r1 * r1) + (r2 * r2 + r3 * r3); v2u wv; wv.x = pg8::cvt_pk_bf16(r0, r1); wv.y = pg8::cvt_pk_bf16(r2, r3); *(v2u*)op = wv; }
    ssq += __shfl_xor(ssq, 32); if (lane < 32) F_oss[tok * 16 + 4 + h] = ssq;
}
__device__ __forceinline__ void nsa_cmp_unit(Frame& F, const Args& A, int u) {
    const int qt = u & 15, b = u >> 4, lane = F.lane, w = F.wave, hi = lane >> 5;
    const int t0 = 256 * qt + 32 * w, tq = t0 + (lane & 31); const size_t tok = (size_t)b * S + tq;
    const bf16* prow = F_proj + tok * PW;
    __syncthreads();
    { const bf16* kc = F_kcb + (size_t)b * 256 * 64; const bf16* vc = F_vcb + (size_t)b * 256 * 64;
#pragma unroll
      for (int q = 0; q < 4; ++q) { const int idx = F.tid + 512 * q, r = idx >> 3, c = idx & 7;
          *(LAS v4u*)(F.lds + (r >> 6) * KT_BYTES + (r & 63) * KP + c * 16) = *(const v4u*)(kc + (size_t)r * 64 + c * 8);
          *(LAS v4u*)(F.lds + 4 * KT_BYTES + (r >> 6) * VT_BYTES + (r & 63) * VP + c * 16) = *(const v4u*)(vc + (size_t)r * 64 + c * 8); } }
    __syncthreads();
    const int nmax = tq >= 31 ? (tq - 31) >> 4 : -1;
    const int nmax_w = (t0 + 31) >= 31 ? (t0 + 31 - 31) >> 4 : -1;
    float IM[4][2][4];
#pragma unroll
    for (int a = 0; a < 4; ++a)
#pragma unroll
        for (int T = 0; T < 2; ++T)
#pragma unroll
            for (int g = 0; g < 4; ++g) IM[a][T][g] = 0.f;
    for (int h = 0; h < 6; ++h) {
        s16x8 qf[4]; load_qfrags(qf, prow + C_QB + h * 64, QSCALE_LOG2, lane);
        float l = 0.f;
#pragma unroll
        for (int kt = 0; kt < 4; ++kt) { if (64 * kt > nmax_w) continue;
            f32x16 p[2]; qk_tile(p, F.lds + kt * KT_BYTES, qf, lane); mask_le(p, nmax - 64 * kt - 4 * hi);
#pragma unroll
            for (int T = 0; T < 2; ++T)
#pragma unroll
                for (int j = 0; j < 16; ++j) l += __builtin_amdgcn_exp2f(p[T][j]); }
        l += __shfl_xor(l, 32);
        const float inv = l > 0.f ? __builtin_amdgcn_rcpf(l) : 0.f;
        f32x16 o[2];
#pragma unroll
        for (int dt = 0; dt < 2; ++dt)
#pragma unroll
            for (int j = 0; j < 16; ++j) o[dt][j] = 0.f;
        float carry = 0.f;
#pragma unroll
        for (int kt = 0; kt < 4; ++kt) { if (64 * kt > nmax_w) continue;
            f32x16 p[2]; qk_tile(p, F.lds + kt * KT_BYTES, qf, lane); mask_le(p, nmax - 64 * kt - 4 * hi);
#pragma unroll
            for (int T = 0; T < 2; ++T)
#pragma unroll
                for (int j = 0; j < 16; ++j) p[T][j] = __builtin_amdgcn_exp2f(p[T][j]) * inv;
            float x[2][4];
#pragma unroll
            for (int T = 0; T < 2; ++T)
#pragma unroll
                for (int g = 0; g < 4; ++g) x[T][g] = __shfl_xor(p[T][4 * g + 3], 32);
#pragma unroll
            for (int T = 0; T < 2; ++T)
#pragma unroll
                for (int g = 0; g < 4; ++g) { const float prev = g > 0 ? x[T][g - 1] : (T > 0 ? x[0][3] : carry);
                    IM[kt][T][g] += ((p[T][4 * g] + p[T][4 * g + 1]) + (p[T][4 * g + 2] + p[T][4 * g + 3])) + (hi ? x[T][g] : prev); }
            carry = x[1][3];
            s16x8 pf[4];
#pragma unroll
            for (int c = 0; c < 4; ++c) { const int T = c >> 1, b8 = (c & 1) * 8;
                pf[c] = pack8(p[T][b8 + 0], p[T][b8 + 1], p[T][b8 + 2], p[T][b8 + 3], p[T][b8 + 4], p[T][b8 + 5], p[T][b8 + 6], p[T][b8 + 7]); }
            pv_tile(o, F.lds + 4 * KT_BYTES + kt * VT_BYTES, pf, lane); }
        store_o(o, sigmoidf_(bf1(prow[C_GB + h * 3 + 0])), F_ocp + tok * 384 + h * 64, lane);
    }
    wq_prefetch(F);
    const int ownb = tq >> 6;
#pragma unroll
    for (int a = 0; a < 4; ++a)
#pragma unroll
        for (int T = 0; T < 2; ++T)
#pragma unroll
            for (int g = 0; g < 4; ++g) { const int mm = 16 * a + 8 * T + 2 * g + hi; float v = IM[a][T][g];
                if (mm == 0 || mm == ownb || mm == ownb - 1) v = 1e4f; if (64 * mm > tq) v = -1e30f; IM[a][T][g] = v; }
    unsigned sl = 0u, sh = 0u;
    for (int r = 0; r < 16; ++r) { float bv = -3.4e38f; int bm = 0;
#pragma unroll
        for (int a = 0; a < 4; ++a)
#pragma unroll
            for (int T = 0; T < 2; ++T)
#pragma unroll
                for (int g = 0; g < 4; ++g) { const int mm = 16 * a + 8 * T + 2 * g + hi; if (IM[a][T][g] > bv) { bv = IM[a][T][g]; bm = mm; } }
        const float ov = __shfl_xor(bv, 32); const int om = __shfl_xor(bm, 32);
        if (ov > bv || (ov == bv && om < bm)) { bv = ov; bm = om; }
        if (bv > -5e29f) { if (bm < 32) sl |= 1u << bm; else sh |= 1u << (bm - 32); }
#pragma unroll
        for (int a = 0; a < 4; ++a)
#pragma unroll
            for (int T = 0; T < 2; ++T)
#pragma unroll
                for (int g = 0; g < 4; ++g) { const int mm = 16 * a + 8 * T + 2 * g + hi; IM[a][T][g] = (mm == bm) ? -3.4e38f : IM[a][T][g]; }
    }
    if (hi == 0) { v2u sm; sm.x = sl; sm.y = sh; *(v2u*)(F_selm + tok * 2) = sm; }
}
__device__ __forceinline__ void moba_unit(Frame& F, const Args& A, int u, int layer) {
    const int own = 15 - (u >> 5), bh = u & 31, b = bh >> 2, h = bh & 3, lane = F.lane, w = F.wave, hi = lane >> 5;
    const int tq = own * 256 + 32 * w + (lane & 31); const size_t tok = (size_t)b * S + tq;
    const bf16* qrow = F_proj + tok * PW + C_QA + h * 64;
    unsigned selm = 0u;
    {   float q[64]; loadq(q, qrow);
        const float* km = F_kmean + (size_t)layer * NB * 4 * 16 * 64 + (size_t)(b * 4 + h) * 16 * 64;
        LAS float* kmL = (LAS float*)(F.lds + 5 * TB_BYTES);
        if (F.tid < 256) *(LAS f32x4*)(kmL + 4 * F.tid) = *(const f32x4*)(km + 4 * F.tid);
        __syncthreads();
        float v1 = -3e38f, v2 = -3e38f, v3 = -3e38f; int i1 = -1, i2 = -1, i3 = -1;
        for (int n = 0; n < own; ++n) { const float g = dot64l(q, kmL + n * 64);
            if (g > v1) { v3 = v2; i3 = i2; v2 = v1; i2 = i1; v1 = g; i1 = n; } else if (g > v2) { v3 = v2; i3 = i2; v2 = g; i2 = n; } else if (g > v3) { v3 = g; i3 = n; } }
        if (i1 >= 0) selm |= 1u << i1; if (i2 >= 0) selm |= 1u << i2; if (i3 >= 0) selm |= 1u << i3;
    }
    s16x8 qf[4]; load_qfrags(qf, qrow, QSCALE_LOG2, lane);
    f32x16 o[2];
#pragma unroll
    for (int dt = 0; dt < 2; ++dt)
#pragma unroll
        for (int j = 0; j < 16; ++j) o[dt][j] = 0.f;
    float m = NEGINF, l = 0.f;
    const bf16* Kb = F_proj + (size_t)b * S * PW + C_KA + h * 64; const bf16* Vb = F_proj + (size_t)b * S * PW + C_VA + h * 64;
    { PolMoba P{selm, own, w, 32 * w + (lane & 31) - 4 * hi}; flash_pass(F, P, 4 * own + 4, Kb, Vb, qf, o, m, l); }
    wq_prefetch(F);
    const float lt = l + __shfl_xor(l, 32);
    store_o(o, lt > 0.f ? 1.f / lt : 0.f, F_o + tok * D + h * 64, lane, F_oss + tok * 16 + h);
}
#ifndef PROBE_PHASE
#define PROBE_PHASE -1
#endif
#define QREPS(g) ((PROBE_PHASE == (g)) ? 2 : 1)
#define WQ_LOOP(CTR, NUNITS, CALL) do { { int z_ = 0; asm volatile("" : "+v"(z_)); F.qctr = (CTR) + z_; } F.tk = 0u; \
    int u = __builtin_amdgcn_readfirstlane(wq_next(F, F.qctr)); \
    while (u < (NUNITS)) { CALL; __syncthreads(); if (F.tid == 0) F.MISC[0] = F.tk; __syncthreads(); u = __builtin_amdgcn_readfirstlane((int)F.MISC[0]); } } while (0)
__device__ __forceinline__ void phase_attn_a(Frame& F0, const Args& A, int l, int rep) {
    Frame F = F0; asm volatile("" : "+v"(F.tid)); F.lane = F.tid & 63;
    attn_convert(F, A, 2 * l);
    WQ_LOOP(F.ctl + CW_WQ + 64 * (l * 4 + 2) + 8 * rep, NB * 16, nsa_cmp_unit(F, A, u));
    WQ_LOOP(F.ctl + CW_WQ + 64 * (l * 4 + 0) + 8 * rep, NB * 4 * 16, moba_unit(F, A, u, l));
    WQ_LOOP(F.ctl + CW_WQ + 64 * (l * 4 + 1) + 8 * rep, NB * 6 * 16, sb_unit(F, A, u));
    __syncthreads();
}
__device__ __forceinline__ void phase_attn_b(Frame& F0, const Args& A, int l, int rep) {
    Frame F = F0; asm volatile("" : "+v"(F.tid)); F.lane = F.tid & 63;
    attn_convert(F, A, 2 * l + 1);
    WQ_LOOP(F.ctl + CW_WQ + 64 * (l * 4 + 3) + 8 * rep, NB * 6 * 16, nsa_sw_unit(F, A, u));
    __syncthreads();
}
struct GnIn { v4u w0, w1; };
__device__ __forceinline__ void gn_load(GnIn& I, const Args& A, int tok, int lane) { const bf16* orow = F_o + (size_t)tok * D; I.w0 = __builtin_nontemporal_load((const v4u*)(orow + lane * 8)); I.w1 = __builtin_nontemporal_load((const v4u*)(orow + 512 + lane * 8)); }
__device__ __forceinline__ void gn_compute(const GnIn& I, const Args& A, int tok, int lane, const float* gg) {
    const v4u w0 = I.w0, w1 = I.w1;
    float v0[8] = {bflo(w0.x), bfhi(w0.x), bflo(w0.y), bfhi(w0.y), bflo(w0.z), bfhi(w0.z), bflo(w0.w), bfhi(w0.w)};
    float v1[8] = {bflo(w1.x), bfhi(w1.x), bflo(w1.y), bfhi(w1.y), bflo(w1.z), bfhi(w1.z), bflo(w1.w), bfhi(w1.w)};
    float s0 = 0.f, s1 = 0.f;
#pragma unroll
    for (int j = 0; j < 8; ++j) { s0 += v0[j] * v0[j]; s1 += v1[j] * v1[j]; }
    const float ssA = wave_sum(lane < 32 ? s0 : 0.f), ssB = wave_sum((lane >= 32 ? s0 : 0.f) + (lane < 16 ? s1 : 0.f)), ssC = wave_sum(lane >= 16 ? s1 : 0.f);
    const float rA = __builtin_amdgcn_rsqf(ssA * (1.f / 256.f) + RMS_EPS), rB = __builtin_amdgcn_rsqf(ssB * (1.f / 384.f) + RMS_EPS), rC = __builtin_amdgcn_rsqf(ssC * (1.f / 384.f) + RMS_EPS);
    const float r0 = lane < 32 ? rA : rB, r1 = lane < 16 ? rB : rC;
    const f32x4 g00 = *(const f32x4*)(gg + lane * 8), g01 = *(const f32x4*)(gg + lane * 8 + 4), g10 = *(const f32x4*)(gg + 512 + lane * 8), g11 = *(const f32x4*)(gg + 512 + lane * 8 + 4);
    v4u o0, o1;
    o0.x = pk2(v0[0] * r0 * g00.x, v0[1] * r0 * g00.y); o0.y = pk2(v0[2] * r0 * g00.z, v0[3] * r0 * g00.w); o0.z = pk2(v0[4] * r0 * g01.x, v0[5] * r0 * g01.y); o0.w = pk2(v0[6] * r0 * g01.z, v0[7] * r0 * g01.w);
    o1.x = pk2(v1[0] * r1 * g10.x, v1[1] * r1 * g10.y); o1.y = pk2(v1[2] * r1 * g10.z, v1[3] * r1 * g10.w); o1.z = pk2(v1[4] * r1 * g11.x, v1[5] * r1 * g11.y); o1.w = pk2(v1[6] * r1 * g11.z, v1[7] * r1 * g11.w);
    bf16* arow = F_act + (size_t)tok * D; *(v4u*)(arow + lane * 8) = o0; *(v4u*)(arow + 512 + lane * 8) = o1;
}
__device__ __forceinline__ void phase_gnorm(Frame& F, const Args& A, int l) {
    const int gw = F.vcu * NWAVES + F.wave, NGW = F.G * NWAVES, lane = F.lane; const float* gg = F_mix_g + (size_t)l * D;
    GnIn Ia, Ib; int tok = gw;
    if (tok < NTOK) gn_load(Ia, A, tok, lane);
    for (; tok < NTOK; tok += 2 * NGW) {
        if (tok + NGW < NTOK) gn_load(Ib, A, tok + NGW, lane);
        gn_compute(Ia, A, tok, lane, gg);
        if (tok + 2 * NGW < NTOK) gn_load(Ia, A, tok + 2 * NGW, lane);
        if (tok + NGW < NTOK) gn_compute(Ib, A, tok + NGW, lane, gg);
    }
}
struct PmIn { f32x4 x[4]; v2u xb[4]; v2u y[4]; };
__device__ __forceinline__ void pm_load(PmIn& I, const Args& A, int tok, int lane, int l) {
    const f32x4* xr = (const f32x4*)(F_x + (size_t)tok * D) + lane; const bf16* xm = F_xmid + (size_t)tok * D; const bf16* yr = F_y + (size_t)tok * D;
#pragma unroll
    for (int j = 0; j < 4; ++j) { if (l == 0) I.x[j] = __builtin_nontemporal_load(xr + 64 * j); else I.xb[j] = __builtin_nontemporal_load((const v2u*)(xm + 4 * lane + 256 * j)); I.y[j] = __builtin_nontemporal_load((const v2u*)(yr + 4 * lane + 256 * j)); } }
__device__ __forceinline__ void pm_compute(const PmIn& I, const Args& A, int tok, int lane, int l, const LAS float* cA1, const LAS float* cA2, const LAS float* cS0, LAS float* rs2out) {
    f32x4 xv[4], yv[4]; float ss = 0.f;
#pragma unroll
    for (int j = 0; j < 4; ++j) { if (l == 0) xv[j] = I.x[j]; else { const v2u xw = I.xb[j]; xv[j] = (f32x4){bflo(xw.x), bfhi(xw.x), bflo(xw.y), bfhi(xw.y)}; } const v2u w = I.y[j]; yv[j] = (f32x4){bflo(w.x), bfhi(w.x), bflo(w.y), bfhi(w.y)};
        ss += (yv[j].x * yv[j].x + yv[j].y * yv[j].y) + (yv[j].z * yv[j].z + yv[j].w * yv[j].w); }
    const float rs = __builtin_amdgcn_rsqf(wave_sum(ss) * (1.f / D) + RMS_EPS);
    bf16* x1r = F_x1b + (size_t)tok * D;
#pragma unroll
    for (int j = 0; j < 4; ++j) { const int c = 4 * lane + 256 * j; const f32x4 a1 = *(const LAS f32x4*)(cA1 + c);
        xv[j] = xv[j] + a1 * (yv[j] * rs); v2u xw; xw.x = pk2(xv[j].x, xv[j].y); xw.y = pk2(xv[j].z, xv[j].w); *(v2u*)(x1r + c) = xw; }
    float s2 = 0.f;
#pragma unroll
    for (int j = 0; j < 4; ++j) s2 += (xv[j].x * xv[j].x + xv[j].y * xv[j].y) + (xv[j].z * xv[j].z + xv[j].w * xv[j].w);
    const float rs2 = __builtin_amdgcn_rsqf(wave_sum(s2) * (1.f / D) + RMS_EPS);
    if (lane == 0) *rs2out = rs2;
    unsigned char* arow8 = F_act8 + (size_t)tok * D;
#pragma unroll
    for (int j = 0; j < 4; ++j) { const int c = 4 * lane + 256 * j; const f32x4 a2 = *(const LAS f32x4*)(cA2 + c), s0 = *(const LAS f32x4*)(cS0 + c);
        const f32x4 r = xv[j] * rs2 * a2 + s0; *(unsigned*)(arow8 + c) = pg8::pk4_fp8(r.x, r.y, r.z, r.w); }
}
__device__ __forceinline__ void phase_postmix(Frame& F, const Args& A, int l, int bank) {
    const int lane = F.lane, wave = F.wave;
    LAS float* lgt = (LAS float*)(F.lds + wave * 4096);
    LAS float* rsv = lgt + 512;
    LAS int* tE = (LAS int*)(F.lds + 32768); LAS int* tR = tE + 512; LAS unsigned* lcnt = (LAS unsigned*)(tR + 512); LAS unsigned* lbase = lcnt + 32; LAS float* tG = (LAS float*)(lbase + 32);
    const float* g1n = F_norm_g + ((size_t)l * 4 + 1) * D; const float* g2n = F_norm_g + ((size_t)l * 4 + 2) * D;
    for (int chunk = blockIdx.x; chunk < NTOK / 128; chunk += F.G) {
        __syncthreads();
        if (F.tid < 32) lcnt[F.tid] = 0u;
        __syncthreads();
        const int tok0 = chunk * 128 + wave * 16, b = tok0 >> 12; const float* md = F_mod + ((size_t)l * NB + b) * 6 * D;
        PmIn Ia, Ib; pm_load(Ia, A, tok0, lane, l);
        LAS float* cA1 = (LAS float*)(F.lds + 65536); LAS float* cA2 = cA1 + D; LAS float* cS0 = cA2 + D;
        for (int i = F.tid; i < D; i += NWAVES * 64) { cA1[i] = md[2 * D + i] * g1n[i]; cA2[i] = g2n[i] * (md[4 * D + i] + 1.f); cS0[i] = md[3 * D + i]; }
        __syncthreads();
        for (int i = 0; i < 16; i += 2) {
            pm_load(Ib, A, tok0 + i + 1, lane, l);
            pm_compute(Ia, A, tok0 + i, lane, l, cA1, cA2, cS0, rsv + i);
            if (i + 2 < 16) pm_load(Ia, A, tok0 + i + 2, lane, l);
            pm_compute(Ib, A, tok0 + i + 1, lane, l, cA1, cA2, cS0, rsv + i + 1);
        }
        VM_WAIT();
        {
            const int m16 = lane & 15, kg = lane >> 4; constexpr int BPB = 272;
            const bf16* ap = F_x1b + (size_t)(tok0 + m16) * D + 8 * kg;
            const unsigned short* bsrc = F_rw3 + ((size_t)l * NB + b) * NE * 3 * D + (size_t)(F.tid >> 4) * 3 * D + (F.tid & 15) * 8;
            LAS unsigned char* bl = F.lds + 77824; LAS unsigned char* bw = bl + (F.tid >> 4) * BPB + (F.tid & 15) * 16;
            f32x4 c0 = (f32x4){0.f, 0.f, 0.f, 0.f}, c1 = c0;
            v4u g[3]; c16x8 ac[4], an[4];
#pragma unroll
            for (int p = 0; p < 3; ++p) g[p] = *(const v4u*)(bsrc + p * D);
#pragma unroll
            for (int q4 = 0; q4 < 4; ++q4) ac[q4] = *(const c16x8*)(ap + 32 * q4);
#pragma unroll
            for (int p = 0; p < 3; ++p) *(LAS v4u*)(bw + p * 32 * BPB) = g[p];
            __syncthreads();
#pragma unroll
            for (int kc = 0; kc < 8; ++kc) { const LAS unsigned char* br = bl + (kc & 1) * 3 * 32 * BPB + m16 * BPB + 16 * kg;
                if (kc + 1 < 8) {
#pragma unroll
                    for (int p = 0; p < 3; ++p) g[p] = *(const v4u*)(bsrc + p * D + 128 * (kc + 1));
#pragma unroll
                    for (int q4 = 0; q4 < 4; ++q4) an[q4] = *(const c16x8*)(ap + 128 * (kc + 1) + 32 * q4); }
#pragma unroll
                for (int q4 = 0; q4 < 4; ++q4)
#pragma unroll
                    for (int p = 0; p < 3; ++p) { const c16x8 b0 = *(const LAS c16x8*)(br + p * 32 * BPB + 64 * q4), b1 = *(const LAS c16x8*)(br + p * 32 * BPB + 16 * BPB + 64 * q4);
                        c0 = __builtin_amdgcn_mfma_f32_16x16x32_bf16(ac[q4], b0, c0, 0, 0, 0); c1 = __builtin_amdgcn_mfma_f32_16x16x32_bf16(ac[q4], b1, c1, 0, 0, 0); }
                if (kc + 1 < 8) { LAS unsigned char* bn = bw + ((kc + 1) & 1) * 3 * 32 * BPB;
#pragma unroll
                    for (int p = 0; p < 3; ++p) *(LAS v4u*)(bn + p * 32 * BPB) = g[p];
#pragma unroll
                    for (int q4 = 0; q4 < 4; ++q4) ac[q4] = an[q4]; }
                __syncthreads(); }
#pragma unroll
            for (int r = 0; r < 4; ++r) { lgt[(4 * kg + r) * 32 + m16] = c0[r]; lgt[(4 * kg + r) * 32 + 16 + m16] = c1[r]; } }
        LDS_WAIT(); asm volatile("" ::: "memory");
        if (lane < 16) { const int tl = wave * 16 + lane, tok = tok0 + lane; const float rs2 = rsv[lane]; const float* rc = F_rconst + ((size_t)l * NB + b) * NE;
            float v0 = -3e38f, v1 = -3e38f, v2 = -3e38f, v3 = -3e38f; int i0 = 0, i1 = 0, i2 = 0, i3 = 0;
#pragma unroll 8
            for (int e = 0; e < NE; ++e) { const float g = lgt[lane * 32 + e] * rs2 + rc[e];
                if (g > v3) { if (g > v1) { v3 = v2; i3 = i2; v2 = v1; i2 = i1; if (g > v0) { v1 = v0; i1 = i0; v0 = g; i0 = e; } else { v1 = g; i1 = e; } }
                              else { if (g > v2) { v3 = v2; i3 = i2; v2 = g; i2 = e; } else { v3 = g; i3 = e; } } } }
            const float e1 = __expf(v1 - v0), e2 = __expf(v2 - v0), e3 = __expf(v3 - v0); const float inv = 1.f / (1.f + e1 + e2 + e3);
            const int ei[4] = {i0, i1, i2, i3}; const float gt[4] = {inv, e1 * inv, e2 * inv, e3 * inv};
#pragma unroll
            for (int s = 0; s < 4; ++s) { const unsigned rk = __hip_atomic_fetch_add(&lcnt[ei[s]], 1u, __ATOMIC_RELAXED, __HIP_MEMORY_SCOPE_WORKGROUP); tE[tl * 4 + s] = ei[s]; tR[tl * 4 + s] = (int)rk; tG[tl * 4 + s] = gt[s]; } }
        LDS_WAIT(); asm volatile("" ::: "memory");
        __syncthreads();
        if (F.tid < 32) lbase[F.tid] = atomicAdd((unsigned*)(F.ctl + CW_CNT + 64 * bank + F.tid), lcnt[F.tid]);
        __syncthreads();
        { const int tok = chunk * 128 + (F.tid >> 2), s = F.tid & 3, e = tE[F.tid]; const int pos = (int)lbase[e] + tR[F.tid]; F_list[(size_t)e * NTOK + pos] = tok * 4 + s; F_lgate[(size_t)e * NTOK + pos] = tG[F.tid]; }
    }
    __syncthreads();
}
__device__ __forceinline__ int moe_tables(Frame& F, const Args& A, int l) {
    LAS int* rowbase = (LAS int*)(F.lds + TAB_OFF); LAS unsigned char* texp = (LAS unsigned char*)(F.lds + TAB_OFF + 256); LAS int* ecnt = (LAS int*)(F.lds + TAB_OFF + 896);
    __syncthreads();
    if (F.tid < 64) { const int ln = F.tid;
        const int c = ln < NE ? (int)__hip_atomic_load(F.ctl + CW_CNT + 64 * l + ln, RLX_AGENT) : 0; const int nt = (c + 255) >> 8;
        int incl = nt;
#pragma unroll
        for (int o = 1; o < 64; o <<= 1) { const int t = __shfl_up(incl, o); if (ln >= o) incl += t; }
        const int excl = incl - nt;
        if (ln < NE) { rowbase[ln] = excl << 8; ecnt[ln] = c; for (int k = 0; k < nt; ++k) texp[excl + k] = (unsigned char)ln; }
        if (ln == NE - 1) rowbase[NE] = incl << 8; }
    __syncthreads();
    return rowbase[NE] >> 8;
}
struct CbIn { unsigned yb[4][4]; v2u x1[4]; };
__device__ __forceinline__ void cb_load(CbIn& I, const Args& A, int tok, int lane) { const unsigned char* yr = F_yt8 + (size_t)tok * 4 * D; const bf16* x1r = F_x1b + (size_t)tok * D;
#pragma unroll
    for (int s = 0; s < 4; ++s)
#pragma unroll
        for (int j = 0; j < 4; ++j) I.yb[s][j] = __builtin_nontemporal_load((const unsigned*)(yr + (size_t)s * D + 4 * lane + 256 * j));
#pragma unroll
    for (int j = 0; j < 4; ++j) I.x1[j] = __builtin_nontemporal_load((const v2u*)(x1r + 4 * lane + 256 * j)); }
__device__ __forceinline__ void cb_compute(const CbIn& I, const Args& A, int tok, int lane, int l, const LAS float* cA3, const LAS float* cA4, const LAS float* cS4) {
    f32x4 xv[4], yv[4];
#pragma unroll
    for (int j = 0; j < 4; ++j) { const v2u xw = I.x1[j]; xv[j] = (f32x4){bflo(xw.x), bfhi(xw.x), bflo(xw.y), bfhi(xw.y)}; yv[j] = (f32x4){0.f, 0.f, 0.f, 0.f};
#pragma unroll
        for (int s = 0; s < 4; ++s) { typedef float f32x2_ __attribute__((ext_vector_type(2))); const f32x2_ lo = __builtin_amdgcn_cvt_pk_f32_fp8((int)I.yb[s][j], false), hi2 = __builtin_amdgcn_cvt_pk_f32_fp8((int)I.yb[s][j], true); yv[j] = yv[j] + (f32x4){lo.x, lo.y, hi2.x, hi2.y}; } }
    float ss = 0.f;
#pragma unroll
    for (int j = 0; j < 4; ++j) ss += (yv[j].x * yv[j].x + yv[j].y * yv[j].y) + (yv[j].z * yv[j].z + yv[j].w * yv[j].w);
    const float rs = __builtin_amdgcn_rsqf(wave_sum(ss) * (1.f / D) + RMS_EPS * (pg8::YT8_SCALE * pg8::YT8_SCALE));
    f32x4* outr = (f32x4*)(F_out + (size_t)tok * D) + lane; bf16* xmr = F_xmid + (size_t)tok * D;
#pragma unroll
    for (int j = 0; j < 4; ++j) { const int c = 4 * lane + 256 * j; const f32x4 a3 = *(const LAS f32x4*)(cA3 + c);
        xv[j] = xv[j] + a3 * (yv[j] * rs);
        if (l + 1 < NL) { v2u xw; xw.x = pk2(xv[j].x, xv[j].y); xw.y = pk2(xv[j].z, xv[j].w); *(v2u*)(xmr + c) = xw; } else outr[64 * j] = xv[j]; }
    if (l + 1 < NL) mod_norm_row_l(xv, cA4, cS4, F_act + (size_t)tok * D, lane);
}
__device__ __forceinline__ void phase_combine(Frame& F, const Args& A, int l) {
    const int lane = F.lane; const float* g3n = F_norm_g + ((size_t)l * 4 + 3) * D;
    LAS float* cA3 = (LAS float*)(F.lds + 65536); LAS float* cA4 = cA3 + D; LAS float* cS4 = cA4 + D;
    for (int chunk = blockIdx.x; chunk < NTOK / 128; chunk += F.G) {
        const int tok0 = chunk * 128 + F.wave * 16, b = tok0 >> 12; const float* md = F_mod + ((size_t)l * NB + b) * 6 * D;
        CbIn Ia, Ib; cb_load(Ia, A, tok0, lane);
        __syncthreads();
        for (int i = F.tid; i < D; i += NWAVES * 64) { cA3[i] = md[5 * D + i] * g3n[i];
            if (l + 1 < NL) { const float* md2 = F_mod + ((size_t)(l + 1) * NB + b) * 6 * D; cA4[i] = F_norm_g[(size_t)(l + 1) * 4 * D + i] * (md2[D + i] + 1.f); cS4[i] = md2[i]; } }
        __syncthreads();
        for (int i = 0; i < 16; i += 2) {
            cb_load(Ib, A, tok0 + i + 1, lane);
            cb_compute(Ia, A, tok0 + i, lane, l, cA3, cA4, cS4);
            if (i + 2 < 16) cb_load(Ia, A, tok0 + i + 2, lane);
            cb_compute(Ib, A, tok0 + i + 1, lane, l, cA3, cA4, cS4);
        }
    }
}
#ifndef MK_SINGLE
#define MK_SINGLE 1
#endif
#ifndef DUPMASK
#define DUPMASK 0
#endif
#define REPS(g) ((PROBE_PHASE == (g)) ? 2 : 1)
#define IN(k) (lo <= (k) && (k) < hi)
#define SEAM(k) do { if (IN((k) + 1)) xcd_barrier(bar); } while (0)
template <int l> __device__ __forceinline__ void layer_phases(Frame& F, const Args& A, const int lo, const int hi, const XcdBarrier& bar) {
        enum { P_HM = 0, P_PROJ, P_CMPR, P_ATTA, P_ATTB, P_OUT, P_POST, P_GU, P_DN, P_COMB, NPL };
        const int pb = 1 + NPL * l;
        if (IN(pb + P_HM) && l == 0) { _Pragma("nounroll") for (int rep = 0; rep < REPS(1); ++rep) phase_hm0(F, A); SEAM(pb + P_HM); }
        if (IN(pb + P_PROJ)) {
            pg8::Gemm g{F_act, F_WinT + (size_t)l * PW * D, NTOK, PW, D}; pg8::StaticOrder So; So.init(NTOK, PW, F.G, (int)blockIdx.x);
            pg8::EpiProj E{F_proj, PW, F_ropec, F_ropes, F_kmean + (size_t)l * NB * 4 * 16 * 64};
            pg8::gemm_phase<pg8::EpiProj, pg8::StaticOrder, true, true>(F.lds, g, So, E);
            if (l == 0) { const int rem = ((NTOK / 256) * (PW / 256)) % F.G, c = (int)blockIdx.x;
                if (rem == 0) router_tables(F, A, c, F.G); else if (c >= rem) router_tables(F, A, c - rem, F.G - rem); }
            SEAM(pb + P_PROJ); }
        if (IN(pb + P_CMPR)) { _Pragma("nounroll") for (int rep = 0; rep < REPS(3); ++rep) phase_compress(F, A, l); SEAM(pb + P_CMPR); }
        if (IN(pb + P_ATTA)) { _Pragma("nounroll") for (int rep = 0; rep < REPS(4); ++rep) phase_attn_a(F, A, l, rep); SEAM(pb + P_ATTA); }
        if (IN(pb + P_ATTB)) { _Pragma("nounroll") for (int rep = 0; rep < REPS(5); ++rep) phase_attn_b(F, A, l, rep); SEAM(pb + P_ATTB); }
        if (IN(pb + P_OUT)) {
            pg8::Gemm g{F_o, F_WoutT + (size_t)l * D * D, NTOK, D, D}; pg8::StaticOrder So; So.init(NTOK, D, F.G, (int)blockIdx.x);
            LAS float* rt = (LAS float*)(F.lds + TAB_OFF + 2048);
            { const int ui = F.tid >> 8, r = F.tid & 255; pg8::Unit uu; if (So.next(ui, uu)) { const f32x4* sp = (const f32x4*)(F_oss + ((size_t)uu.pm * 256 + r) * 16);
                  const f32x4 a = sp[0], b1 = sp[1], c1 = sp[2], d1 = sp[3];
                  const float ssA = (a.x + a.y) + (a.z + a.w), ssB = ((b1.x + b1.y) + (b1.z + b1.w)) + (c1.x + c1.y), ssC = (c1.z + c1.w) + ((d1.x + d1.y) + (d1.z + d1.w));
                  const float rA = __builtin_amdgcn_rsqf(ssA * (1.f / 256.f) + RMS_EPS), rB = __builtin_amdgcn_rsqf(ssB * (1.f / 384.f) + RMS_EPS), rC = __builtin_amdgcn_rsqf(ssC * (1.f / 384.f) + RMS_EPS);
                  *(LAS f32x4*)(rt + (ui * 256 + r) * 4) = (f32x4){rA * __builtin_amdgcn_rcpf(rB), rB * __builtin_amdgcn_rcpf(rC), rC, 0.f}; } }
            __syncthreads();
            pg8::EpiBf16 E{F_y, D, nullptr, 0, 0};
            pg8::gemm_phase_gn<pg8::EpiBf16, pg8::StaticOrder, true, true>(F.lds, g, So, E, (const LAS float*)rt);
            SEAM(pb + P_OUT); }
        if (IN(pb + P_POST)) { _Pragma("nounroll") for (int rep = 0; rep < REPS(8); ++rep) phase_postmix(F, A, l, l + 2 * rep); SEAM(pb + P_POST); }
        if (IN(pb + P_GU)) {
            const int nt = moe_tables(F, A, l);
            pg8::Gemm g{(const pg8::bf16_t*)F_act8, (const pg8::bf16_t*)(F_Wgu8 + (size_t)l * NE * 2048 * D), MAXROWS, NE * 2048, D};
            pg8::MoeOrder So{8, nt, F.G, F.vcu, (const LAS unsigned char*)(F.lds + TAB_OFF + 256), (const LAS int*)(F.lds + TAB_OFF), (const LAS int*)(F.lds + TAB_OFF + 896), F_list, NTOK};
            pg8::EpiSwiglu8 E{F_sact8, F_b_gu + (size_t)l * NE * 2048, (LAS float*)(F.lds + TAB_OFF + 2048)};
            _Pragma("nounroll") for (int rep = 0; rep < REPS(9); ++rep) pg8::gemm_phase_g8<pg8::EpiSwiglu8, pg8::MoeOrder, true, true>(F.lds, g, So, E);
            SEAM(pb + P_GU); }
        if (IN(pb + P_DN)) {
            const int nt = moe_tables(F, A, l);
            pg8::Gemm g{(const pg8::bf16_t*)F_sact8, (const pg8::bf16_t*)(F_Wdn8 + (size_t)l * NE * D * D), MAXROWS, NE * D, D};
            pg8::MoeOrder So{4, nt, F.G, F.vcu, (const LAS unsigned char*)(F.lds + TAB_OFF + 256), (const LAS int*)(F.lds + TAB_OFF), (const LAS int*)(F.lds + TAB_OFF + 896), F_list, NTOK};
            pg8::EpiDn E{F_yt8, F_b_dn + (size_t)l * NE * D, (const LAS int*)(F.lds + TAB_OFF), (const LAS int*)(F.lds + TAB_OFF + 896), F_list, NTOK, F_lgate, (LAS float*)(F.lds + TAB_OFF + 2048)};
            _Pragma("nounroll") for (int rep = 0; rep < REPS(10); ++rep) pg8::gemm_phase8<pg8::EpiDn, pg8::MoeOrder, true, true>(F.lds, g, So, E);
            SEAM(pb + P_DN); }
        if (IN(pb + P_COMB)) { _Pragma("nounroll") for (int rep = 0; rep < REPS(11); ++rep) phase_combine(F, A, l); SEAM(pb + P_COMB); }
    }
#undef IN
#undef SEAM
__global__ void __launch_bounds__(NWAVES * 64, 2) mk_fwd(Args A) {
    extern __shared__ __attribute__((aligned(16))) unsigned char lds[];
    Frame F;
    F.lds = (LAS unsigned char*)lds; F.MISC = (volatile LAS unsigned*)(F.lds + MISC_OFF);
    F.tid = threadIdx.x; F.lane = F.tid & 63; F.wave = __builtin_amdgcn_readfirstlane(F.tid >> 6);
    F.G = gridDim.x; { const int bx = blockIdx.x; F.vcu = (F.G % 8 == 0) ? (bx % 8) * (F.G / 8) + bx / 8 : bx; }
    F.ctl = (gu32*)(A.ws + WS_CTL);
    for (int u = F.tid; u < (LDS_BYTES - LDSCTL_OFF) / 4; u += NWAVES * 64) ((LAS unsigned*)(F.lds + LDSCTL_OFF))[u] = 0u;
    __syncthreads();
    const int lo = A.ph_lo, hi = A.ph_hi;
    XcdBarrier bar; bar.bar = (unsigned*)(F.ctl + CW_BAR) + A.li * XCD_BAR_WORDS; bar.x = 0; bar.st = nullptr;
    if (hi - lo > 1) bar = xcd_barrier_post((unsigned*)(F.ctl + CW_BAR) + A.li * XCD_BAR_WORDS, F.MISC + 8);
#define IN(k) (lo <= (k) && (k) < hi)
#define SEAM(k) do { if (IN((k) + 1)) xcd_barrier(bar); } while (0)
    if (IN(0)) { _Pragma("nounroll") for (int rep = 0; rep < REPS(0); ++rep) p0_prologue(F, A); SEAM(0); }
    layer_phases<0>(F, A, lo, hi, bar);
    layer_phases<1>(F, A, lo, hi, bar);
#undef IN
#undef SEAM
}

extern "C" void kernel_launch(void* const* d_in, const int* in_sizes, int n_in, void* d_out, int out_size, void* d_ws, size_t ws_size, hipStream_t stream) {
    static int grid = 0;
    if (grid == 0) {
        if (n_in != 17 || in_sizes[0] != NTOK * D || out_size != NTOK * D || ws_size < WS_END) { fprintf(stderr, "kernel_launch: unexpected shapes (n_in %d, in0 %d, out %d, ws %zu); nothing launched\n", n_in, n_in > 0 ? in_sizes[0] : -1, out_size, ws_size); grid = -1; return; }
        int dev = 0, cus = 0, per_cu = 0;
        if (hipGetDevice(&dev) != hipSuccess || hipDeviceGetAttribute(&cus, hipDeviceAttributeMultiprocessorCount, dev) != hipSuccess) { grid = -1; return; }
        if (hipFuncSetAttribute((const void*)mk_fwd, hipFuncAttributeMaxDynamicSharedMemorySize, LDS_BYTES) != hipSuccess) { fprintf(stderr, "kernel_launch: hipFuncSetAttribute failed\n"); grid = -1; return; }
        if (hipOccupancyMaxActiveBlocksPerMultiprocessor(&per_cu, (const void*)mk_fwd, NWAVES * 64, LDS_BYTES) != hipSuccess || per_cu < 1) { fprintf(stderr, "kernel_launch: occupancy query says %d blocks per CU\n", per_cu); }
        (void)hipGetLastError();
        grid = cus;
    }
    if (grid < 0) return;
    if (hipMemsetAsync((char*)d_ws + WS_CTL, 0, CTL_ZERO_BYTES, stream) != hipSuccess) return;
    Args a{};
    for (int i = 0; i < 17; ++i) a.in[i] = (const float*)d_in[i];
        a.out = (float*)d_out; a.ws = (unsigned char*)d_ws; a.pad = 0;
#if MK_SINGLE
    a.ph_lo = 0; a.ph_hi = NPHASE; a.li = 0;
    hipLaunchKernelGGL(mk_fwd, dim3(grid), dim3(NWAVES * 64), LDS_BYTES, stream, a);
#else
    int li = 0;
    for (int p = 0; p < NPHASE; ++p) { if (p == 11) continue;
        a.ph_lo = p; a.ph_hi = p + 1; a.li = li++;
        hipLaunchKernelGGL(mk_fwd, dim3(grid), dim3(NWAVES * 64), LDS_BYTES, stream, a); }
#endif
    const hipError_t le = hipPeekAtLastError();
    if (le != hipSuccess) fprintf(stderr, "kernel_launch: launch failed: %s\n", hipGetErrorName(le));
}
```
